# Optimizing an MI355X kernel written in HIP

```python
import math
import jax, jax.numpy as jnp
from jax import lax
import numpy as np

D_MODEL = 2048
BATCH = 4
SEQ = 4096
DEPTH = 1

NSA_HEADS = 16
NSA_KV_HEADS = 4
NSA_GROUP = NSA_HEADS // NSA_KV_HEADS
HEAD_DIM = 64
NSA_WIDTH = NSA_HEADS * HEAD_DIM
KV_WIDTH = NSA_KV_HEADS * HEAD_DIM
CMP_LEN = 32
CMP_STRIDE = 16
CMP_HIDDEN = 256
SEL_BLOCK = 64
SEL_TOP = 16
SEL_Q_BLOCK = 64
WINDOW = 512
WIN_Q_BLOCK = 128
S5_WIDTH = 1024
S5_GROUP = 16
S5_GROUPS = S5_WIDTH // S5_GROUP
S5_STATE = 64
DT_MIN = 1e-3
DT_MAX = 1e-1
REL_BUCKETS = 32
REL_MAX_DIST = 128
PEER_KEYS = 128
PEER_EXPERTS = PEER_KEYS * PEER_KEYS
PEER_HEADS = 8
PEER_TOPK = 16
PEER_QDIM = 256
PEER_CHUNK = 128
N_BRANCHES = 2
IN_WIDTH = NSA_WIDTH + 6 * KV_WIDTH + 3 * NSA_HEADS + S5_WIDTH + N_BRANCHES * D_MODEL
EPS = 1e-6
NEG_INF = -1e30
FORCE_BONUS = 1e4

kernel_name = "hybrid_nsa_s5_peer_block"


def _split_points():
    widths = [NSA_WIDTH] + [KV_WIDTH] * 6 + [3 * NSA_HEADS, S5_WIDTH, N_BRANCHES * D_MODEL]
    pts, acc = [], 0
    for w in widths[:-1]:
        acc += w
        pts.append(acc)
    return pts


def rms_norm(x, g):
    xf = x.astype(jnp.float32)
    xf = xf * lax.rsqrt(jnp.mean(xf * xf, axis=-1, keepdims=True) + EPS)
    return xf.astype(x.dtype) * g


def t5_bucket(dist):
    dist = jnp.maximum(dist, 0)
    max_exact = REL_BUCKETS // 2
    log_ratio = jnp.log(jnp.maximum(dist, 1).astype(jnp.float32) / max_exact) / math.log(REL_MAX_DIST / max_exact)
    large = jnp.minimum(max_exact + (log_ratio * (REL_BUCKETS - max_exact)).astype(jnp.int32), REL_BUCKETS - 1)
    return jnp.where(dist < max_exact, dist, large)


def compress_kv(k, pos, w1, b1, w2, b2):
    b, l = k.shape[:2]
    kb = k.reshape(b, l // CMP_STRIDE, CMP_STRIDE, NSA_KV_HEADS, HEAD_DIM)
    blocks = jnp.concatenate([kb[:, :-1], kb[:, 1:]], axis=2)
    blocks = blocks + pos[None, None, :, None, :]
    flat = blocks.transpose(0, 1, 3, 2, 4).reshape(b, -1, NSA_KV_HEADS, CMP_LEN * HEAD_DIM)
    return jax.nn.gelu(flat @ w1 + b1) @ w2 + b2


def cmp_to_sel_matrix(n_cmp, n_sel):
    cs = np.arange(n_cmp)[:, None] * CMP_STRIDE
    ss = np.arange(n_sel)[None, :] * SEL_BLOCK
    ov = np.clip(np.minimum(cs + CMP_LEN, ss + SEL_BLOCK) - np.maximum(cs, ss), 0, None)
    return jnp.asarray(ov / CMP_LEN, dtype=jnp.float32)


def nsa(q, kc, vc, ks, vs, kw, vw, gate_logits, rel_bias):
    b, l = q.shape[:2]
    scale = HEAD_DIM ** -0.5
    qg = q.reshape(b, l, NSA_KV_HEADS, NSA_GROUP, HEAD_DIM)
    t = jnp.arange(l)

    n_cmp = kc.shape[1]
    cmp_end = jnp.arange(n_cmp) * CMP_STRIDE + CMP_LEN - 1
    dist_c = t[:, None] - cmp_end[None, :]
    valid_c = dist_c >= 0
    bias_c = rel_bias[t5_bucket(dist_c)].transpose(2, 0, 1).reshape(NSA_KV_HEADS, NSA_GROUP, l, n_cmp)
    s_c = jnp.einsum('blkgd,bnkd->bkgln', qg, kc).astype(jnp.float32) * scale + bias_c
    p_c = jax.nn.softmax(jnp.where(valid_c, s_c, NEG_INF), axis=-1) * valid_c
    o_c = jnp.einsum('bkgln,bnkd->blkgd', p_c.astype(vc.dtype), vc)

    n_sel = l // SEL_BLOCK
    n_top = min(SEL_TOP, n_sel)
    imp = jnp.einsum('bkgln,nj->bklj', p_c, cmp_to_sel_matrix(n_cmp, n_sel))
    blk = jnp.arange(n_sel)[None, :]
    cur = (t // SEL_BLOCK)[:, None]
    forced = (blk == 0) | (blk == cur) | (blk == cur - 1)
    imp = jnp.where(blk <= cur, imp + FORCE_BONUS * forced, NEG_INF)
    _, sel_idx = lax.top_k(imp, n_top)

    ks_blocks = ks.reshape(b, n_sel, SEL_BLOCK, NSA_KV_HEADS, HEAD_DIM).transpose(0, 3, 1, 2, 4)
    vs_blocks = vs.reshape(b, n_sel, SEL_BLOCK, NSA_KV_HEADS, HEAD_DIM).transpose(0, 3, 1, 2, 4)
    gather = jax.vmap(jax.vmap(lambda blocks, idx: blocks[idx]))
    tbl = rel_bias.reshape(REL_BUCKETS, NSA_KV_HEADS, NSA_GROUP).transpose(1, 0, 2)
    lookup = jax.vmap(lambda tb, bk: tb[bk], in_axes=(0, 1), out_axes=1)

    def sel_block(args):
        q_b, idx_b, t_b = args
        k_g = gather(ks_blocks, idx_b).reshape(b, NSA_KV_HEADS, SEL_Q_BLOCK, -1, HEAD_DIM)
        v_g = gather(vs_blocks, idx_b).reshape(b, NSA_KV_HEADS, SEL_Q_BLOCK, -1, HEAD_DIM)
        pos = (idx_b[..., None] * SEL_BLOCK + jnp.arange(SEL_BLOCK)).reshape(b, NSA_KV_HEADS, SEL_Q_BLOCK, -1)
        dist = t_b[:, None] - pos
        bias = lookup(tbl, t5_bucket(dist)).transpose(0, 1, 4, 2, 3)
        s = jnp.einsum('btkgd,bktsd->bkgts', q_b, k_g).astype(jnp.float32) * scale + bias
        s = jnp.where((dist >= 0)[:, :, None], s, NEG_INF)
        p = jax.nn.softmax(s, axis=-1).astype(v_g.dtype)
        return jnp.einsum('bkgts,bktsd->btkgd', p, v_g)

    n_qb = l // SEL_Q_BLOCK
    q_blocks = qg.reshape(b, n_qb, SEL_Q_BLOCK, NSA_KV_HEADS, NSA_GROUP, HEAD_DIM).swapaxes(0, 1)
    idx_blocks = sel_idx.reshape(b, NSA_KV_HEADS, n_qb, SEL_Q_BLOCK, n_top).transpose(2, 0, 1, 3, 4)
    t_blocks = t.reshape(n_qb, SEL_Q_BLOCK)
    o_s = lax.map(sel_block, (q_blocks, idx_blocks, t_blocks))
    o_s = o_s.swapaxes(0, 1).reshape(b, l, NSA_KV_HEADS, NSA_GROUP, HEAD_DIM)

    n_wb = l // WIN_Q_BLOCK
    nw = WINDOW // WIN_Q_BLOCK

    def band(k):
        kb = k.reshape(b, n_wb, WIN_Q_BLOCK, NSA_KV_HEADS, HEAD_DIM)
        kp = jnp.pad(kb, ((0, 0), (nw, 0), (0, 0), (0, 0), (0, 0)))
        return jnp.concatenate([kp[:, i:i + n_wb] for i in range(nw + 1)], axis=2)

    k_band, v_band = band(kw), band(vw)
    qi = jnp.arange(WIN_Q_BLOCK)
    kj = jnp.arange((nw + 1) * WIN_Q_BLOCK)
    dist_w = qi[:, None] + nw * WIN_Q_BLOCK - kj[None, :]
    in_win = (dist_w >= 0) & (dist_w < WINDOW)
    kpos = jnp.arange(n_wb)[:, None] * WIN_Q_BLOCK + kj[None, :] - nw * WIN_Q_BLOCK
    mask_w = in_win[None] & (kpos >= 0)[:, None, :]
    bias_w = rel_bias[t5_bucket(dist_w)].transpose(2, 0, 1).reshape(NSA_KV_HEADS, NSA_GROUP, WIN_Q_BLOCK, -1)
    qw = qg.reshape(b, n_wb, WIN_Q_BLOCK, NSA_KV_HEADS, NSA_GROUP, HEAD_DIM)
    s_w = jnp.einsum('bnqkgd,bnskd->bnkgqs', qw, k_band).astype(jnp.float32) * scale + bias_w
    s_w = jnp.where(mask_w[None, :, None, None], s_w, NEG_INF)
    p_w = jax.nn.softmax(s_w, axis=-1).astype(v_band.dtype)
    o_w = jnp.einsum('bnkgqs,bnskd->bnqkgd', p_w, v_band).reshape(b, l, NSA_KV_HEADS, NSA_GROUP, HEAD_DIM)

    g = jax.nn.sigmoid(gate_logits).reshape(b, l, NSA_KV_HEADS, NSA_GROUP, 3, 1)
    o = g[..., 0, :] * o_c + g[..., 1, :] * o_s + g[..., 2, :] * o_w
    return o.reshape(b, l, NSA_WIDTH)


def s5(u, lam_re, lam_im, log_step, b_re, b_im, c_re, c_im, d_skip):
    b, l, _ = u.shape
    f32 = jnp.float32
    ug = u.astype(f32).reshape(b, l, S5_GROUPS, S5_GROUP).transpose(1, 0, 2, 3)
    lam_re, lam_im = lam_re.astype(f32), lam_im.astype(f32)
    step = jnp.exp(log_step.astype(f32))[:, None]
    mag = jnp.exp(lam_re * step)
    lb_re, lb_im = mag * jnp.cos(lam_im * step), mag * jnp.sin(lam_im * step)
    den = lam_re * lam_re + lam_im * lam_im
    n_re = lb_re - 1.0
    f_re = (n_re * lam_re + lb_im * lam_im) / den
    f_im = (lb_im * lam_re - n_re * lam_im) / den
    b_re, b_im = b_re.astype(f32), b_im.astype(f32)
    bb_re = f_re[..., None] * b_re - f_im[..., None] * b_im
    bb_im = f_re[..., None] * b_im + f_im[..., None] * b_re
    bu_re = jnp.einsum('lbgh,gph->lbgp', ug, bb_re)
    bu_im = jnp.einsum('lbgh,gph->lbgp', ug, bb_im)
    a_re = jnp.broadcast_to(lb_re, bu_re.shape)
    a_im = jnp.broadcast_to(lb_im, bu_re.shape)

    def combine(e1, e2):
        a1r, a1i, b1r, b1i = e1
        a2r, a2i, b2r, b2i = e2
        return (a2r * a1r - a2i * a1i, a2r * a1i + a2i * a1r,
                a2r * b1r - a2i * b1i + b2r, a2r * b1i + a2i * b1r + b2i)

    _, _, x_re, x_im = lax.associative_scan(combine, (a_re, a_im, bu_re, bu_im), axis=0)
    y = jnp.einsum('lbgp,ghp->lbgh', x_re, c_re.astype(f32)) - jnp.einsum('lbgp,ghp->lbgh', x_im, c_im.astype(f32))
    y = y + d_skip.astype(f32).reshape(S5_GROUPS, S5_GROUP) * ug
    return y.transpose(1, 0, 2, 3).reshape(b, l, S5_WIDTH).astype(u.dtype)


def peer(h, w_q, sub_keys, u_tab, v_tab):
    b, l, d = h.shape
    n_tok = b * l
    hf = h.reshape(n_tok, d)
    q = (hf @ w_q).reshape(n_tok, PEER_HEADS, 2, PEER_QDIM // 2)
    s = jnp.einsum('thcd,hcnd->thcn', q, sub_keys).astype(jnp.float32)
    v1, i1 = lax.top_k(s[:, :, 0], PEER_TOPK)
    v2, i2 = lax.top_k(s[:, :, 1], PEER_TOPK)
    cand_s = (v1[..., :, None] + v2[..., None, :]).reshape(n_tok, PEER_HEADS, -1)
    cand_i = (i1[..., :, None] * PEER_KEYS + i2[..., None, :]).reshape(n_tok, PEER_HEADS, -1)
    top_s, top_p = lax.top_k(cand_s, PEER_TOPK)
    expert = jnp.take_along_axis(cand_i, top_p, axis=-1)
    gate = jax.nn.softmax(top_s, axis=-1)
    n_ch = n_tok // PEER_CHUNK

    def chunk(args):
        x_c, e_c, g_c = args
        a = jnp.einsum('td,thkd->thk', x_c, u_tab[e_c]).astype(jnp.float32)
        w = (g_c * jax.nn.gelu(a)).astype(x_c.dtype)
        return jnp.einsum('thk,thkd->td', w, v_tab[e_c])

    out = lax.map(chunk, (hf.reshape(n_ch, PEER_CHUNK, d),
                          expert.reshape(n_ch, PEER_CHUNK, PEER_HEADS, PEER_TOPK),
                          gate.reshape(n_ch, PEER_CHUNK, PEER_HEADS, PEER_TOPK)))
    return out.reshape(b, l, d)


def setup_inputs(seed: int = 0) -> dict:
    key = jax.random.key(seed)
    ks = jax.random.split(key, 40)
    f32 = jnp.float32

    def nrm(k, shape, s):
        return jax.random.normal(k, shape, f32) * s

    L = DEPTH
    lam_im = jnp.broadcast_to(math.pi * jnp.arange(S5_STATE, dtype=f32), (L, S5_GROUPS, S5_STATE))
    return {
        "x": nrm(ks[0], (BATCH, SEQ, D_MODEL), 1.0),
        "c": nrm(ks[1], (BATCH, D_MODEL), 1.0),
        "ada_w": nrm(ks[2], (L, D_MODEL, 6 * D_MODEL), 0.5 * D_MODEL ** -0.5),
        "ada_b": nrm(ks[3], (L, 6 * D_MODEL), 0.02),
        "norm_mix_g": 1.0 + nrm(ks[4], (L, D_MODEL), 0.02),
        "norm_ffn_g": 1.0 + nrm(ks[5], (L, D_MODEL), 0.02),
        "w_in": nrm(ks[6], (L, D_MODEL, IN_WIDTH), D_MODEL ** -0.5),
        "cmp_pos": nrm(ks[7], (L, 2, CMP_LEN, HEAD_DIM), 0.1),
        "cmp_w1": nrm(ks[8], (L, 2, CMP_LEN * HEAD_DIM, CMP_HIDDEN), (CMP_LEN * HEAD_DIM) ** -0.5),
        "cmp_b1": nrm(ks[9], (L, 2, CMP_HIDDEN), 0.02),
        "cmp_w2": nrm(ks[10], (L, 2, CMP_HIDDEN, HEAD_DIM), CMP_HIDDEN ** -0.5),
        "cmp_b2": nrm(ks[11], (L, 2, HEAD_DIM), 0.02),
        "rel_bias": nrm(ks[12], (REL_BUCKETS, NSA_HEADS), 0.3),
        "s5_lam_re": -0.5 + nrm(ks[13], (L, S5_GROUPS, S5_STATE), 0.01),
        "s5_lam_im": lam_im + nrm(ks[14], (L, S5_GROUPS, S5_STATE), 0.01),
        "s5_log_step": jax.random.uniform(ks[15], (L, S5_GROUPS), f32, math.log(DT_MIN), math.log(DT_MAX)),
        "s5_b_re": nrm(ks[16], (L, S5_GROUPS, S5_STATE, S5_GROUP), (2 * S5_GROUP) ** -0.5),
        "s5_b_im": nrm(ks[17], (L, S5_GROUPS, S5_STATE, S5_GROUP), (2 * S5_GROUP) ** -0.5),
        "s5_c_re": nrm(ks[18], (L, S5_GROUPS, S5_GROUP, S5_STATE), 0.5),
        "s5_c_im": nrm(ks[19], (L, S5_GROUPS, S5_GROUP, S5_STATE), 0.5),
        "s5_d": nrm(ks[20], (L, S5_WIDTH), 1.0),
        "glu_w": nrm(ks[21], (L, S5_WIDTH, S5_WIDTH), S5_WIDTH ** -0.5),
        "glu_b": nrm(ks[22], (L, S5_WIDTH), 0.02),
        "w_up_attn": nrm(ks[23], (L, NSA_WIDTH, D_MODEL), NSA_WIDTH ** -0.5),
        "w_up_ssm": nrm(ks[24], (L, S5_WIDTH, D_MODEL), S5_WIDTH ** -0.5),
        "w_out": nrm(ks[25], (L, D_MODEL, D_MODEL), D_MODEL ** -0.5),
        "peer_w_q": nrm(ks[26], (L, D_MODEL, PEER_HEADS * PEER_QDIM), D_MODEL ** -0.5),
        "peer_sub_keys": nrm(ks[27], (L, PEER_HEADS, 2, PEER_KEYS, PEER_QDIM // 2), (PEER_QDIM // 2) ** -0.5),
        "peer_u": nrm(ks[28], (L, PEER_EXPERTS, D_MODEL), D_MODEL ** -0.5),
        "peer_v": nrm(ks[29], (L, PEER_EXPERTS, D_MODEL), 0.5),
        "final_g": 1.0 + nrm(ks[30], (D_MODEL,), 0.02),
    }


def reference(x, c, ada_w, ada_b, norm_mix_g, norm_ffn_g, w_in, cmp_pos, cmp_w1, cmp_b1, cmp_w2, cmp_b2,
              rel_bias, s5_lam_re, s5_lam_im, s5_log_step, s5_b_re, s5_b_im, s5_c_re, s5_c_im, s5_d,
              glu_w, glu_b, w_up_attn, w_up_ssm, w_out, peer_w_q, peer_sub_keys, peer_u, peer_v, final_g):
    b, l, _ = x.shape
    points = _split_points()
    for i in range(DEPTH):
        mod = jax.nn.silu(c) @ ada_w[i] + ada_b[i]
        sh1, sc1, g1, sh2, sc2, g2 = jnp.split(mod[:, None, :], 6, axis=-1)

        h = rms_norm(x, norm_mix_g[i]) * (1.0 + sc1) + sh1
        proj = h @ w_in[i]
        q, kc, vc, ks_, vs_, kw, vw, nsa_gates, u, merge_g = jnp.split(proj, points, axis=-1)
        kv = lambda t_: t_.reshape(b, l, NSA_KV_HEADS, HEAD_DIM)
        kc_c = compress_kv(kv(kc), cmp_pos[i, 0], cmp_w1[i, 0], cmp_b1[i, 0], cmp_w2[i, 0], cmp_b2[i, 0])
        vc_c = compress_kv(kv(vc), cmp_pos[i, 1], cmp_w1[i, 1], cmp_b1[i, 1], cmp_w2[i, 1], cmp_b2[i, 1])
        o_attn = nsa(q.reshape(b, l, NSA_HEADS, HEAD_DIM), kc_c, vc_c, kv(ks_), kv(vs_), kv(kw), kv(vw),
                     nsa_gates, rel_bias)

        y = s5(u, s5_lam_re[i], s5_lam_im[i], s5_log_step[i], s5_b_re[i], s5_b_im[i],
               s5_c_re[i], s5_c_im[i], s5_d[i])
        y = jax.nn.gelu(y)
        y = y * jax.nn.sigmoid(y @ glu_w[i] + glu_b[i])

        ga, gb = jnp.split(jax.nn.sigmoid(merge_g), N_BRANCHES, axis=-1)
        mixed = ga * (o_attn @ w_up_attn[i]) + gb * (y @ w_up_ssm[i])
        x = x + g1 * (mixed @ w_out[i])

        h2 = rms_norm(x, norm_ffn_g[i]) * (1.0 + sc2) + sh2
        x = x + g2 * peer(h2, peer_w_q[i], peer_sub_keys[i], peer_u[i], peer_v[i])
    return rms_norm(x, final_g)
```

```cpp
#include <hip/hip_runtime.h>
#include <stdint.h>
#include <stdio.h>
#include <math.h>
#include <type_traits>


#ifndef MK_PER_PHASE
#define MK_PER_PHASE 0
#endif

#define XB_TMO      128
#define XB_XCNT(j)  (256  + 64 * (j))
#define XB_XSUB(j)  (1280 + 64 * (j))
#define XB_XGEN(j)  (2304 + 64 * (j))
#define XB_TOP      3328
#define XB_TOPGEN   3392
#define XCD_BAR_WORDS 3456
#define XB_SPIN_CAP (1u << 18)
#define LAS __attribute__((address_space(3)))

__device__ __forceinline__ unsigned xb_ld(unsigned* p)              { return __hip_atomic_load(p, __ATOMIC_RELAXED, __HIP_MEMORY_SCOPE_AGENT); }
__device__ __forceinline__ unsigned xb_add(unsigned* p, unsigned v) { return __hip_atomic_fetch_add(p, v, __ATOMIC_RELAXED, __HIP_MEMORY_SCOPE_AGENT); }
__device__ __forceinline__ unsigned xb_xcc_id() { return (unsigned)__builtin_amdgcn_s_getreg((3 << 11) | 20) & 0xFu; }
#define XB_SPIN(cond, bar) do { unsigned _sp = 0; while (cond) { __builtin_amdgcn_s_sleep(1); \
    if ((++_sp & 255u) == 0u) { if (xb_ld(&(bar)[XB_TMO])) break; if (_sp > XB_SPIN_CAP) { atomicAdd(&(bar)[XB_TMO], 1u); break; } } } } while (0)

struct XcdBarrier {
    unsigned* bar; unsigned x;
    volatile LAS unsigned* st;
};

__device__ __forceinline__ XcdBarrier xcd_barrier_post(unsigned* bar, volatile LAS unsigned* st) {
    XcdBarrier b; b.bar = bar; b.x = xb_xcc_id(); b.st = st;
    if (threadIdx.x == 0) (void)xb_add(&bar[XB_XCNT(b.x)], 1u);
    return b;
}
__device__ __forceinline__ void xcd_barrier_complete(unsigned* bar, unsigned x, unsigned& nloc, unsigned& nx) {
    const unsigned G = gridDim.x * gridDim.y * gridDim.z;
    unsigned sum, cnt, mine, sp = 0u;
    for (;;) {
        sum = 0u; cnt = 0u; mine = 0u;
#pragma unroll
        for (unsigned j = 0; j < 16; ++j) { const unsigned c = xb_ld(&bar[XB_XCNT(j)]); sum += c; cnt += (c > 0u) ? 1u : 0u; mine = (j == x) ? c : mine; }
        if (sum == G) break;
        __builtin_amdgcn_s_sleep(1);
        if ((++sp & 255u) == 0u) { if (xb_ld(&bar[XB_TMO])) break; if (sp > XB_SPIN_CAP) { atomicAdd(&bar[XB_TMO], 1u); break; } }
    }
    nloc = mine > 0u ? mine : 1u; nx = cnt > 0u ? cnt : 1u;
}

__device__ __forceinline__ void xcd_barrier(const XcdBarrier& b) {
    asm volatile("s_waitcnt vmcnt(0)" ::: "memory");
    __syncthreads();
    if (threadIdx.x == 0) {
        unsigned* bar = b.bar;
        __builtin_amdgcn_s_waitcnt(0);
        unsigned nloc = b.st[0], nx = b.st[1];
        if (nloc == 0u) { xcd_barrier_complete(bar, b.x, nloc, nx); b.st[0] = nloc; b.st[1] = nx; }
        const unsigned old = xb_add(&bar[XB_XSUB(b.x)], 1u);
        const unsigned gen = old / nloc;
        if (old + 1u == (gen + 1u) * nloc) {
            __builtin_amdgcn_fence(__ATOMIC_RELEASE, "agent");
            asm volatile("s_waitcnt vmcnt(0)" ::: "memory");
            const unsigned og = xb_add(&bar[XB_TOP], 1u);
            const unsigned tg = og / nx;
            if (og + 1u == (tg + 1u) * nx) xb_add(&bar[XB_TOPGEN], 1u);
            else XB_SPIN(xb_ld(&bar[XB_TOPGEN]) == tg, bar);
            __builtin_amdgcn_fence(__ATOMIC_ACQUIRE, "agent");
            xb_add(&bar[XB_XGEN(b.x)], 1u);
            asm volatile("s_waitcnt vmcnt(0)" ::: "memory");
        } else {
            XB_SPIN(xb_ld(&bar[XB_XGEN(b.x)]) == gen, bar);
            __builtin_amdgcn_fence(__ATOMIC_ACQUIRE, "agent");
            asm volatile("s_waitcnt vmcnt(0)" ::: "memory");
        }
    }
    __syncthreads();
}


namespace pg8 {
#define PG8_LAS __attribute__((address_space(3)))
typedef unsigned short bf16_t;
typedef short bf16x8 __attribute__((ext_vector_type(8)));
typedef float f32x4 __attribute__((ext_vector_type(4)));
typedef unsigned u32x4 __attribute__((ext_vector_type(4)));
constexpr int BM = 256, BK = 64, HALF = 128, HTB = HALF * BK * 2  , STAGE_BYTES = 8 * HTB, NXCD = 8, WGM = 8;

__host__ __device__ __forceinline__ int lds_byte(int r, int c) { const int st = (r >> 4) * 2 + (c >> 5), rr = r & 15, cc = c & 31, ob = rr * 64 + cc * 2; return st * 1024 + (ob ^ (((ob >> 9) & 1) << 5)); }
__host__ __device__ __forceinline__ void stage_rc(int b, int& R, int& C) { const int st = b / 1024, sb = b % 1024, swz = sb ^ (((sb >> 9) & 1) << 5); R = (st >> 1) * 16 + swz / 64; C = (st & 1) * 32 + (swz % 64) / 2; }
__host__ __device__ __forceinline__ int perm32(int rho) { const int n = rho >> 4, i = rho & 15; return 8 * (i >> 2) + 4 * n + (i & 3); }

struct Unit { int pm, pn; };
struct Gemm { const bf16_t* A; const bf16_t* Bt; int lda, ldb, K; };
struct StaticOrder {
    int nM, nN, nwg, G, c;
    __host__ __device__ void init(int M, int N, int G_, int c_) { nM = M / BM; nN = N / BM; nwg = nM * nN; G = G_; c = c_; }
    __host__ __device__ bool next(int i, Unit& u) const {
        const long L = (long)i * G + c; if (L >= nwg) return false;
        int wgid = (int)L; { const int q = nwg / NXCD, r = nwg % NXCD, xcd = wgid % NXCD, off = wgid / NXCD; wgid = (xcd < r ? xcd * (q + 1) : r * (q + 1) + (xcd - r) * q) + off; }
        const int nig = WGM * nN, gid = wgid / nig, fm = gid * WGM, gsz = (nM - fm) < WGM ? (nM - fm) : WGM;
        u.pm = fm + ((wgid % nig) % gsz); u.pn = (wgid % nig) / gsz; return true;
    }
    __device__ __forceinline__ void a_ready(const Unit&) const {}
    __device__ __forceinline__ void done(const Unit&) const {}
};
template <class Epi, class Sched, bool F8 = false>
__device__ __forceinline__ void gemm_phase(PG8_LAS unsigned char* lds, const Gemm g, const Sched& S, const Epi& E) {
    const int tid = threadIdx.x, wid = __builtin_amdgcn_readfirstlane(tid >> 6), lane = tid & 63, wr = wid >> 2, wc = wid & 3, fr = lane & 15, fq = lane >> 4;
    constexpr int ES = F8 ? 1 : 2;
    const int K = g.K, nt = K * ES / 128;
    unsigned voffA[2], voffB[2];
#pragma unroll
    for (int i = 0; i < 2; ++i) { int R, C; stage_rc(tid * 16 + i * 8192, R, C); const int Rb = Epi::PERM ? ((R & ~31) + perm32(R & 31)) : R;
        voffA[i] = (unsigned)(R * g.lda * ES + C * 2); voffB[i] = (unsigned)(Rb * g.ldb * ES + C * 2); }
    const size_t kstep = (size_t)(BK * 2);
    const size_t hstepA = (size_t)HALF * g.lda * ES, hstepB = (size_t)HALF * g.ldb * ES;
    const size_t tstepA = 2 * hstepA, tstepB = 2 * hstepB;
    const unsigned ldsw = (unsigned)wid * 1024u;
    const int aoff = lds_byte(wr * 64 + fr, fq * 8), boff = lds_byte(wc * 32 + fr, fq * 8);
#define PG8_SA(b, h) (((b) * 2 + (h)) * HTB)
#define PG8_SB(b, h) ((4 + (b) * 2 + (h)) * HTB)
#define PG8_STAGE(bufoff, gbase, voff) do { _Pragma("unroll") for (int _i = 0; _i < 2; ++_i) \
        __builtin_amdgcn_global_load_lds((const unsigned*)((const char*)(gbase) + (voff)[_i]), (PG8_LAS unsigned*)(lds + (bufoff) + ldsw + _i * 8192), 16, 0, 0); } while (0)
#define PG8_LDA(dst, b, h) do { _Pragma("unroll") for (int m = 0; m < 4; ++m) _Pragma("unroll") for (int k = 0; k < 2; ++k) dst[m][k] = *(const PG8_LAS frag_t*)(lds + PG8_SA(b, h) + aoff + m * 2048 + k * 1024); } while (0)
#define PG8_LDB(dst, b, h) do { _Pragma("unroll") for (int n = 0; n < 2; ++n) _Pragma("unroll") for (int k = 0; k < 2; ++k) dst[n][k] = *(const PG8_LAS frag_t*)(lds + PG8_SB(b, h) + boff + n * 2048 + k * 1024); } while (0)
#define PG8_MMA(ai, bj, At, Bt) do { __builtin_amdgcn_s_setprio(1); _Pragma("unroll") for (int m = 0; m < 4; ++m) _Pragma("unroll") for (int n = 0; n < 2; ++n) _Pragma("unroll") for (int k = 0; k < 2; ++k) { \
        if constexpr (F8) { acc[ai][bj][m][n] = __builtin_amdgcn_mfma_f32_16x16x32_fp8_fp8(Bt[n][k][0], At[m][k][0], acc[ai][bj][m][n], 0, 0, 0); \
            acc[ai][bj][m][n] = __builtin_amdgcn_mfma_f32_16x16x32_fp8_fp8(Bt[n][k][1], At[m][k][1], acc[ai][bj][m][n], 0, 0, 0); } \
        else { if constexpr (!F8) acc[ai][bj][m][n] = __builtin_amdgcn_mfma_f32_16x16x32_bf16(Bt[n][k], At[m][k], acc[ai][bj][m][n], 0, 0, 0); } } __builtin_amdgcn_s_setprio(0); } while (0)
#define PG8_WAIT_V(n) asm volatile("s_waitcnt vmcnt(" #n ")" ::: "memory")
#define PG8_WAIT_L(n) asm volatile("s_waitcnt lgkmcnt(" #n ")" ::: "memory")
#define PG8_BAR __builtin_amdgcn_s_barrier()
#define PG8_SCHED __builtin_amdgcn_sched_barrier(0)
    Unit cur, nxt; int ui = 0;
    if (!S.next(0, cur)) return;
    f32x4 acc[2][2][4][2];
#pragma unroll
    for (int a = 0; a < 2; ++a)
#pragma unroll
        for (int b = 0; b < 2; ++b)
#pragma unroll
            for (int m = 0; m < 4; ++m)
#pragma unroll
                for (int n = 0; n < 2; ++n) acc[a][b][m][n] = (f32x4){0.f, 0.f, 0.f, 0.f};
    typedef long pg8_l2 __attribute__((ext_vector_type(2)));
    typedef typename std::conditional<F8, pg8_l2, bf16x8>::type frag_t;
    frag_t At[4][2], B0[2][2], B1[2][2];
    const char* cA = (const char*)g.A + (size_t)cur.pm * tstepA; const char* cB = (const char*)g.Bt + (size_t)cur.pn * tstepB;
    S.a_ready(cur);
    PG8_STAGE(PG8_SB(0, 0), cB, voffB); PG8_STAGE(PG8_SA(0, 0), cA, voffA); PG8_STAGE(PG8_SB(0, 1), cB + hstepB, voffB); PG8_STAGE(PG8_SA(0, 1), cA + hstepA, voffA);
    if (wr == 1) PG8_BAR;
    PG8_WAIT_V(4); PG8_BAR;
    PG8_STAGE(PG8_SB(1, 0), cB + kstep, voffB); PG8_STAGE(PG8_SA(1, 0), cA + kstep, voffA); PG8_STAGE(PG8_SB(1, 1), cB + hstepB + kstep, voffB);
    PG8_WAIT_V(6); PG8_BAR;
    for (;;) {
        const bool has_next = S.next(ui + 1, nxt);
        const char* nA = has_next ? (const char*)g.A + (size_t)nxt.pm * tstepA : cA; const char* nB = has_next ? (const char*)g.Bt + (size_t)nxt.pn * tstepB : cB;
        for (int t = 0; t < nt; t += 2) {
            const bool last = (t == nt - 2);
            const char* a1 = cA + (size_t)(t + 1) * kstep;
            const char* a2 = last ? nA : cA + (size_t)(t + 2) * kstep; const char* b2 = last ? nB : cB + (size_t)(t + 2) * kstep;
            const char* a3 = a2 + kstep; const char* b3 = b2 + kstep;
            if (last && has_next) S.a_ready(nxt);
            PG8_LDB(B0, 0, 0); PG8_SCHED; PG8_LDA(At, 0, 0); PG8_STAGE(PG8_SA(1, 1), a1 + hstepA, voffA);
            PG8_WAIT_L(8); PG8_BAR; PG8_WAIT_L(0); PG8_MMA(0, 0, At, B0); PG8_BAR; PG8_SCHED;
            PG8_LDB(B1, 0, 1); PG8_STAGE(PG8_SB(0, 0), b2, voffB);
            PG8_BAR; PG8_WAIT_L(0); PG8_MMA(0, 1, At, B1); PG8_BAR;
            PG8_LDA(At, 0, 1); PG8_STAGE(PG8_SA(0, 0), a2, voffA);
            PG8_BAR; PG8_WAIT_L(0); PG8_MMA(1, 0, At, B0); PG8_BAR; PG8_SCHED;
            PG8_STAGE(PG8_SB(0, 1), b2 + hstepB, voffB);
            PG8_WAIT_V(6); PG8_BAR; PG8_MMA(1, 1, At, B1); PG8_BAR;
            PG8_LDB(B0, 1, 0); PG8_SCHED; PG8_LDA(At, 1, 0); PG8_STAGE(PG8_SA(0, 1), a2 + hstepA, voffA);
            PG8_WAIT_L(8); PG8_BAR; PG8_WAIT_L(0); PG8_MMA(0, 0, At, B0); PG8_BAR; PG8_SCHED;
            PG8_LDB(B1, 1, 1); PG8_STAGE(PG8_SB(1, 0), b3, voffB);
            PG8_BAR; PG8_WAIT_L(0); PG8_MMA(0, 1, At, B1); PG8_BAR;
            PG8_LDA(At, 1, 1); PG8_STAGE(PG8_SA(1, 0), a3, voffA);
            PG8_BAR; PG8_WAIT_L(0); PG8_MMA(1, 0, At, B0); PG8_BAR; PG8_SCHED;
            PG8_STAGE(PG8_SB(1, 1), b3 + hstepB, voffB);
            PG8_WAIT_V(6); PG8_BAR; PG8_MMA(1, 1, At, B1); PG8_BAR;
        }
        if constexpr (!Epi::AFTER_DRAIN) { E(acc, cur, wr, wc, fr, fq); S.done(cur); }
        if (!has_next) break;
#pragma unroll
        for (int a = 0; a < 2; ++a)
#pragma unroll
            for (int b = 0; b < 2; ++b)
#pragma unroll
                for (int m = 0; m < 4; ++m)
#pragma unroll
                    for (int n = 0; n < 2; ++n) acc[a][b][m][n] = (f32x4){0.f, 0.f, 0.f, 0.f};
        cur = nxt; cA = nA; cB = nB; ++ui;
    }
    PG8_WAIT_V(0);
    if (wr == 0) PG8_BAR;
    PG8_BAR;
    if constexpr (Epi::AFTER_DRAIN) { E.fused(acc, cur, wr, wc, fr, fq, lds, wid, lane); S.done(cur); }
#undef PG8_SA
#undef PG8_SB
#undef PG8_STAGE
#undef PG8_LDA
#undef PG8_LDB
#undef PG8_MMA
#undef PG8_WAIT_V
#undef PG8_WAIT_L
#undef PG8_BAR
#undef PG8_SCHED
}
}

typedef unsigned short bf16_t;
typedef short bf16x8 __attribute__((ext_vector_type(8)));
typedef short s16x4 __attribute__((ext_vector_type(4)));
typedef float f32x2 __attribute__((ext_vector_type(2)));
typedef float f32x4 __attribute__((ext_vector_type(4)));
typedef float f32x16 __attribute__((ext_vector_type(16)));
typedef unsigned u32x2 __attribute__((ext_vector_type(2)));
typedef unsigned u32x4 __attribute__((ext_vector_type(4)));
typedef __bf16 bf16v2 __attribute__((ext_vector_type(2)));

constexpr int NB = 4, SEQ = 4096, NT = NB * SEQ, DM = 2048;
constexpr int NPROJ = 7936;
constexpr int NCMP = 255;
constexpr float QSCALE = 0.125f * 1.4426950408889634f;
constexpr float LOG2E = 1.4426950408889634f;
constexpr float NEGBIG = -1e30f;
constexpr float OATT_SCALE = 64.f, Y2_SCALE = 16.f, MIX_SCALE = 64.f;

constexpr size_t WS_BAR   = 0;
constexpr size_t WS_MOD   = 65536;
constexpr size_t WS_CB    = WS_MOD + 196608;
constexpr size_t WS_A16   = WS_CB + 2048;
constexpr size_t WS_W     = 327680;
constexpr size_t WS_WIN   = WS_W;
constexpr size_t WS_WGLU  = WS_WIN + (size_t)NPROJ * 2048 * 2;
constexpr size_t WS_WUA   = WS_WGLU + 2097152;
constexpr size_t WS_WUS   = WS_WUA + 4194304;
constexpr size_t WS_WOUT  = WS_WUS + 4194304;
constexpr size_t WS_WQ    = WS_WOUT + 8388608;
constexpr size_t WS_KBD   = WS_WQ + 8388608;
constexpr size_t WS_WSC   = WS_KBD + 8388608;
constexpr size_t WS_WC1   = WS_WSC + 8388608;
constexpr size_t WS_S5B1  = WS_WC1 + 2097152;
constexpr size_t WS_S5B2  = WS_S5B1 + 8388608;
constexpr size_t WS_HID   = WS_S5B2 + 12582912;
constexpr size_t WS_CKV   = WS_HID + 4194304;
constexpr size_t WS_GATE  = WS_CKV + 1048576;
constexpr size_t WS_SELM  = WS_GATE + 3145728;
constexpr size_t WS_RA    = WS_SELM + 524288;
constexpr size_t WS_RB    = WS_RA + 67108864;
constexpr size_t WS_RC    = WS_RB + 134217728;
constexpr size_t WS_RD    = WS_RC + 134217728;
constexpr size_t WS_END   = WS_RD + 134217728;
constexpr size_t WS_H = WS_RA, WS_HSC = WS_RD + 104857600  , WS_OC = WS_RA, WS_OW = WS_RA + 33554432, WS_MIX = WS_RA, WS_H2 = WS_RA;
constexpr size_t WS_MG = WS_RB, WS_SC = WS_RB;
constexpr size_t WS_Q = WS_RC, WS_KV = WS_RC + 33554432, WS_A2 = WS_KV + 6 * 8388608, WS_X1 = WS_RC;
constexpr size_t WS_XL = WS_RD, WS_YACT = WS_RD + 33554432, WS_Y2 = WS_RD + 67108864, WS_OATT = WS_RD + 100663296, WS_TMP = WS_RD, WS_PU = WS_RD, WS_PV = WS_RD + 33554432, WS_PSU = WS_RD + 67108864, WS_PSV = WS_RD + 67108864 + 65536, WS_EX = WS_RD + 68157440, WS_GT = WS_EX + 8388608, WS_SS = WS_GT + 8388608, WS_SU = WS_SS + 1048576, WS_PA = WS_RB;

constexpr int LDS_BYTES = 147456;
constexpr int LDS_MISC = 131072;

struct Params {
    const float* x; const float* c; const float* ada_w; const float* ada_b; const float* norm_mix_g; const float* norm_ffn_g; const float* w_in;
    const float* cmp_pos; const float* cmp_w1; const float* cmp_b1; const float* cmp_w2; const float* cmp_b2; const float* rel_bias;
    const float* s5_lam_re; const float* s5_lam_im; const float* s5_log_step; const float* s5_b_re; const float* s5_b_im; const float* s5_c_re; const float* s5_c_im; const float* s5_d;
    const float* glu_w; const float* glu_b; const float* w_up_attn; const float* w_up_ssm; const float* w_out; const float* peer_w_q; const float* peer_sub_keys;
    const float* peer_u; const float* peer_v; const float* final_g;
    float* out; unsigned char* ws; int ph_lo, ph_hi;
};

#define DI __device__ __forceinline__
DI unsigned pk_bf16(float lo, float hi) { bf16v2 v; v[0] = (__bf16)lo; v[1] = (__bf16)hi; return __builtin_bit_cast(unsigned, v); }
DI bf16_t f2bf(float x) { return (bf16_t)(pk_bf16(x, 0.f) & 0xffffu); }
DI float bf_lo(unsigned u) { return __uint_as_float(u << 16); }
DI float bf_hi(unsigned u) { return __uint_as_float(u & 0xffff0000u); }
DI float bf2f(bf16_t b) { return __uint_as_float(((unsigned)b) << 16); }
DI bf16v2 bf16pair(unsigned w) { return __builtin_bit_cast(bf16v2, w); }
DI float dot2_bf16(unsigned w, unsigned x, float acc) { return __builtin_amdgcn_fdot2_f32_bf16(__builtin_bit_cast(bf16v2, w), __builtin_bit_cast(bf16v2, x), acc, false); }
DI float sigm(float x) { return __builtin_amdgcn_rcpf(1.f + __builtin_amdgcn_exp2f(-1.4426950408889634f * x)); }
DI float gelu_tanh(float x) { const float u = 1.5957691216f * (x + 0.044715f * x * x * x); return x * __builtin_amdgcn_rcpf(1.f + __builtin_amdgcn_exp2f(-1.4426950408889634f * u)); }
DI float xor32_add(float x) { const auto r = __builtin_amdgcn_permlane32_swap(__float_as_uint(x), __float_as_uint(x), false, false); return __uint_as_float(r[0]) + __uint_as_float(r[1]); }
DI float xor16_add(float x) { const auto r = __builtin_amdgcn_permlane16_swap(__float_as_uint(x), __float_as_uint(x), false, false); return __uint_as_float(r[0]) + __uint_as_float(r[1]); }
DI float xor32_max(float x) { const auto r = __builtin_amdgcn_permlane32_swap(__float_as_uint(x), __float_as_uint(x), false, false); return fmaxf(__uint_as_float(r[0]), __uint_as_float(r[1])); }
DI float row16_sum(float v) {
    asm volatile("s_nop 1\n\tv_add_f32_dpp %0, %0, %0 quad_perm:[1,0,3,2] row_mask:0xf bank_mask:0xf\n\ts_nop 1\n\tv_add_f32_dpp %0, %0, %0 quad_perm:[2,3,0,1] row_mask:0xf bank_mask:0xf\n\t"
                 "s_nop 1\n\tv_add_f32_dpp %0, %0, %0 row_half_mirror row_mask:0xf bank_mask:0xf\n\ts_nop 1\n\tv_add_f32_dpp %0, %0, %0 row_mirror row_mask:0xf bank_mask:0xf\n\ts_nop 1" : "+v"(v));
    return v; }
DI float wave_sum(float v) { return xor32_add(xor16_add(row16_sum(v))); }
DI float reduce8_row16(const float (&v)[8], int li) {
    const bool b3 = (li & 8) != 0, b2 = (li & 4) != 0, b1 = (li & 2) != 0; float t[4], u[2], w, z;
#pragma unroll
    for (int k = 0; k < 4; ++k) { const float keep = b3 ? v[4 + k] : v[k], send = b3 ? v[k] : v[4 + k];
        asm volatile("s_nop 1\n\tv_add_f32_dpp %0, %1, %2 row_mirror row_mask:0xf bank_mask:0xf" : "=v"(t[k]) : "v"(send), "v"(keep)); }
#pragma unroll
    for (int k = 0; k < 2; ++k) { const float keep = b2 ? t[2 + k] : t[k], send = b2 ? t[k] : t[2 + k];
        asm volatile("s_nop 1\n\tv_add_f32_dpp %0, %1, %2 row_half_mirror row_mask:0xf bank_mask:0xf" : "=v"(u[k]) : "v"(send), "v"(keep)); }
    { const float keep = b1 ? u[1] : u[0], send = b1 ? u[0] : u[1];
      asm volatile("s_nop 1\n\tv_add_f32_dpp %0, %1, %2 quad_perm:[3,2,1,0] row_mask:0xf bank_mask:0xf" : "=v"(w) : "v"(send), "v"(keep)); }
    asm volatile("s_nop 1\n\tv_add_f32_dpp %0, %1, %1 quad_perm:[1,0,3,2] row_mask:0xf bank_mask:0xf" : "=v"(z) : "v"(w));
    return z; }
DI unsigned row16_max_u32(unsigned v) {
    asm volatile("s_nop 1\n\tv_max_u32_dpp %0, %0, %0 quad_perm:[1,0,3,2] row_mask:0xf bank_mask:0xf\n\ts_nop 1\n\tv_max_u32_dpp %0, %0, %0 quad_perm:[2,3,0,1] row_mask:0xf bank_mask:0xf\n\t"
                 "s_nop 1\n\tv_max_u32_dpp %0, %0, %0 row_half_mirror row_mask:0xf bank_mask:0xf\n\ts_nop 1\n\tv_max_u32_dpp %0, %0, %0 row_mirror row_mask:0xf bank_mask:0xf\n\ts_nop 1" : "+v"(v));
    return v; }
DI unsigned wave_max_u32(unsigned v) {
    v = row16_max_u32(v);
    { const auto r = __builtin_amdgcn_permlane16_swap(v, v, false, false); v = max(r[0], r[1]); }
    { const auto r = __builtin_amdgcn_permlane32_swap(v, v, false, false); v = max(r[0], r[1]); }
    return (unsigned)__builtin_amdgcn_readfirstlane((int)v); }
DI unsigned mono_u32(float x) { const unsigned b = __float_as_uint(x); return b ^ (((int)b >> 31) | 0x80000000u); }
DI void store8_bf16(bf16_t* p, f32x4 a, f32x4 b) { u32x4 w; w[0] = pk_bf16(a[0], a[1]); w[1] = pk_bf16(a[2], a[3]); w[2] = pk_bf16(b[0], b[1]); w[3] = pk_bf16(b[2], b[3]); *(u32x4*)p = w; }
DI float clamp448(float x) { return __builtin_amdgcn_fmed3f(x, -448.f, 448.f); }
DI void store8_fp8(unsigned char* p, f32x4 a, f32x4 b, float sc) {
    int p0 = __builtin_amdgcn_cvt_pk_fp8_f32(clamp448(a[0] * sc), clamp448(a[1] * sc), 0, false); p0 = __builtin_amdgcn_cvt_pk_fp8_f32(clamp448(a[2] * sc), clamp448(a[3] * sc), p0, true);
    int p1 = __builtin_amdgcn_cvt_pk_fp8_f32(clamp448(b[0] * sc), clamp448(b[1] * sc), 0, false); p1 = __builtin_amdgcn_cvt_pk_fp8_f32(clamp448(b[2] * sc), clamp448(b[3] * sc), p1, true);
    u32x2 w; w[0] = (unsigned)p0; w[1] = (unsigned)p1; *(u32x2*)p = w; }
DI void load8_bf16(const bf16_t* p, f32x4& a, f32x4& b) { const u32x4 w = *(const u32x4*)p; a = (f32x4){bf_lo(w[0]), bf_hi(w[0]), bf_lo(w[1]), bf_hi(w[1])}; b = (f32x4){bf_lo(w[2]), bf_hi(w[2]), bf_lo(w[3]), bf_hi(w[3])}; }

#define EPI_ROWS(ai, m) for (int ai = 0; ai < 2; ++ai) for (int m = 0; m < 4; ++m)
struct EpiProj {
    static constexpr bool PERM = true, AFTER_DRAIN = false;
    unsigned char* ws; const float* hsc;
    DI void operator()(const f32x4 (&acc)[2][2][4][2], const pg8::Unit& u, int wr, int wc, int fr, int fq) const {
        const int pn = u.pn;
#pragma unroll
        for (int ai = 0; ai < 2; ++ai)
#pragma unroll
            for (int m = 0; m < 4; ++m) {
                const int row = u.pm * 256 + ai * 128 + wr * 64 + m * 16 + fr;
                const int b = row >> 12, t = row & 4095; const float rsc = hsc[row] * (1.f / 2048.f);
#pragma unroll
                for (int bj = 0; bj < 2; ++bj) {
                    const int c8 = bj * 128 + wc * 32 + fq * 8;
                    f32x4 v0 = acc[ai][bj][m][0] * rsc, v1 = acc[ai][bj][m][1] * rsc;
                    if (pn < 4) {
                        store8_bf16((bf16_t*)(ws + WS_Q) + (size_t)row * 1024 + pn * 256 + c8, v0 * QSCALE, v1 * QSCALE);
                    } else if (pn < 10) {
                        const int k = c8 >> 6, dd = c8 & 63;
                        store8_bf16((bf16_t*)(ws + WS_KV) + (size_t)(pn - 4) * 4194304 + ((size_t)((b * 4 + k) * 4096 + t)) * 64 + dd, v0, v1);
                    } else if (pn < 14) {
                        const int cu = (pn - 10) * 256 + c8, g = cu >> 4, h0 = cu & 15;
                        store8_bf16((bf16_t*)(ws + WS_A2) + ((size_t)(g * 1024 + b * 256 + (t >> 4))) * 384 + (t & 15) * 16 + h0, v0, v1);
                    } else if (pn < 30) {
                        f32x4 s0, s1;
#pragma unroll
                        for (int e = 0; e < 4; ++e) { s0[e] = sigm(v0[e]); s1[e] = sigm(v1[e]); }
                        store8_bf16((bf16_t*)(ws + WS_MG) + (size_t)row * 4096 + (pn - 14) * 256 + c8, s0, s1);
                    } else {
                        if (c8 < 48) { float* gp = (float*)(ws + WS_GATE) + (size_t)row * 48 + c8; f32x4 s0, s1;
#pragma unroll
                            for (int e = 0; e < 4; ++e) { s0[e] = sigm(v0[e]); s1[e] = sigm(v1[e]); }
                            *(f32x4*)gp = s0; *(f32x4*)(gp + 4) = s1; }
                    }
                }
            }
    }
};
struct EpiBf16Plain {
    static constexpr bool PERM = true, AFTER_DRAIN = false;
    bf16_t* O; int ldc;
    DI void operator()(const f32x4 (&acc)[2][2][4][2], const pg8::Unit& u, int wr, int wc, int fr, int fq) const {
#pragma unroll
        for (int ai = 0; ai < 2; ++ai)
#pragma unroll
            for (int m = 0; m < 4; ++m) { const int row = u.pm * 256 + ai * 128 + wr * 64 + m * 16 + fr;
#pragma unroll
                for (int bj = 0; bj < 2; ++bj) { const int col = u.pn * 256 + bj * 128 + wc * 32 + fq * 8; store8_bf16(O + (size_t)row * ldc + col, acc[ai][bj][m][0], acc[ai][bj][m][1]); } }
    }
};
struct EpiCmp1 {
    static constexpr bool PERM = true, AFTER_DRAIN = false;
    bf16_t* O; const float* bias;
    DI void operator()(const f32x4 (&acc)[2][2][4][2], const pg8::Unit& u, int wr, int wc, int fr, int fq) const {
        const float* bi = bias + (u.pm >> 4) * 256;
#pragma unroll
        for (int ai = 0; ai < 2; ++ai)
#pragma unroll
            for (int m = 0; m < 4; ++m) { const int row = u.pm * 256 + ai * 128 + wr * 64 + m * 16 + fr;
#pragma unroll
                for (int bj = 0; bj < 2; ++bj) { const int col = bj * 128 + wc * 32 + fq * 8; f32x4 v0 = acc[ai][bj][m][0] + *(const f32x4*)(bi + col), v1 = acc[ai][bj][m][1] + *(const f32x4*)(bi + col + 4);
#pragma unroll
                    for (int e = 0; e < 4; ++e) { v0[e] = gelu_tanh(v0[e]); v1[e] = gelu_tanh(v1[e]); }
                    store8_bf16(O + (size_t)row * 256 + col, v0, v1); } }
    }
};
struct EpiS5G1 {
    static constexpr bool PERM = false, AFTER_DRAIN = false;
    float* X;
    DI void operator()(const f32x4 (&acc)[2][2][4][2], const pg8::Unit& u, int wr, int wc, int fr, int fq) const {
#pragma unroll
        for (int ai = 0; ai < 2; ++ai)
#pragma unroll
            for (int m = 0; m < 4; ++m) { const int row = u.pm * 256 + ai * 128 + wr * 64 + m * 16 + fr;
#pragma unroll
                for (int n = 0; n < 2; ++n) { const int col = wc * 32 + n * 16 + fq * 4; *(f32x4*)(X + (size_t)row * 128 + col) = acc[ai][0][m][n]; } }
    }
};
struct EpiS5G2 {
    static constexpr bool PERM = true, AFTER_DRAIN = false;
    bf16_t* Y;
    DI void operator()(const f32x4 (&acc)[2][2][4][2], const pg8::Unit& u, int wr, int wc, int fr, int fq) const {
        const int g = u.pm >> 2;
#pragma unroll
        for (int ai = 0; ai < 2; ++ai)
#pragma unroll
            for (int m = 0; m < 4; ++m) { const int rg = (u.pm & 3) * 256 + ai * 128 + wr * 64 + m * 16 + fr;
                const int b = rg >> 8, ch = rg & 255;
#pragma unroll
                for (int bj = 0; bj < 2; ++bj) { const int c8 = bj * 128 + wc * 32 + fq * 8, tau = c8 >> 4, h0 = c8 & 15; f32x4 v0 = acc[ai][bj][m][0], v1 = acc[ai][bj][m][1];
#pragma unroll
                    for (int e = 0; e < 4; ++e) { v0[e] = gelu_tanh(v0[e]); v1[e] = gelu_tanh(v1[e]); }
                    store8_bf16(Y + ((size_t)(b * 4096 + ch * 16 + tau)) * 1024 + g * 16 + h0, v0, v1); } }
    }
};
struct EpiGlu {
    static constexpr bool PERM = true, AFTER_DRAIN = false;
    const bf16_t* Y; bf16_t* O; const float* bias;
    DI void operator()(const f32x4 (&acc)[2][2][4][2], const pg8::Unit& u, int wr, int wc, int fr, int fq) const {
#pragma unroll
        for (int bj = 0; bj < 2; ++bj) { const int col = u.pn * 256 + bj * 128 + wc * 32 + fq * 8; const f32x4 b0 = *(const f32x4*)(bias + col), b1 = *(const f32x4*)(bias + col + 4);
            u32x4 yv[8];
#pragma unroll
            for (int q = 0; q < 8; ++q) { const int row = u.pm * 256 + (q >> 2) * 128 + wr * 64 + (q & 3) * 16 + fr; yv[q] = *(const u32x4*)(Y + (size_t)row * 1024 + col); }
#pragma unroll
            for (int q = 0; q < 8; ++q) { const int ai = q >> 2, m = q & 3, row = u.pm * 256 + ai * 128 + wr * 64 + m * 16 + fr;
                const f32x4 y0 = (f32x4){bf_lo(yv[q][0]), bf_hi(yv[q][0]), bf_lo(yv[q][1]), bf_hi(yv[q][1])}, y1 = (f32x4){bf_lo(yv[q][2]), bf_hi(yv[q][2]), bf_lo(yv[q][3]), bf_hi(yv[q][3])};
                f32x4 v0 = acc[ai][bj][m][0] + b0, v1 = acc[ai][bj][m][1] + b1;
#pragma unroll
                for (int e = 0; e < 4; ++e) { v0[e] = y0[e] * sigm(v0[e]); v1[e] = y1[e] * sigm(v1[e]); }
                store8_fp8((unsigned char*)O + (size_t)row * 1024 + col, v0, v1, Y2_SCALE); } }
    }
};
template <int SECOND> struct EpiUp {
    static constexpr bool PERM = true, AFTER_DRAIN = false;
    const bf16_t* MG; const bf16_t* TMP; bf16_t* O; float ascale;
    DI void operator()(const f32x4 (&acc)[2][2][4][2], const pg8::Unit& u, int wr, int wc, int fr, int fq) const {
#pragma unroll
        for (int bj = 0; bj < 2; ++bj) { const int col = u.pn * 256 + bj * 128 + wc * 32 + fq * 8;
            u32x4 gv[8], tv[8];
#pragma unroll
            for (int q = 0; q < 8; ++q) { const int row = u.pm * 256 + (q >> 2) * 128 + wr * 64 + (q & 3) * 16 + fr; gv[q] = *(const u32x4*)(MG + (size_t)row * 4096 + SECOND * 2048 + col);
                if (SECOND) tv[q] = *(const u32x4*)(TMP + (size_t)row * 2048 + col); }
#pragma unroll
            for (int q = 0; q < 8; ++q) { const int ai = q >> 2, m = q & 3, row = u.pm * 256 + ai * 128 + wr * 64 + m * 16 + fr;
                const f32x4 g0 = (f32x4){bf_lo(gv[q][0]), bf_hi(gv[q][0]), bf_lo(gv[q][1]), bf_hi(gv[q][1])}, g1 = (f32x4){bf_lo(gv[q][2]), bf_hi(gv[q][2]), bf_lo(gv[q][3]), bf_hi(gv[q][3])};
                f32x4 v0 = acc[ai][bj][m][0] * (g0 * ascale), v1 = acc[ai][bj][m][1] * (g1 * ascale);
                if (SECOND) { v0 += (f32x4){bf_lo(tv[q][0]), bf_hi(tv[q][0]), bf_lo(tv[q][1]), bf_hi(tv[q][1])}; v1 += (f32x4){bf_lo(tv[q][2]), bf_hi(tv[q][2]), bf_lo(tv[q][3]), bf_hi(tv[q][3])};
                    store8_fp8((unsigned char*)O + (size_t)row * 2048 + col, v0, v1, MIX_SCALE); }
                else store8_bf16(O + (size_t)row * 2048 + col, v0, v1); } }
    }
};
struct EpiOut {
    static constexpr bool PERM = false, AFTER_DRAIN = false;
    const float* X; const float* mod; float* O;
    DI void operator()(const f32x4 (&acc)[2][2][4][2], const pg8::Unit& u, int wr, int wc, int fr, int fq) const {
        const float* g1 = mod + ((u.pm * 256) >> 12) * 12288 + 4096;
#pragma unroll
        for (int bj = 0; bj < 2; ++bj)
#pragma unroll
            for (int n = 0; n < 2; ++n) { const int col = u.pn * 256 + bj * 128 + wc * 32 + n * 16 + fq * 4; const f32x4 gg = *(const f32x4*)(g1 + col) * (1.f / (MIX_SCALE * 2048.f));
                f32x4 xv[8];
#pragma unroll
                for (int q = 0; q < 8; ++q) { const int row = u.pm * 256 + (q >> 2) * 128 + wr * 64 + (q & 3) * 16 + fr; xv[q] = *(const f32x4*)(X + (size_t)row * 2048 + col); }
#pragma unroll
                for (int q = 0; q < 8; ++q) { const int ai = q >> 2, m = q & 3, row = u.pm * 256 + ai * 128 + wr * 64 + m * 16 + fr;
                    *(f32x4*)(O + (size_t)row * 2048 + col) = xv[q] + gg * acc[ai][bj][m][n];
                } }
    }
};
struct EpiF32Plain {
    static constexpr bool PERM = false, AFTER_DRAIN = false;
    float* C; int ldc;
    DI void operator()(const f32x4 (&acc)[2][2][4][2], const pg8::Unit& u, int wr, int wc, int fr, int fq) const {
#pragma unroll
        for (int ai = 0; ai < 2; ++ai)
#pragma unroll
            for (int m = 0; m < 4; ++m) { const int row = u.pm * 256 + ai * 128 + wr * 64 + m * 16 + fr;
#pragma unroll
                for (int bj = 0; bj < 2; ++bj)
#pragma unroll
                    for (int n = 0; n < 2; ++n) { const int col = u.pn * 256 + bj * 128 + wc * 32 + n * 16 + fq * 4; *(f32x4*)(C + (size_t)row * ldc + col) = acc[ai][bj][m][n]; } }
    }
};
struct GroupOrder {
    int n, G, c, div;
    DI bool next(int i, pg8::Unit& u) const { const int L = i * G + c; if (L >= n) return false; u.pm = L; u.pn = L / div; return true; }
    DI void a_ready(const pg8::Unit&) const {}
    DI void done(const pg8::Unit&) const {}
};

template <int MODE> DI int src_col(int n) {
    if (MODE == 0) return n;
    if (n < 2560) return n; if (n < 7680) return n + 48; if (n < 7728) return n - 7680 + 2560; return -1; }
template <int MODE, bool F8OUT = false> DI void tconv_tiles(const float* __restrict__ src, int ld, int K, int Nd, bf16_t* __restrict__ dst, LAS float* tile, int first, int stride, float f8scale = 1.f) {
    const int tid = threadIdx.x, ntk = K >> 6, ntot = ntk * (Nd >> 6);
    for (int it = first; it < ntot; it += stride) {
        const int n0 = (it / ntk) << 6, k0 = (it % ntk) << 6;
        __syncthreads();
        { const int j = tid & 63, i0 = tid >> 6, sc = src_col<MODE>(n0 + j);
#pragma unroll
          for (int rr = 0; rr < 8; ++rr) { const int i = i0 + 8 * rr; tile[i * 65 + j] = sc >= 0 ? src[(size_t)(k0 + i) * ld + sc] : 0.f; } }
        __syncthreads();
        { const int jj = tid >> 3, ii0 = (tid & 7) * 8; float v[8];
#pragma unroll
          for (int e = 0; e < 8; ++e) v[e] = tile[(ii0 + e) * 65 + jj];
          if constexpr (F8OUT) { int p0 = __builtin_amdgcn_cvt_pk_fp8_f32(clamp448(v[0] * f8scale), clamp448(v[1] * f8scale), 0, false); p0 = __builtin_amdgcn_cvt_pk_fp8_f32(clamp448(v[2] * f8scale), clamp448(v[3] * f8scale), p0, true);
              int p1 = __builtin_amdgcn_cvt_pk_fp8_f32(clamp448(v[4] * f8scale), clamp448(v[5] * f8scale), 0, false); p1 = __builtin_amdgcn_cvt_pk_fp8_f32(clamp448(v[6] * f8scale), clamp448(v[7] * f8scale), p1, true);
              u32x2 w; w[0] = (unsigned)p0; w[1] = (unsigned)p1; *(u32x2*)((unsigned char*)dst + (size_t)(n0 + jj) * K + k0 + ii0) = w; }
          else { u32x4 w; w[0] = pk_bf16(v[0], v[1]); w[1] = pk_bf16(v[2], v[3]); w[2] = pk_bf16(v[4], v[5]); w[3] = pk_bf16(v[6], v[7]);
              *(u32x4*)(dst + (size_t)(n0 + jj) * K + k0 + ii0) = w; } }
    }
}
DI void conv_bf16_flat(const float* __restrict__ src, bf16_t* __restrict__ dst, size_t n8  , size_t first, size_t stride) {
    for (size_t i = first; i < n8; i += stride) { const f32x4 a = *(const f32x4*)(src + i * 8), b = *(const f32x4*)(src + i * 8 + 4); store8_bf16(dst + i * 8, a, b); }
}

DI void conv_rows_fp8(const float* __restrict__ src, unsigned char* __restrict__ dst, float* __restrict__ inv_scale, int nrows) {
    const int lane = threadIdx.x & 63, wave = __builtin_amdgcn_readfirstlane(threadIdx.x >> 6);
    for (int row = blockIdx.x * 8 + wave; row < nrows; row += gridDim.x * 8) {
        const float* sr = src + (size_t)row * 2048; f32x4 v[8]; float am = 0.f;
#pragma unroll
        for (int k = 0; k < 8; ++k) { v[k] = *(const f32x4*)(sr + k * 256 + lane * 4); am = fmaxf(am, fmaxf(fmaxf(fabsf(v[k][0]), fabsf(v[k][1])), fmaxf(fabsf(v[k][2]), fabsf(v[k][3])))); }
#pragma unroll
        for (int o = 32; o >= 1; o >>= 1) am = fmaxf(am, __shfl_xor(am, o));
        const float sc = am > 0.f ? 448.f / am : 1.f;
#pragma unroll
        for (int k = 0; k < 8; ++k) { int p = __builtin_amdgcn_cvt_pk_fp8_f32(v[k][0] * sc, v[k][1] * sc, 0, false); p = __builtin_amdgcn_cvt_pk_fp8_f32(v[k][2] * sc, v[k][3] * sc, p, true);
            *(unsigned*)(dst + (size_t)k * 4194304 + (size_t)row * 256 + lane * 4) = (unsigned)p; }
        if (lane == 0) inv_scale[row] = am > 0.f ? am / 448.f : 1.f;
    }
}

DI void p0_prologue(const Params& P, LAS unsigned char* lds) {
    unsigned char* ws = P.ws; const int tid = threadIdx.x, G = gridDim.x, bx = blockIdx.x;
    LAS float* fl = (LAS float*)lds;
    {
        LAS float* sc = fl;
        LAS float* red = fl + 8192;
        for (int i = tid; i < 8192; i += 512) { const float v = P.c[i]; sc[i] = v / (1.f + __expf(-v)); }
        __syncthreads();
        for (int it = bx; it < 192 + 8; it += G) {
            const bool is_cb = it >= 192;
            const int col = tid & 63, kg = tid >> 6;
            float a0 = 0.f, a1 = 0.f, a2 = 0.f, a3 = 0.f;
            if (!is_cb) {
                const float* wp = P.ada_w + (size_t)(kg * 256) * 12288 + it * 64 + col;
#pragma unroll 8
                for (int j = 0; j < 256; ++j) { const float w = wp[(size_t)j * 12288]; const int jj = kg * 256 + j; a0 += sc[jj] * w; a1 += sc[2048 + jj] * w; a2 += sc[4096 + jj] * w; a3 += sc[6144 + jj] * w; }
            } else {
                const int i = (it - 192) >> 2, c0 = ((it - 192) & 3) * 64;
                const float* wp = P.cmp_w1 + (size_t)i * 2048 * 256 + (size_t)(kg * 256) * 256 + c0 + col; const float* pp = P.cmp_pos + i * 2048 + kg * 256;
#pragma unroll 8
                for (int j = 0; j < 256; ++j) a0 += pp[j] * wp[(size_t)j * 256];
            }
            red[(kg * 4 + 0) * 64 + col] = a0; red[(kg * 4 + 1) * 64 + col] = a1; red[(kg * 4 + 2) * 64 + col] = a2; red[(kg * 4 + 3) * 64 + col] = a3;
            __syncthreads();
            if (tid < 256) { const int b = tid >> 6, cc = tid & 63; float s = 0.f;
#pragma unroll
                for (int q = 0; q < 8; ++q) s += red[(q * 4 + b) * 64 + cc];
                if (!is_cb) ((float*)(ws + WS_MOD))[b * 12288 + it * 64 + cc] = s + P.ada_b[it * 64 + cc];
                else if (b == 0) { const int i = (it - 192) >> 2, c0 = ((it - 192) & 3) * 64; ((float*)(ws + WS_CB))[i * 256 + c0 + cc] = s + P.cmp_b1[i * 256 + c0 + cc]; } }
            __syncthreads();
        }
    }
    for (int g4 = bx; g4 < 256; g4 += G) {
        const int g = g4 >> 2, part = g4 & 3;
        LAS double* pw = (LAS double*)lds;
        LAS double* ff = pw + 17 * 64 * 2;
        LAS double* bb = ff + 128;
        LAS float* cc = (LAS float*)(bb + 2048);
        LAS float* kern = cc + 2048;
        __syncthreads();
        const double step = exp((double)P.s5_log_step[g]);
        for (int i = tid; i < 17 * 64; i += 512) { const int p = i & 63, dl = i >> 6; const double lr = P.s5_lam_re[g * 64 + p], li = P.s5_lam_im[g * 64 + p];
            const double mag = exp(dl * lr * step), ang = dl * li * step; const double cr = mag * cos(ang), ci = mag * sin(ang);
            pw[i * 2] = cr; pw[i * 2 + 1] = ci;
            if (dl == 1) { const double nr = cr - 1.0, den = lr * lr + li * li; ff[p * 2] = (nr * lr + ci * li) / den; ff[p * 2 + 1] = (ci * lr - nr * li) / den; }
            if (dl == 16 && part == 0) { float* a16 = (float*)(ws + WS_A16) + (g * 64 + p) * 2; a16[0] = (float)cr; a16[1] = (float)ci; } }
        for (int i = tid; i < 1024; i += 512) { const int h = i >> 6, p = i & 63; cc[i * 2] = P.s5_c_re[(g * 16 + h) * 64 + p]; cc[i * 2 + 1] = P.s5_c_im[(g * 16 + h) * 64 + p]; }
        __syncthreads();
        for (int i = tid; i < 1024; i += 512) { const int p = i >> 4; const double br = P.s5_b_re[g * 1024 + i], bi = P.s5_b_im[g * 1024 + i], fr = ff[p * 2], fi = ff[p * 2 + 1];
            bb[i * 2] = fr * br - fi * bi; bb[i * 2 + 1] = fr * bi + fi * br; }
        __syncthreads();
        for (int o1 = tid; o1 < 1024; o1 += 512) {
            const int dl = o1 >> 6, h = 4 * part + ((o1 >> 4) & 3), h2 = o1 & 15, o = (dl * 16 + h) * 16 + h2; double s = 0.0;
            for (int p = 0; p < 64; ++p) { const double cr = cc[(h * 64 + p) * 2], ci = cc[(h * 64 + p) * 2 + 1], ar = pw[(dl * 64 + p) * 2], ai = pw[(dl * 64 + p) * 2 + 1];
                const double zr = cr * ar - ci * ai, zi = cr * ai + ci * ar; s += zr * bb[(p * 16 + h2) * 2] - zi * bb[(p * 16 + h2) * 2 + 1]; }
            kern[o] = (float)s; }
        __syncthreads();
        bf16_t* B2 = (bf16_t*)(ws + WS_S5B2) + (size_t)g * 256 * 384;
        for (int i = tid; i < 64 * 384 / 2; i += 512) {
            const int rr = i / 192, c0 = (i % 192) * 2, tau = rr >> 2, h = 4 * part + (rr & 3), row = tau * 16 + h; float v[2];
#pragma unroll
            for (int e = 0; e < 2; ++e) { const int col = c0 + e; float x;
                if (col < 256) { const int s = col >> 4, h2 = col & 15; x = (s <= tau) ? kern[((tau - s) * 16 + h) * 16 + h2] : 0.f; if (s == tau && h2 == h) x += P.s5_d[g * 16 + h]; }
                else { const int p = (col - 256) & 63; const double cr = cc[(h * 64 + p) * 2], ci = cc[(h * 64 + p) * 2 + 1], ar = pw[((tau + 1) * 64 + p) * 2], ai = pw[((tau + 1) * 64 + p) * 2 + 1];
                    x = (col < 320) ? (float)(cr * ar - ci * ai) : (float)(-(cr * ai + ci * ar)); }
                v[e] = x; }
            *(unsigned*)(B2 + (size_t)row * 384 + c0) = pk_bf16(v[0], v[1]); }
        bf16_t* B1 = (bf16_t*)(ws + WS_S5B1) + (size_t)g * 256 * 256;
        for (int i = tid; i < 64 * 256 / 2; i += 512) {
            const int n = 64 * part + (i >> 7), c0 = (i & 127) * 2; float v[2];
#pragma unroll
            for (int e = 0; e < 2; ++e) { const int col = c0 + e, s = col >> 4, h = col & 15; float x = 0.f;
                if (n < 128) { const int p = n & 63; const double ar = pw[((15 - s) * 64 + p) * 2], ai = pw[((15 - s) * 64 + p) * 2 + 1], br = bb[(p * 16 + h) * 2], bi = bb[(p * 16 + h) * 2 + 1];
                    x = (n < 64) ? (float)(ar * br - ai * bi) : (float)(ar * bi + ai * br); }
                v[e] = x; }
            *(unsigned*)(B1 + (size_t)n * 256 + c0) = pk_bf16(v[0], v[1]); }
    }
    __syncthreads();
    LAS float* tile = fl;
    tconv_tiles<1, true>(P.w_in, 7728, 2048, NPROJ, (bf16_t*)(ws + WS_WIN), tile, bx, G, 2048.f);
    tconv_tiles<0>(P.glu_w, 1024, 1024, 1024, (bf16_t*)(ws + WS_WGLU), tile, bx, G);
    tconv_tiles<0, true>(P.w_up_attn, 2048, 1024, 2048, (bf16_t*)(ws + WS_WUA), tile, bx, G, 1024.f);
    tconv_tiles<0, true>(P.w_up_ssm, 2048, 1024, 2048, (bf16_t*)(ws + WS_WUS), tile, bx, G, 1024.f);
    tconv_tiles<0, true>(P.w_out, 2048, 2048, 2048, (bf16_t*)(ws + WS_WOUT), tile, bx, G, 2048.f);
    tconv_tiles<0>(P.cmp_w1, 256, 2048, 256, (bf16_t*)(ws + WS_WC1), tile, bx, G);
    tconv_tiles<0>(P.cmp_w1 + 2048 * 256, 256, 2048, 256, (bf16_t*)(ws + WS_WC1) + 256 * 2048, tile, bx, G);
    __syncthreads();
    const size_t gt = (size_t)bx * 512 + tid, gs = (size_t)G * 512;
    conv_bf16_flat(P.peer_w_q, (bf16_t*)(ws + WS_WQ), (size_t)2048 * 2048 / 8, gt, gs);
    { bf16_t* kb = (bf16_t*)(ws + WS_KBD);
      for (size_t i = gt; i < (size_t)2048 * 2048 / 8; i += gs) { const int row = (int)(i >> 8), k0 = (int)(i & 255) * 8, hc = row >> 7, n = row & 127;
          if ((k0 >> 7) == hc) { const float* s = P.peer_sub_keys + ((size_t)(hc * 128 + n)) * 128 + (k0 & 127); store8_bf16(kb + i * 8, *(const f32x4*)s, *(const f32x4*)(s + 4)); }
          else *(u32x4*)(kb + i * 8) = (u32x4){0u, 0u, 0u, 0u}; } }
}

DI void phase_norm(const float* __restrict__ X, const float* __restrict__ gain, const float* __restrict__ mod, int sh_off, int sc_off, bf16_t* __restrict__ H) {
    const int lane = threadIdx.x & 63, wave = __builtin_amdgcn_readfirstlane(threadIdx.x >> 6);
    for (int row = blockIdx.x * 8 + wave; row < NT; row += gridDim.x * 8) {
        const float* xr = X + (size_t)row * 2048; f32x4 v[8]; float ss = 0.f;
#pragma unroll
        for (int k = 0; k < 8; ++k) { v[k] = *(const f32x4*)(xr + k * 256 + lane * 4); ss += v[k][0] * v[k][0] + v[k][1] * v[k][1] + v[k][2] * v[k][2] + v[k][3] * v[k][3]; }
        ss = wave_sum(ss); const float rs = rsqrtf(ss * (1.f / 2048.f) + 1e-6f);
        const float* mb = mod + (row >> 12) * 12288;
#pragma unroll
        for (int k = 0; k < 8; ++k) { const int d = k * 256 + lane * 4; const f32x4 g = *(const f32x4*)(gain + d), sc = *(const f32x4*)(mb + sc_off + d), sh = *(const f32x4*)(mb + sh_off + d);
            f32x4 o;
#pragma unroll
            for (int e = 0; e < 4; ++e) o[e] = v[k][e] * rs * g[e] * (1.f + sc[e]) + sh[e];
            u32x2 w; w[0] = pk_bf16(o[0], o[1]); w[1] = pk_bf16(o[2], o[3]); *(u32x2*)(H + (size_t)row * 2048 + d) = w; }
    }
}

DI void phase_norm_f8(const float* __restrict__ X, const float* __restrict__ gain, const float* __restrict__ mod, int sh_off, int sc_off, unsigned char* __restrict__ H8, float* __restrict__ hsc) {
    const int lane = threadIdx.x & 63, wave = __builtin_amdgcn_readfirstlane(threadIdx.x >> 6);
    for (int row = blockIdx.x * 8 + wave; row < NT; row += gridDim.x * 8) {
        const float* xr = X + (size_t)row * 2048; f32x4 v[8]; float ss = 0.f;
#pragma unroll
        for (int k = 0; k < 8; ++k) { v[k] = *(const f32x4*)(xr + k * 256 + lane * 4); ss += v[k][0] * v[k][0] + v[k][1] * v[k][1] + v[k][2] * v[k][2] + v[k][3] * v[k][3]; }
        ss = wave_sum(ss); const float rs = rsqrtf(ss * (1.f / 2048.f) + 1e-6f);
        const float* mb = mod + (row >> 12) * 12288; float am = 0.f;
#pragma unroll
        for (int k = 0; k < 8; ++k) { const int d = k * 256 + lane * 4; const f32x4 g = *(const f32x4*)(gain + d), sc = *(const f32x4*)(mb + sc_off + d), sh = *(const f32x4*)(mb + sh_off + d);
#pragma unroll
            for (int e = 0; e < 4; ++e) { v[k][e] = v[k][e] * rs * g[e] * (1.f + sc[e]) + sh[e]; am = fmaxf(am, fabsf(v[k][e])); } }
#pragma unroll
        for (int o = 32; o >= 1; o >>= 1) am = fmaxf(am, __shfl_xor(am, o));
        const float q = am > 0.f ? 448.f / am : 1.f;
#pragma unroll
        for (int k = 0; k < 8; ++k) { int p = __builtin_amdgcn_cvt_pk_fp8_f32(v[k][0] * q, v[k][1] * q, 0, false); p = __builtin_amdgcn_cvt_pk_fp8_f32(v[k][2] * q, v[k][3] * q, p, true);
            *(unsigned*)(H8 + (size_t)row * 2048 + k * 256 + lane * 4) = (unsigned)p; }
        if (lane == 0) hsc[row] = am > 0.f ? am * (1.f / 448.f) : 1.f;
    }
}

DI void phase_cmp2(const Params& P) {
    unsigned char* ws = P.ws; const bf16_t* hid = (const bf16_t*)(ws + WS_HID); bf16_t* ckv = (bf16_t*)(ws + WS_CKV);
    for (int o = blockIdx.x * 512 + threadIdx.x; o < 2 * 16 * 256 * 64; o += gridDim.x * 512) {
        const int dd = o & 63, row = o >> 6, i = row >> 12, n = row & 255;
        float s = 0.f;
        if (n < NCMP) { const bf16_t* hr = hid + (size_t)row * 256; const float* w2 = P.cmp_w2 + i * 256 * 64 + dd; s = P.cmp_b2[i * 64 + dd];
#pragma unroll 4
            for (int j = 0; j < 256; j += 8) { const u32x4 hv = *(const u32x4*)(hr + j);
#pragma unroll
                for (int e = 0; e < 4; ++e) { s += bf_lo(hv[e]) * w2[(j + 2 * e) * 64]; s += bf_hi(hv[e]) * w2[(j + 2 * e + 1) * 64]; } } }
        ckv[o] = f2bf(s);
    }
}
DI void phase_scan(const Params& P) {
    unsigned char* ws = P.ws; const int lane = threadIdx.x & 63, wave = __builtin_amdgcn_readfirstlane(threadIdx.x >> 6);
    if (wave != 0) return;
    for (int bg = blockIdx.x; bg < 256; bg += gridDim.x) {
        const int b = bg >> 6, g = bg & 63, p = lane;
        const float ar = ((const float*)(ws + WS_A16))[(g * 64 + p) * 2], ai = ((const float*)(ws + WS_A16))[(g * 64 + p) * 2 + 1];
        const float* xl = (const float*)(ws + WS_XL) + (size_t)(g * 1024 + b * 256) * 128; bf16_t* a2 = (bf16_t*)(ws + WS_A2) + (size_t)(g * 1024 + b * 256) * 384 + 256;
        float xr = 0.f, xi = 0.f;
        for (int c = 0; c < 256; c += 8) { float lr[8], li[8];
#pragma unroll
            for (int e = 0; e < 8; ++e) { lr[e] = xl[(size_t)(c + e) * 128 + p]; li[e] = xl[(size_t)(c + e) * 128 + 64 + p]; }
#pragma unroll
            for (int e = 0; e < 8; ++e) { a2[(size_t)(c + e) * 384 + p] = f2bf(xr); a2[(size_t)(c + e) * 384 + 64 + p] = f2bf(xi);
                const float nr = ar * xr - ai * xi + lr[e], ni = ar * xi + ai * xr + li[e]; xr = nr; xi = ni; } }
    }
}

constexpr int AT_K = 0, AT_V = 18432, AT_TB = 34816, AT_IMP = 43008, AT_END = 112640;
#define MFMA32(a, b, c) __builtin_amdgcn_mfma_f32_32x32x16_bf16((a), (b), (c), 0, 0, 0)

DI void attn_setup_tables(const Params& P, LAS unsigned char* lds) {
    LAS float* tb = (LAS float*)(lds + AT_TB);
    __syncthreads();
    for (int i = threadIdx.x; i < 16 * 128; i += 512) { const int hd = i >> 7, dist = i & 127; int bk = dist;
        if (dist >= 16) { const float lr = __logf((float)dist * (1.f / 16.f)) / 2.0794415417f; bk = min(16 + (int)(lr * 16.f), 31); }
        tb[i] = P.rel_bias[bk * 16 + hd] * LOG2E; }
    __syncthreads();
}

#define ATTN_BODY \
             \
            bf16x8 vfr[2][2][2]; \
            f32x16 sacc[2]; \
_Pragma("unroll") \
            for (int kb = 0; kb < 2; ++kb) { \
_Pragma("unroll") \
                for (int i = 0; i < 16; ++i) sacc[kb][i] = 0.f; \
_Pragma("unroll") \
                for (int s = 0; s < 4; ++s) { const bf16x8 kf = *(const LAS bf16x8*)(Kl + krd + kb * 32 * 144 + s * 32); sacc[kb] = MFMA32(kf, qf[s], sacc[kb]); } } \
            if (pass == 0 && MODE != 0) {                                             \
_Pragma("unroll") \
                for (int kb = 0; kb < 2; ++kb) \
_Pragma("unroll") \
                    for (int s2 = 0; s2 < 2; ++s2) \
_Pragma("unroll") \
                        for (int db = 0; db < 2; ++db) { const unsigned a0 = (unsigned)(32 * kb + 16 * s2) * 128u + vrow * 128u + vcol[db]; \
                            const s16x4 lo = __builtin_amdgcn_ds_read_tr16_b64_v4i16((LAS s16x4*)(Vl + a0)), hi = __builtin_amdgcn_ds_read_tr16_b64_v4i16((LAS s16x4*)(Vl + a0 + 8 * 128)); \
                            vfr[kb][s2][db] = __builtin_shufflevector(lo, hi, 0, 1, 2, 3, 4, 5, 6, 7); } \
            } \
             \
            const bool near = (MODE == 0) || (qb - j <= 2) || (MODE == 2 && j == qb - 8); \
            const bool lsel = (MODE != 1) || (((j < 32 ? (mlo >> j) : (mhi >> (j - 32))) & 1u) != 0u); \
            if (near) { \
                const int dq = (MODE == 0) ? (tq - 31 - 1024 * j) : (tq - 64 * j); \
_Pragma("unroll") \
                for (int kb = 0; kb < 2; ++kb) \
_Pragma("unroll") \
                    for (int i = 0; i < 16; ++i) { const int kl = 32 * kb + (i & 3) + 8 * (i >> 2) + 4 * h; const int dist = dq - ((MODE == 0) ? 16 * kl : kl); \
                        bool ok = (dist >= 0) && lsel; if (MODE == 2) ok = ok && (dist < 512); \
                        sacc[kb][i] = (sacc[kb][i] + tb[min(max(dist, 0), 127)]) + (ok ? 0.f : NEGBIG); }      \
            } else { \
                const float cb = lsel ? farb : NEGBIG;                   \
_Pragma("unroll") \
                for (int kb = 0; kb < 2; ++kb) \
_Pragma("unroll") \
                    for (int i = 0; i < 16; ++i) sacc[kb][i] += cb; \
            } \
            bf16x8 pf[2][2]; \
            if (pass == 0) { \
                 \
                float mx = fmaxf(fmaxf(sacc[0][0], sacc[0][1]), sacc[1][0]); \
_Pragma("unroll") \
                for (int kb = 0; kb < 2; ++kb) \
_Pragma("unroll") \
                    for (int i = 0; i < 16; i += 2) mx = fmaxf(fmaxf(mx, sacc[kb][i]), sacc[kb][i + 1]); \
                mx = xor32_max(mx); \
                const float m_new = fmaxf(m_run, mx); \
                if (__any(m_new > m_run)) { const float alpha = __builtin_amdgcn_exp2f(m_run - m_new); l_run *= alpha; \
_Pragma("unroll") \
                    for (int i = 0; i < 16; ++i) { oacc[0][i] *= alpha; oacc[1][i] *= alpha; } } \
                m_run = m_new; \
                f32x2 ls2 = {0.f, 0.f}; const f32x2 mn2 = {m_new, m_new}; \
_Pragma("unroll") \
                for (int kb = 0; kb < 2; ++kb) \
_Pragma("unroll") \
                    for (int i = 0; i < 16; i += 2) { f32x2 d2 = (f32x2){sacc[kb][i], sacc[kb][i + 1]} - mn2; d2.x = __builtin_amdgcn_exp2f(d2.x); d2.y = __builtin_amdgcn_exp2f(d2.y); sacc[kb][i] = d2.x; sacc[kb][i + 1] = d2.y; ls2 += d2; } \
                l_run += ls2.x + ls2.y; \
            } else { \
_Pragma("unroll") \
                for (int kb = 0; kb < 2; ++kb) \
_Pragma("unroll") \
                    for (int i = 0; i < 16; ++i) sacc[kb][i] = __builtin_amdgcn_exp2f(sacc[kb][i] - m_fin) * inv_fin; \
            } \
_Pragma("unroll") \
            for (int kb = 0; kb < 2; ++kb) \
_Pragma("unroll") \
                for (int s2 = 0; s2 < 2; ++s2) { u32x4 w; \
_Pragma("unroll") \
                    for (int e = 0; e < 4; ++e) w[e] = pk_bf16(sacc[kb][8 * s2 + 2 * e], sacc[kb][8 * s2 + 2 * e + 1]); \
                    pf[kb][s2] = __builtin_bit_cast(bf16x8, w); } \
            if (pass == 0) { \
                 \
_Pragma("unroll") \
                for (int kb = 0; kb < 2; ++kb) \
_Pragma("unroll") \
                    for (int s2 = 0; s2 < 2; ++s2) \
_Pragma("unroll") \
                        for (int db = 0; db < 2; ++db) { \
                            if (MODE != 0) oacc[db] = MFMA32(vfr[kb][s2][db], pf[kb][s2], oacc[db]); \
                            else { const unsigned a0 = (unsigned)(32 * kb + 16 * s2) * 128u + vrow * 128u + vcol[db]; \
                                const s16x4 lo = __builtin_amdgcn_ds_read_tr16_b64_v4i16((LAS s16x4*)(Vl + a0)), hi = __builtin_amdgcn_ds_read_tr16_b64_v4i16((LAS s16x4*)(Vl + a0 + 8 * 128)); \
                                oacc[db] = MFMA32(__builtin_shufflevector(lo, hi, 0, 1, 2, 3, 4, 5, 6, 7), pf[kb][s2], oacc[db]); } } \
            } else { \
                 \
                bf16x8 mfrag[2][2]; \
_Pragma("unroll") \
                for (int kb = 0; kb < 2; ++kb) \
_Pragma("unroll") \
                    for (int s2 = 0; s2 < 2; ++s2) \
_Pragma("unroll") \
                        for (int jj = 0; jj < 8; ++jj) { const int key = 32 * kb + 16 * s2 + 8 * (jj >> 2) + 4 * h + (jj & 3); \
                            mfrag[kb][s2][jj] = (key == 4 * r - 1 || key == 4 * r + 3) ? (short)0x3F00 : ((key >= 4 * r && key <= 4 * r + 2) ? (short)0x3F80 : (short)0); } \
                f32x16 ia; \
_Pragma("unroll") \
                for (int i = 0; i < 16; ++i) ia[i] = 0.f; \
_Pragma("unroll") \
                for (int kb = 0; kb < 2; ++kb) \
_Pragma("unroll") \
                    for (int s2 = 0; s2 < 2; ++s2) ia = MFMA32(mfrag[kb][s2], pf[kb][s2], ia); \
                LAS float* ip = (LAS float*)(lds + AT_IMP) + (g * 64 + tq_loc) * 68 + 16 * j; \
_Pragma("unroll") \
                for (int i = 0; i < 9; ++i) { const int jp = (i & 3) + 8 * (i >> 2) + 4 * h; if (jp <= 16) ip[jp] += ia[i]; } \
            } \


template <int MODE> DI void attn_unit(const Params& P, LAS unsigned char* lds, int b, int k, int qb) {
    unsigned char* ws = P.ws;
    const int tid = threadIdx.x, lane = tid & 63, wave = __builtin_amdgcn_readfirstlane(tid >> 6);
    const int g = wave >> 1, th = wave & 1, r = lane & 31, h = lane >> 5;
    const int tq_loc = th * 32 + r, tq = qb * 64 + tq_loc, hd = k * 4 + g, bk = b * 4 + k;
    const LAS float* tb = (const LAS float*)(lds + AT_TB) + hd * 128;
    const float farb = tb[127];
    bf16x8 qf[4];
    { const bf16_t* qg = (const bf16_t*)(ws + WS_Q) + ((size_t)(b * 4096 + tq)) * 1024 + hd * 64 + 8 * h;
#pragma unroll
      for (int s = 0; s < 4; ++s) qf[s] = *(const bf16x8*)(qg + 16 * s); }
    const bf16_t *Kg, *Vg;
    if (MODE == 0) { Kg = (const bf16_t*)(ws + WS_CKV) + (size_t)bk * 256 * 64; Vg = Kg + 16 * 256 * 64; }
    else { Kg = (const bf16_t*)(ws + WS_KV) + (size_t)(MODE == 1 ? 2 : 4) * 4194304 + (size_t)bk * 4096 * 64; Vg = Kg + 4194304; }
    unsigned long long tiles; unsigned mlo = 0u, mhi = 0u;
    if (MODE == 0) { const int kmax = min(3, (4 * qb + 2) >> 6); tiles = (2ull << kmax) - 1ull; }
    else if (MODE == 2) { const int lo = max(0, qb - 8); tiles = ((2ull << qb) - 1ull) & ~((1ull << lo) - 1ull); }
    else { const unsigned* sm = (const unsigned*)(ws + WS_SELM) + ((size_t)(bk * 4096 + qb * 64)) * 2;
        mlo = sm[tq_loc * 2]; mhi = sm[tq_loc * 2 + 1];
        unsigned ulo = sm[lane * 2], uhi = sm[lane * 2 + 1];
#pragma unroll
        for (int o = 32; o >= 1; o >>= 1) { ulo |= __shfl_xor(ulo, o); uhi |= __shfl_xor(uhi, o); }
        tiles = (((unsigned long long)(unsigned)__builtin_amdgcn_readfirstlane(uhi) << 32) | (unsigned)__builtin_amdgcn_readfirstlane(ulo)) & ((2ull << qb) - 1ull); }
    const int ntile = __popcll(tiles);
    const int skey = tid >> 3, sch = tid & 7;
    const unsigned kst = (unsigned)(skey * 144 + sch * 16), vst = (unsigned)(skey * 128 + ((sch ^ (((skey >> 1) & 1) << 2)) * 16));
    const int q4 = (lane & 15) >> 2, pp = lane & 3, blk = (lane >> 4) & 1;
    const unsigned vrow = (unsigned)(4 * h + q4);
    unsigned vcol[2];
#pragma unroll
    for (int db = 0; db < 2; ++db) { const int ch = 4 * db + 2 * blk + (pp >> 1); vcol[db] = (unsigned)(((ch ^ (((q4 >> 1) & 1) << 2)) * 16) + (pp & 1) * 8); }
    const unsigned krd = (unsigned)(r * 144 + 16 * h);

    f32x16 oacc[2]; float m_run = NEGBIG, l_run = 0.f;
#pragma unroll
    for (int i = 0; i < 16; ++i) { oacc[0][i] = 0.f; oacc[1][i] = 0.f; }
    float m_fin = 0.f, inv_fin = 0.f;

    const int npass = (MODE == 0) ? 2 : 1;
    for (int pass = 0; pass < npass; ++pass) {
        if (MODE == 0 && pass == 1) {
            LAS float* imp = (LAS float*)(lds + AT_IMP);
            for (int i = tid; i < 4 * 64 * 68; i += 512) imp[i] = 0.f;
        }
        __syncthreads();
        unsigned long long rem = tiles; int jA = __ffsll((long long)rem) - 1; rem &= rem - 1ull; int jB = rem ? __ffsll((long long)rem) - 1 : jA; rem &= rem - 1ull;
        u32x4 kregA = *(const u32x4*)(Kg + (size_t)(jA * 64 + skey) * 64 + sch * 8), vregA = *(const u32x4*)(Vg + (size_t)(jA * 64 + skey) * 64 + sch * 8);
        u32x4 kregB = *(const u32x4*)(Kg + (size_t)(jB * 64 + skey) * 64 + sch * 8), vregB = *(const u32x4*)(Vg + (size_t)(jB * 64 + skey) * 64 + sch * 8);
#define ATTN_STEP(KR, VR, JV, PAR) { const int j = JV; \
            LAS unsigned char* Kl = lds + AT_K + (PAR) * 9216; LAS unsigned char* Vl = lds + AT_V + (PAR) * 8192; \
            *(LAS u32x4*)(Kl + kst) = KR; *(LAS u32x4*)(Vl + vst) = VR; \
            __syncthreads(); \
            { const int j2 = rem ? __ffsll((long long)rem) - 1 : JV; rem &= rem - 1ull; JV = j2; \
              KR = *(const u32x4*)(Kg + (size_t)(j2 * 64 + skey) * 64 + sch * 8); VR = *(const u32x4*)(Vg + (size_t)(j2 * 64 + skey) * 64 + sch * 8); } \
            ATTN_BODY }
        if constexpr (true) { rem = tiles & (tiles - 1ull);
            for (int it = 0; it < ntile; ++it) ATTN_STEP(kregA, vregA, jA, (it & 1))
        } else {
            for (int it = 0; it < ntile; it += 2) {
                ATTN_STEP(kregA, vregA, jA, 0)
                if (it + 1 < ntile) ATTN_STEP(kregB, vregB, jB, 1)
            }
        }
#undef ATTN_STEP
        if (pass == 0) {
            const float lt = xor32_add(l_run); const bool live = m_run > -1e29f; const float inv = live ? 1.f / lt : 0.f;
            m_fin = live ? m_run : 0.f; inv_fin = inv;
            int tqo = tq; asm volatile("" : "+v"(tqo));
            bf16_t* og = (bf16_t*)(ws + (MODE == 0 ? WS_OC : (MODE == 2 ? WS_OW : WS_OATT))) + ((size_t)(b * 4096 + tqo)) * 1024 + hd * 64;
            float g0 = 0.f, g1 = 1.f, g2 = 0.f; const bf16_t *oc = nullptr, *ow = nullptr;
            if (MODE == 1) { const float* gp = (const float*)(ws + WS_GATE) + (size_t)(b * 4096 + tqo) * 48 + hd * 3; g0 = gp[0]; g1 = gp[1]; g2 = gp[2];
                oc = (const bf16_t*)(ws + WS_OC) + ((size_t)(b * 4096 + tqo)) * 1024 + hd * 64; ow = (const bf16_t*)(ws + WS_OW) + ((size_t)(b * 4096 + tqo)) * 1024 + hd * 64; }
#pragma unroll
            for (int db = 0; db < 2; ++db)
#pragma unroll
                for (int a = 0; a < 4; ++a) { const int d0 = 32 * db + 8 * a + 4 * h; float v[4];
#pragma unroll
                    for (int e = 0; e < 4; ++e) v[e] = oacc[db][4 * a + e] * inv;
                    if (MODE == 1) { const u32x2 c2 = *(const u32x2*)(oc + d0), w2 = *(const u32x2*)(ow + d0);
                        v[0] = g1 * v[0] + g0 * bf_lo(c2[0]) + g2 * bf_lo(w2[0]); v[1] = g1 * v[1] + g0 * bf_hi(c2[0]) + g2 * bf_hi(w2[0]);
                        v[2] = g1 * v[2] + g0 * bf_lo(c2[1]) + g2 * bf_lo(w2[1]); v[3] = g1 * v[3] + g0 * bf_hi(c2[1]) + g2 * bf_hi(w2[1]); }
                    if (MODE == 1) { int p8 = __builtin_amdgcn_cvt_pk_fp8_f32(clamp448(v[0] * OATT_SCALE), clamp448(v[1] * OATT_SCALE), 0, false); p8 = __builtin_amdgcn_cvt_pk_fp8_f32(clamp448(v[2] * OATT_SCALE), clamp448(v[3] * OATT_SCALE), p8, true);
                        *(int*)((unsigned char*)(ws + WS_OATT) + ((size_t)(b * 4096 + tqo)) * 1024 + hd * 64 + d0) = p8; }
                    else { u32x2 w; w[0] = pk_bf16(v[0], v[1]); w[1] = pk_bf16(v[2], v[3]); *(u32x2*)(og + d0) = w; } }
        }
    }
    if (MODE == 0) {
        __syncthreads();
        const LAS float* imp = (const LAS float*)(lds + AT_IMP); unsigned* sm = (unsigned*)(ws + WS_SELM) + ((size_t)(bk * 4096 + qb * 64)) * 2;
        const int cur = qb;
        for (int tk = 0; tk < 8; ++tk) { const int tok = wave * 8 + tk, jb = lane;
            const float v = imp[(0 * 64 + tok) * 68 + jb] + imp[(1 * 64 + tok) * 68 + jb] + imp[(2 * 64 + tok) * 68 + jb] + imp[(3 * 64 + tok) * 68 + jb];
            const bool valid = jb <= cur, forced = valid && (jb == 0 || jb == cur || jb == cur - 1);
            bool sel = forced;
            if (cur <= 15) sel = valid;
            else { unsigned key = (valid && !forced) ? ((__float_as_uint(fmaxf(v, 0.f)) & ~63u) | (unsigned)(63 - jb)) : 0u;
                for (int rd = 0; rd < 13; ++rd) { const unsigned w = wave_max_u32(key); const int win = 63 - (int)(w & 63u); if (jb == win && w != 0u) { sel = true; key = 0u; } } }
            const unsigned long long bal = __ballot(sel);
            if (lane == 0) { sm[tok * 2] = (unsigned)bal; sm[tok * 2 + 1] = (unsigned)(bal >> 32); } }
    }
}

DI void phase_attn_win_early(const Params& P, LAS unsigned char* lds) {
    if (gridDim.x != 256) return;
    const int bx = blockIdx.x; if (bx >= 128 && bx < 160) return;
    attn_setup_tables(P, lds);
    const int nb = bx < 128 ? bx : bx - 32;
    for (int u = nb; u < 672; u += 224) { const int qb = u >> 4, bk = u & 15; attn_unit<2>(P, lds, bk >> 2, bk & 3, qb); }
}
DI void phase_attn_cmp_win(const Params& P, LAS unsigned char* lds) {
    attn_setup_tables(P, lds);
    for (int u = blockIdx.x; u < 1024; u += gridDim.x) { const int qb = 63 - (u >> 4), bk = u & 15; attn_unit<0>(P, lds, bk >> 2, bk & 3, qb); }
    for (int u = (gridDim.x == 256 ? 672 : 0) + blockIdx.x; u < 1024; u += gridDim.x) { const int qb = u >> 4, bk = u & 15; attn_unit<2>(P, lds, bk >> 2, bk & 3, qb); }
}
DI void phase_attn_sel(const Params& P, LAS unsigned char* lds) {
    attn_setup_tables(P, lds);
    for (int pr = blockIdx.x; pr < 512; pr += gridDim.x) { const int bk = pr >> 5, qp = pr & 31;
        attn_unit<1>(P, lds, bk >> 2, bk & 3, 63 - qp); attn_unit<1>(P, lds, bk >> 2, bk & 3, qp); }
}

DI unsigned row_max_u32(unsigned v) {
    asm volatile("s_nop 1\n\tv_max_u32_dpp %0, %0, %0 quad_perm:[1,0,3,2] row_mask:0xf bank_mask:0xf\n\ts_nop 1\n\tv_max_u32_dpp %0, %0, %0 quad_perm:[2,3,0,1] row_mask:0xf bank_mask:0xf\n\t"
                 "s_nop 1\n\tv_max_u32_dpp %0, %0, %0 row_half_mirror row_mask:0xf bank_mask:0xf\n\ts_nop 1\n\tv_max_u32_dpp %0, %0, %0 row_mirror row_mask:0xf bank_mask:0xf\n\ts_nop 1" : "+v"(v));
    return v; }
DI float row_max_f32(float v) {
    asm volatile("s_nop 1\n\tv_max_f32_dpp %0, %0, %0 quad_perm:[1,0,3,2] row_mask:0xf bank_mask:0xf\n\ts_nop 1\n\tv_max_f32_dpp %0, %0, %0 quad_perm:[2,3,0,1] row_mask:0xf bank_mask:0xf\n\t"
                 "s_nop 1\n\tv_max_f32_dpp %0, %0, %0 row_half_mirror row_mask:0xf bank_mask:0xf\n\ts_nop 1\n\tv_max_f32_dpp %0, %0, %0 row_mirror row_mask:0xf bank_mask:0xf\n\ts_nop 1" : "+v"(v));
    return v; }
DI float row_sum_f32(float v) {
    asm volatile("s_nop 1\n\tv_add_f32_dpp %0, %0, %0 quad_perm:[1,0,3,2] row_mask:0xf bank_mask:0xf\n\ts_nop 1\n\tv_add_f32_dpp %0, %0, %0 quad_perm:[2,3,0,1] row_mask:0xf bank_mask:0xf\n\t"
                 "s_nop 1\n\tv_add_f32_dpp %0, %0, %0 row_half_mirror row_mask:0xf bank_mask:0xf\n\ts_nop 1\n\tv_add_f32_dpp %0, %0, %0 row_mirror row_mask:0xf bank_mask:0xf\n\ts_nop 1" : "+v"(v));
    return v; }
DI float demono_f32(unsigned u) { return __uint_as_float((u & 0x80000000u) ? (u ^ 0x80000000u) : ~u); }

DI void phase_peer(const Params& P, LAS unsigned char* lds) {
    unsigned char* ws = P.ws; const int lane = threadIdx.x & 63, wave = __builtin_amdgcn_readfirstlane(threadIdx.x >> 6), rw = lane >> 4, li = lane & 15, p = lane & 31, hsel = lane >> 5;
    const float* SC = (const float*)(ws + WS_SC);
    LAS unsigned char* ptab = lds + 8192;
    LAS float* vs = (LAS float*)(lds + wave * 512); LAS int* ns = (LAS int*)(lds + wave * 512 + 256);
    __syncthreads();
    if (threadIdx.x == 0) { int q = 0; for (int a = 0; a < 16; ++a) for (int b = 0; b < 16 / (a + 1); ++b) ptab[q++] = (unsigned char)(a * 16 + b); for (; q < 64; ++q) ptab[q] = 0; }
    __syncthreads();
    const int q0 = p, q1 = p + 32; const int ab0 = ptab[q0], ab1 = ptab[q1 < 50 ? q1 : 0];
    for (int t = blockIdx.x * 8 + wave; t < NT; t += gridDim.x * 8) {
        for (int bt = 0; bt < 4; ++bt) {
            const float* sp = SC + (size_t)t * 2048 + (bt * 4 + rw) * 128 + li; unsigned k[8];
#pragma unroll
            for (int i = 0; i < 8; ++i) k[i] = (mono_u32(sp[16 * i]) & ~127u) | (unsigned)(127 - (li + 16 * i));
            unsigned win = 0u;
            for (int rd = 0; rd < 16; ++rd) {
                unsigned m = max(max(max(k[0], k[1]), max(k[2], k[3])), max(max(k[4], k[5]), max(k[6], k[7])));
                m = row_max_u32(m);
#pragma unroll
                for (int i = 0; i < 8; ++i) k[i] = (k[i] == m) ? 0u : k[i];
                if (li == rd) win = m; }
            vs[rw * 16 + li] = demono_f32(win & ~127u); ns[rw * 16 + li] = 127 - (int)(win & 127u);
            const LAS float* v1 = vs + hsel * 32; const LAS float* v2 = v1 + 16;
            const float c0 = v1[ab0 >> 4] + v2[ab0 & 15], c1 = v1[ab1 >> 4] + v2[ab1 & 15];
            unsigned k0 = (mono_u32(c0) & ~63u) | (unsigned)(63 - q0), k1 = (q1 < 50) ? ((mono_u32(c1) & ~63u) | (unsigned)(63 - q1)) : 0u;
            unsigned w2 = 0u;
            for (int rd = 0; rd < 16; ++rd) {
                unsigned m = row_max_u32(max(k0, k1));
                { const auto r_ = __builtin_amdgcn_permlane16_swap(m, m, false, false); m = max(r_[0], r_[1]); }
                k0 = (k0 == m) ? 0u : k0; k1 = (k1 == m) ? 0u : k1;
                if (p == rd) w2 = m; }
            if (p < 16) {
                const int ab = ptab[63 - (int)(w2 & 63u)], a = ab >> 4, b = ab & 15;
                const float tsv = v1[a] + v2[b]; const int ee = ns[hsel * 32 + a] * 128 + ns[hsel * 32 + 16 + b];
                const float mx = row_max_f32(tsv), ex = __expf(tsv - mx), sm = row16_sum(ex);
                const int slot = (2 * bt + hsel) * 16 + p;
                ((int*)(ws + WS_EX))[(size_t)t * 128 + slot] = ee;
                ((float*)(ws + WS_GT))[(size_t)t * 128 + slot] = (ex / sm) * ((const float*)(ws + WS_PSV))[ee]; ((float*)(ws + WS_SU))[(size_t)t * 128 + slot] = ((const float*)(ws + WS_PSU))[ee]; }
        }
    }
}

DI void peer_slice_map(const Params& P, LAS unsigned char* lds, int& vx, int& rank, int& nrank) {
    volatile LAS unsigned* misc = (volatile LAS unsigned*)(lds + LDS_MISC);
    const unsigned* bar = (const unsigned*)(P.ws + WS_BAR);
    const int xcc = (int)misc[4], rk = (int)misc[5];
    bool ok = true; int mine = 0;
#pragma unroll
    for (int j = 0; j < 16; ++j) { const unsigned c = __hip_atomic_load(bar + XB_XCNT(j), __ATOMIC_RELAXED, __HIP_MEMORY_SCOPE_AGENT); if (j < 8 ? c == 0u : c != 0u) ok = false; if (j == xcc) mine = (int)c; }
    if (ok && (P.ph_hi - P.ph_lo > 1)) { vx = xcc; rank = rk; nrank = mine; }
    else { vx = blockIdx.x & 7; rank = blockIdx.x >> 3; nrank = (gridDim.x + 7 - vx) >> 3; }
}
DI void phase_peer_a(const Params& P, LAS unsigned char* lds) {
    unsigned char* ws = P.ws; const int lane = threadIdx.x & 63, wave = __builtin_amdgcn_readfirstlane(threadIdx.x >> 6); int vx, rank, nrank; peer_slice_map(P, lds, vx, rank, nrank);
    const int gq = lane >> 4, li = lane & 15;
    LAS int* el = (LAS int*)(lds + wave * 1024);
    const unsigned char* PU = ws + WS_PU + (size_t)vx * 4194304; const unsigned li16 = (unsigned)li * 16u; const bf16_t* H2 = (const bf16_t*)(ws + WS_H2) + vx * 256 + li * 16;
    float* PA = (float*)(ws + WS_PA) + (size_t)vx * NT * 128;
    for (int t = rank * 8 + wave; t < NT; t += nrank * 8) {
        const int* exg = (const int*)(ws + WS_EX) + (size_t)t * 128;
        el[lane] = exg[lane]; el[64 + lane] = exg[64 + lane];
        unsigned hq[8];
        { const u32x4 ha = *(const u32x4*)(H2 + (size_t)t * 2048), hb = *(const u32x4*)(H2 + (size_t)t * 2048 + 8);
#pragma unroll
          for (int q = 0; q < 4; ++q) { hq[q] = ha[q]; hq[4 + q] = hb[q]; } }
#pragma unroll
        for (int jb = 0; jb < 32; jb += 8) {
            u32x4 rw[8];
#pragma unroll
            for (int i = 0; i < 8; ++i) { const unsigned ex = (unsigned)el[4 * (jb + i) + gq]; rw[i] = *(const u32x4*)(PU + (ex * 256u + li16)); }
            float pr[8];
#pragma unroll
            for (int i = 0; i < 8; ++i) { float a0 = 0.f, a1 = 0.f;
#pragma unroll
                for (int q = 0; q < 4; ++q) { a0 = __builtin_amdgcn_fdot2_f32_bf16(__builtin_amdgcn_cvt_scalef32_pk_bf16_fp8(rw[i][q], 1.0f, false), bf16pair(hq[2 * q]), a0, false);
                    a1 = __builtin_amdgcn_fdot2_f32_bf16(__builtin_amdgcn_cvt_scalef32_pk_bf16_fp8(rw[i][q], 1.0f, true), bf16pair(hq[2 * q + 1]), a1, false); }
                pr[i] = a0 + a1; }
            const float tot = reduce8_row16(pr, li);
            if (!(li & 1)) PA[(size_t)t * 128 + 4 * (jb + (li >> 1)) + gq] = tot;
        }
    }
}
DI void phase_peer_w(const Params& P) {
    unsigned char* ws = P.ws; const float* PA = (const float*)(ws + WS_PA); float* GT = (float*)(ws + WS_GT); const float* SU = (const float*)(ws + WS_SU);
    for (size_t i = (size_t)blockIdx.x * 512 + threadIdx.x; i < (size_t)NT * 128; i += (size_t)gridDim.x * 512) { float a = 0.f;
#pragma unroll
        for (int x = 0; x < 8; ++x) a += PA[(size_t)x * NT * 128 + i];
        GT[i] = GT[i] * gelu_tanh(a * SU[i]); }
}
DI void phase_peer_b(const Params& P, LAS unsigned char* lds) {
    unsigned char* ws = P.ws; const int lane = threadIdx.x & 63, wave = __builtin_amdgcn_readfirstlane(threadIdx.x >> 6); int vx, rank, nrank; peer_slice_map(P, lds, vx, rank, nrank);
    const int gq = lane >> 4, li = lane & 15;
    LAS int* el = (LAS int*)(lds + wave * 1024); LAS float* wl = (LAS float*)(lds + wave * 1024 + 512);
    const unsigned char* PV = ws + WS_PV + (size_t)vx * 4194304; const unsigned li16 = (unsigned)li * 16u;
    const float* X1 = (const float*)(ws + WS_X1); const float* mod = (const float*)(ws + WS_MOD);
    for (int t = rank * 8 + wave; t < NT; t += nrank * 8) {
        const int* exg = (const int*)(ws + WS_EX) + (size_t)t * 128; const float* gtg = (const float*)(ws + WS_GT) + (size_t)t * 128;
        el[lane] = exg[lane]; el[64 + lane] = exg[64 + lane]; wl[lane] = gtg[lane]; wl[64 + lane] = gtg[64 + lane];
        f32x2 oa[8];
#pragma unroll
        for (int i = 0; i < 8; ++i) oa[i] = (f32x2){0.f, 0.f};
#pragma unroll
        for (int jb = 0; jb < 32; jb += 8) {
            u32x4 rw[8]; float wv[8];
#pragma unroll
            for (int i = 0; i < 8; ++i) { const int slot = 4 * (jb + i) + gq; const unsigned ex = (unsigned)el[slot]; wv[i] = wl[slot]; rw[i] = *(const u32x4*)(PV + (ex * 256u + li16)); }
#pragma unroll
            for (int i = 0; i < 8; ++i) { const f32x2 w2 = {wv[i], wv[i]};
#pragma unroll
                for (int q = 0; q < 4; ++q) { oa[2 * q] += w2 * __builtin_amdgcn_cvt_pk_f32_fp8((int)rw[i][q], false); oa[2 * q + 1] += w2 * __builtin_amdgcn_cvt_pk_f32_fp8((int)rw[i][q], true); } }
        }
        float v16[16], w8[8], o4[4];
#pragma unroll
        for (int i = 0; i < 8; ++i) { v16[2 * i] = oa[i].x; v16[2 * i + 1] = oa[i].y; }
#pragma unroll
        for (int k = 0; k < 8; ++k) { const auto r = __builtin_amdgcn_permlane16_swap(__float_as_uint(v16[k]), __float_as_uint(v16[8 + k]), false, false); w8[k] = __uint_as_float(r[0]) + __uint_as_float(r[1]); }
#pragma unroll
        for (int k = 0; k < 4; ++k) { const auto r = __builtin_amdgcn_permlane32_swap(__float_as_uint(w8[k]), __float_as_uint(w8[4 + k]), false, false); o4[k] = __uint_as_float(r[0]) + __uint_as_float(r[1]); }
        const int cq = ((gq & 1) << 1) | (gq >> 1);
        const int d = vx * 256 + li * 16 + 4 * cq; const f32x4 xa = *(const f32x4*)(X1 + (size_t)t * 2048 + d), ga = *(const f32x4*)(mod + (t >> 12) * 12288 + 10240 + d);
        f32x4 y; float ss = 0.f;
#pragma unroll
        for (int e = 0; e < 4; ++e) { y[e] = xa[e] + ga[e] * o4[e]; ss += y[e] * y[e]; }
        *(f32x4*)(P.out + (size_t)t * 2048 + d) = y;
        ss = wave_sum(ss); if (lane == 0) ((float*)(ws + WS_SS))[(size_t)vx * NT + t] = ss;
    }
}
DI void phase_peer_norm(const Params& P) {
    unsigned char* ws = P.ws; const int lane = threadIdx.x & 63, wave = __builtin_amdgcn_readfirstlane(threadIdx.x >> 6); const float* SS = (const float*)(ws + WS_SS);
    for (int t = blockIdx.x * 8 + wave; t < NT; t += gridDim.x * 8) {
        float ss = 0.f;
#pragma unroll
        for (int x = 0; x < 8; ++x) ss += SS[(size_t)x * NT + t];
        const float rs = rsqrtf(ss * (1.f / 2048.f) + 1e-6f); float* o = P.out + (size_t)t * 2048;
#pragma unroll
        for (int k = 0; k < 8; ++k) { const int d = k * 256 + lane * 4; f32x4 v = *(const f32x4*)(o + d); const f32x4 g = *(const f32x4*)(P.final_g + d);
#pragma unroll
            for (int e = 0; e < 4; ++e) v[e] = v[e] * rs * g[e];
            *(f32x4*)(o + d) = v; }
    }
}


constexpr int N_PHASES = 16;
template <int K> DI void run_phase(const Params& P, LAS unsigned char* lds) {
    unsigned char* ws = P.ws; const int G = gridDim.x, bx = blockIdx.x, tid = threadIdx.x; (void)G; (void)bx; (void)tid;
    if constexpr (K == 0) { p0_prologue(P, lds); }
    if constexpr (K == 1) { phase_norm_f8(P.x, P.norm_mix_g, (const float*)(ws + WS_MOD), 0, 2048, ws + WS_H, (float*)(ws + WS_HSC)); }
    if constexpr (K == 2) {
        { pg8::Gemm g{(const bf16_t*)(ws + WS_H), (const bf16_t*)(ws + WS_WIN), 2048, 2048, 2048}; pg8::StaticOrder S; S.init(NT, NPROJ, G, bx); EpiProj E{ws, (const float*)(ws + WS_HSC)};
          pg8::gemm_phase<EpiProj, pg8::StaticOrder, true>(lds, g, S, E); }
        { pg8::Gemm g{(const bf16_t*)(ws + WS_KBD), (const bf16_t*)(ws + WS_WQ), 2048, 2048, 2048}; pg8::StaticOrder S; S.init(2048, 2048, G, (bx + 64) % G); EpiBf16Plain E{(bf16_t*)(ws + WS_WSC), 2048};
          pg8::gemm_phase<EpiBf16Plain, pg8::StaticOrder>(lds, g, S, E); }
    }
    if constexpr (K == 3) {
        { pg8::Gemm g{(const bf16_t*)(ws + WS_A2), (const bf16_t*)(ws + WS_S5B1), 384, 256, 256}; GroupOrder S{256, G, bx, 4}; EpiS5G1 E{(float*)(ws + WS_XL)};
          pg8::gemm_phase<EpiS5G1, GroupOrder>(lds, g, S, E); }
        { pg8::Gemm g{(const bf16_t*)(ws + WS_KV), (const bf16_t*)(ws + WS_WC1), 1024, 2048, 2048}; GroupOrder S{32, G, (bx + 128) % G, 16}; EpiCmp1 E{(bf16_t*)(ws + WS_HID), (const float*)(ws + WS_CB)};
          pg8::gemm_phase<EpiCmp1, GroupOrder>(lds, g, S, E); }
        phase_attn_win_early(P, lds);
    }
    if constexpr (K == 4) { phase_scan(P); phase_cmp2(P); }
    if constexpr (K == 5) {
        { pg8::Gemm g{(const bf16_t*)(ws + WS_A2), (const bf16_t*)(ws + WS_S5B2), 384, 384, 384}; GroupOrder S{256, G, bx, 4}; EpiS5G2 E{(bf16_t*)(ws + WS_YACT)};
          pg8::gemm_phase<EpiS5G2, GroupOrder>(lds, g, S, E); }
        phase_attn_cmp_win(P, lds);
    }
    if constexpr (K == 6) {
        { pg8::Gemm g{(const bf16_t*)(ws + WS_YACT), (const bf16_t*)(ws + WS_WGLU), 1024, 1024, 1024}; pg8::StaticOrder S; S.init(NT, 1024, G, bx); EpiGlu E{(const bf16_t*)(ws + WS_YACT), (bf16_t*)(ws + WS_Y2), P.glu_b};
          pg8::gemm_phase<EpiGlu, pg8::StaticOrder>(lds, g, S, E); }
        phase_attn_sel(P, lds);
    }
    if constexpr (K == 7) {
        { pg8::Gemm g{(const bf16_t*)(ws + WS_OATT), (const bf16_t*)(ws + WS_WUA), 1024, 1024, 1024}; pg8::StaticOrder S; S.init(NT, 2048, G, bx); EpiUp<0> E{(const bf16_t*)(ws + WS_MG), nullptr, (bf16_t*)(ws + WS_TMP), 1.f / (OATT_SCALE * 1024.f)};
          pg8::gemm_phase<EpiUp<0>, pg8::StaticOrder, true>(lds, g, S, E); }
        { pg8::Gemm g{(const bf16_t*)(ws + WS_Y2), (const bf16_t*)(ws + WS_WUS), 1024, 1024, 1024}; pg8::StaticOrder S; S.init(NT, 2048, G, bx); EpiUp<1> E{(const bf16_t*)(ws + WS_MG), (const bf16_t*)(ws + WS_TMP), (bf16_t*)(ws + WS_MIX), 1.f / (Y2_SCALE * 1024.f)};
          pg8::gemm_phase<EpiUp<1>, pg8::StaticOrder, true>(lds, g, S, E); }
    }
    if constexpr (K == 8) {
        pg8::Gemm g{(const bf16_t*)(ws + WS_MIX), (const bf16_t*)(ws + WS_WOUT), 2048, 2048, 2048}; pg8::StaticOrder S; S.init(NT, 2048, G, bx); EpiOut E{P.x, (const float*)(ws + WS_MOD), (float*)(ws + WS_X1)};
        pg8::gemm_phase<EpiOut, pg8::StaticOrder, true>(lds, g, S, E);
    }
    if constexpr (K == 9) {
        phase_norm((const float*)(ws + WS_X1), P.norm_ffn_g, (const float*)(ws + WS_MOD), 6144, 8192, (bf16_t*)(ws + WS_H2));
        conv_rows_fp8(P.peer_u, ws + WS_PU, (float*)(ws + WS_PSU), 16384);
        conv_rows_fp8(P.peer_v, ws + WS_PV, (float*)(ws + WS_PSV), 16384);
    }
    if constexpr (K == 10) {
        pg8::Gemm g{(const bf16_t*)(ws + WS_H2), (const bf16_t*)(ws + WS_WSC), 2048, 2048, 2048}; pg8::StaticOrder S; S.init(NT, 2048, G, bx); EpiF32Plain E{(float*)(ws + WS_SC), 2048};
        pg8::gemm_phase<EpiF32Plain, pg8::StaticOrder>(lds, g, S, E);
    }
    if constexpr (K == 11) { phase_peer(P, lds); }
    if constexpr (K == 12) { phase_peer_a(P, lds); }
    if constexpr (K == 13) { phase_peer_w(P); }
    if constexpr (K == 14) { phase_peer_b(P, lds); }
    if constexpr (K == 15) { phase_peer_norm(P); }
}

__global__ void __launch_bounds__(512, 2) mk_fwd(Params P) {
    extern __shared__ __attribute__((aligned(16))) unsigned char lds_raw[];
    LAS unsigned char* lds = (LAS unsigned char*)lds_raw;
    unsigned char* ws = P.ws;
    const int G = gridDim.x, bx = blockIdx.x, tid = threadIdx.x;
    volatile LAS unsigned* misc = (volatile LAS unsigned*)(lds + LDS_MISC);
    if (tid < 8) misc[tid] = 0u;
    __syncthreads();
    const int lo = P.ph_lo, hi = P.ph_hi;
    XcdBarrier bar; bar.bar = (unsigned*)(ws + WS_BAR); bar.x = 0; bar.st = misc;
    if (hi - lo > 1) bar = xcd_barrier_post((unsigned*)(ws + WS_BAR), misc);
    if (tid == 0) { const unsigned xcc = xb_xcc_id(); misc[4] = xcc; misc[5] = (hi - lo > 1) ? xb_add((unsigned*)(ws + WS_BAR) + 8192 + 64 * (xcc & 15u), 1u) : 0u; }
    __syncthreads();
#define IN(k) (lo <= (k) && (k) < hi)
#define SEAM(k) do { if (IN(k) && IN((k) + 1)) xcd_barrier(bar); } while (0)

    if (IN(0)) run_phase<0>(P, lds);
    SEAM(0);
    if (IN(1)) run_phase<1>(P, lds);
    SEAM(1);
    if (IN(2)) run_phase<2>(P, lds);
    SEAM(2);
    if (IN(3)) run_phase<3>(P, lds);
    SEAM(3);
    if (IN(4)) run_phase<4>(P, lds);
    SEAM(4);
    if (IN(5)) run_phase<5>(P, lds);
    SEAM(5);
    if (IN(6)) run_phase<6>(P, lds);
    SEAM(6);
    if (IN(7)) run_phase<7>(P, lds);
    SEAM(7);
    if (IN(8)) run_phase<8>(P, lds);
    SEAM(8);
    if (IN(9)) run_phase<9>(P, lds);
    SEAM(9);
    if (IN(10)) run_phase<10>(P, lds);
    SEAM(10);
    if (IN(11)) run_phase<11>(P, lds);
    SEAM(11);
    if (IN(12)) run_phase<12>(P, lds);
    SEAM(12);
    if (IN(13)) run_phase<13>(P, lds);
    SEAM(13);
    if (IN(14)) run_phase<14>(P, lds);
    SEAM(14);
    if (IN(15)) run_phase<15>(P, lds);
#undef IN
#undef SEAM
}

extern "C" void kernel_launch(void* const* d_in, const int* in_sizes, int n_in, void* d_out, int out_size, void* d_ws, size_t ws_size, hipStream_t stream) {
    static int grid = 0;
    if (grid == 0) {
        if (n_in != 31 || ws_size < WS_END) { fprintf(stderr, "kernel_launch: expected 31 inputs and >= %zu bytes of workspace (got %d, %zu)\n", (size_t)WS_END, n_in, ws_size); grid = -1; return; }
        int dev = 0, cus = 0, per_cu = 0;
        if (hipGetDevice(&dev) != hipSuccess || hipDeviceGetAttribute(&cus, hipDeviceAttributeMultiprocessorCount, dev) != hipSuccess) { grid = -1; return; }
        if (hipFuncSetAttribute((const void*)mk_fwd, hipFuncAttributeMaxDynamicSharedMemorySize, LDS_BYTES) != hipSuccess) { fprintf(stderr, "kernel_launch: hipFuncSetAttribute failed\n"); grid = -1; return; }
        if (hipOccupancyMaxActiveBlocksPerMultiprocessor(&per_cu, (const void*)mk_fwd, 512, LDS_BYTES) != hipSuccess || per_cu < 1) { fprintf(stderr, "kernel_launch: occupancy query reports %d blocks per CU\n", per_cu); (void)hipGetLastError(); grid = -1; return; }
        grid = cus;
    }
    if (grid < 0) return;
    (void)hipMemsetAsync((char*)d_ws + WS_BAR, 0, 65536, stream);
    Params p{};
    const float** f = (const float**)&p;
    for (int i = 0; i < 31; ++i) f[i] = (const float*)d_in[i];
    p.out = (float*)d_out; p.ws = (unsigned char*)d_ws;
#if MK_PER_PHASE
    for (int ph = 0; ph < N_PHASES; ++ph) { p.ph_lo = ph; p.ph_hi = ph + 1; hipLaunchKernelGGL(mk_fwd, dim3(grid), dim3(512), LDS_BYTES, stream, p); }
#else
    p.ph_lo = 0; p.ph_hi = N_PHASES; hipLaunchKernelGGL(mk_fwd, dim3(grid), dim3(512), LDS_BYTES, stream, p);
#endif
}
```

```cpp
#include <hip/hip_runtime.h>
#include <stdint.h>
#include <stdio.h>
#include <math.h>
#include <type_traits>


#ifndef MK_PER_PHASE
#define MK_PER_PHASE 0
#endif

#define XB_TMO      128
#define XB_XCNT(j)  (256  + 64 * (j))
#define XB_XSUB(j)  (1280 + 64 * (j))
#define XB_XGEN(j)  (2304 + 64 * (j))
#define XB_TOP      3328
#define XB_TOPGEN   3392
#define XCD_BAR_WORDS 3456
#define XB_SPIN_CAP (1u << 18)
#define LAS __attribute__((address_space(3)))

__device__ __forceinline__ unsigned xb_ld(unsigned* p)              { return __hip_atomic_load(p, __ATOMIC_RELAXED, __HIP_MEMORY_SCOPE_AGENT); }
__device__ __forceinline__ unsigned xb_add(unsigned* p, unsigned v) { return __hip_atomic_fetch_add(p, v, __ATOMIC_RELAXED, __HIP_MEMORY_SCOPE_AGENT); }
__device__ __forceinline__ unsigned xb_xcc_id() { return (unsigned)__builtin_amdgcn_s_getreg((3 << 11) | 20) & 0xFu; }
#define XB_SPIN(cond, bar) do { unsigned _sp = 0; while (cond) { __builtin_amdgcn_s_sleep(1); \
    if ((++_sp & 255u) == 0u) { if (xb_ld(&(bar)[XB_TMO])) break; if (_sp > XB_SPIN_CAP) { atomicAdd(&(bar)[XB_TMO], 1u); break; } } } } while (0)

struct XcdBarrier {
    unsigned* bar; unsigned x;
    volatile LAS unsigned* st;
};

__device__ __forceinline__ XcdBarrier xcd_barrier_post(unsigned* bar, volatile LAS unsigned* st) {
    XcdBarrier b; b.bar = bar; b.x = xb_xcc_id(); b.st = st;
    if (threadIdx.x == 0) (void)xb_add(&bar[XB_XCNT(b.x)], 1u);
    return b;
}
__device__ __forceinline__ void xcd_barrier_complete(unsigned* bar, unsigned x, unsigned& nloc, unsigned& nx) {
    const unsigned G = gridDim.x * gridDim.y * gridDim.z;
    unsigned sum, cnt, mine, sp = 0u;
    for (;;) {
        sum = 0u; cnt = 0u; mine = 0u;
#pragma unroll
        for (unsigned j = 0; j < 16; ++j) { const unsigned c = xb_ld(&bar[XB_XCNT(j)]); sum += c; cnt += (c > 0u) ? 1u : 0u; mine = (j == x) ? c : mine; }
        if (sum == G) break;
        __builtin_amdgcn_s_sleep(1);
        if ((++sp & 255u) == 0u) { if (xb_ld(&bar[XB_TMO])) break; if (sp > XB_SPIN_CAP) { atomicAdd(&bar[XB_TMO], 1u); break; } }
    }
    nloc = mine > 0u ? mine : 1u; nx = cnt > 0u ? cnt : 1u;
}

__device__ __forceinline__ void xcd_barrier(const XcdBarrier& b) {
    asm volatile("s_waitcnt vmcnt(0)" ::: "memory");
    __syncthreads();
    if (threadIdx.x == 0) {
        unsigned* bar = b.bar;
        __builtin_amdgcn_s_waitcnt(0);
        unsigned nloc = b.st[0], nx = b.st[1];
        if (nloc == 0u) { xcd_barrier_complete(bar, b.x, nloc, nx); b.st[0] = nloc; b.st[1] = nx; }
        const unsigned old = xb_add(&bar[XB_XSUB(b.x)], 1u);
        const unsigned gen = old / nloc;
        if (old + 1u == (gen + 1u) * nloc) {
            __builtin_amdgcn_fence(__ATOMIC_RELEASE, "agent");
            asm volatile("s_waitcnt vmcnt(0)" ::: "memory");
            const unsigned og = xb_add(&bar[XB_TOP], 1u);
            const unsigned tg = og / nx;
            if (og + 1u == (tg + 1u) * nx) xb_add(&bar[XB_TOPGEN], 1u);
            else XB_SPIN(xb_ld(&bar[XB_TOPGEN]) == tg, bar);
            __builtin_amdgcn_fence(__ATOMIC_ACQUIRE, "agent");
            xb_add(&bar[XB_XGEN(b.x)], 1u);
            asm volatile("s_waitcnt vmcnt(0)" ::: "memory");
        } else {
            XB_SPIN(xb_ld(&bar[XB_XGEN(b.x)]) == gen, bar);
            __builtin_amdgcn_fence(__ATOMIC_ACQUIRE, "agent");
            asm volatile("s_waitcnt vmcnt(0)" ::: "memory");
        }
    }
    __syncthreads();
}


namespace pg8 {
#define PG8_LAS __attribute__((address_space(3)))
typedef unsigned short bf16_t;
typedef short bf16x8 __attribute__((ext_vector_type(8)));
typedef float f32x4 __attribute__((ext_vector_type(4)));
typedef unsigned u32x4 __attribute__((ext_vector_type(4)));
constexpr int BM = 256, BK = 64, HALF = 128, HTB = HALF * BK * 2  , STAGE_BYTES = 8 * HTB, NXCD = 8, WGM = 8;

__host__ __device__ __forceinline__ int lds_byte(int r, int c) { const int st = (r >> 4) * 2 + (c >> 5), rr = r & 15, cc = c & 31, ob = rr * 64 + cc * 2; return st * 1024 + (ob ^ (((ob >> 9) & 1) << 5)); }
__host__ __device__ __forceinline__ void stage_rc(int b, int& R, int& C) { const int st = b / 1024, sb = b % 1024, swz = sb ^ (((sb >> 9) & 1) << 5); R = (st >> 1) * 16 + swz / 64; C = (st & 1) * 32 + (swz % 64) / 2; }
__host__ __device__ __forceinline__ int perm32(int rho) { const int n = rho >> 4, i = rho & 15; return 8 * (i >> 2) + 4 * n + (i & 3); }

struct Unit { int pm, pn; };
struct Gemm { const bf16_t* A; const bf16_t* Bt; int lda, ldb, K; };
struct StaticOrder {
    int nM, nN, nwg, G, c;
    __host__ __device__ void init(int M, int N, int G_, int c_) { nM = M / BM; nN = N / BM; nwg = nM * nN; G = G_; c = c_; }
    __host__ __device__ bool next(int i, Unit& u) const {
        const long L = (long)i * G + c; if (L >= nwg) return false;
        int wgid = (int)L; { const int q = nwg / NXCD, r = nwg % NXCD, xcd = wgid % NXCD, off = wgid / NXCD; wgid = (xcd < r ? xcd * (q + 1) : r * (q + 1) + (xcd - r) * q) + off; }
        const int nig = WGM * nN, gid = wgid / nig, fm = gid * WGM, gsz = (nM - fm) < WGM ? (nM - fm) : WGM;
        u.pm = fm + ((wgid % nig) % gsz); u.pn = (wgid % nig) / gsz; return true;
    }
    __device__ __forceinline__ void a_ready(const Unit&) const {}
    __device__ __forceinline__ void done(const Unit&) const {}
};
template <class Epi, class Sched, bool F8 = false>
__device__ __forceinline__ void gemm_phase(PG8_LAS unsigned char* lds, const Gemm g, const Sched& S, const Epi& E) {
    const int tid = threadIdx.x, wid = __builtin_amdgcn_readfirstlane(tid >> 6), lane = tid & 63, wr = wid >> 2, wc = wid & 3, fr = lane & 15, fq = lane >> 4;
    constexpr int ES = F8 ? 1 : 2;
    const int K = g.K, nt = K * ES / 128;
    unsigned voffA[2], voffB[2];
#pragma unroll
    for (int i = 0; i < 2; ++i) { int R, C; stage_rc(tid * 16 + i * 8192, R, C); const int Rb = Epi::PERM ? ((R & ~31) + perm32(R & 31)) : R;
        voffA[i] = (unsigned)(R * g.lda * ES + C * 2); voffB[i] = (unsigned)(Rb * g.ldb * ES + C * 2); }
    const size_t kstep = (size_t)(BK * 2);
    const size_t hstepA = (size_t)HALF * g.lda * ES, hstepB = (size_t)HALF * g.ldb * ES;
    const size_t tstepA = 2 * hstepA, tstepB = 2 * hstepB;
    const unsigned ldsw = (unsigned)wid * 1024u;
    const int aoff = lds_byte(wr * 64 + fr, fq * 8), boff = lds_byte(wc * 32 + fr, fq * 8);
#define PG8_SA(b, h) (((b) * 2 + (h)) * HTB)
#define PG8_SB(b, h) ((4 + (b) * 2 + (h)) * HTB)
#define PG8_STAGE(bufoff, gbase, voff) do { _Pragma("unroll") for (int _i = 0; _i < 2; ++_i) \
        __builtin_amdgcn_global_load_lds((const unsigned*)((const char*)(gbase) + (voff)[_i]), (PG8_LAS unsigned*)(lds + (bufoff) + ldsw + _i * 8192), 16, 0, 0); } while (0)
#define PG8_LDA(dst, b, h) do { _Pragma("unroll") for (int m = 0; m < 4; ++m) _Pragma("unroll") for (int k = 0; k < 2; ++k) dst[m][k] = *(const PG8_LAS frag_t*)(lds + PG8_SA(b, h) + aoff + m * 2048 + k * 1024); } while (0)
#define PG8_LDB(dst, b, h) do { _Pragma("unroll") for (int n = 0; n < 2; ++n) _Pragma("unroll") for (int k = 0; k < 2; ++k) dst[n][k] = *(const PG8_LAS frag_t*)(lds + PG8_SB(b, h) + boff + n * 2048 + k * 1024); } while (0)
#define PG8_MMA(ai, bj, At, Bt) do { __builtin_amdgcn_s_setprio(1); _Pragma("unroll") for (int m = 0; m < 4; ++m) _Pragma("unroll") for (int n = 0; n < 2; ++n) _Pragma("unroll") for (int k = 0; k < 2; ++k) { \
        if constexpr (F8) { acc[ai][bj][m][n] = __builtin_amdgcn_mfma_f32_16x16x32_fp8_fp8(Bt[n][k][0], At[m][k][0], acc[ai][bj][m][n], 0, 0, 0); \
            acc[ai][bj][m][n] = __builtin_amdgcn_mfma_f32_16x16x32_fp8_fp8(Bt[n][k][1], At[m][k][1], acc[ai][bj][m][n], 0, 0, 0); } \
        else { if constexpr (!F8) acc[ai][bj][m][n] = __builtin_amdgcn_mfma_f32_16x16x32_bf16(Bt[n][k], At[m][k], acc[ai][bj][m][n], 0, 0, 0); } } __builtin_amdgcn_s_setprio(0); } while (0)
#define PG8_WAIT_V(n) asm volatile("s_waitcnt vmcnt(" #n ")" ::: "memory")
#define PG8_WAIT_L(n) asm volatile("s_waitcnt lgkmcnt(" #n ")" ::: "memory")
#define PG8_BAR __builtin_amdgcn_s_barrier()
#define PG8_SCHED __builtin_amdgcn_sched_barrier(0)
    Unit cur, nxt; int ui = 0;
    if (!S.next(0, cur)) return;
    f32x4 acc[2][2][4][2];
#pragma unroll
    for (int a = 0; a < 2; ++a)
#pragma unroll
        for (int b = 0; b < 2; ++b)
#pragma unroll
            for (int m = 0; m < 4; ++m)
#pragma unroll
                for (int n = 0; n < 2; ++n) acc[a][b][m][n] = (f32x4){0.f, 0.f, 0.f, 0.f};
    typedef long pg8_l2 __attribute__((ext_vector_type(2)));
    typedef typename std::conditional<F8, pg8_l2, bf16x8>::type frag_t;
    frag_t At[4][2], B0[2][2], B1[2][2];
    const char* cA = (const char*)g.A + (size_t)cur.pm * tstepA; const char* cB = (const char*)g.Bt + (size_t)cur.pn * tstepB;
    S.a_ready(cur);
    PG8_STAGE(PG8_SB(0, 0), cB, voffB); PG8_STAGE(PG8_SA(0, 0), cA, voffA); PG8_STAGE(PG8_SB(0, 1), cB + hstepB, voffB); PG8_STAGE(PG8_SA(0, 1), cA + hstepA, voffA);
    if (wr == 1) PG8_BAR;
    PG8_WAIT_V(4); PG8_BAR;
    PG8_STAGE(PG8_SB(1, 0), cB + kstep, voffB); PG8_STAGE(PG8_SA(1, 0), cA + kstep, voffA); PG8_STAGE(PG8_SB(1, 1), cB + hstepB + kstep, voffB);
    PG8_WAIT_V(6); PG8_BAR;
    for (;;) {
        const bool has_next = S.next(ui + 1, nxt);
        const char* nA = has_next ? (const char*)g.A + (size_t)nxt.pm * tstepA : cA; const char* nB = has_next ? (const char*)g.Bt + (size_t)nxt.pn * tstepB : cB;
        for (int t = 0; t < nt; t += 2) {
            const bool last = (t == nt - 2);
            const char* a1 = cA + (size_t)(t + 1) * kstep;
            const char* a2 = last ? nA : cA + (size_t)(t + 2) * kstep; const char* b2 = last ? nB : cB + (size_t)(t + 2) * kstep;
            const char* a3 = a2 + kstep; const char* b3 = b2 + kstep;
            if (last && has_next) S.a_ready(nxt);
            PG8_LDB(B0, 0, 0); PG8_SCHED; PG8_LDA(At, 0, 0); PG8_STAGE(PG8_SA(1, 1), a1 + hstepA, voffA);
            PG8_WAIT_L(8); PG8_BAR; PG8_WAIT_L(0); PG8_MMA(0, 0, At, B0); PG8_BAR; PG8_SCHED;
            PG8_LDB(B1, 0, 1); PG8_STAGE(PG8_SB(0, 0), b2, voffB);
            PG8_BAR; PG8_WAIT_L(0); PG8_MMA(0, 1, At, B1); PG8_BAR;
            PG8_LDA(At, 0, 1); PG8_STAGE(PG8_SA(0, 0), a2, voffA);
            PG8_BAR; PG8_WAIT_L(0); PG8_MMA(1, 0, At, B0); PG8_BAR; PG8_SCHED;
            PG8_STAGE(PG8_SB(0, 1), b2 + hstepB, voffB);
            PG8_WAIT_V(6); PG8_BAR; PG8_MMA(1, 1, At, B1); PG8_BAR;
            PG8_LDB(B0, 1, 0); PG8_SCHED; PG8_LDA(At, 1, 0); PG8_STAGE(PG8_SA(0, 1), a2 + hstepA, voffA);
            PG8_WAIT_L(8); PG8_BAR; PG8_WAIT_L(0); PG8_MMA(0, 0, At, B0); PG8_BAR; PG8_SCHED;
            PG8_LDB(B1, 1, 1); PG8_STAGE(PG8_SB(1, 0), b3, voffB);
            PG8_BAR; PG8_WAIT_L(0); PG8_MMA(0, 1, At, B1); PG8_BAR;
            PG8_LDA(At, 1, 1); PG8_STAGE(PG8_SA(1, 0), a3, voffA);
            PG8_BAR; PG8_WAIT_L(0); PG8_MMA(1, 0, At, B0); PG8_BAR; PG8_SCHED;
            PG8_STAGE(PG8_SB(1, 1), b3 + hstepB, voffB);
            PG8_WAIT_V(6); PG8_BAR; PG8_MMA(1, 1, At, B1); PG8_BAR;
        }
        if constexpr (!Epi::AFTER_DRAIN) { E(acc, cur, wr, wc, fr, fq); S.done(cur); }
        if (!has_next) break;
#pragma unroll
        for (int a = 0; a < 2; ++a)
#pragma unroll
            for (int b = 0; b < 2; ++b)
#pragma unroll
                for (int m = 0; m < 4; ++m)
#pragma unroll
                    for (int n = 0; n < 2; ++n) acc[a][b][m][n] = (f32x4){0.f, 0.f, 0.f, 0.f};
        cur = nxt; cA = nA; cB = nB; ++ui;
    }
    PG8_WAIT_V(0);
    if (wr == 0) PG8_BAR;
    PG8_BAR;
    if constexpr (Epi::AFTER_DRAIN) { E.fused(acc, cur, wr, wc, fr, fq, lds, wid, lane); S.done(cur); }
#undef PG8_SA
#undef PG8_SB
#undef PG8_STAGE
#undef PG8_LDA
#undef PG8_LDB
#undef PG8_MMA
#undef PG8_WAIT_V
#undef PG8_WAIT_L
#undef PG8_BAR
#undef PG8_SCHED
}
}

typedef unsigned short bf16_t;
typedef short bf16x8 __attribute__((ext_vector_type(8)));
typedef short s16x4 __attribute__((ext_vector_type(4)));
typedef float f32x2 __attribute__((ext_vector_type(2)));
typedef float f32x4 __attribute__((ext_vector_type(4)));
typedef float f32x16 __attribute__((ext_vector_type(16)));
typedef unsigned u32x2 __attribute__((ext_vector_type(2)));
typedef unsigned u32x4 __attribute__((ext_vector_type(4)));
typedef __bf16 bf16v2 __attribute__((ext_vector_type(2)));

constexpr int NB = 4, SEQ = 4096, NT = NB * SEQ, DM = 2048;
constexpr int NPROJ = 7936;
constexpr int NCMP = 255;
constexpr float QSCALE = 0.125f * 1.4426950408889634f;
constexpr float LOG2E = 1.4426950408889634f;
constexpr float NEGBIG = -1e30f;
constexpr float OATT_SCALE = 64.f, Y2_SCALE = 16.f, MIX_SCALE = 64.f;

constexpr size_t WS_BAR   = 0;
constexpr size_t WS_MOD   = 65536;
constexpr size_t WS_CB    = WS_MOD + 196608;
constexpr size_t WS_A16   = WS_CB + 2048;
constexpr size_t WS_W     = 327680;
constexpr size_t WS_WIN   = WS_W;
constexpr size_t WS_WGLU  = WS_WIN + (size_t)NPROJ * 2048 * 2;
constexpr size_t WS_WUA   = WS_WGLU + 2097152;
constexpr size_t WS_WUS   = WS_WUA + 4194304;
constexpr size_t WS_WOUT  = WS_WUS + 4194304;
constexpr size_t WS_WQ    = WS_WOUT + 8388608;
constexpr size_t WS_KBD   = WS_WQ + 8388608;
constexpr size_t WS_WSC   = WS_KBD + 8388608;
constexpr size_t WS_WC1   = WS_WSC + 8388608;
constexpr size_t WS_S5B1  = WS_WC1 + 2097152;
constexpr size_t WS_S5B2  = WS_S5B1 + 8388608;
constexpr size_t WS_HID   = WS_S5B2 + 12582912;
constexpr size_t WS_CKV   = WS_HID + 4194304;
constexpr size_t WS_GATE  = WS_CKV + 1048576;
constexpr size_t WS_SELM  = WS_GATE + 3145728;
constexpr size_t WS_RA    = WS_SELM + 524288;
constexpr size_t WS_RB    = WS_RA + 67108864;
constexpr size_t WS_RC    = WS_RB + 134217728;
constexpr size_t WS_RD    = WS_RC + 134217728;
constexpr size_t WS_END   = WS_RD + 134217728;
constexpr size_t WS_H = WS_RA, WS_HSC = WS_RD + 104857600  , WS_OC = WS_RA, WS_OW = WS_RA + 33554432, WS_MIX = WS_RA, WS_H2 = WS_RA;
constexpr size_t WS_MG = WS_RB, WS_SC = WS_RB;
constexpr size_t WS_Q = WS_RC, WS_KV = WS_RC + 33554432, WS_A2 = WS_KV + 6 * 8388608, WS_X1 = WS_RC;
constexpr size_t WS_XL = WS_RD, WS_YACT = WS_RD + 33554432, WS_Y2 = WS_RD + 67108864, WS_OATT = WS_RD + 100663296, WS_TMP = WS_RD, WS_PU = WS_RD, WS_PV = WS_RD + 33554432, WS_PSU = WS_RD + 67108864, WS_PSV = WS_RD + 67108864 + 65536, WS_EX = WS_RD + 68157440, WS_GT = WS_EX + 8388608, WS_SS = WS_GT + 8388608, WS_SU = WS_SS + 1048576, WS_PA = WS_RB;

constexpr int LDS_BYTES = 147456;
constexpr int LDS_MISC = 131072;

struct Params {
    const float* x; const float* c; const float* ada_w; const float* ada_b; const float* norm_mix_g; const float* norm_ffn_g; const float* w_in;
    const float* cmp_pos; const float* cmp_w1; const float* cmp_b1; const float* cmp_w2; const float* cmp_b2; const float* rel_bias;
    const float* s5_lam_re; const float* s5_lam_im; const float* s5_log_step; const float* s5_b_re; const float* s5_b_im; const float* s5_c_re; const float* s5_c_im; const float* s5_d;
    const float* glu_w; const float* glu_b; const float* w_up_attn; const float* w_up_ssm; const float* w_out; const float* peer_w_q; const float* peer_sub_keys;
    const float* peer_u; const float* peer_v; const float* final_g;
    float* out; unsigned char* ws; int ph_lo, ph_hi;
};

#define DI __device__ __forceinline__
DI unsigned pk_bf16(float lo, float hi) { bf16v2 v; v[0] = (__bf16)lo; v[1] = (__bf16)hi; return __builtin_bit_cast(unsigned, v); }
DI bf16_t f2bf(float x) { return (bf16_t)(pk_bf16(x, 0.f) & 0xffffu); }
DI float bf_lo(unsigned u) { return __uint_as_float(u << 16); }
DI float bf_hi(unsigned u) { return __uint_as_float(u & 0xffff0000u); }
DI float bf2f(bf16_t b) { return __uint_as_float(((unsigned)b) << 16); }
DI bf16v2 bf16pair(unsigned w) { return __builtin_bit_cast(bf16v2, w); }
DI float dot2_bf16(unsigned w, unsigned x, float acc) { return __builtin_amdgcn_fdot2_f32_bf16(__builtin_bit_cast(bf16v2, w), __builtin_bit_cast(bf16v2, x), acc, false); }
DI float sigm(float x) { return __builtin_amdgcn_rcpf(1.f + __builtin_amdgcn_exp2f(-1.4426950408889634f * x)); }
DI float gelu_tanh(float x) { const float u = 1.5957691216f * (x + 0.044715f * x * x * x); return x * __builtin_amdgcn_rcpf(1.f + __builtin_amdgcn_exp2f(-1.4426950408889634f * u)); }
DI float xor32_add(float x) { const auto r = __builtin_amdgcn_permlane32_swap(__float_as_uint(x), __float_as_uint(x), false, false); return __uint_as_float(r[0]) + __uint_as_float(r[1]); }
DI float xor16_add(float x) { const auto r = __builtin_amdgcn_permlane16_swap(__float_as_uint(x), __float_as_uint(x), false, false); return __uint_as_float(r[0]) + __uint_as_float(r[1]); }
DI float xor32_max(float x) { const auto r = __builtin_amdgcn_permlane32_swap(__float_as_uint(x), __float_as_uint(x), false, false); return fmaxf(__uint_as_float(r[0]), __uint_as_float(r[1])); }
DI float row16_sum(float v) {
    asm volatile("s_nop 1\n\tv_add_f32_dpp %0, %0, %0 quad_perm:[1,0,3,2] row_mask:0xf bank_mask:0xf\n\ts_nop 1\n\tv_add_f32_dpp %0, %0, %0 quad_perm:[2,3,0,1] row_mask:0xf bank_mask:0xf\n\t"
                 "s_nop 1\n\tv_add_f32_dpp %0, %0, %0 row_half_mirror row_mask:0xf bank_mask:0xf\n\ts_nop 1\n\tv_add_f32_dpp %0, %0, %0 row_mirror row_mask:0xf bank_mask:0xf\n\ts_nop 1" : "+v"(v));
    return v; }
DI float wave_sum(float v) { return xor32_add(xor16_add(row16_sum(v))); }
DI float reduce8_row16(const float (&v)[8], int li) {
    const bool b3 = (li & 8) != 0, b2 = (li & 4) != 0, b1 = (li & 2) != 0; float t[4], u[2], w, z;
#pragma unroll
    for (int k = 0; k < 4; ++k) { const float keep = b3 ? v[4 + k] : v[k], send = b3 ? v[k] : v[4 + k];
        asm volatile("s_nop 1\n\tv_add_f32_dpp %0, %1, %2 row_mirror row_mask:0xf bank_mask:0xf" : "=v"(t[k]) : "v"(send), "v"(keep)); }
#pragma unroll
    for (int k = 0; k < 2; ++k) { const float keep = b2 ? t[2 + k] : t[k], send = b2 ? t[k] : t[2 + k];
        asm volatile("s_nop 1\n\tv_add_f32_dpp %0, %1, %2 row_half_mirror row_mask:0xf bank_mask:0xf" : "=v"(u[k]) : "v"(send), "v"(keep)); }
    { const float keep = b1 ? u[1] : u[0], send = b1 ? u[0] : u[1];
      asm volatile("s_nop 1\n\tv_add_f32_dpp %0, %1, %2 quad_perm:[3,2,1,0] row_mask:0xf bank_mask:0xf" : "=v"(w) : "v"(send), "v"(keep)); }
    asm volatile("s_nop 1\n\tv_add_f32_dpp %0, %1, %1 quad_perm:[1,0,3,2] row_mask:0xf bank_mask:0xf" : "=v"(z) : "v"(w));
    return z; }
DI unsigned row16_max_u32(unsigned v) {
    asm volatile("s_nop 1\n\tv_max_u32_dpp %0, %0, %0 quad_perm:[1,0,3,2] row_mask:0xf bank_mask:0xf\n\ts_nop 1\n\tv_max_u32_dpp %0, %0, %0 quad_perm:[2,3,0,1] row_mask:0xf bank_mask:0xf\n\t"
                 "s_nop 1\n\tv_max_u32_dpp %0, %0, %0 row_half_mirror row_mask:0xf bank_mask:0xf\n\ts_nop 1\n\tv_max_u32_dpp %0, %0, %0 row_mirror row_mask:0xf bank_mask:0xf\n\ts_nop 1" : "+v"(v));
    return v; }
DI unsigned wave_max_u32(unsigned v) {
    v = row16_max_u32(v);
    { const auto r = __builtin_amdgcn_permlane16_swap(v, v, false, false); v = max(r[0], r[1]); }
    { const auto r = __builtin_amdgcn_permlane32_swap(v, v, false, false); v = max(r[0], r[1]); }
    return (unsigned)__builtin_amdgcn_readfirstlane((int)v); }
DI unsigned mono_u32(float x) { const unsigned b = __float_as_uint(x); return b ^ (((int)b >> 31) | 0x80000000u); }
DI void store8_bf16(bf16_t* p, f32x4 a, f32x4 b) { u32x4 w; w[0] = pk_bf16(a[0], a[1]); w[1] = pk_bf16(a[2], a[3]); w[2] = pk_bf16(b[0], b[1]); w[3] = pk_bf16(b[2], b[3]); *(u32x4*)p = w; }
DI float clamp448(float x) { return __builtin_amdgcn_fmed3f(x, -448.f, 448.f); }
DI void store8_fp8(unsigned char* p, f32x4 a, f32x4 b, float sc) {
    int p0 = __builtin_amdgcn_cvt_pk_fp8_f32(clamp448(a[0] * sc), clamp448(a[1] * sc), 0, false); p0 = __builtin_amdgcn_cvt_pk_fp8_f32(clamp448(a[2] * sc), clamp448(a[3] * sc), p0, true);
    int p1 = __builtin_amdgcn_cvt_pk_fp8_f32(clamp448(b[0] * sc), clamp448(b[1] * sc), 0, false); p1 = __builtin_amdgcn_cvt_pk_fp8_f32(clamp448(b[2] * sc), clamp448(b[3] * sc), p1, true);
    u32x2 w; w[0] = (unsigned)p0; w[1] = (unsigned)p1; *(u32x2*)p = w; }
DI void load8_bf16(const bf16_t* p, f32x4& a, f32x4& b) { const u32x4 w = *(const u32x4*)p; a = (f32x4){bf_lo(w[0]), bf_hi(w[0]), bf_lo(w[1]), bf_hi(w[1])}; b = (f32x4){bf_lo(w[2]), bf_hi(w[2]), bf_lo(w[3]), bf_hi(w[3])}; }

#define EPI_ROWS(ai, m) for (int ai = 0; ai < 2; ++ai) for (int m = 0; m < 4; ++m)
struct EpiProj {
    static constexpr bool PERM = true, AFTER_DRAIN = false;
    unsigned char* ws; const float* hsc;
    DI void operator()(const f32x4 (&acc)[2][2][4][2], const pg8::Unit& u, int wr, int wc, int fr, int fq) const {
        const int pn = u.pn;
#pragma unroll
        for (int ai = 0; ai < 2; ++ai)
#pragma unroll
            for (int m = 0; m < 4; ++m) {
                const int row = u.pm * 256 + ai * 128 + wr * 64 + m * 16 + fr;
                const int b = row >> 12, t = row & 4095; const float rsc = hsc[row] * (1.f / 2048.f);
#pragma unroll
                for (int bj = 0; bj < 2; ++bj) {
                    const int c8 = bj * 128 + wc * 32 + fq * 8;
                    f32x4 v0 = acc[ai][bj][m][0] * rsc, v1 = acc[ai][bj][m][1] * rsc;
                    if (pn < 4) {
                        store8_bf16((bf16_t*)(ws + WS_Q) + (size_t)row * 1024 + pn * 256 + c8, v0 * QSCALE, v1 * QSCALE);
                    } else if (pn < 10) {
                        const int k = c8 >> 6, dd = c8 & 63;
                        store8_bf16((bf16_t*)(ws + WS_KV) + (size_t)(pn - 4) * 4194304 + ((size_t)((b * 4 + k) * 4096 + t)) * 64 + dd, v0, v1);
                    } else if (pn < 14) {
                        const int cu = (pn - 10) * 256 + c8, g = cu >> 4, h0 = cu & 15;
                        store8_bf16((bf16_t*)(ws + WS_A2) + ((size_t)(g * 1024 + b * 256 + (t >> 4))) * 384 + (t & 15) * 16 + h0, v0, v1);
                    } else if (pn < 30) {
                        f32x4 s0, s1;
#pragma unroll
                        for (int e = 0; e < 4; ++e) { s0[e] = sigm(v0[e]); s1[e] = sigm(v1[e]); }
                        store8_bf16((bf16_t*)(ws + WS_MG) + (size_t)row * 4096 + (pn - 14) * 256 + c8, s0, s1);
                    } else {
                        if (c8 < 48) { float* gp = (float*)(ws + WS_GATE) + (size_t)row * 48 + c8; f32x4 s0, s1;
#pragma unroll
                            for (int e = 0; e < 4; ++e) { s0[e] = sigm(v0[e]); s1[e] = sigm(v1[e]); }
                            *(f32x4*)gp = s0; *(f32x4*)(gp + 4) = s1; }
                    }
                }
            }
    }
};
struct EpiBf16Plain {
    static constexpr bool PERM = true, AFTER_DRAIN = false;
    bf16_t* O; int ldc;
    DI void operator()(const f32x4 (&acc)[2][2][4][2], const pg8::Unit& u, int wr, int wc, int fr, int fq) const {
#pragma unroll
        for (int ai = 0; ai < 2; ++ai)
#pragma unroll
            for (int m = 0; m < 4; ++m) { const int row = u.pm * 256 + ai * 128 + wr * 64 + m * 16 + fr;
#pragma unroll
                for (int bj = 0; bj < 2; ++bj) { const int col = u.pn * 256 + bj * 128 + wc * 32 + fq * 8; store8_bf16(O + (size_t)row * ldc + col, acc[ai][bj][m][0], acc[ai][bj][m][1]); } }
    }
};
struct EpiCmp1 {
    static constexpr bool PERM = true, AFTER_DRAIN = false;
    bf16_t* O; const float* bias;
    DI void operator()(const f32x4 (&acc)[2][2][4][2], const pg8::Unit& u, int wr, int wc, int fr, int fq) const {
        const float* bi = bias + (u.pm >> 4) * 256;
#pragma unroll
        for (int ai = 0; ai < 2; ++ai)
#pragma unroll
            for (int m = 0; m < 4; ++m) { const int row = u.pm * 256 + ai * 128 + wr * 64 + m * 16 + fr;
#pragma unroll
                for (int bj = 0; bj < 2; ++bj) { const int col = bj * 128 + wc * 32 + fq * 8; f32x4 v0 = acc[ai][bj][m][0] + *(const f32x4*)(bi + col), v1 = acc[ai][bj][m][1] + *(const f32x4*)(bi + col + 4);
#pragma unroll
                    for (int e = 0; e < 4; ++e) { v0[e] = gelu_tanh(v0[e]); v1[e] = gelu_tanh(v1[e]); }
                    store8_bf16(O + (size_t)row * 256 + col, v0, v1); } }
    }
};
struct EpiS5G1 {
    static constexpr bool PERM = false, AFTER_DRAIN = false;
    float* X;
    DI void operator()(const f32x4 (&acc)[2][2][4][2], const pg8::Unit& u, int wr, int wc, int fr, int fq) const {
#pragma unroll
        for (int ai = 0; ai < 2; ++ai)
#pragma unroll
            for (int m = 0; m < 4; ++m) { const int row = u.pm * 256 + ai * 128 + wr * 64 + m * 16 + fr;
#pragma unroll
                for (int n = 0; n < 2; ++n) { const int col = wc * 32 + n * 16 + fq * 4; *(f32x4*)(X + (size_t)row * 128 + col) = acc[ai][0][m][n]; } }
    }
};
struct EpiS5G2 {
    static constexpr bool PERM = true, AFTER_DRAIN = false;
    bf16_t* Y;
    DI void operator()(const f32x4 (&acc)[2][2][4][2], const pg8::Unit& u, int wr, int wc, int fr, int fq) const {
        const int g = u.pm >> 2;
#pragma unroll
        for (int ai = 0; ai < 2; ++ai)
#pragma unroll
            for (int m = 0; m < 4; ++m) { const int rg = (u.pm & 3) * 256 + ai * 128 + wr * 64 + m * 16 + fr;
                const int b = rg >> 8, ch = rg & 255;
#pragma unroll
                for (int bj = 0; bj < 2; ++bj) { const int c8 = bj * 128 + wc * 32 + fq * 8, tau = c8 >> 4, h0 = c8 & 15; f32x4 v0 = acc[ai][bj][m][0], v1 = acc[ai][bj][m][1];
#pragma unroll
                    for (int e = 0; e < 4; ++e) { v0[e] = gelu_tanh(v0[e]); v1[e] = gelu_tanh(v1[e]); }
                    store8_bf16(Y + ((size_t)(b * 4096 + ch * 16 + tau)) * 1024 + g * 16 + h0, v0, v1); } }
    }
};
struct EpiGlu {
    static constexpr bool PERM = true, AFTER_DRAIN = false;
    const bf16_t* Y; bf16_t* O; const float* bias;
    DI void operator()(const f32x4 (&acc)[2][2][4][2], const pg8::Unit& u, int wr, int wc, int fr, int fq) const {
#pragma unroll
        for (int bj = 0; bj < 2; ++bj) { const int col = u.pn * 256 + bj * 128 + wc * 32 + fq * 8; const f32x4 b0 = *(const f32x4*)(bias + col), b1 = *(const f32x4*)(bias + col + 4);
            u32x4 yv[8];
#pragma unroll
            for (int q = 0; q < 8; ++q) { const int row = u.pm * 256 + (q >> 2) * 128 + wr * 64 + (q & 3) * 16 + fr; yv[q] = *(const u32x4*)(Y + (size_t)row * 1024 + col); }
#pragma unroll
            for (int q = 0; q < 8; ++q) { const int ai = q >> 2, m = q & 3, row = u.pm * 256 + ai * 128 + wr * 64 + m * 16 + fr;
                const f32x4 y0 = (f32x4){bf_lo(yv[q][0]), bf_hi(yv[q][0]), bf_lo(yv[q][1]), bf_hi(yv[q][1])}, y1 = (f32x4){bf_lo(yv[q][2]), bf_hi(yv[q][2]), bf_lo(yv[q][3]), bf_hi(yv[q][3])};
                f32x4 v0 = acc[ai][bj][m][0] + b0, v1 = acc[ai][bj][m][1] + b1;
#pragma unroll
                for (int e = 0; e < 4; ++e) { v0[e] = y0[e] * sigm(v0[e]); v1[e] = y1[e] * sigm(v1[e]); }
                store8_fp8((unsigned char*)O + (size_t)row * 1024 + col, v0, v1, Y2_SCALE); } }
    }
};
template <int SECOND> struct EpiUp {
    static constexpr bool PERM = true, AFTER_DRAIN = false;
    const bf16_t* MG; const bf16_t* TMP; bf16_t* O; float ascale;
    DI void operator()(const f32x4 (&acc)[2][2][4][2], const pg8::Unit& u, int wr, int wc, int fr, int fq) const {
#pragma unroll
        for (int bj = 0; bj < 2; ++bj) { const int col = u.pn * 256 + bj * 128 + wc * 32 + fq * 8;
            u32x4 gv[8], tv[8];
#pragma unroll
            for (int q = 0; q < 8; ++q) { const int row = u.pm * 256 + (q >> 2) * 128 + wr * 64 + (q & 3) * 16 + fr; gv[q] = *(const u32x4*)(MG + (size_t)row * 4096 + SECOND * 2048 + col);
                if (SECOND) tv[q] = *(const u32x4*)(TMP + (size_t)row * 2048 + col); }
#pragma unroll
            for (int q = 0; q < 8; ++q) { const int ai = q >> 2, m = q & 3, row = u.pm * 256 + ai * 128 + wr * 64 + m * 16 + fr;
                const f32x4 g0 = (f32x4){bf_lo(gv[q][0]), bf_hi(gv[q][0]), bf_lo(gv[q][1]), bf_hi(gv[q][1])}, g1 = (f32x4){bf_lo(gv[q][2]), bf_hi(gv[q][2]), bf_lo(gv[q][3]), bf_hi(gv[q][3])};
                f32x4 v0 = acc[ai][bj][m][0] * (g0 * ascale), v1 = acc[ai][bj][m][1] * (g1 * ascale);
                if (SECOND) { v0 += (f32x4){bf_lo(tv[q][0]), bf_hi(tv[q][0]), bf_lo(tv[q][1]), bf_hi(tv[q][1])}; v1 += (f32x4){bf_lo(tv[q][2]), bf_hi(tv[q][2]), bf_lo(tv[q][3]), bf_hi(tv[q][3])};
                    store8_fp8((unsigned char*)O + (size_t)row * 2048 + col, v0, v1, MIX_SCALE); }
                else store8_bf16(O + (size_t)row * 2048 + col, v0, v1); } }
    }
};
struct EpiOut {
    static constexpr bool PERM = false, AFTER_DRAIN = false;
    const float* X; const float* mod; float* O;
    DI void operator()(const f32x4 (&acc)[2][2][4][2], const pg8::Unit& u, int wr, int wc, int fr, int fq) const {
        const float* g1 = mod + ((u.pm * 256) >> 12) * 12288 + 4096;
#pragma unroll
        for (int bj = 0; bj < 2; ++bj)
#pragma unroll
            for (int n = 0; n < 2; ++n) { const int col = u.pn * 256 + bj * 128 + wc * 32 + n * 16 + fq * 4; const f32x4 gg = *(const f32x4*)(g1 + col) * (1.f / (MIX_SCALE * 2048.f));
                f32x4 xv[8];
#pragma unroll
                for (int q = 0; q < 8; ++q) { const int row = u.pm * 256 + (q >> 2) * 128 + wr * 64 + (q & 3) * 16 + fr; xv[q] = *(const f32x4*)(X + (size_t)row * 2048 + col); }
#pragma unroll
                for (int q = 0; q < 8; ++q) { const int ai = q >> 2, m = q & 3, row = u.pm * 256 + ai * 128 + wr * 64 + m * 16 + fr;
                    *(f32x4*)(O + (size_t)row * 2048 + col) = xv[q] + gg * acc[ai][bj][m][n];
                } }
    }
};
struct EpiF32Plain {
    static constexpr bool PERM = false, AFTER_DRAIN = false;
    float* C; int ldc;
    DI void operator()(const f32x4 (&acc)[2][2][4][2], const pg8::Unit& u, int wr, int wc, int fr, int fq) const {
#pragma unroll
        for (int ai = 0; ai < 2; ++ai)
#pragma unroll
            for (int m = 0; m < 4; ++m) { const int row = u.pm * 256 + ai * 128 + wr * 64 + m * 16 + fr;
#pragma unroll
                for (int bj = 0; bj < 2; ++bj)
#pragma unroll
                    for (int n = 0; n < 2; ++n) { const int col = u.pn * 256 + bj * 128 + wc * 32 + n * 16 + fq * 4; *(f32x4*)(C + (size_t)row * ldc + col) = acc[ai][bj][m][n]; } }
    }
};
struct GroupOrder {
    int n, G, c, div;
    DI bool next(int i, pg8::Unit& u) const { const int L = i * G + c; if (L >= n) return false; u.pm = L; u.pn = L / div; return true; }
    DI void a_ready(const pg8::Unit&) const {}
    DI void done(const pg8::Unit&) const {}
};

template <int MODE> DI int src_col(int n) {
    if (MODE == 0) return n;
    if (n < 2560) return n; if (n < 7680) return n + 48; if (n < 7728) return n - 7680 + 2560; return -1; }
template <int MODE, bool F8OUT = false> DI void tconv_tiles(const float* __restrict__ src, int ld, int K, int Nd, bf16_t* __restrict__ dst, LAS float* tile, int first, int stride, float f8scale = 1.f) {
    const int tid = threadIdx.x, ntk = K >> 6, ntot = ntk * (Nd >> 6);
    for (int it = first; it < ntot; it += stride) {
        const int n0 = (it / ntk) << 6, k0 = (it % ntk) << 6;
        __syncthreads();
        { const int j = tid & 63, i0 = tid >> 6, sc = src_col<MODE>(n0 + j);
#pragma unroll
          for (int rr = 0; rr < 8; ++rr) { const int i = i0 + 8 * rr; tile[i * 65 + j] = sc >= 0 ? src[(size_t)(k0 + i) * ld + sc] : 0.f; } }
        __syncthreads();
        { const int jj = tid >> 3, ii0 = (tid & 7) * 8; float v[8];
#pragma unroll
          for (int e = 0; e < 8; ++e) v[e] = tile[(ii0 + e) * 65 + jj];
          if constexpr (F8OUT) { int p0 = __builtin_amdgcn_cvt_pk_fp8_f32(clamp448(v[0] * f8scale), clamp448(v[1] * f8scale), 0, false); p0 = __builtin_amdgcn_cvt_pk_fp8_f32(clamp448(v[2] * f8scale), clamp448(v[3] * f8scale), p0, true);
              int p1 = __builtin_amdgcn_cvt_pk_fp8_f32(clamp448(v[4] * f8scale), clamp448(v[5] * f8scale), 0, false); p1 = __builtin_amdgcn_cvt_pk_fp8_f32(clamp448(v[6] * f8scale), clamp448(v[7] * f8scale), p1, true);
              u32x2 w; w[0] = (unsigned)p0; w[1] = (unsigned)p1; *(u32x2*)((unsigned char*)dst + (size_t)(n0 + jj) * K + k0 + ii0) = w; }
          else { u32x4 w; w[0] = pk_bf16(v[0], v[1]); w[1] = pk_bf16(v[2], v[3]); w[2] = pk_bf16(v[4], v[5]); w[3] = pk_bf16(v[6], v[7]);
              *(u32x4*)(dst + (size_t)(n0 + jj) * K + k0 + ii0) = w; } }
    }
}
DI void conv_bf16_flat(const float* __restrict__ src, bf16_t* __restrict__ dst, size_t n8  , size_t first, size_t stride) {
    for (size_t i = first; i < n8; i += stride) { const f32x4 a = *(const f32x4*)(src + i * 8), b = *(const f32x4*)(src + i * 8 + 4); store8_bf16(dst + i * 8, a, b); }
}

DI void conv_rows_fp8(const float* __restrict__ src, unsigned char* __restrict__ dst, float* __restrict__ inv_scale, int nrows) {
    const int lane = threadIdx.x & 63, wave = __builtin_amdgcn_readfirstlane(threadIdx.x >> 6);
    for (int row = blockIdx.x * 8 + wave; row < nrows; row += gridDim.x * 8) {
        const float* sr = src + (size_t)row * 2048; f32x4 v[8]; float am = 0.f;
#pragma unroll
        for (int k = 0; k < 8; ++k) { v[k] = *(const f32x4*)(sr + k * 256 + lane * 4); am = fmaxf(am, fmaxf(fmaxf(fabsf(v[k][0]), fabsf(v[k][1])), fmaxf(fabsf(v[k][2]), fabsf(v[k][3])))); }
#pragma unroll
        for (int o = 32; o >= 1; o >>= 1) am = fmaxf(am, __shfl_xor(am, o));
        const float sc = am > 0.f ? 448.f / am : 1.f;
#pragma unroll
        for (int k = 0; k < 8; ++k) { int p = __builtin_amdgcn_cvt_pk_fp8_f32(v[k][0] * sc, v[k][1] * sc, 0, false); p = __builtin_amdgcn_cvt_pk_fp8_f32(v[k][2] * sc, v[k][3] * sc, p, true);
            *(unsigned*)(dst + (size_t)k * 4194304 + (size_t)row * 256 + lane * 4) = (unsigned)p; }
        if (lane == 0) inv_scale[row] = am > 0.f ? am / 448.f : 1.f;
    }
}

DI void p0_prologue(const Params& P, LAS unsigned char* lds) {
    unsigned char* ws = P.ws; const int tid = threadIdx.x, G = gridDim.x, bx = blockIdx.x;
    LAS float* fl = (LAS float*)lds;
    {
        LAS float* sc = fl;
        LAS float* red = fl + 8192;
        for (int i = tid; i < 8192; i += 512) { const float v = P.c[i]; sc[i] = v / (1.f + __expf(-v)); }
        __syncthreads();
        for (int it = bx; it < 192 + 8; it += G) {
            const bool is_cb = it >= 192;
            const int col = tid & 63, kg = tid >> 6;
            float a0 = 0.f, a1 = 0.f, a2 = 0.f, a3 = 0.f;
            if (!is_cb) {
                const float* wp = P.ada_w + (size_t)(kg * 256) * 12288 + it * 64 + col;
#pragma unroll 8
                for (int j = 0; j < 256; ++j) { const float w = wp[(size_t)j * 12288]; const int jj = kg * 256 + j; a0 += sc[jj] * w; a1 += sc[2048 + jj] * w; a2 += sc[4096 + jj] * w; a3 += sc[6144 + jj] * w; }
            } else {
                const int i = (it - 192) >> 2, c0 = ((it - 192) & 3) * 64;
                const float* wp = P.cmp_w1 + (size_t)i * 2048 * 256 + (size_t)(kg * 256) * 256 + c0 + col; const float* pp = P.cmp_pos + i * 2048 + kg * 256;
#pragma unroll 8
                for (int j = 0; j < 256; ++j) a0 += pp[j] * wp[(size_t)j * 256];
            }
            red[(kg * 4 + 0) * 64 + col] = a0; red[(kg * 4 + 1) * 64 + col] = a1; red[(kg * 4 + 2) * 64 + col] = a2; red[(kg * 4 + 3) * 64 + col] = a3;
            __syncthreads();
            if (tid < 256) { const int b = tid >> 6, cc = tid & 63; float s = 0.f;
#pragma unroll
                for (int q = 0; q < 8; ++q) s += red[(q * 4 + b) * 64 + cc];
                if (!is_cb) ((float*)(ws + WS_MOD))[b * 12288 + it * 64 + cc] = s + P.ada_b[it * 64 + cc];
                else if (b == 0) { const int i = (it - 192) >> 2, c0 = ((it - 192) & 3) * 64; ((float*)(ws + WS_CB))[i * 256 + c0 + cc] = s + P.cmp_b1[i * 256 + c0 + cc]; } }
            __syncthreads();
        }
    }
    for (int g4 = bx; g4 < 256; g4 += G) {
        const int g = g4 >> 2, part = g4 & 3;
        LAS double* pw = (LAS double*)lds;
        LAS double* ff = pw + 17 * 64 * 2;
        LAS double* bb = ff + 128;
        LAS float* cc = (LAS float*)(bb + 2048);
        LAS float* kern = cc + 2048;
        __syncthreads();
        const double step = exp((double)P.s5_log_step[g]);
        for (int i = tid; i < 17 * 64; i += 512) { const int p = i & 63, dl = i >> 6; const double lr = P.s5_lam_re[g * 64 + p], li = P.s5_lam_im[g * 64 + p];
            const double mag = exp(dl * lr * step), ang = dl * li * step; const double cr = mag * cos(ang), ci = mag * sin(ang);
            pw[i * 2] = cr; pw[i * 2 + 1] = ci;
            if (dl == 1) { const double nr = cr - 1.0, den = lr * lr + li * li; ff[p * 2] = (nr * lr + ci * li) / den; ff[p * 2 + 1] = (ci * lr - nr * li) / den; }
            if (dl == 16 && part == 0) { float* a16 = (float*)(ws + WS_A16) + (g * 64 + p) * 2; a16[0] = (float)cr; a16[1] = (float)ci; } }
        for (int i = tid; i < 1024; i += 512) { const int h = i >> 6, p = i & 63; cc[i * 2] = P.s5_c_re[(g * 16 + h) * 64 + p]; cc[i * 2 + 1] = P.s5_c_im[(g * 16 + h) * 64 + p]; }
        __syncthreads();
        for (int i = tid; i < 1024; i += 512) { const int p = i >> 4; const double br = P.s5_b_re[g * 1024 + i], bi = P.s5_b_im[g * 1024 + i], fr = ff[p * 2], fi = ff[p * 2 + 1];
            bb[i * 2] = fr * br - fi * bi; bb[i * 2 + 1] = fr * bi + fi * br; }
        __syncthreads();
        for (int o1 = tid; o1 < 1024; o1 += 512) {
            const int dl = o1 >> 6, h = 4 * part + ((o1 >> 4) & 3), h2 = o1 & 15, o = (dl * 16 + h) * 16 + h2; double s = 0.0;
            for (int p = 0; p < 64; ++p) { const double cr = cc[(h * 64 + p) * 2], ci = cc[(h * 64 + p) * 2 + 1], ar = pw[(dl * 64 + p) * 2], ai = pw[(dl * 64 + p) * 2 + 1];
                const double zr = cr * ar - ci * ai, zi = cr * ai + ci * ar; s += zr * bb[(p * 16 + h2) * 2] - zi * bb[(p * 16 + h2) * 2 + 1]; }
            kern[o] = (float)s; }
        __syncthreads();
        bf16_t* B2 = (bf16_t*)(ws + WS_S5B2) + (size_t)g * 256 * 384;
        for (int i = tid; i < 64 * 384 / 2; i += 512) {
            const int rr = i / 192, c0 = (i % 192) * 2, tau = rr >> 2, h = 4 * part + (rr & 3), row = tau * 16 + h; float v[2];
#pragma unroll
            for (int e = 0; e < 2; ++e) { const int col = c0 + e; float x;
                if (col < 256) { const int s = col >> 4, h2 = col & 15; x = (s <= tau) ? kern[((tau - s) * 16 + h) * 16 + h2] : 0.f; if (s == tau && h2 == h) x += P.s5_d[g * 16 + h]; }
                else { const int p = (col - 256) & 63; const double cr = cc[(h * 64 + p) * 2], ci = cc[(h * 64 + p) * 2 + 1], ar = pw[((tau + 1) * 64 + p) * 2], ai = pw[((tau + 1) * 64 + p) * 2 + 1];
                    x = (col < 320) ? (float)(cr * ar - ci * ai) : (float)(-(cr * ai + ci * ar)); }
                v[e] = x; }
            *(unsigned*)(B2 + (size_t)row * 384 + c0) = pk_bf16(v[0], v[1]); }
        bf16_t* B1 = (bf16_t*)(ws + WS_S5B1) + (size_t)g * 256 * 256;
        for (int i = tid; i < 64 * 256 / 2; i += 512) {
            const int n = 64 * part + (i >> 7), c0 = (i & 127) * 2; float v[2];
#pragma unroll
            for (int e = 0; e < 2; ++e) { const int col = c0 + e, s = col >> 4, h = col & 15; float x = 0.f;
                if (n < 128) { const int p = n & 63; const double ar = pw[((15 - s) * 64 + p) * 2], ai = pw[((15 - s) * 64 + p) * 2 + 1], br = bb[(p * 16 + h) * 2], bi = bb[(p * 16 + h) * 2 + 1];
                    x = (n < 64) ? (float)(ar * br - ai * bi) : (float)(ar * bi + ai * br); }
                v[e] = x; }
            *(unsigned*)(B1 + (size_t)n * 256 + c0) = pk_bf16(v[0], v[1]); }
    }
    __syncthreads();
    LAS float* tile = fl;
    tconv_tiles<1, true>(P.w_in, 7728, 2048, NPROJ, (bf16_t*)(ws + WS_WIN), tile, bx, G, 2048.f);
    tconv_tiles<0>(P.glu_w, 1024, 1024, 1024, (bf16_t*)(ws + WS_WGLU), tile, bx, G);
    tconv_tiles<0, true>(P.w_up_attn, 2048, 1024, 2048, (bf16_t*)(ws + WS_WUA), tile, bx, G, 1024.f);
    tconv_tiles<0, true>(P.w_up_ssm, 2048, 1024, 2048, (bf16_t*)(ws + WS_WUS), tile, bx, G, 1024.f);
    tconv_tiles<0, true>(P.w_out, 2048, 2048, 2048, (bf16_t*)(ws + WS_WOUT), tile, bx, G, 2048.f);
    tconv_tiles<0>(P.cmp_w1, 256, 2048, 256, (bf16_t*)(ws + WS_WC1), tile, bx, G);
    tconv_tiles<0>(P.cmp_w1 + 2048 * 256, 256, 2048, 256, (bf16_t*)(ws + WS_WC1) + 256 * 2048, tile, bx, G);
    __syncthreads();
    const size_t gt = (size_t)bx * 512 + tid, gs = (size_t)G * 512;
    conv_bf16_flat(P.peer_w_q, (bf16_t*)(ws + WS_WQ), (size_t)2048 * 2048 / 8, gt, gs);
    { bf16_t* kb = (bf16_t*)(ws + WS_KBD);
      for (size_t i = gt; i < (size_t)2048 * 2048 / 8; i += gs) { const int row = (int)(i >> 8), k0 = (int)(i & 255) * 8, hc = row >> 7, n = row & 127;
          if ((k0 >> 7) == hc) { const float* s = P.peer_sub_keys + ((size_t)(hc * 128 + n)) * 128 + (k0 & 127); store8_bf16(kb + i * 8, *(const f32x4*)s, *(const f32x4*)(s + 4)); }
          else *(u32x4*)(kb + i * 8) = (u32x4){0u, 0u, 0u, 0u}; } }
}

DI void phase_norm(const float* __restrict__ X, const float* __restrict__ gain, const float* __restrict__ mod, int sh_off, int sc_off, bf16_t* __restrict__ H) {
    const int lane = threadIdx.x & 63, wave = __builtin_amdgcn_readfirstlane(threadIdx.x >> 6);
    for (int row = blockIdx.x * 8 + wave; row < NT; row += gridDim.x * 8) {
        const float* xr = X + (size_t)row * 2048; f32x4 v[8]; float ss = 0.f;
#pragma unroll
        for (int k = 0; k < 8; ++k) { v[k] = *(const f32x4*)(xr + k * 256 + lane * 4); ss += v[k][0] * v[k][0] + v[k][1] * v[k][1] + v[k][2] * v[k][2] + v[k][3] * v[k][3]; }
        ss = wave_sum(ss); const float rs = rsqrtf(ss * (1.f / 2048.f) + 1e-6f);
        const float* mb = mod + (row >> 12) * 12288;
#pragma unroll
        for (int k = 0; k < 8; ++k) { const int d = k * 256 + lane * 4; const f32x4 g = *(const f32x4*)(gain + d), sc = *(const f32x4*)(mb + sc_off + d), sh = *(const f32x4*)(mb + sh_off + d);
            f32x4 o;
#pragma unroll
            for (int e = 0; e < 4; ++e) o[e] = v[k][e] * rs * g[e] * (1.f + sc[e]) + sh[e];
            u32x2 w; w[0] = pk_bf16(o[0], o[1]); w[1] = pk_bf16(o[2], o[3]); *(u32x2*)(H + (size_t)row * 2048 + d) = w; }
    }
}

DI void phase_norm_f8(const float* __restrict__ X, const float* __restrict__ gain, const float* __restrict__ mod, int sh_off, int sc_off, unsigned char* __restrict__ H8, float* __restrict__ hsc) {
    const int lane = threadIdx.x & 63, wave = __builtin_amdgcn_readfirstlane(threadIdx.x >> 6);
    for (int row = blockIdx.x * 8 + wave; row < NT; row += gridDim.x * 8) {
        const float* xr = X + (size_t)row * 2048; f32x4 v[8]; float ss = 0.f;
#pragma unroll
        for (int k = 0; k < 8; ++k) { v[k] = *(const f32x4*)(xr + k * 256 + lane * 4); ss += v[k][0] * v[k][0] + v[k][1] * v[k][1] + v[k][2] * v[k][2] + v[k][3] * v[k][3]; }
        ss = wave_sum(ss); const float rs = rsqrtf(ss * (1.f / 2048.f) + 1e-6f);
        const float* mb = mod + (row >> 12) * 12288; float am = 0.f;
#pragma unroll
        for (int k = 0; k < 8; ++k) { const int d = k * 256 + lane * 4; const f32x4 g = *(const f32x4*)(gain + d), sc = *(const f32x4*)(mb + sc_off + d), sh = *(const f32x4*)(mb + sh_off + d);
#pragma unroll
            for (int e = 0; e < 4; ++e) { v[k][e] = v[k][e] * rs * g[e] * (1.f + sc[e]) + sh[e]; am = fmaxf(am, fabsf(v[k][e])); } }
#pragma unroll
        for (int o = 32; o >= 1; o >>= 1) am = fmaxf(am, __shfl_xor(am, o));
        const float q = am > 0.f ? 448.f / am : 1.f;
#pragma unroll
        for (int k = 0; k < 8; ++k) { int p = __builtin_amdgcn_cvt_pk_fp8_f32(v[k][0] * q, v[k][1] * q, 0, false); p = __builtin_amdgcn_cvt_pk_fp8_f32(v[k][2] * q, v[k][3] * q, p, true);
            *(unsigned*)(H8 + (size_t)row * 2048 + k * 256 + lane * 4) = (unsigned)p; }
        if (lane == 0) hsc[row] = am > 0.f ? am * (1.f / 448.f) : 1.f;
    }
}

DI void phase_cmp2(const Params& P) {
    unsigned char* ws = P.ws; const bf16_t* hid = (const bf16_t*)(ws + WS_HID); bf16_t* ckv = (bf16_t*)(ws + WS_CKV);
    for (int o = blockIdx.x * 512 + threadIdx.x; o < 2 * 16 * 256 * 64; o += gridDim.x * 512) {
        const int dd = o & 63, row = o >> 6, i = row >> 12, n = row & 255;
        float s = 0.f;
        if (n < NCMP) { const bf16_t* hr = hid + (size_t)row * 256; const float* w2 = P.cmp_w2 + i * 256 * 64 + dd; s = P.cmp_b2[i * 64 + dd];
#pragma unroll 4
            for (int j = 0; j < 256; j += 8) { const u32x4 hv = *(const u32x4*)(hr + j);
#pragma unroll
                for (int e = 0; e < 4; ++e) { s += bf_lo(hv[e]) * w2[(j + 2 * e) * 64]; s += bf_hi(hv[e]) * w2[(j + 2 * e + 1) * 64]; } } }
        ckv[o] = f2bf(s);
    }
}
DI void phase_scan(const Params& P) {
    unsigned char* ws = P.ws; const int lane = threadIdx.x & 63, wave = __builtin_amdgcn_readfirstlane(threadIdx.x >> 6);
    if (wave != 0) return;
    for (int bg = blockIdx.x; bg < 256; bg += gridDim.x) {
        const int b = bg >> 6, g = bg & 63, p = lane;
        const float ar = ((const float*)(ws + WS_A16))[(g * 64 + p) * 2], ai = ((const float*)(ws + WS_A16))[(g * 64 + p) * 2 + 1];
        const float* xl = (const float*)(ws + WS_XL) + (size_t)(g * 1024 + b * 256) * 128; bf16_t* a2 = (bf16_t*)(ws + WS_A2) + (size_t)(g * 1024 + b * 256) * 384 + 256;
        float xr = 0.f, xi = 0.f;
        for (int c = 0; c < 256; c += 8) { float lr[8], li[8];
#pragma unroll
            for (int e = 0; e < 8; ++e) { lr[e] = xl[(size_t)(c + e) * 128 + p]; li[e] = xl[(size_t)(c + e) * 128 + 64 + p]; }
#pragma unroll
            for (int e = 0; e < 8; ++e) { a2[(size_t)(c + e) * 384 + p] = f2bf(xr); a2[(size_t)(c + e) * 384 + 64 + p] = f2bf(xi);
                const float nr = ar * xr - ai * xi + lr[e], ni = ar * xi + ai * xr + li[e]; xr = nr; xi = ni; } }
    }
}

constexpr int AT_K = 0, AT_V = 18432, AT_TB = 34816, AT_IMP = 43008, AT_END = 112640;
#define MFMA32(a, b, c) __builtin_amdgcn_mfma_f32_32x32x16_bf16((a), (b), (c), 0, 0, 0)

DI void attn_setup_tables(const Params& P, LAS unsigned char* lds) {
    LAS float* tb = (LAS float*)(lds + AT_TB);
    __syncthreads();
    for (int i = threadIdx.x; i < 16 * 128; i += 512) { const int hd = i >> 7, dist = i & 127; int bk = dist;
        if (dist >= 16) { const float lr = __logf((float)dist * (1.f / 16.f)) / 2.0794415417f; bk = min(16 + (int)(lr * 16.f), 31); }
        tb[i] = P.rel_bias[bk * 16 + hd] * LOG2E; }
    __syncthreads();
}

#define ATTN_BODY \
             \
            bf16x8 vfr[2][2][2]; \
            f32x16 sacc[2]; \
_Pragma("unroll") \
            for (int kb = 0; kb < 2; ++kb) { \
_Pragma("unroll") \
                for (int i = 0; i < 16; ++i) sacc[kb][i] = 0.f; \
_Pragma("unroll") \
                for (int s = 0; s < 4; ++s) { const bf16x8 kf = *(const LAS bf16x8*)(Kl + krd + kb * 32 * 144 + s * 32); sacc[kb] = MFMA32(kf, qf[s], sacc[kb]); } } \
            if (pass == 0 && MODE != 0) {                                             \
_Pragma("unroll") \
                for (int kb = 0; kb < 2; ++kb) \
_Pragma("unroll") \
                    for (int s2 = 0; s2 < 2; ++s2) \
_Pragma("unroll") \
                        for (int db = 0; db < 2; ++db) { const unsigned a0 = (unsigned)(32 * kb + 16 * s2) * 128u + vrow * 128u + vcol[db]; \
                            const s16x4 lo = __builtin_amdgcn_ds_read_tr16_b64_v4i16((LAS s16x4*)(Vl + a0)), hi = __builtin_amdgcn_ds_read_tr16_b64_v4i16((LAS s16x4*)(Vl + a0 + 8 * 128)); \
                            vfr[kb][s2][db] = __builtin_shufflevector(lo, hi, 0, 1, 2, 3, 4, 5, 6, 7); } \
            } \
             \
            const bool near = (MODE == 0) || (qb - j <= 2) || (MODE == 2 && j == qb - 8); \
            const bool lsel = (MODE != 1) || (((j < 32 ? (mlo >> j) : (mhi >> (j - 32))) & 1u) != 0u); \
            if (near) { \
                const int dq = (MODE == 0) ? (tq - 31 - 1024 * j) : (tq - 64 * j); \
_Pragma("unroll") \
                for (int kb = 0; kb < 2; ++kb) \
_Pragma("unroll") \
                    for (int i = 0; i < 16; ++i) { const int kl = 32 * kb + (i & 3) + 8 * (i >> 2) + 4 * h; const int dist = dq - ((MODE == 0) ? 16 * kl : kl); \
                        bool ok = (dist >= 0) && lsel; if (MODE == 2) ok = ok && (dist < 512); \
                        sacc[kb][i] = (sacc[kb][i] + tb[min(max(dist, 0), 127)]) + (ok ? 0.f : NEGBIG); }      \
            } else { \
                const float cb = lsel ? farb : NEGBIG;                   \
_Pragma("unroll") \
                for (int kb = 0; kb < 2; ++kb) \
_Pragma("unroll") \
                    for (int i = 0; i < 16; ++i) sacc[kb][i] += cb; \
            } \
            bf16x8 pf[2][2]; \
            if (pass == 0) { \
                 \
                float mx = fmaxf(fmaxf(sacc[0][0], sacc[0][1]), sacc[1][0]); \
_Pragma("unroll") \
                for (int kb = 0; kb < 2; ++kb) \
_Pragma("unroll") \
                    for (int i = 0; i < 16; i += 2) mx = fmaxf(fmaxf(mx, sacc[kb][i]), sacc[kb][i + 1]); \
                mx = xor32_max(mx); \
                const float m_new = fmaxf(m_run, mx); \
                if (__any(m_new > m_run)) { const float alpha = __builtin_amdgcn_exp2f(m_run - m_new); l_run *= alpha; \
_Pragma("unroll") \
                    for (int i = 0; i < 16; ++i) { oacc[0][i] *= alpha; oacc[1][i] *= alpha; } } \
                m_run = m_new; \
                f32x2 ls2 = {0.f, 0.f}; const f32x2 mn2 = {m_new, m_new}; \
_Pragma("unroll") \
                for (int kb = 0; kb < 2; ++kb) \
_Pragma("unroll") \
                    for (int i = 0; i < 16; i += 2) { f32x2 d2 = (f32x2){sacc[kb][i], sacc[kb][i + 1]} - mn2; d2.x = __builtin_amdgcn_exp2f(d2.x); d2.y = __builtin_amdgcn_exp2f(d2.y); sacc[kb][i] = d2.x; sacc[kb][i + 1] = d2.y; ls2 += d2; } \
                l_run += ls2.x + ls2.y; \
            } else { \
_Pragma("unroll") \
                for (int kb = 0; kb < 2; ++kb) \
_Pragma("unroll") \
                    for (int i = 0; i < 16; ++i) sacc[kb][i] = __builtin_amdgcn_exp2f(sacc[kb][i] - m_fin) * inv_fin; \
            } \
_Pragma("unroll") \
            for (int kb = 0; kb < 2; ++kb) \
_Pragma("unroll") \
                for (int s2 = 0; s2 < 2; ++s2) { u32x4 w; \
_Pragma("unroll") \
                    for (int e = 0; e < 4; ++e) w[e] = pk_bf16(sacc[kb][8 * s2 + 2 * e], sacc[kb][8 * s2 + 2 * e + 1]); \
                    pf[kb][s2] = __builtin_bit_cast(bf16x8, w); } \
            if (pass == 0) { \
                 \
_Pragma("unroll") \
                for (int kb = 0; kb < 2; ++kb) \
_Pragma("unroll") \
                    for (int s2 = 0; s2 < 2; ++s2) \
_Pragma("unroll") \
                        for (int db = 0; db < 2; ++db) { \
                            if (MODE != 0) oacc[db] = MFMA32(vfr[kb][s2][db], pf[kb][s2], oacc[db]); \
                            else { const unsigned a0 = (unsigned)(32 * kb + 16 * s2) * 128u + vrow * 128u + vcol[db]; \
                                const s16x4 lo = __builtin_amdgcn_ds_read_tr16_b64_v4i16((LAS s16x4*)(Vl + a0)), hi = __builtin_amdgcn_ds_read_tr16_b64_v4i16((LAS s16x4*)(Vl + a0 + 8 * 128)); \
                                oacc[db] = MFMA32(__builtin_shufflevector(lo, hi, 0, 1, 2, 3, 4, 5, 6, 7), pf[kb][s2], oacc[db]); } } \
            } else { \
                 \
                bf16x8 mfrag[2][2]; \
_Pragma("unroll") \
                for (int kb = 0; kb < 2; ++kb) \
_Pragma("unroll") \
                    for (int s2 = 0; s2 < 2; ++s2) \
_Pragma("unroll") \
                        for (int jj = 0; jj < 8; ++jj) { const int key = 32 * kb + 16 * s2 + 8 * (jj >> 2) + 4 * h + (jj & 3); \
                            mfrag[kb][s2][jj] = (key == 4 * r - 1 || key == 4 * r + 3) ? (short)0x3F00 : ((key >= 4 * r && key <= 4 * r + 2) ? (short)0x3F80 : (short)0); } \
                f32x16 ia; \
_Pragma("unroll") \
                for (int i = 0; i < 16; ++i) ia[i] = 0.f; \
_Pragma("unroll") \
                for (int kb = 0; kb < 2; ++kb) \
_Pragma("unroll") \
                    for (int s2 = 0; s2 < 2; ++s2) ia = MFMA32(mfrag[kb][s2], pf[kb][s2], ia); \
                LAS float* ip = (LAS float*)(lds + AT_IMP) + (g * 64 + tq_loc) * 68 + 16 * j; \
_Pragma("unroll") \
                for (int i = 0; i < 9; ++i) { const int jp = (i & 3) + 8 * (i >> 2) + 4 * h; if (jp <= 16) ip[jp] += ia[i]; } \
            } \


template <int MODE> DI void attn_unit(const Params& P, LAS unsigned char* lds, int b, int k, int qb) {
    unsigned char* ws = P.ws;
    const int tid = threadIdx.x, lane = tid & 63, wave = __builtin_amdgcn_readfirstlane(tid >> 6);
    const int g = wave >> 1, th = wave & 1, r = lane & 31, h = lane >> 5;
    const int tq_loc = th * 32 + r, tq = qb * 64 + tq_loc, hd = k * 4 + g, bk = b * 4 + k;
    const LAS float* tb = (const LAS float*)(lds + AT_TB) + hd * 128;
    const float farb = tb[127];
    bf16x8 qf[4];
    { const bf16_t* qg = (const bf16_t*)(ws + WS_Q) + ((size_t)(b * 4096 + tq)) * 1024 + hd * 64 + 8 * h;
#pragma unroll
      for (int s = 0; s < 4; ++s) qf[s] = *(const bf16x8*)(qg + 16 * s); }
    const bf16_t *Kg, *Vg;
    if (MODE == 0) { Kg = (const bf16_t*)(ws + WS_CKV) + (size_t)bk * 256 * 64; Vg = Kg + 16 * 256 * 64; }
    else { Kg = (const bf16_t*)(ws + WS_KV) + (size_t)(MODE == 1 ? 2 : 4) * 4194304 + (size_t)bk * 4096 * 64; Vg = Kg + 4194304; }
    unsigned long long tiles; unsigned mlo = 0u, mhi = 0u;
    if (MODE == 0) { const int kmax = min(3, (4 * qb + 2) >> 6); tiles = (2ull << kmax) - 1ull; }
    else if (MODE == 2) { const int lo = max(0, qb - 8); tiles = ((2ull << qb) - 1ull) & ~((1ull << lo) - 1ull); }
    else { const unsigned* sm = (const unsigned*)(ws + WS_SELM) + ((size_t)(bk * 4096 + qb * 64)) * 2;
        mlo = sm[tq_loc * 2]; mhi = sm[tq_loc * 2 + 1];
        unsigned ulo = sm[lane * 2], uhi = sm[lane * 2 + 1];
#pragma unroll
        for (int o = 32; o >= 1; o >>= 1) { ulo |= __shfl_xor(ulo, o); uhi |= __shfl_xor(uhi, o); }
        tiles = (((unsigned long long)(unsigned)__builtin_amdgcn_readfirstlane(uhi) << 32) | (unsigned)__builtin_amdgcn_readfirstlane(ulo)) & ((2ull << qb) - 1ull); }
    const int ntile = __popcll(tiles);
    const int skey = tid >> 3, sch = tid & 7;
    const unsigned kst = (unsigned)(skey * 144 + sch * 16), vst = (unsigned)(skey * 128 + ((sch ^ (((skey >> 1) & 1) << 2)) * 16));
    const int q4 = (lane & 15) >> 2, pp = lane & 3, blk = (lane >> 4) & 1;
    const unsigned vrow = (unsigned)(4 * h + q4);
    unsigned vcol[2];
#pragma unroll
    for (int db = 0; db < 2; ++db) { const int ch = 4 * db + 2 * blk + (pp >> 1); vcol[db] = (unsigned)(((ch ^ (((q4 >> 1) & 1) << 2)) * 16) + (pp & 1) * 8); }
    const unsigned krd = (unsigned)(r * 144 + 16 * h);

    f32x16 oacc[2]; float m_run = NEGBIG, l_run = 0.f;
#pragma unroll
    for (int i = 0; i < 16; ++i) { oacc[0][i] = 0.f; oacc[1][i] = 0.f; }
    float m_fin = 0.f, inv_fin = 0.f;

    const int npass = (MODE == 0) ? 2 : 1;
    for (int pass = 0; pass < npass; ++pass) {
        if (MODE == 0 && pass == 1) {
            LAS float* imp = (LAS float*)(lds + AT_IMP);
            for (int i = tid; i < 4 * 64 * 68; i += 512) imp[i] = 0.f;
        }
        __syncthreads();
        unsigned long long rem = tiles; int jA = __ffsll((long long)rem) - 1; rem &= rem - 1ull; int jB = rem ? __ffsll((long long)rem) - 1 : jA; rem &= rem - 1ull;
        u32x4 kregA = *(const u32x4*)(Kg + (size_t)(jA * 64 + skey) * 64 + sch * 8), vregA = *(const u32x4*)(Vg + (size_t)(jA * 64 + skey) * 64 + sch * 8);
        u32x4 kregB = *(const u32x4*)(Kg + (size_t)(jB * 64 + skey) * 64 + sch * 8), vregB = *(const u32x4*)(Vg + (size_t)(jB * 64 + skey) * 64 + sch * 8);
#define ATTN_STEP(KR, VR, JV, PAR) { const int j = JV; \
            LAS unsigned char* Kl = lds + AT_K + (PAR) * 9216; LAS unsigned char* Vl = lds + AT_V + (PAR) * 8192; \
            *(LAS u32x4*)(Kl + kst) = KR; *(LAS u32x4*)(Vl + vst) = VR; \
            __syncthreads(); \
            { const int j2 = rem ? __ffsll((long long)rem) - 1 : JV; rem &= rem - 1ull; JV = j2; \
              KR = *(const u32x4*)(Kg + (size_t)(j2 * 64 + skey) * 64 + sch * 8); VR = *(const u32x4*)(Vg + (size_t)(j2 * 64 + skey) * 64 + sch * 8); } \
            ATTN_BODY }
        if constexpr (true) { rem = tiles & (tiles - 1ull);
            for (int it = 0; it < ntile; ++it) ATTN_STEP(kregA, vregA, jA, (it & 1))
        } else {
            for (int it = 0; it < ntile; it += 2) {
                ATTN_STEP(kregA, vregA, jA, 0)
                if (it + 1 < ntile) ATTN_STEP(kregB, vregB, jB, 1)
            }
        }
#undef ATTN_STEP
        if (pass == 0) {
            const float lt = xor32_add(l_run); const bool live = m_run > -1e29f; const float inv = live ? 1.f / lt : 0.f;
            m_fin = live ? m_run : 0.f; inv_fin = inv;
            int tqo = tq; asm volatile("" : "+v"(tqo));
            bf16_t* og = (bf16_t*)(ws + (MODE == 0 ? WS_OC : (MODE == 2 ? WS_OW : WS_OATT))) + ((size_t)(b * 4096 + tqo)) * 1024 + hd * 64;
            float g0 = 0.f, g1 = 1.f, g2 = 0.f; const bf16_t *oc = nullptr, *ow = nullptr;
            if (MODE == 1) { const float* gp = (const float*)(ws + WS_GATE) + (size_t)(b * 4096 + tqo) * 48 + hd * 3; g0 = gp[0]; g1 = gp[1]; g2 = gp[2];
                oc = (const bf16_t*)(ws + WS_OC) + ((size_t)(b * 4096 + tqo)) * 1024 + hd * 64; ow = (const bf16_t*)(ws + WS_OW) + ((size_t)(b * 4096 + tqo)) * 1024 + hd * 64; }
#pragma unroll
            for (int db = 0; db < 2; ++db)
#pragma unroll
                for (int a = 0; a < 4; ++a) { const int d0 = 32 * db + 8 * a + 4 * h; float v[4];
#pragma unroll
                    for (int e = 0; e < 4; ++e) v[e] = oacc[db][4 * a + e] * inv;
                    if (MODE == 1) { const u32x2 c2 = *(const u32x2*)(oc + d0), w2 = *(const u32x2*)(ow + d0);
                        v[0] = g1 * v[0] + g0 * bf_lo(c2[0]) + g2 * bf_lo(w2[0]); v[1] = g1 * v[1] + g0 * bf_hi(c2[0]) + g2 * bf_hi(w2[0]);
                        v[2] = g1 * v[2] + g0 * bf_lo(c2[1]) + g2 * bf_lo(w2[1]); v[3] = g1 * v[3] + g0 * bf_hi(c2[1]) + g2 * bf_hi(w2[1]); }
                    if (MODE == 1) { int p8 = __builtin_amdgcn_cvt_pk_fp8_f32(clamp448(v[0] * OATT_SCALE), clamp448(v[1] * OATT_SCALE), 0, false); p8 = __builtin_amdgcn_cvt_pk_fp8_f32(clamp448(v[2] * OATT_SCALE), clamp448(v[3] * OATT_SCALE), p8, true);
                        *(int*)((unsigned char*)(ws + WS_OATT) + ((size_t)(b * 4096 + tqo)) * 1024 + hd * 64 + d0) = p8; }
                    else { u32x2 w; w[0] = pk_bf16(v[0], v[1]); w[1] = pk_bf16(v[2], v[3]); *(u32x2*)(og + d0) = w; } }
        }
    }
    if (MODE == 0) {
        __syncthreads();
        const LAS float* imp = (const LAS float*)(lds + AT_IMP); unsigned* sm = (unsigned*)(ws + WS_SELM) + ((size_t)(bk * 4096 + qb * 64)) * 2;
        const int cur = qb;
        for (int tk = 0; tk < 8; ++tk) { const int tok = wave * 8 + tk, jb = lane;
            const float v = imp[(0 * 64 + tok) * 68 + jb] + imp[(1 * 64 + tok) * 68 + jb] + imp[(2 * 64 + tok) * 68 + jb] + imp[(3 * 64 + tok) * 68 + jb];
            const bool valid = jb <= cur, forced = valid && (jb == 0 || jb == cur || jb == cur - 1);
            bool sel = forced;
            if (cur <= 15) sel = valid;
            else { unsigned key = (valid && !forced) ? ((__float_as_uint(fmaxf(v, 0.f)) & ~63u) | (unsigned)(63 - jb)) : 0u;
                for (int rd = 0; rd < 13; ++rd) { const unsigned w = wave_max_u32(key); const int win = 63 - (int)(w & 63u); if (jb == win && w != 0u) { sel = true; key = 0u; } } }
            const unsigned long long bal = __ballot(sel);
            if (lane == 0) { sm[tok * 2] = (unsigned)bal; sm[tok * 2 + 1] = (unsigned)(bal >> 32); } }
    }
}

constexpr float AT_THR = 6.f;
#define AP_QK(S, Kl_, C_) { _Pragma("unroll") for (int kb = 0; kb < 2; ++kb) { \
        _Pragma("unroll") for (int s = 0; s < 4; ++s) { const bf16x8 kf = *(const LAS bf16x8*)((Kl_) + krd + kb * 32 * 144 + s * 32); if (s == 0) S[kb] = MFMA32(kf, qf[0], C_); else S[kb] = MFMA32(kf, qf[s], S[kb]); } } }
#define AP_CSEL(C_, jt) f32x16 C_; { const int j_ = (jt); const bool lsel_ = (MODE != 1) || (((j_ < 32 ? (mlo >> j_) : (mhi >> (j_ - 32))) & 1u) != 0u); const bool near_ = (qb - j_ <= 2) || (MODE == 2 && j_ == qb - 8); \
        _Pragma("unroll") for (int i = 0; i < 16; ++i) C_[i] = (lsel_ || near_) ? cinit[i] : NEGBIG; }
#define AP_NEAR(S, jt) { const int j_ = (jt); const bool near_ = (qb - j_ <= 2) || (MODE == 2 && j_ == qb - 8); \
        if (near_) { const bool lsel_ = (MODE != 1) || (((j_ < 32 ? (mlo >> j_) : (mhi >> (j_ - 32))) & 1u) != 0u); const int dq = tq - 64 * j_; \
            _Pragma("unroll") for (int kb = 0; kb < 2; ++kb) _Pragma("unroll") for (int i = 0; i < 16; ++i) { const int kl = 32 * kb + (i & 3) + 8 * (i >> 2) + 4 * h; const int dist = dq - kl; \
                bool ok = (dist >= 0) && lsel_; if (MODE == 2) ok = ok && (dist < 512); \
                S[kb][i] = (S[kb][i] + (tb[min(max(dist, 0), 127)] - farb)) + (ok ? 0.f : NEGBIG); } } }
#define AP_STEP(SC, SN, PAR, HASNEXT) { \
        LAS unsigned char* Kn = lds + AT_K + ((PAR) ^ 1) * 9216; LAS unsigned char* Vc = lds + AT_V + (PAR) * 8192; \
        *(LAS u32x4*)(Kn + kst) = kreg; *(LAS u32x4*)(Vc + vst) = vreg; \
        __syncthreads(); \
        { vreg = *(const u32x4*)(Vg + (size_t)(jn * 64 + skey) * 64 + sch * 8); kreg = *(const u32x4*)(Kg + (size_t)(jnn * 64 + skey) * 64 + sch * 8); } \
        const bool hn_ = (HASNEXT); \
        float mx = fmaxf(fmaxf(SC[0][0], SC[0][1]), SC[1][0]); \
        _Pragma("unroll") for (int kb = 0; kb < 2; ++kb) _Pragma("unroll") for (int i = 0; i < 16; i += 2) mx = fmaxf(fmaxf(mx, SC[kb][i]), SC[kb][i + 1]); \
        mx = xor32_max(mx); \
        if (__any(mx > AT_THR || (mx < -24.f && mx > -1e29f))) {         \
            const float dl = (mx > -1e29f) ? mx : 0.f, alpha = __builtin_amdgcn_exp2f(-dl); m_run += dl; l_run *= alpha; \
            _Pragma("unroll") for (int i = 0; i < 16; ++i) { oacc[0][i] *= alpha; oacc[1][i] *= alpha; cinit[i] -= dl; SC[0][i] -= dl; SC[1][i] -= dl; } } \
        AP_CSEL(cn_, jn) \
        AP_QK(SN, Kn, cn_)        \
        float ls0 = 0.f, ls1 = 0.f; \
        _Pragma("unroll") for (int kb = 0; kb < 2; ++kb) _Pragma("unroll") for (int i = 0; i < 16; i += 2) { const float p0 = __builtin_amdgcn_exp2f(SC[kb][i]), p1 = __builtin_amdgcn_exp2f(SC[kb][i + 1]); SC[kb][i] = p0; SC[kb][i + 1] = p1; ls0 += p0; ls1 += p1; } \
        l_run += ls0 + ls1; \
        _Pragma("unroll") for (int kb = 0; kb < 2; ++kb) _Pragma("unroll") for (int s2 = 0; s2 < 2; ++s2) { u32x4 w; \
            _Pragma("unroll") for (int e = 0; e < 4; ++e) w[e] = pk_bf16(SC[kb][8 * s2 + 2 * e], SC[kb][8 * s2 + 2 * e + 1]); \
            const bf16x8 pf = __builtin_bit_cast(bf16x8, w); \
            _Pragma("unroll") for (int db = 0; db < 2; ++db) { const unsigned a0 = (unsigned)(32 * kb + 16 * s2) * 128u + vrow * 128u + vcol[db]; \
                const s16x4 lo = __builtin_amdgcn_ds_read_tr16_b64_v4i16((LAS s16x4*)(Vc + a0)), hi = __builtin_amdgcn_ds_read_tr16_b64_v4i16((LAS s16x4*)(Vc + a0 + 8 * 128)); \
                oacc[db] = MFMA32(__builtin_shufflevector(lo, hi, 0, 1, 2, 3, 4, 5, 6, 7), pf, oacc[db]); } } \
        if (hn_) AP_NEAR(SN, jn) \
        jn = jnn; jnn = rem ? __ffsll((long long)rem) - 1 : jnn; rem &= rem - 1ull; }

template <int MODE> DI void attn_unit_pipe(const Params& P, LAS unsigned char* lds, int b, int k, int qb) {
    unsigned char* ws = P.ws;
    const int tid = threadIdx.x, lane = tid & 63, wave = __builtin_amdgcn_readfirstlane(tid >> 6);
    const int g = wave >> 1, th = wave & 1, r = lane & 31, h = lane >> 5;
    const int tq_loc = th * 32 + r, tq = qb * 64 + tq_loc, hd = k * 4 + g, bk = b * 4 + k;
    const LAS float* tb = (const LAS float*)(lds + AT_TB) + hd * 128;
    const float farb = tb[127];
    bf16x8 qf[4];
    { const bf16_t* qg = (const bf16_t*)(ws + WS_Q) + ((size_t)(b * 4096 + tq)) * 1024 + hd * 64 + 8 * h;
#pragma unroll
      for (int s = 0; s < 4; ++s) qf[s] = *(const bf16x8*)(qg + 16 * s); }
    const bf16_t* Kg = (const bf16_t*)(ws + WS_KV) + (size_t)(MODE == 1 ? 2 : 4) * 4194304 + (size_t)bk * 4096 * 64; const bf16_t* Vg = Kg + 4194304;
    unsigned long long tiles; unsigned mlo = 0u, mhi = 0u;
    if (MODE == 2) { const int lo = max(0, qb - 8); tiles = ((2ull << qb) - 1ull) & ~((1ull << lo) - 1ull); }
    else { const unsigned* sm = (const unsigned*)(ws + WS_SELM) + ((size_t)(bk * 4096 + qb * 64)) * 2;
        mlo = sm[tq_loc * 2]; mhi = sm[tq_loc * 2 + 1];
        unsigned ulo = sm[lane * 2], uhi = sm[lane * 2 + 1];
#pragma unroll
        for (int o = 32; o >= 1; o >>= 1) { ulo |= __shfl_xor(ulo, o); uhi |= __shfl_xor(uhi, o); }
        tiles = (((unsigned long long)(unsigned)__builtin_amdgcn_readfirstlane(uhi) << 32) | (unsigned)__builtin_amdgcn_readfirstlane(ulo)) & ((2ull << qb) - 1ull); }
    const int ntile = __popcll(tiles);
    const int skey = tid >> 3, sch = tid & 7;
    const unsigned kst = (unsigned)(skey * 144 + sch * 16), vst = (unsigned)(skey * 128 + ((sch ^ (((skey >> 1) & 1) << 2)) * 16));
    const int q4 = (lane & 15) >> 2, pp = lane & 3, blk = (lane >> 4) & 1;
    const unsigned vrow = (unsigned)(4 * h + q4);
    unsigned vcol[2];
#pragma unroll
    for (int db = 0; db < 2; ++db) { const int ch = 4 * db + 2 * blk + (pp >> 1); vcol[db] = (unsigned)(((ch ^ (((q4 >> 1) & 1) << 2)) * 16) + (pp & 1) * 8); }
    const unsigned krd = (unsigned)(r * 144 + 16 * h);
    f32x16 oacc[2], sA[2], sB[2], cinit; float m_run = 0.f, l_run = 0.f;
#pragma unroll
    for (int i = 0; i < 16; ++i) { oacc[0][i] = 0.f; oacc[1][i] = 0.f; cinit[i] = farb; }
    unsigned long long rem = tiles; const int jc = __ffsll((long long)rem) - 1; rem &= rem - 1ull;
    int jn = rem ? __ffsll((long long)rem) - 1 : jc; rem &= rem - 1ull; int jnn = rem ? __ffsll((long long)rem) - 1 : jn; rem &= rem - 1ull;
    u32x4 kreg = *(const u32x4*)(Kg + (size_t)(jc * 64 + skey) * 64 + sch * 8), vreg = *(const u32x4*)(Vg + (size_t)(jc * 64 + skey) * 64 + sch * 8);
    __syncthreads();
    *(LAS u32x4*)(lds + AT_K + kst) = kreg;
    kreg = *(const u32x4*)(Kg + (size_t)(jn * 64 + skey) * 64 + sch * 8);
    __syncthreads();
    { AP_CSEL(c0_, jc) AP_QK(sA, lds + AT_K, c0_) AP_NEAR(sA, jc) }
    for (int it = 0; it < ntile; it += 2) {
        AP_STEP(sA, sB, 0, it + 1 < ntile)
        if (it + 1 < ntile) AP_STEP(sB, sA, 1, it + 2 < ntile)
    }
    const float lt = xor32_add(l_run); const float inv = lt > 0.f ? 1.f / lt : 0.f;
    int tqo = tq; asm volatile("" : "+v"(tqo));
    float g0 = 0.f, g1 = 1.f, g2 = 0.f; const bf16_t *oc = nullptr, *ow = nullptr;
    if (MODE == 1) { const float* gp = (const float*)(ws + WS_GATE) + (size_t)(b * 4096 + tqo) * 48 + hd * 3; g0 = gp[0]; g1 = gp[1]; g2 = gp[2];
        oc = (const bf16_t*)(ws + WS_OC) + ((size_t)(b * 4096 + tqo)) * 1024 + hd * 64; ow = (const bf16_t*)(ws + WS_OW) + ((size_t)(b * 4096 + tqo)) * 1024 + hd * 64; }
#pragma unroll
    for (int db = 0; db < 2; ++db)
#pragma unroll
        for (int a = 0; a < 4; ++a) { const int d0 = 32 * db + 8 * a + 4 * h; float v[4];
#pragma unroll
            for (int e = 0; e < 4; ++e) v[e] = oacc[db][4 * a + e] * inv;
            if (MODE == 1) { const u32x2 c2 = *(const u32x2*)(oc + d0), w2 = *(const u32x2*)(ow + d0);
                v[0] = g1 * v[0] + g0 * bf_lo(c2[0]) + g2 * bf_lo(w2[0]); v[1] = g1 * v[1] + g0 * bf_hi(c2[0]) + g2 * bf_hi(w2[0]);
                v[2] = g1 * v[2] + g0 * bf_lo(c2[1]) + g2 * bf_lo(w2[1]); v[3] = g1 * v[3] + g0 * bf_hi(c2[1]) + g2 * bf_hi(w2[1]);
                int p8 = __builtin_amdgcn_cvt_pk_fp8_f32(clamp448(v[0] * OATT_SCALE), clamp448(v[1] * OATT_SCALE), 0, false); p8 = __builtin_amdgcn_cvt_pk_fp8_f32(clamp448(v[2] * OATT_SCALE), clamp448(v[3] * OATT_SCALE), p8, true);
                *(int*)((unsigned char*)(ws + WS_OATT) + ((size_t)(b * 4096 + tqo)) * 1024 + hd * 64 + d0) = p8; }
            else { u32x2 w; w[0] = pk_bf16(v[0], v[1]); w[1] = pk_bf16(v[2], v[3]); *(u32x2*)((bf16_t*)(ws + WS_OW) + ((size_t)(b * 4096 + tqo)) * 1024 + hd * 64 + d0) = w; } }
}
#undef AP_STEP
#undef AP_NEAR
#undef AP_CSEL
#undef AP_QK

DI void phase_attn_win_early(const Params& P, LAS unsigned char* lds) {
    if (gridDim.x != 256) return;
    const int bx = blockIdx.x; if (bx >= 128 && bx < 160) return;
    attn_setup_tables(P, lds);
    const int nb = bx < 128 ? bx : bx - 32;
    for (int u = nb; u < 672; u += 224) { const int qb = u >> 4, bk = u & 15; attn_unit_pipe<2>(P, lds, bk >> 2, bk & 3, qb); }
}
DI void phase_attn_cmp_win(const Params& P, LAS unsigned char* lds) {
    attn_setup_tables(P, lds);
    for (int u = blockIdx.x; u < 1024; u += gridDim.x) { const int qb = 63 - (u >> 4), bk = u & 15; attn_unit<0>(P, lds, bk >> 2, bk & 3, qb); }
    for (int u = (gridDim.x == 256 ? 672 : 0) + blockIdx.x; u < 1024; u += gridDim.x) { const int qb = u >> 4, bk = u & 15; attn_unit_pipe<2>(P, lds, bk >> 2, bk & 3, qb); }
}
DI void phase_attn_sel(const Params& P, LAS unsigned char* lds) {
    attn_setup_tables(P, lds);
    for (int pr = blockIdx.x; pr < 512; pr += gridDim.x) { const int bk = pr >> 5, qp = pr & 31;
        attn_unit_pipe<1>(P, lds, bk >> 2, bk & 3, 63 - qp); attn_unit_pipe<1>(P, lds, bk >> 2, bk & 3, qp); }
}

DI unsigned row_max_u32(unsigned v) {
    asm volatile("s_nop 1\n\tv_max_u32_dpp %0, %0, %0 quad_perm:[1,0,3,2] row_mask:0xf bank_mask:0xf\n\ts_nop 1\n\tv_max_u32_dpp %0, %0, %0 quad_perm:[2,3,0,1] row_mask:0xf bank_mask:0xf\n\t"
                 "s_nop 1\n\tv_max_u32_dpp %0, %0, %0 row_half_mirror row_mask:0xf bank_mask:0xf\n\ts_nop 1\n\tv_max_u32_dpp %0, %0, %0 row_mirror row_mask:0xf bank_mask:0xf\n\ts_nop 1" : "+v"(v));
    return v; }
DI float row_max_f32(float v) {
    asm volatile("s_nop 1\n\tv_max_f32_dpp %0, %0, %0 quad_perm:[1,0,3,2] row_mask:0xf bank_mask:0xf\n\ts_nop 1\n\tv_max_f32_dpp %0, %0, %0 quad_perm:[2,3,0,1] row_mask:0xf bank_mask:0xf\n\t"
                 "s_nop 1\n\tv_max_f32_dpp %0, %0, %0 row_half_mirror row_mask:0xf bank_mask:0xf\n\ts_nop 1\n\tv_max_f32_dpp %0, %0, %0 row_mirror row_mask:0xf bank_mask:0xf\n\ts_nop 1" : "+v"(v));
    return v; }
DI float row_sum_f32(float v) {
    asm volatile("s_nop 1\n\tv_add_f32_dpp %0, %0, %0 quad_perm:[1,0,3,2] row_mask:0xf bank_mask:0xf\n\ts_nop 1\n\tv_add_f32_dpp %0, %0, %0 quad_perm:[2,3,0,1] row_mask:0xf bank_mask:0xf\n\t"
                 "s_nop 1\n\tv_add_f32_dpp %0, %0, %0 row_half_mirror row_mask:0xf bank_mask:0xf\n\ts_nop 1\n\tv_add_f32_dpp %0, %0, %0 row_mirror row_mask:0xf bank_mask:0xf\n\ts_nop 1" : "+v"(v));
    return v; }
DI float demono_f32(unsigned u) { return __uint_as_float((u & 0x80000000u) ? (u ^ 0x80000000u) : ~u); }

DI void phase_peer(const Params& P, LAS unsigned char* lds) {
    unsigned char* ws = P.ws; const int lane = threadIdx.x & 63, wave = __builtin_amdgcn_readfirstlane(threadIdx.x >> 6), rw = lane >> 4, li = lane & 15, p = lane & 31, hsel = lane >> 5;
    const float* SC = (const float*)(ws + WS_SC);
    LAS unsigned char* ptab = lds + 8192;
    LAS float* vs = (LAS float*)(lds + wave * 512); LAS int* ns = (LAS int*)(lds + wave * 512 + 256);
    __syncthreads();
    if (threadIdx.x == 0) { int q = 0; for (int a = 0; a < 16; ++a) for (int b = 0; b < 16 / (a + 1); ++b) ptab[q++] = (unsigned char)(a * 16 + b); for (; q < 64; ++q) ptab[q] = 0; }
    __syncthreads();
    const int q0 = p, q1 = p + 32; const int ab0 = ptab[q0], ab1 = ptab[q1 < 50 ? q1 : 0];
    for (int t = blockIdx.x * 8 + wave; t < NT; t += gridDim.x * 8) {
        for (int bt = 0; bt < 4; ++bt) {
            const float* sp = SC + (size_t)t * 2048 + (bt * 4 + rw) * 128 + li; unsigned k[8];
#pragma unroll
            for (int i = 0; i < 8; ++i) k[i] = (mono_u32(sp[16 * i]) & ~127u) | (unsigned)(127 - (li + 16 * i));
            unsigned win = 0u;
            for (int rd = 0; rd < 16; ++rd) {
                unsigned m = max(max(max(k[0], k[1]), max(k[2], k[3])), max(max(k[4], k[5]), max(k[6], k[7])));
                m = row_max_u32(m);
#pragma unroll
                for (int i = 0; i < 8; ++i) k[i] = (k[i] == m) ? 0u : k[i];
                if (li == rd) win = m; }
            vs[rw * 16 + li] = demono_f32(win & ~127u); ns[rw * 16 + li] = 127 - (int)(win & 127u);
            const LAS float* v1 = vs + hsel * 32; const LAS float* v2 = v1 + 16;
            const float c0 = v1[ab0 >> 4] + v2[ab0 & 15], c1 = v1[ab1 >> 4] + v2[ab1 & 15];
            unsigned k0 = (mono_u32(c0) & ~63u) | (unsigned)(63 - q0), k1 = (q1 < 50) ? ((mono_u32(c1) & ~63u) | (unsigned)(63 - q1)) : 0u;
            unsigned w2 = 0u;
            for (int rd = 0; rd < 16; ++rd) {
                unsigned m = row_max_u32(max(k0, k1));
                { const auto r_ = __builtin_amdgcn_permlane16_swap(m, m, false, false); m = max(r_[0], r_[1]); }
                k0 = (k0 == m) ? 0u : k0; k1 = (k1 == m) ? 0u : k1;
                if (p == rd) w2 = m; }
            if (p < 16) {
                const int ab = ptab[63 - (int)(w2 & 63u)], a = ab >> 4, b = ab & 15;
                const float tsv = v1[a] + v2[b]; const int ee = ns[hsel * 32 + a] * 128 + ns[hsel * 32 + 16 + b];
                const float mx = row_max_f32(tsv), ex = __expf(tsv - mx), sm = row16_sum(ex);
                const int slot = (2 * bt + hsel) * 16 + p;
                ((int*)(ws + WS_EX))[(size_t)t * 128 + slot] = ee;
                ((float*)(ws + WS_GT))[(size_t)t * 128 + slot] = (ex / sm) * ((const float*)(ws + WS_PSV))[ee]; ((float*)(ws + WS_SU))[(size_t)t * 128 + slot] = ((const float*)(ws + WS_PSU))[ee]; }
        }
    }
}

DI void peer_slice_map(const Params& P, LAS unsigned char* lds, int& vx, int& rank, int& nrank) {
    volatile LAS unsigned* misc = (volatile LAS unsigned*)(lds + LDS_MISC);
    const unsigned* bar = (const unsigned*)(P.ws + WS_BAR);
    const int xcc = (int)misc[4], rk = (int)misc[5];
    bool ok = true; int mine = 0;
#pragma unroll
    for (int j = 0; j < 16; ++j) { const unsigned c = __hip_atomic_load(bar + XB_XCNT(j), __ATOMIC_RELAXED, __HIP_MEMORY_SCOPE_AGENT); if (j < 8 ? c == 0u : c != 0u) ok = false; if (j == xcc) mine = (int)c; }
    if (ok && (P.ph_hi - P.ph_lo > 1)) { vx = xcc; rank = rk; nrank = mine; }
    else { vx = blockIdx.x & 7; rank = blockIdx.x >> 3; nrank = (gridDim.x + 7 - vx) >> 3; }
}
DI void phase_peer_a(const Params& P, LAS unsigned char* lds) {
    unsigned char* ws = P.ws; const int lane = threadIdx.x & 63, wave = __builtin_amdgcn_readfirstlane(threadIdx.x >> 6); int vx, rank, nrank; peer_slice_map(P, lds, vx, rank, nrank);
    const int gq = lane >> 4, li = lane & 15;
    LAS int* el = (LAS int*)(lds + wave * 1024);
    const unsigned char* PU = ws + WS_PU + (size_t)vx * 4194304; const unsigned li16 = (unsigned)li * 16u; const bf16_t* H2 = (const bf16_t*)(ws + WS_H2) + vx * 256 + li * 16;
    float* PA = (float*)(ws + WS_PA) + (size_t)vx * NT * 128;
    for (int t = rank * 8 + wave; t < NT; t += nrank * 8) {
        const int* exg = (const int*)(ws + WS_EX) + (size_t)t * 128;
        el[lane] = exg[lane]; el[64 + lane] = exg[64 + lane];
        unsigned hq[8];
        { const u32x4 ha = *(const u32x4*)(H2 + (size_t)t * 2048), hb = *(const u32x4*)(H2 + (size_t)t * 2048 + 8);
#pragma unroll
          for (int q = 0; q < 4; ++q) { hq[q] = ha[q]; hq[4 + q] = hb[q]; } }
#pragma unroll
        for (int jb = 0; jb < 32; jb += 8) {
            u32x4 rw[8];
#pragma unroll
            for (int i = 0; i < 8; ++i) { const unsigned ex = (unsigned)el[4 * (jb + i) + gq]; rw[i] = *(const u32x4*)(PU + (ex * 256u + li16)); }
            float pr[8];
#pragma unroll
            for (int i = 0; i < 8; ++i) { float a0 = 0.f, a1 = 0.f;
#pragma unroll
                for (int q = 0; q < 4; ++q) { a0 = __builtin_amdgcn_fdot2_f32_bf16(__builtin_amdgcn_cvt_scalef32_pk_bf16_fp8(rw[i][q], 1.0f, false), bf16pair(hq[2 * q]), a0, false);
                    a1 = __builtin_amdgcn_fdot2_f32_bf16(__builtin_amdgcn_cvt_scalef32_pk_bf16_fp8(rw[i][q], 1.0f, true), bf16pair(hq[2 * q + 1]), a1, false); }
                pr[i] = a0 + a1; }
            const float tot = reduce8_row16(pr, li);
            if (!(li & 1)) PA[(size_t)t * 128 + 4 * (jb + (li >> 1)) + gq] = tot;
        }
    }
}
DI void phase_peer_w(const Params& P) {
    unsigned char* ws = P.ws; const float* PA = (const float*)(ws + WS_PA); float* GT = (float*)(ws + WS_GT); const float* SU = (const float*)(ws + WS_SU);
    for (size_t i = (size_t)blockIdx.x * 512 + threadIdx.x; i < (size_t)NT * 128; i += (size_t)gridDim.x * 512) { float a = 0.f;
#pragma unroll
        for (int x = 0; x < 8; ++x) a += PA[(size_t)x * NT * 128 + i];
        GT[i] = GT[i] * gelu_tanh(a * SU[i]); }
}
DI void phase_peer_b(const Params& P, LAS unsigned char* lds) {
    unsigned char* ws = P.ws; const int lane = threadIdx.x & 63, wave = __builtin_amdgcn_readfirstlane(threadIdx.x >> 6); int vx, rank, nrank; peer_slice_map(P, lds, vx, rank, nrank);
    const int gq = lane >> 4, li = lane & 15;
    LAS int* el = (LAS int*)(lds + wave * 1024); LAS float* wl = (LAS float*)(lds + wave * 1024 + 512);
    const unsigned char* PV = ws + WS_PV + (size_t)vx * 4194304; const unsigned li16 = (unsigned)li * 16u;
    const float* X1 = (const float*)(ws + WS_X1); const float* mod = (const float*)(ws + WS_MOD);
    for (int t = rank * 8 + wave; t < NT; t += nrank * 8) {
        const int* exg = (const int*)(ws + WS_EX) + (size_t)t * 128; const float* gtg = (const float*)(ws + WS_GT) + (size_t)t * 128;
        el[lane] = exg[lane]; el[64 + lane] = exg[64 + lane]; wl[lane] = gtg[lane]; wl[64 + lane] = gtg[64 + lane];
        f32x2 oa[8];
#pragma unroll
        for (int i = 0; i < 8; ++i) oa[i] = (f32x2){0.f, 0.f};
#pragma unroll
        for (int jb = 0; jb < 32; jb += 8) {
            u32x4 rw[8]; float wv[8];
#pragma unroll
            for (int i = 0; i < 8; ++i) { const int slot = 4 * (jb + i) + gq; const unsigned ex = (unsigned)el[slot]; wv[i] = wl[slot]; rw[i] = *(const u32x4*)(PV + (ex * 256u + li16)); }
#pragma unroll
            for (int i = 0; i < 8; ++i) { const f32x2 w2 = {wv[i], wv[i]};
#pragma unroll
                for (int q = 0; q < 4; ++q) { oa[2 * q] += w2 * __builtin_amdgcn_cvt_pk_f32_fp8((int)rw[i][q], false); oa[2 * q + 1] += w2 * __builtin_amdgcn_cvt_pk_f32_fp8((int)rw[i][q], true); } }
        }
        float v16[16], w8[8], o4[4];
#pragma unroll
        for (int i = 0; i < 8; ++i) { v16[2 * i] = oa[i].x; v16[2 * i + 1] = oa[i].y; }
#pragma unroll
        for (int k = 0; k < 8; ++k) { const auto r = __builtin_amdgcn_permlane16_swap(__float_as_uint(v16[k]), __float_as_uint(v16[8 + k]), false, false); w8[k] = __uint_as_float(r[0]) + __uint_as_float(r[1]); }
#pragma unroll
        for (int k = 0; k < 4; ++k) { const auto r = __builtin_amdgcn_permlane32_swap(__float_as_uint(w8[k]), __float_as_uint(w8[4 + k]), false, false); o4[k] = __uint_as_float(r[0]) + __uint_as_float(r[1]); }
        const int cq = ((gq & 1) << 1) | (gq >> 1);
        const int d = vx * 256 + li * 16 + 4 * cq; const f32x4 xa = *(const f32x4*)(X1 + (size_t)t * 2048 + d), ga = *(const f32x4*)(mod + (t >> 12) * 12288 + 10240 + d);
        f32x4 y; float ss = 0.f;
#pragma unroll
        for (int e = 0; e < 4; ++e) { y[e] = xa[e] + ga[e] * o4[e]; ss += y[e] * y[e]; }
        *(f32x4*)(P.out + (size_t)t * 2048 + d) = y;
        ss = wave_sum(ss); if (lane == 0) ((float*)(ws + WS_SS))[(size_t)vx * NT + t] = ss;
    }
}
DI void phase_peer_norm(const Params& P) {
    unsigned char* ws = P.ws; const int lane = threadIdx.x & 63, wave = __builtin_amdgcn_readfirstlane(threadIdx.x >> 6); const float* SS = (const float*)(ws + WS_SS);
    for (int t = blockIdx.x * 8 + wave; t < NT; t += gridDim.x * 8) {
        float ss = 0.f;
#pragma unroll
        for (int x = 0; x < 8; ++x) ss += SS[(size_t)x * NT + t];
        const float rs = rsqrtf(ss * (1.f / 2048.f) + 1e-6f); float* o = P.out + (size_t)t * 2048;
#pragma unroll
        for (int k = 0; k < 8; ++k) { const int d = k * 256 + lane * 4; f32x4 v = *(const f32x4*)(o + d); const f32x4 g = *(const f32x4*)(P.final_g + d);
#pragma unroll
            for (int e = 0; e < 4; ++e) v[e] = v[e] * rs * g[e];
            *(f32x4*)(o + d) = v; }
    }
}


constexpr int N_PHASES = 16;
template <int K> DI void run_phase(const Params& P, LAS unsigned char* lds) {
    unsigned char* ws = P.ws; const int G = gridDim.x, bx = blockIdx.x, tid = threadIdx.x; (void)G; (void)bx; (void)tid;
    if constexpr (K == 0) { p0_prologue(P, lds); }
    if constexpr (K == 1) { phase_norm_f8(P.x, P.norm_mix_g, (const float*)(ws + WS_MOD), 0, 2048, ws + WS_H, (float*)(ws + WS_HSC)); }
    if constexpr (K == 2) {
        { pg8::Gemm g{(const bf16_t*)(ws + WS_H), (const bf16_t*)(ws + WS_WIN), 2048, 2048, 2048}; pg8::StaticOrder S; S.init(NT, NPROJ, G, bx); EpiProj E{ws, (const float*)(ws + WS_HSC)};
          pg8::gemm_phase<EpiProj, pg8::StaticOrder, true>(lds, g, S, E); }
        { pg8::Gemm g{(const bf16_t*)(ws + WS_KBD), (const bf16_t*)(ws + WS_WQ), 2048, 2048, 2048}; pg8::StaticOrder S; S.init(2048, 2048, G, (bx + 64) % G); EpiBf16Plain E{(bf16_t*)(ws + WS_WSC), 2048};
          pg8::gemm_phase<EpiBf16Plain, pg8::StaticOrder>(lds, g, S, E); }
    }
    if constexpr (K == 3) {
        { pg8::Gemm g{(const bf16_t*)(ws + WS_A2), (const bf16_t*)(ws + WS_S5B1), 384, 256, 256}; GroupOrder S{256, G, bx, 4}; EpiS5G1 E{(float*)(ws + WS_XL)};
          pg8::gemm_phase<EpiS5G1, GroupOrder>(lds, g, S, E); }
        { pg8::Gemm g{(const bf16_t*)(ws + WS_KV), (const bf16_t*)(ws + WS_WC1), 1024, 2048, 2048}; GroupOrder S{32, G, (bx + 128) % G, 16}; EpiCmp1 E{(bf16_t*)(ws + WS_HID), (const float*)(ws + WS_CB)};
          pg8::gemm_phase<EpiCmp1, GroupOrder>(lds, g, S, E); }
        phase_attn_win_early(P, lds);
    }
    if constexpr (K == 4) { phase_scan(P); phase_cmp2(P); }
    if constexpr (K == 5) {
        { pg8::Gemm g{(const bf16_t*)(ws + WS_A2), (const bf16_t*)(ws + WS_S5B2), 384, 384, 384}; GroupOrder S{256, G, bx, 4}; EpiS5G2 E{(bf16_t*)(ws + WS_YACT)};
          pg8::gemm_phase<EpiS5G2, GroupOrder>(lds, g, S, E); }
        phase_attn_cmp_win(P, lds);
    }
    if constexpr (K == 6) {
        { pg8::Gemm g{(const bf16_t*)(ws + WS_YACT), (const bf16_t*)(ws + WS_WGLU), 1024, 1024, 1024}; pg8::StaticOrder S; S.init(NT, 1024, G, bx); EpiGlu E{(const bf16_t*)(ws + WS_YACT), (bf16_t*)(ws + WS_Y2), P.glu_b};
          pg8::gemm_phase<EpiGlu, pg8::StaticOrder>(lds, g, S, E); }
        phase_attn_sel(P, lds);
    }
    if constexpr (K == 7) {
        { pg8::Gemm g{(const bf16_t*)(ws + WS_OATT), (const bf16_t*)(ws + WS_WUA), 1024, 1024, 1024}; pg8::StaticOrder S; S.init(NT, 2048, G, bx); EpiUp<0> E{(const bf16_t*)(ws + WS_MG), nullptr, (bf16_t*)(ws + WS_TMP), 1.f / (OATT_SCALE * 1024.f)};
          pg8::gemm_phase<EpiUp<0>, pg8::StaticOrder, true>(lds, g, S, E); }
        { pg8::Gemm g{(const bf16_t*)(ws + WS_Y2), (const bf16_t*)(ws + WS_WUS), 1024, 1024, 1024}; pg8::StaticOrder S; S.init(NT, 2048, G, bx); EpiUp<1> E{(const bf16_t*)(ws + WS_MG), (const bf16_t*)(ws + WS_TMP), (bf16_t*)(ws + WS_MIX), 1.f / (Y2_SCALE * 1024.f)};
          pg8::gemm_phase<EpiUp<1>, pg8::StaticOrder, true>(lds, g, S, E); }
    }
    if constexpr (K == 8) {
        pg8::Gemm g{(const bf16_t*)(ws + WS_MIX), (const bf16_t*)(ws + WS_WOUT), 2048, 2048, 2048}; pg8::StaticOrder S; S.init(NT, 2048, G, bx); EpiOut E{P.x, (const float*)(ws + WS_MOD), (float*)(ws + WS_X1)};
        pg8::gemm_phase<EpiOut, pg8::StaticOrder, true>(lds, g, S, E);
    }
    if constexpr (K == 9) {
        phase_norm((const float*)(ws + WS_X1), P.norm_ffn_g, (const float*)(ws + WS_MOD), 6144, 8192, (bf16_t*)(ws + WS_H2));
        conv_rows_fp8(P.peer_u, ws + WS_PU, (float*)(ws + WS_PSU), 16384);
        conv_rows_fp8(P.peer_v, ws + WS_PV, (float*)(ws + WS_PSV), 16384);
    }
    if constexpr (K == 10) {
        pg8::Gemm g{(const bf16_t*)(ws + WS_H2), (const bf16_t*)(ws + WS_WSC), 2048, 2048, 2048}; pg8::StaticOrder S; S.init(NT, 2048, G, bx); EpiF32Plain E{(float*)(ws + WS_SC), 2048};
        pg8::gemm_phase<EpiF32Plain, pg8::StaticOrder>(lds, g, S, E);
    }
    if constexpr (K == 11) { phase_peer(P, lds); }
    if constexpr (K == 12) { phase_peer_a(P, lds); }
    if constexpr (K == 13) { phase_peer_w(P); }
    if constexpr (K == 14) { phase_peer_b(P, lds); }
    if constexpr (K == 15) { phase_peer_norm(P); }
}

__global__ void __launch_bounds__(512, 2) mk_fwd(Params P) {
    extern __shared__ __attribute__((aligned(16))) unsigned char lds_raw[];
    LAS unsigned char* lds = (LAS unsigned char*)lds_raw;
    unsigned char* ws = P.ws;
    const int G = gridDim.x, bx = blockIdx.x, tid = threadIdx.x;
    volatile LAS unsigned* misc = (volatile LAS unsigned*)(lds + LDS_MISC);
    if (tid < 8) misc[tid] = 0u;
    __syncthreads();
    const int lo = P.ph_lo, hi = P.ph_hi;
    XcdBarrier bar; bar.bar = (unsigned*)(ws + WS_BAR); bar.x = 0; bar.st = misc;
    if (hi - lo > 1) bar = xcd_barrier_post((unsigned*)(ws + WS_BAR), misc);
    if (tid == 0) { const unsigned xcc = xb_xcc_id(); misc[4] = xcc; misc[5] = (hi - lo > 1) ? xb_add((unsigned*)(ws + WS_BAR) + 8192 + 64 * (xcc & 15u), 1u) : 0u; }
    __syncthreads();
#define IN(k) (lo <= (k) && (k) < hi)
#define SEAM(k) do { if (IN(k) && IN((k) + 1)) xcd_barrier(bar); } while (0)

    if (IN(0)) run_phase<0>(P, lds);
    SEAM(0);
    if (IN(1)) run_phase<1>(P, lds);
    SEAM(1);
    if (IN(2)) run_phase<2>(P, lds);
    SEAM(2);
    if (IN(3)) run_phase<3>(P, lds);
    SEAM(3);
    if (IN(4)) run_phase<4>(P, lds);
    SEAM(4);
    if (IN(5)) run_phase<5>(P, lds);
    SEAM(5);
    if (IN(6)) run_phase<6>(P, lds);
    SEAM(6);
    if (IN(7)) run_phase<7>(P, lds);
    SEAM(7);
    if (IN(8)) run_phase<8>(P, lds);
    SEAM(8);
    if (IN(9)) run_phase<9>(P, lds);
    SEAM(9);
    if (IN(10)) run_phase<10>(P, lds);
    SEAM(10);
    if (IN(11)) run_phase<11>(P, lds);
    SEAM(11);
    if (IN(12)) run_phase<12>(P, lds);
    SEAM(12);
    if (IN(13)) run_phase<13>(P, lds);
    SEAM(13);
    if (IN(14)) run_phase<14>(P, lds);
    SEAM(14);
    if (IN(15)) run_phase<15>(P, lds);
#undef IN
#undef SEAM
}

extern "C" void kernel_launch(void* const* d_in, const int* in_sizes, int n_in, void* d_out, int out_size, void* d_ws, size_t ws_size, hipStream_t stream) {
    static int grid = 0;
    if (grid == 0) {
        if (n_in != 31 || ws_size < WS_END) { fprintf(stderr, "kernel_launch: expected 31 inputs and >= %zu bytes of workspace (got %d, %zu)\n", (size_t)WS_END, n_in, ws_size); grid = -1; return; }
        int dev = 0, cus = 0, per_cu = 0;
        if (hipGetDevice(&dev) != hipSuccess || hipDeviceGetAttribute(&cus, hipDeviceAttributeMultiprocessorCount, dev) != hipSuccess) { grid = -1; return; }
        if (hipFuncSetAttribute((const void*)mk_fwd, hipFuncAttributeMaxDynamicSharedMemorySize, LDS_BYTES) != hipSuccess) { fprintf(stderr, "kernel_launch: hipFuncSetAttribute failed\n"); grid = -1; return; }
        if (hipOccupancyMaxActiveBlocksPerMultiprocessor(&per_cu, (const void*)mk_fwd, 512, LDS_BYTES) != hipSuccess || per_cu < 1) { fprintf(stderr, "kernel_launch: occupancy query reports %d blocks per CU\n", per_cu); (void)hipGetLastError(); grid = -1; return; }
        grid = cus;
    }
    if (grid < 0) return;
    (void)hipMemsetAsync((char*)d_ws + WS_BAR, 0, 65536, stream);
    Params p{};
    const float** f = (const float**)&p;
    for (int i = 0; i < 31; ++i) f[i] = (const float*)d_in[i];
    p.out = (float*)d_out; p.ws = (unsigned char*)d_ws;
#if MK_PER_PHASE
    for (int ph = 0; ph < N_PHASES; ++ph) { p.ph_lo = ph; p.ph_hi = ph + 1; hipLaunchKernelGGL(mk_fwd, dim3(grid), dim3(512), LDS_BYTES, stream, p); }
#else
    p.ph_lo = 0; p.ph_hi = N_PHASES; hipLaunchKernelGGL(mk_fwd, dim3(grid), dim3(512), LDS_BYTES, stream, p);
#endif
}
```

```cpp
#include <hip/hip_runtime.h>
#include <stdint.h>
#include <stdio.h>
#include <math.h>
#include <type_traits>


#ifndef MK_PER_PHASE
#define MK_PER_PHASE 0
#endif

#define XB_TMO      128
#define XB_XCNT(j)  (256  + 64 * (j))
#define XB_XSUB(j)  (1280 + 64 * (j))
#define XB_XGEN(j)  (2304 + 64 * (j))
#define XB_TOP      3328
#define XB_TOPGEN   3392
#define XCD_BAR_WORDS 3456
#define XB_SPIN_CAP (1u << 18)
#define LAS __attribute__((address_space(3)))

__device__ __forceinline__ unsigned xb_ld(unsigned* p)              { return __hip_atomic_load(p, __ATOMIC_RELAXED, __HIP_MEMORY_SCOPE_AGENT); }
__device__ __forceinline__ unsigned xb_add(unsigned* p, unsigned v) { return __hip_atomic_fetch_add(p, v, __ATOMIC_RELAXED, __HIP_MEMORY_SCOPE_AGENT); }
__device__ __forceinline__ unsigned xb_xcc_id() { return (unsigned)__builtin_amdgcn_s_getreg((3 << 11) | 20) & 0xFu; }
#define XB_SPIN(cond, bar) do { unsigned _sp = 0; while (cond) { __builtin_amdgcn_s_sleep(1); \
    if ((++_sp & 255u) == 0u) { if (xb_ld(&(bar)[XB_TMO])) break; if (_sp > XB_SPIN_CAP) { atomicAdd(&(bar)[XB_TMO], 1u); break; } } } } while (0)

struct XcdBarrier {
    unsigned* bar; unsigned x;
    volatile LAS unsigned* st;
};

__device__ __forceinline__ XcdBarrier xcd_barrier_post(unsigned* bar, volatile LAS unsigned* st) {
    XcdBarrier b; b.bar = bar; b.x = xb_xcc_id(); b.st = st;
    if (threadIdx.x == 0) (void)xb_add(&bar[XB_XCNT(b.x)], 1u);
    return b;
}
__device__ __forceinline__ void xcd_barrier_complete(unsigned* bar, unsigned x, unsigned& nloc, unsigned& nx) {
    const unsigned G = gridDim.x * gridDim.y * gridDim.z;
    unsigned sum, cnt, mine, sp = 0u;
    for (;;) {
        sum = 0u; cnt = 0u; mine = 0u;
#pragma unroll
        for (unsigned j = 0; j < 16; ++j) { const unsigned c = xb_ld(&bar[XB_XCNT(j)]); sum += c; cnt += (c > 0u) ? 1u : 0u; mine = (j == x) ? c : mine; }
        if (sum == G) break;
        __builtin_amdgcn_s_sleep(1);
        if ((++sp & 255u) == 0u) { if (xb_ld(&bar[XB_TMO])) break; if (sp > XB_SPIN_CAP) { atomicAdd(&bar[XB_TMO], 1u); break; } }
    }
    nloc = mine > 0u ? mine : 1u; nx = cnt > 0u ? cnt : 1u;
}

__device__ __forceinline__ void xcd_barrier(const XcdBarrier& b) {
    asm volatile("s_waitcnt vmcnt(0)" ::: "memory");
    __syncthreads();
    if (threadIdx.x == 0) {
        unsigned* bar = b.bar;
        __builtin_amdgcn_s_waitcnt(0);
        unsigned nloc = b.st[0], nx = b.st[1];
        if (nloc == 0u) { xcd_barrier_complete(bar, b.x, nloc, nx); b.st[0] = nloc; b.st[1] = nx; }
        const unsigned old = xb_add(&bar[XB_XSUB(b.x)], 1u);
        const unsigned gen = old / nloc;
        if (old + 1u == (gen + 1u) * nloc) {
            __builtin_amdgcn_fence(__ATOMIC_RELEASE, "agent");
            asm volatile("s_waitcnt vmcnt(0)" ::: "memory");
            const unsigned og = xb_add(&bar[XB_TOP], 1u);
            const unsigned tg = og / nx;
            if (og + 1u == (tg + 1u) * nx) xb_add(&bar[XB_TOPGEN], 1u);
            else XB_SPIN(xb_ld(&bar[XB_TOPGEN]) == tg, bar);
            __builtin_amdgcn_fence(__ATOMIC_ACQUIRE, "agent");
            xb_add(&bar[XB_XGEN(b.x)], 1u);
            asm volatile("s_waitcnt vmcnt(0)" ::: "memory");
        } else {
            XB_SPIN(xb_ld(&bar[XB_XGEN(b.x)]) == gen, bar);
            __builtin_amdgcn_fence(__ATOMIC_ACQUIRE, "agent");
            asm volatile("s_waitcnt vmcnt(0)" ::: "memory");
        }
    }
    __syncthreads();
}


namespace pg8 {
#define PG8_LAS __attribute__((address_space(3)))
typedef unsigned short bf16_t;
typedef short bf16x8 __attribute__((ext_vector_type(8)));
typedef float f32x4 __attribute__((ext_vector_type(4)));
typedef unsigned u32x4 __attribute__((ext_vector_type(4)));
constexpr int BM = 256, BK = 64, HALF = 128, HTB = HALF * BK * 2  , STAGE_BYTES = 8 * HTB, NXCD = 8, WGM = 8;

__host__ __device__ __forceinline__ int lds_byte(int r, int c) { const int st = (r >> 4) * 2 + (c >> 5), rr = r & 15, cc = c & 31, ob = rr * 64 + cc * 2; return st * 1024 + (ob ^ (((ob >> 9) & 1) << 5)); }
__host__ __device__ __forceinline__ void stage_rc(int b, int& R, int& C) { const int st = b / 1024, sb = b % 1024, swz = sb ^ (((sb >> 9) & 1) << 5); R = (st >> 1) * 16 + swz / 64; C = (st & 1) * 32 + (swz % 64) / 2; }
__host__ __device__ __forceinline__ int perm32(int rho) { const int n = rho >> 4, i = rho & 15; return 8 * (i >> 2) + 4 * n + (i & 3); }

struct Unit { int pm, pn; };
struct Gemm { const bf16_t* A; const bf16_t* Bt; int lda, ldb, K; };
struct StaticOrder {
    int nM, nN, nwg, G, c;
    __host__ __device__ void init(int M, int N, int G_, int c_) { nM = M / BM; nN = N / BM; nwg = nM * nN; G = G_; c = c_; }
    __host__ __device__ bool next(int i, Unit& u) const {
        const long L = (long)i * G + c; if (L >= nwg) return false;
        int wgid = (int)L; { const int q = nwg / NXCD, r = nwg % NXCD, xcd = wgid % NXCD, off = wgid / NXCD; wgid = (xcd < r ? xcd * (q + 1) : r * (q + 1) + (xcd - r) * q) + off; }
        const int nig = WGM * nN, gid = wgid / nig, fm = gid * WGM, gsz = (nM - fm) < WGM ? (nM - fm) : WGM;
        u.pm = fm + ((wgid % nig) % gsz); u.pn = (wgid % nig) / gsz; return true;
    }
    __device__ __forceinline__ void a_ready(const Unit&) const {}
    __device__ __forceinline__ void done(const Unit&) const {}
};
template <class Epi, class Sched, bool F8 = false>
__device__ __forceinline__ void gemm_phase(PG8_LAS unsigned char* lds, const Gemm g, const Sched& S, const Epi& E) {
    const int tid = threadIdx.x, wid = __builtin_amdgcn_readfirstlane(tid >> 6), lane = tid & 63, wr = wid >> 2, wc = wid & 3, fr = lane & 15, fq = lane >> 4;
    constexpr int ES = F8 ? 1 : 2;
    const int K = g.K, nt = K * ES / 128;
    unsigned voffA[2], voffB[2];
#pragma unroll
    for (int i = 0; i < 2; ++i) { int R, C; stage_rc(tid * 16 + i * 8192, R, C); const int Rb = Epi::PERM ? ((R & ~31) + perm32(R & 31)) : R;
        voffA[i] = (unsigned)(R * g.lda * ES + C * 2); voffB[i] = (unsigned)(Rb * g.ldb * ES + C * 2); }
    const size_t kstep = (size_t)(BK * 2);
    const size_t hstepA = (size_t)HALF * g.lda * ES, hstepB = (size_t)HALF * g.ldb * ES;
    const size_t tstepA = 2 * hstepA, tstepB = 2 * hstepB;
    const unsigned ldsw = (unsigned)wid * 1024u;
    const int aoff = lds_byte(wr * 64 + fr, fq * 8), boff = lds_byte(wc * 32 + fr, fq * 8);
#define PG8_SA(b, h) (((b) * 2 + (h)) * HTB)
#define PG8_SB(b, h) ((4 + (b) * 2 + (h)) * HTB)
#define PG8_STAGE(bufoff, gbase, voff) do { _Pragma("unroll") for (int _i = 0; _i < 2; ++_i) \
        __builtin_amdgcn_global_load_lds((const unsigned*)((const char*)(gbase) + (voff)[_i]), (PG8_LAS unsigned*)(lds + (bufoff) + ldsw + _i * 8192), 16, 0, 0); } while (0)
#define PG8_LDA(dst, b, h) do { _Pragma("unroll") for (int m = 0; m < 4; ++m) _Pragma("unroll") for (int k = 0; k < 2; ++k) dst[m][k] = *(const PG8_LAS frag_t*)(lds + PG8_SA(b, h) + aoff + m * 2048 + k * 1024); } while (0)
#define PG8_LDB(dst, b, h) do { _Pragma("unroll") for (int n = 0; n < 2; ++n) _Pragma("unroll") for (int k = 0; k < 2; ++k) dst[n][k] = *(const PG8_LAS frag_t*)(lds + PG8_SB(b, h) + boff + n * 2048 + k * 1024); } while (0)
#define PG8_MMA(ai, bj, At, Bt) do { __builtin_amdgcn_s_setprio(1); _Pragma("unroll") for (int m = 0; m < 4; ++m) _Pragma("unroll") for (int n = 0; n < 2; ++n) _Pragma("unroll") for (int k = 0; k < 2; ++k) { \
        if constexpr (F8) { acc[ai][bj][m][n] = __builtin_amdgcn_mfma_f32_16x16x32_fp8_fp8(Bt[n][k][0], At[m][k][0], acc[ai][bj][m][n], 0, 0, 0); \
            acc[ai][bj][m][n] = __builtin_amdgcn_mfma_f32_16x16x32_fp8_fp8(Bt[n][k][1], At[m][k][1], acc[ai][bj][m][n], 0, 0, 0); } \
        else { if constexpr (!F8) acc[ai][bj][m][n] = __builtin_amdgcn_mfma_f32_16x16x32_bf16(Bt[n][k], At[m][k], acc[ai][bj][m][n], 0, 0, 0); } } __builtin_amdgcn_s_setprio(0); } while (0)
#define PG8_WAIT_V(n) asm volatile("s_waitcnt vmcnt(" #n ")" ::: "memory")
#define PG8_WAIT_L(n) asm volatile("s_waitcnt lgkmcnt(" #n ")" ::: "memory")
#define PG8_BAR __builtin_amdgcn_s_barrier()
#define PG8_SCHED __builtin_amdgcn_sched_barrier(0)
    Unit cur, nxt; int ui = 0;
    if (!S.next(0, cur)) return;
    f32x4 acc[2][2][4][2];
#pragma unroll
    for (int a = 0; a < 2; ++a)
#pragma unroll
        for (int b = 0; b < 2; ++b)
#pragma unroll
            for (int m = 0; m < 4; ++m)
#pragma unroll
                for (int n = 0; n < 2; ++n) acc[a][b][m][n] = (f32x4){0.f, 0.f, 0.f, 0.f};
    typedef long pg8_l2 __attribute__((ext_vector_type(2)));
    typedef typename std::conditional<F8, pg8_l2, bf16x8>::type frag_t;
    frag_t At[4][2], B0[2][2], B1[2][2];
    const char* cA = (const char*)g.A + (size_t)cur.pm * tstepA; const char* cB = (const char*)g.Bt + (size_t)cur.pn * tstepB;
    S.a_ready(cur);
    PG8_STAGE(PG8_SB(0, 0), cB, voffB); PG8_STAGE(PG8_SA(0, 0), cA, voffA); PG8_STAGE(PG8_SB(0, 1), cB + hstepB, voffB); PG8_STAGE(PG8_SA(0, 1), cA + hstepA, voffA);
    if (wr == 1) PG8_BAR;
    PG8_WAIT_V(4); PG8_BAR;
    PG8_STAGE(PG8_SB(1, 0), cB + kstep, voffB); PG8_STAGE(PG8_SA(1, 0), cA + kstep, voffA); PG8_STAGE(PG8_SB(1, 1), cB + hstepB + kstep, voffB);
    PG8_WAIT_V(6); PG8_BAR;
    for (;;) {
        const bool has_next = S.next(ui + 1, nxt);
        const char* nA = has_next ? (const char*)g.A + (size_t)nxt.pm * tstepA : cA; const char* nB = has_next ? (const char*)g.Bt + (size_t)nxt.pn * tstepB : cB;
        for (int t = 0; t < nt; t += 2) {
            const bool last = (t == nt - 2);
            const char* a1 = cA + (size_t)(t + 1) * kstep;
            const char* a2 = last ? nA : cA + (size_t)(t + 2) * kstep; const char* b2 = last ? nB : cB + (size_t)(t + 2) * kstep;
            const char* a3 = a2 + kstep; const char* b3 = b2 + kstep;
            if (last && has_next) S.a_ready(nxt);
            PG8_LDB(B0, 0, 0); PG8_SCHED; PG8_LDA(At, 0, 0); PG8_STAGE(PG8_SA(1, 1), a1 + hstepA, voffA);
            PG8_WAIT_L(8); PG8_BAR; PG8_WAIT_L(0); PG8_MMA(0, 0, At, B0); PG8_BAR; PG8_SCHED;
            PG8_LDB(B1, 0, 1); PG8_STAGE(PG8_SB(0, 0), b2, voffB);
            PG8_BAR; PG8_WAIT_L(0); PG8_MMA(0, 1, At, B1); PG8_BAR;
            PG8_LDA(At, 0, 1); PG8_STAGE(PG8_SA(0, 0), a2, voffA);
            PG8_BAR; PG8_WAIT_L(0); PG8_MMA(1, 0, At, B0); PG8_BAR; PG8_SCHED;
            PG8_STAGE(PG8_SB(0, 1), b2 + hstepB, voffB);
            PG8_WAIT_V(6); PG8_BAR; PG8_MMA(1, 1, At, B1); PG8_BAR;
            PG8_LDB(B0, 1, 0); PG8_SCHED; PG8_LDA(At, 1, 0); PG8_STAGE(PG8_SA(0, 1), a2 + hstepA, voffA);
            PG8_WAIT_L(8); PG8_BAR; PG8_WAIT_L(0); PG8_MMA(0, 0, At, B0); PG8_BAR; PG8_SCHED;
            PG8_LDB(B1, 1, 1); PG8_STAGE(PG8_SB(1, 0), b3, voffB);
            PG8_BAR; PG8_WAIT_L(0); PG8_MMA(0, 1, At, B1); PG8_BAR;
            PG8_LDA(At, 1, 1); PG8_STAGE(PG8_SA(1, 0), a3, voffA);
            PG8_BAR; PG8_WAIT_L(0); PG8_MMA(1, 0, At, B0); PG8_BAR; PG8_SCHED;
            PG8_STAGE(PG8_SB(1, 1), b3 + hstepB, voffB);
            PG8_WAIT_V(6); PG8_BAR; PG8_MMA(1, 1, At, B1); PG8_BAR;
        }
        if constexpr (!Epi::AFTER_DRAIN) { E(acc, cur, wr, wc, fr, fq); S.done(cur); }
        if (!has_next) break;
#pragma unroll
        for (int a = 0; a < 2; ++a)
#pragma unroll
            for (int b = 0; b < 2; ++b)
#pragma unroll
                for (int m = 0; m < 4; ++m)
#pragma unroll
                    for (int n = 0; n < 2; ++n) acc[a][b][m][n] = (f32x4){0.f, 0.f, 0.f, 0.f};
        cur = nxt; cA = nA; cB = nB; ++ui;
    }
    PG8_WAIT_V(0);
    if (wr == 0) PG8_BAR;
    PG8_BAR;
    if constexpr (Epi::AFTER_DRAIN) { E.fused(acc, cur, wr, wc, fr, fq, lds, wid, lane); S.done(cur); }
#undef PG8_SA
#undef PG8_SB
#undef PG8_STAGE
#undef PG8_LDA
#undef PG8_LDB
#undef PG8_MMA
#undef PG8_WAIT_V
#undef PG8_WAIT_L
#undef PG8_BAR
#undef PG8_SCHED
}
}

typedef unsigned short bf16_t;
typedef short bf16x8 __attribute__((ext_vector_type(8)));
typedef short s16x4 __attribute__((ext_vector_type(4)));
typedef float f32x2 __attribute__((ext_vector_type(2)));
typedef float f32x4 __attribute__((ext_vector_type(4)));
typedef float f32x16 __attribute__((ext_vector_type(16)));
typedef unsigned u32x2 __attribute__((ext_vector_type(2)));
typedef unsigned u32x4 __attribute__((ext_vector_type(4)));
typedef __bf16 bf16v2 __attribute__((ext_vector_type(2)));

constexpr int NB = 4, SEQ = 4096, NT = NB * SEQ, DM = 2048;
constexpr int NPROJ = 7936;
constexpr int NCMP = 255;
constexpr float QSCALE = 0.125f * 1.4426950408889634f;
constexpr float LOG2E = 1.4426950408889634f;
constexpr float NEGBIG = -1e30f;
constexpr float OATT_SCALE = 64.f, Y2_SCALE = 16.f, MIX_SCALE = 64.f;

constexpr size_t WS_BAR   = 0;
constexpr size_t WS_MOD   = 65536;
constexpr size_t WS_CB    = WS_MOD + 196608;
constexpr size_t WS_A16   = WS_CB + 2048;
constexpr size_t WS_W     = 327680;
constexpr size_t WS_WIN   = WS_W;
constexpr size_t WS_WGLU  = WS_WIN + (size_t)NPROJ * 2048 * 2;
constexpr size_t WS_WUA   = WS_WGLU + 2097152;
constexpr size_t WS_WUS   = WS_WUA + 4194304;
constexpr size_t WS_WOUT  = WS_WUS + 4194304;
constexpr size_t WS_WQ    = WS_WOUT + 8388608;
constexpr size_t WS_KBD   = WS_WQ + 8388608;
constexpr size_t WS_WSC   = WS_KBD + 8388608;
constexpr size_t WS_WC1   = WS_WSC + 8388608;
constexpr size_t WS_S5B1  = WS_WC1 + 2097152;
constexpr size_t WS_S5B2  = WS_S5B1 + 8388608;
constexpr size_t WS_HID   = WS_S5B2 + 12582912;
constexpr size_t WS_CKV   = WS_HID + 4194304;
constexpr size_t WS_GATE  = WS_CKV + 1048576;
constexpr size_t WS_SELM  = WS_GATE + 3145728;
constexpr size_t WS_RA    = WS_SELM + 524288;
constexpr size_t WS_RB    = WS_RA + 67108864;
constexpr size_t WS_RC    = WS_RB + 134217728;
constexpr size_t WS_RD    = WS_RC + 134217728;
constexpr size_t WS_END   = WS_RD + 134217728;
constexpr size_t WS_H = WS_RA, WS_HSC = WS_RD + 104857600  , WS_OC = WS_RA, WS_OW = WS_RA + 33554432, WS_MIX = WS_RA, WS_H2 = WS_RA;
constexpr size_t WS_MG = WS_RB, WS_SC = WS_RB;
constexpr size_t WS_Q = WS_RC, WS_KV = WS_RC + 33554432, WS_A2 = WS_KV + 6 * 8388608, WS_X1 = WS_RC;
constexpr size_t WS_XL = WS_RD, WS_YACT = WS_RD + 33554432, WS_Y2 = WS_RD + 67108864, WS_OATT = WS_RD + 100663296, WS_TMP = WS_RD, WS_PU = WS_RD, WS_PV = WS_RD + 33554432, WS_PSU = WS_RD + 67108864, WS_PSV = WS_RD + 67108864 + 65536, WS_EX = WS_RD + 68157440, WS_GT = WS_EX + 8388608, WS_SS = WS_GT + 8388608, WS_SU = WS_SS + 1048576, WS_PA = WS_RB;

constexpr int LDS_BYTES = 147456;
constexpr int LDS_MISC = 131072;

struct Params {
    const float* x; const float* c; const float* ada_w; const float* ada_b; const float* norm_mix_g; const float* norm_ffn_g; const float* w_in;
    const float* cmp_pos; const float* cmp_w1; const float* cmp_b1; const float* cmp_w2; const float* cmp_b2; const float* rel_bias;
    const float* s5_lam_re; const float* s5_lam_im; const float* s5_log_step; const float* s5_b_re; const float* s5_b_im; const float* s5_c_re; const float* s5_c_im; const float* s5_d;
    const float* glu_w; const float* glu_b; const float* w_up_attn; const float* w_up_ssm; const float* w_out; const float* peer_w_q; const float* peer_sub_keys;
    const float* peer_u; const float* peer_v; const float* final_g;
    float* out; unsigned char* ws; int ph_lo, ph_hi;
};

#define DI __device__ __forceinline__
DI unsigned pk_bf16(float lo, float hi) { bf16v2 v; v[0] = (__bf16)lo; v[1] = (__bf16)hi; return __builtin_bit_cast(unsigned, v); }
DI bf16_t f2bf(float x) { return (bf16_t)(pk_bf16(x, 0.f) & 0xffffu); }
DI float bf_lo(unsigned u) { return __uint_as_float(u << 16); }
DI float bf_hi(unsigned u) { return __uint_as_float(u & 0xffff0000u); }
DI float bf2f(bf16_t b) { return __uint_as_float(((unsigned)b) << 16); }
DI bf16v2 bf16pair(unsigned w) { return __builtin_bit_cast(bf16v2, w); }
DI float dot2_bf16(unsigned w, unsigned x, float acc) { return __builtin_amdgcn_fdot2_f32_bf16(__builtin_bit_cast(bf16v2, w), __builtin_bit_cast(bf16v2, x), acc, false); }
DI float sigm(float x) { return __builtin_amdgcn_rcpf(1.f + __builtin_amdgcn_exp2f(-1.4426950408889634f * x)); }
DI float gelu_tanh(float x) { const float u = 1.5957691216f * (x + 0.044715f * x * x * x); return x * __builtin_amdgcn_rcpf(1.f + __builtin_amdgcn_exp2f(-1.4426950408889634f * u)); }
DI float xor32_add(float x) { const auto r = __builtin_amdgcn_permlane32_swap(__float_as_uint(x), __float_as_uint(x), false, false); return __uint_as_float(r[0]) + __uint_as_float(r[1]); }
DI float xor16_add(float x) { const auto r = __builtin_amdgcn_permlane16_swap(__float_as_uint(x), __float_as_uint(x), false, false); return __uint_as_float(r[0]) + __uint_as_float(r[1]); }
DI float xor32_max(float x) { const auto r = __builtin_amdgcn_permlane32_swap(__float_as_uint(x), __float_as_uint(x), false, false); return fmaxf(__uint_as_float(r[0]), __uint_as_float(r[1])); }
DI float row16_sum(float v) {
    asm volatile("s_nop 1\n\tv_add_f32_dpp %0, %0, %0 quad_perm:[1,0,3,2] row_mask:0xf bank_mask:0xf\n\ts_nop 1\n\tv_add_f32_dpp %0, %0, %0 quad_perm:[2,3,0,1] row_mask:0xf bank_mask:0xf\n\t"
                 "s_nop 1\n\tv_add_f32_dpp %0, %0, %0 row_half_mirror row_mask:0xf bank_mask:0xf\n\ts_nop 1\n\tv_add_f32_dpp %0, %0, %0 row_mirror row_mask:0xf bank_mask:0xf\n\ts_nop 1" : "+v"(v));
    return v; }
DI float wave_sum(float v) { return xor32_add(xor16_add(row16_sum(v))); }
DI float reduce8_row16(const float (&v)[8], int li) {
    const bool b3 = (li & 8) != 0, b2 = (li & 4) != 0, b1 = (li & 2) != 0; float t[4], u[2], w, z;
#pragma unroll
    for (int k = 0; k < 4; ++k) { const float keep = b3 ? v[4 + k] : v[k], send = b3 ? v[k] : v[4 + k];
        asm volatile("s_nop 1\n\tv_add_f32_dpp %0, %1, %2 row_mirror row_mask:0xf bank_mask:0xf" : "=v"(t[k]) : "v"(send), "v"(keep)); }
#pragma unroll
    for (int k = 0; k < 2; ++k) { const float keep = b2 ? t[2 + k] : t[k], send = b2 ? t[k] : t[2 + k];
        asm volatile("s_nop 1\n\tv_add_f32_dpp %0, %1, %2 row_half_mirror row_mask:0xf bank_mask:0xf" : "=v"(u[k]) : "v"(send), "v"(keep)); }
    { const float keep = b1 ? u[1] : u[0], send = b1 ? u[0] : u[1];
      asm volatile("s_nop 1\n\tv_add_f32_dpp %0, %1, %2 quad_perm:[3,2,1,0] row_mask:0xf bank_mask:0xf" : "=v"(w) : "v"(send), "v"(keep)); }
    asm volatile("s_nop 1\n\tv_add_f32_dpp %0, %1, %1 quad_perm:[1,0,3,2] row_mask:0xf bank_mask:0xf" : "=v"(z) : "v"(w));
    return z; }
DI unsigned row16_max_u32(unsigned v) {
    asm volatile("s_nop 1\n\tv_max_u32_dpp %0, %0, %0 quad_perm:[1,0,3,2] row_mask:0xf bank_mask:0xf\n\ts_nop 1\n\tv_max_u32_dpp %0, %0, %0 quad_perm:[2,3,0,1] row_mask:0xf bank_mask:0xf\n\t"
                 "s_nop 1\n\tv_max_u32_dpp %0, %0, %0 row_half_mirror row_mask:0xf bank_mask:0xf\n\ts_nop 1\n\tv_max_u32_dpp %0, %0, %0 row_mirror row_mask:0xf bank_mask:0xf\n\ts_nop 1" : "+v"(v));
    return v; }
DI unsigned wave_max_u32(unsigned v) {
    v = row16_max_u32(v);
    { const auto r = __builtin_amdgcn_permlane16_swap(v, v, false, false); v = max(r[0], r[1]); }
    { const auto r = __builtin_amdgcn_permlane32_swap(v, v, false, false); v = max(r[0], r[1]); }
    return (unsigned)__builtin_amdgcn_readfirstlane((int)v); }
DI unsigned mono_u32(float x) { const unsigned b = __float_as_uint(x); return b ^ (((int)b >> 31) | 0x80000000u); }
DI void store8_bf16(bf16_t* p, f32x4 a, f32x4 b) { u32x4 w; w[0] = pk_bf16(a[0], a[1]); w[1] = pk_bf16(a[2], a[3]); w[2] = pk_bf16(b[0], b[1]); w[3] = pk_bf16(b[2], b[3]); *(u32x4*)p = w; }
DI float clamp448(float x) { return __builtin_amdgcn_fmed3f(x, -448.f, 448.f); }
DI void store8_fp8(unsigned char* p, f32x4 a, f32x4 b, float sc) {
    int p0 = __builtin_amdgcn_cvt_pk_fp8_f32(clamp448(a[0] * sc), clamp448(a[1] * sc), 0, false); p0 = __builtin_amdgcn_cvt_pk_fp8_f32(clamp448(a[2] * sc), clamp448(a[3] * sc), p0, true);
    int p1 = __builtin_amdgcn_cvt_pk_fp8_f32(clamp448(b[0] * sc), clamp448(b[1] * sc), 0, false); p1 = __builtin_amdgcn_cvt_pk_fp8_f32(clamp448(b[2] * sc), clamp448(b[3] * sc), p1, true);
    u32x2 w; w[0] = (unsigned)p0; w[1] = (unsigned)p1; *(u32x2*)p = w; }
DI void load8_bf16(const bf16_t* p, f32x4& a, f32x4& b) { const u32x4 w = *(const u32x4*)p; a = (f32x4){bf_lo(w[0]), bf_hi(w[0]), bf_lo(w[1]), bf_hi(w[1])}; b = (f32x4){bf_lo(w[2]), bf_hi(w[2]), bf_lo(w[3]), bf_hi(w[3])}; }

#define EPI_ROWS(ai, m) for (int ai = 0; ai < 2; ++ai) for (int m = 0; m < 4; ++m)
struct EpiProj {
    static constexpr bool PERM = true, AFTER_DRAIN = false;
    unsigned char* ws; const float* hsc;
    DI void operator()(const f32x4 (&acc)[2][2][4][2], const pg8::Unit& u, int wr, int wc, int fr, int fq) const {
        const int pn = u.pn;
#pragma unroll
        for (int ai = 0; ai < 2; ++ai)
#pragma unroll
            for (int m = 0; m < 4; ++m) {
                const int row = u.pm * 256 + ai * 128 + wr * 64 + m * 16 + fr;
                const int b = row >> 12, t = row & 4095; const float rsc = hsc[row] * (1.f / 2048.f);
#pragma unroll
                for (int bj = 0; bj < 2; ++bj) {
                    const int c8 = bj * 128 + wc * 32 + fq * 8;
                    f32x4 v0 = acc[ai][bj][m][0] * rsc, v1 = acc[ai][bj][m][1] * rsc;
                    if (pn < 4) {
                        store8_bf16((bf16_t*)(ws + WS_Q) + (size_t)row * 1024 + pn * 256 + c8, v0 * QSCALE, v1 * QSCALE);
                    } else if (pn < 10) {
                        const int k = c8 >> 6, dd = c8 & 63;
                        store8_bf16((bf16_t*)(ws + WS_KV) + (size_t)(pn - 4) * 4194304 + ((size_t)((b * 4 + k) * 4096 + t)) * 64 + dd, v0, v1);
                    } else if (pn < 14) {
                        const int cu = (pn - 10) * 256 + c8, g = cu >> 4, h0 = cu & 15;
                        store8_bf16((bf16_t*)(ws + WS_A2) + ((size_t)(g * 1024 + b * 256 + (t >> 4))) * 384 + (t & 15) * 16 + h0, v0, v1);
                    } else if (pn < 30) {
                        f32x4 s0, s1;
#pragma unroll
                        for (int e = 0; e < 4; ++e) { s0[e] = sigm(v0[e]); s1[e] = sigm(v1[e]); }
                        store8_bf16((bf16_t*)(ws + WS_MG) + (size_t)row * 4096 + (pn - 14) * 256 + c8, s0, s1);
                    } else {
                        if (c8 < 48) { float* gp = (float*)(ws + WS_GATE) + (size_t)row * 48 + c8; f32x4 s0, s1;
#pragma unroll
                            for (int e = 0; e < 4; ++e) { s0[e] = sigm(v0[e]); s1[e] = sigm(v1[e]); }
                            *(f32x4*)gp = s0; *(f32x4*)(gp + 4) = s1; }
                    }
                }
            }
    }
};
struct EpiBf16Plain {
    static constexpr bool PERM = true, AFTER_DRAIN = false;
    bf16_t* O; int ldc;
    DI void operator()(const f32x4 (&acc)[2][2][4][2], const pg8::Unit& u, int wr, int wc, int fr, int fq) const {
#pragma unroll
        for (int ai = 0; ai < 2; ++ai)
#pragma unroll
            for (int m = 0; m < 4; ++m) { const int row = u.pm * 256 + ai * 128 + wr * 64 + m * 16 + fr;
#pragma unroll
                for (int bj = 0; bj < 2; ++bj) { const int col = u.pn * 256 + bj * 128 + wc * 32 + fq * 8; store8_bf16(O + (size_t)row * ldc + col, acc[ai][bj][m][0], acc[ai][bj][m][1]); } }
    }
};
struct EpiCmp1 {
    static constexpr bool PERM = true, AFTER_DRAIN = false;
    bf16_t* O; const float* bias;
    DI void operator()(const f32x4 (&acc)[2][2][4][2], const pg8::Unit& u, int wr, int wc, int fr, int fq) const {
        const float* bi = bias + (u.pm >> 4) * 256;
#pragma unroll
        for (int ai = 0; ai < 2; ++ai)
#pragma unroll
            for (int m = 0; m < 4; ++m) { const int row = u.pm * 256 + ai * 128 + wr * 64 + m * 16 + fr;
#pragma unroll
                for (int bj = 0; bj < 2; ++bj) { const int col = bj * 128 + wc * 32 + fq * 8; f32x4 v0 = acc[ai][bj][m][0] + *(const f32x4*)(bi + col), v1 = acc[ai][bj][m][1] + *(const f32x4*)(bi + col + 4);
#pragma unroll
                    for (int e = 0; e < 4; ++e) { v0[e] = gelu_tanh(v0[e]); v1[e] = gelu_tanh(v1[e]); }
                    store8_bf16(O + (size_t)row * 256 + col, v0, v1); } }
    }
};
struct EpiS5G1 {
    static constexpr bool PERM = false, AFTER_DRAIN = false;
    float* X;
    DI void operator()(const f32x4 (&acc)[2][2][4][2], const pg8::Unit& u, int wr, int wc, int fr, int fq) const {
#pragma unroll
        for (int ai = 0; ai < 2; ++ai)
#pragma unroll
            for (int m = 0; m < 4; ++m) { const int row = u.pm * 256 + ai * 128 + wr * 64 + m * 16 + fr;
#pragma unroll
                for (int n = 0; n < 2; ++n) { const int col = wc * 32 + n * 16 + fq * 4; *(f32x4*)(X + (size_t)row * 128 + col) = acc[ai][0][m][n]; } }
    }
};
struct EpiS5G2 {
    static constexpr bool PERM = true, AFTER_DRAIN = false;
    bf16_t* Y;
    DI void operator()(const f32x4 (&acc)[2][2][4][2], const pg8::Unit& u, int wr, int wc, int fr, int fq) const {
        const int g = u.pm >> 2;
#pragma unroll
        for (int ai = 0; ai < 2; ++ai)
#pragma unroll
            for (int m = 0; m < 4; ++m) { const int rg = (u.pm & 3) * 256 + ai * 128 + wr * 64 + m * 16 + fr;
                const int b = rg >> 8, ch = rg & 255;
#pragma unroll
                for (int bj = 0; bj < 2; ++bj) { const int c8 = bj * 128 + wc * 32 + fq * 8, tau = c8 >> 4, h0 = c8 & 15; f32x4 v0 = acc[ai][bj][m][0], v1 = acc[ai][bj][m][1];
#pragma unroll
                    for (int e = 0; e < 4; ++e) { v0[e] = gelu_tanh(v0[e]); v1[e] = gelu_tanh(v1[e]); }
                    store8_bf16(Y + ((size_t)(b * 4096 + ch * 16 + tau)) * 1024 + g * 16 + h0, v0, v1); } }
    }
};
struct EpiGlu {
    static constexpr bool PERM = true, AFTER_DRAIN = false;
    const bf16_t* Y; bf16_t* O; const float* bias;
    DI void operator()(const f32x4 (&acc)[2][2][4][2], const pg8::Unit& u, int wr, int wc, int fr, int fq) const {
#pragma unroll
        for (int bj = 0; bj < 2; ++bj) { const int col = u.pn * 256 + bj * 128 + wc * 32 + fq * 8; const f32x4 b0 = *(const f32x4*)(bias + col), b1 = *(const f32x4*)(bias + col + 4);
            u32x4 yv[8];
#pragma unroll
            for (int q = 0; q < 8; ++q) { const int row = u.pm * 256 + (q >> 2) * 128 + wr * 64 + (q & 3) * 16 + fr; yv[q] = *(const u32x4*)(Y + (size_t)row * 1024 + col); }
#pragma unroll
            for (int q = 0; q < 8; ++q) { const int ai = q >> 2, m = q & 3, row = u.pm * 256 + ai * 128 + wr * 64 + m * 16 + fr;
                const f32x4 y0 = (f32x4){bf_lo(yv[q][0]), bf_hi(yv[q][0]), bf_lo(yv[q][1]), bf_hi(yv[q][1])}, y1 = (f32x4){bf_lo(yv[q][2]), bf_hi(yv[q][2]), bf_lo(yv[q][3]), bf_hi(yv[q][3])};
                f32x4 v0 = acc[ai][bj][m][0] + b0, v1 = acc[ai][bj][m][1] + b1;
#pragma unroll
                for (int e = 0; e < 4; ++e) { v0[e] = y0[e] * sigm(v0[e]); v1[e] = y1[e] * sigm(v1[e]); }
                store8_fp8((unsigned char*)O + (size_t)row * 1024 + col, v0, v1, Y2_SCALE); } }
    }
};
template <int SECOND> struct EpiUp {
    static constexpr bool PERM = true, AFTER_DRAIN = false;
    const bf16_t* MG; const bf16_t* TMP; bf16_t* O; float ascale;
    DI void operator()(const f32x4 (&acc)[2][2][4][2], const pg8::Unit& u, int wr, int wc, int fr, int fq) const {
#pragma unroll
        for (int bj = 0; bj < 2; ++bj) { const int col = u.pn * 256 + bj * 128 + wc * 32 + fq * 8;
            u32x4 gv[8], tv[8];
#pragma unroll
            for (int q = 0; q < 8; ++q) { const int row = u.pm * 256 + (q >> 2) * 128 + wr * 64 + (q & 3) * 16 + fr; gv[q] = *(const u32x4*)(MG + (size_t)row * 4096 + SECOND * 2048 + col);
                if (SECOND) tv[q] = *(const u32x4*)(TMP + (size_t)row * 2048 + col); }
#pragma unroll
            for (int q = 0; q < 8; ++q) { const int ai = q >> 2, m = q & 3, row = u.pm * 256 + ai * 128 + wr * 64 + m * 16 + fr;
                const f32x4 g0 = (f32x4){bf_lo(gv[q][0]), bf_hi(gv[q][0]), bf_lo(gv[q][1]), bf_hi(gv[q][1])}, g1 = (f32x4){bf_lo(gv[q][2]), bf_hi(gv[q][2]), bf_lo(gv[q][3]), bf_hi(gv[q][3])};
                f32x4 v0 = acc[ai][bj][m][0] * (g0 * ascale), v1 = acc[ai][bj][m][1] * (g1 * ascale);
                if (SECOND) { v0 += (f32x4){bf_lo(tv[q][0]), bf_hi(tv[q][0]), bf_lo(tv[q][1]), bf_hi(tv[q][1])}; v1 += (f32x4){bf_lo(tv[q][2]), bf_hi(tv[q][2]), bf_lo(tv[q][3]), bf_hi(tv[q][3])};
                    store8_fp8((unsigned char*)O + (size_t)row * 2048 + col, v0, v1, MIX_SCALE); }
                else store8_bf16(O + (size_t)row * 2048 + col, v0, v1); } }
    }
};
struct EpiOut {
    static constexpr bool PERM = false, AFTER_DRAIN = false;
    const float* X; const float* mod; float* O;
    DI void operator()(const f32x4 (&acc)[2][2][4][2], const pg8::Unit& u, int wr, int wc, int fr, int fq) const {
        const float* g1 = mod + ((u.pm * 256) >> 12) * 12288 + 4096;
#pragma unroll
        for (int bj = 0; bj < 2; ++bj)
#pragma unroll
            for (int n = 0; n < 2; ++n) { const int col = u.pn * 256 + bj * 128 + wc * 32 + n * 16 + fq * 4; const f32x4 gg = *(const f32x4*)(g1 + col) * (1.f / (MIX_SCALE * 2048.f));
                f32x4 xv[8];
#pragma unroll
                for (int q = 0; q < 8; ++q) { const int row = u.pm * 256 + (q >> 2) * 128 + wr * 64 + (q & 3) * 16 + fr; xv[q] = *(const f32x4*)(X + (size_t)row * 2048 + col); }
#pragma unroll
                for (int q = 0; q < 8; ++q) { const int ai = q >> 2, m = q & 3, row = u.pm * 256 + ai * 128 + wr * 64 + m * 16 + fr;
                    *(f32x4*)(O + (size_t)row * 2048 + col) = xv[q] + gg * acc[ai][bj][m][n];
                } }
    }
};
struct EpiF32Plain {
    static constexpr bool PERM = false, AFTER_DRAIN = false;
    float* C; int ldc;
    DI void operator()(const f32x4 (&acc)[2][2][4][2], const pg8::Unit& u, int wr, int wc, int fr, int fq) const {
#pragma unroll
        for (int ai = 0; ai < 2; ++ai)
#pragma unroll
            for (int m = 0; m < 4; ++m) { const int row = u.pm * 256 + ai * 128 + wr * 64 + m * 16 + fr;
#pragma unroll
                for (int bj = 0; bj < 2; ++bj)
#pragma unroll
                    for (int n = 0; n < 2; ++n) { const int col = u.pn * 256 + bj * 128 + wc * 32 + n * 16 + fq * 4; *(f32x4*)(C + (size_t)row * ldc + col) = acc[ai][bj][m][n]; } }
    }
};
struct GroupOrder {
    int n, G, c, div;
    DI bool next(int i, pg8::Unit& u) const { const int L = i * G + c; if (L >= n) return false; u.pm = L; u.pn = L / div; return true; }
    DI void a_ready(const pg8::Unit&) const {}
    DI void done(const pg8::Unit&) const {}
};

template <int MODE> DI int src_col(int n) {
    if (MODE == 0) return n;
    if (n < 2560) return n; if (n < 7680) return n + 48; if (n < 7728) return n - 7680 + 2560; return -1; }
template <int MODE, bool F8OUT = false> DI void tconv_tiles(const float* __restrict__ src, int ld, int K, int Nd, bf16_t* __restrict__ dst, LAS float* tile, int first, int stride, float f8scale = 1.f) {
    const int tid = threadIdx.x, ntk = K >> 6, ntot = ntk * (Nd >> 6);
    for (int it = first; it < ntot; it += stride) {
        const int n0 = (it / ntk) << 6, k0 = (it % ntk) << 6;
        __syncthreads();
        { const int j = tid & 63, i0 = tid >> 6, sc = src_col<MODE>(n0 + j);
#pragma unroll
          for (int rr = 0; rr < 8; ++rr) { const int i = i0 + 8 * rr; tile[i * 65 + j] = sc >= 0 ? src[(size_t)(k0 + i) * ld + sc] : 0.f; } }
        __syncthreads();
        { const int jj = tid >> 3, ii0 = (tid & 7) * 8; float v[8];
#pragma unroll
          for (int e = 0; e < 8; ++e) v[e] = tile[(ii0 + e) * 65 + jj];
          if constexpr (F8OUT) { int p0 = __builtin_amdgcn_cvt_pk_fp8_f32(clamp448(v[0] * f8scale), clamp448(v[1] * f8scale), 0, false); p0 = __builtin_amdgcn_cvt_pk_fp8_f32(clamp448(v[2] * f8scale), clamp448(v[3] * f8scale), p0, true);
              int p1 = __builtin_amdgcn_cvt_pk_fp8_f32(clamp448(v[4] * f8scale), clamp448(v[5] * f8scale), 0, false); p1 = __builtin_amdgcn_cvt_pk_fp8_f32(clamp448(v[6] * f8scale), clamp448(v[7] * f8scale), p1, true);
              u32x2 w; w[0] = (unsigned)p0; w[1] = (unsigned)p1; *(u32x2*)((unsigned char*)dst + (size_t)(n0 + jj) * K + k0 + ii0) = w; }
          else { u32x4 w; w[0] = pk_bf16(v[0], v[1]); w[1] = pk_bf16(v[2], v[3]); w[2] = pk_bf16(v[4], v[5]); w[3] = pk_bf16(v[6], v[7]);
              *(u32x4*)(dst + (size_t)(n0 + jj) * K + k0 + ii0) = w; } }
    }
}
DI void conv_bf16_flat(const float* __restrict__ src, bf16_t* __restrict__ dst, size_t n8  , size_t first, size_t stride) {
    for (size_t i = first; i < n8; i += stride) { const f32x4 a = *(const f32x4*)(src + i * 8), b = *(const f32x4*)(src + i * 8 + 4); store8_bf16(dst + i * 8, a, b); }
}

DI void conv_rows_fp8(const float* __restrict__ src, unsigned char* __restrict__ dst, float* __restrict__ inv_scale, int nrows) {
    const int lane = threadIdx.x & 63, wave = __builtin_amdgcn_readfirstlane(threadIdx.x >> 6);
    for (int row = blockIdx.x * 8 + wave; row < nrows; row += gridDim.x * 8) {
        const float* sr = src + (size_t)row * 2048; f32x4 v[8]; float am = 0.f;
#pragma unroll
        for (int k = 0; k < 8; ++k) { v[k] = *(const f32x4*)(sr + k * 256 + lane * 4); am = fmaxf(am, fmaxf(fmaxf(fabsf(v[k][0]), fabsf(v[k][1])), fmaxf(fabsf(v[k][2]), fabsf(v[k][3])))); }
#pragma unroll
        for (int o = 32; o >= 1; o >>= 1) am = fmaxf(am, __shfl_xor(am, o));
        const float sc = am > 0.f ? 448.f / am : 1.f;
#pragma unroll
        for (int k = 0; k < 8; ++k) { int p = __builtin_amdgcn_cvt_pk_fp8_f32(v[k][0] * sc, v[k][1] * sc, 0, false); p = __builtin_amdgcn_cvt_pk_fp8_f32(v[k][2] * sc, v[k][3] * sc, p, true);
            *(unsigned*)(dst + (size_t)k * 4194304 + (size_t)row * 256 + lane * 4) = (unsigned)p; }
        if (lane == 0) inv_scale[row] = am > 0.f ? am / 448.f : 1.f;
    }
}

DI void p0_prologue(const Params& P, LAS unsigned char* lds) {
    unsigned char* ws = P.ws; const int tid = threadIdx.x, G = gridDim.x, bx = blockIdx.x;
    LAS float* fl = (LAS float*)lds;
    {
        LAS float* sc = fl;
        LAS float* red = fl + 8192;
        for (int i = tid; i < 8192; i += 512) { const float v = P.c[i]; sc[i] = v / (1.f + __expf(-v)); }
        __syncthreads();
        for (int it = bx; it < 192 + 8; it += G) {
            const bool is_cb = it >= 192;
            const int col = tid & 63, kg = tid >> 6;
            float a0 = 0.f, a1 = 0.f, a2 = 0.f, a3 = 0.f;
            if (!is_cb) {
                const float* wp = P.ada_w + (size_t)(kg * 256) * 12288 + it * 64 + col;
#pragma unroll 8
                for (int j = 0; j < 256; ++j) { const float w = wp[(size_t)j * 12288]; const int jj = kg * 256 + j; a0 += sc[jj] * w; a1 += sc[2048 + jj] * w; a2 += sc[4096 + jj] * w; a3 += sc[6144 + jj] * w; }
            } else {
                const int i = (it - 192) >> 2, c0 = ((it - 192) & 3) * 64;
                const float* wp = P.cmp_w1 + (size_t)i * 2048 * 256 + (size_t)(kg * 256) * 256 + c0 + col; const float* pp = P.cmp_pos + i * 2048 + kg * 256;
#pragma unroll 8
                for (int j = 0; j < 256; ++j) a0 += pp[j] * wp[(size_t)j * 256];
            }
            red[(kg * 4 + 0) * 64 + col] = a0; red[(kg * 4 + 1) * 64 + col] = a1; red[(kg * 4 + 2) * 64 + col] = a2; red[(kg * 4 + 3) * 64 + col] = a3;
            __syncthreads();
            if (tid < 256) { const int b = tid >> 6, cc = tid & 63; float s = 0.f;
#pragma unroll
                for (int q = 0; q < 8; ++q) s += red[(q * 4 + b) * 64 + cc];
                if (!is_cb) ((float*)(ws + WS_MOD))[b * 12288 + it * 64 + cc] = s + P.ada_b[it * 64 + cc];
                else if (b == 0) { const int i = (it - 192) >> 2, c0 = ((it - 192) & 3) * 64; ((float*)(ws + WS_CB))[i * 256 + c0 + cc] = s + P.cmp_b1[i * 256 + c0 + cc]; } }
            __syncthreads();
        }
    }
    for (int g4 = bx; g4 < 256; g4 += G) {
        const int g = g4 >> 2, part = g4 & 3;
        LAS double* pw = (LAS double*)lds;
        LAS double* ff = pw + 17 * 64 * 2;
        LAS double* bb = ff + 128;
        LAS float* cc = (LAS float*)(bb + 2048);
        LAS float* kern = cc + 2048;
        __syncthreads();
        const double step = exp((double)P.s5_log_step[g]);
        for (int i = tid; i < 17 * 64; i += 512) { const int p = i & 63, dl = i >> 6; const double lr = P.s5_lam_re[g * 64 + p], li = P.s5_lam_im[g * 64 + p];
            const double mag = exp(dl * lr * step), ang = dl * li * step; const double cr = mag * cos(ang), ci = mag * sin(ang);
            pw[i * 2] = cr; pw[i * 2 + 1] = ci;
            if (dl == 1) { const double nr = cr - 1.0, den = lr * lr + li * li; ff[p * 2] = (nr * lr + ci * li) / den; ff[p * 2 + 1] = (ci * lr - nr * li) / den; }
            if (dl == 16 && part == 0) { float* a16 = (float*)(ws + WS_A16) + (g * 64 + p) * 2; a16[0] = (float)cr; a16[1] = (float)ci; } }
        for (int i = tid; i < 1024; i += 512) { const int h = i >> 6, p = i & 63; cc[i * 2] = P.s5_c_re[(g * 16 + h) * 64 + p]; cc[i * 2 + 1] = P.s5_c_im[(g * 16 + h) * 64 + p]; }
        __syncthreads();
        for (int i = tid; i < 1024; i += 512) { const int p = i >> 4; const double br = P.s5_b_re[g * 1024 + i], bi = P.s5_b_im[g * 1024 + i], fr = ff[p * 2], fi = ff[p * 2 + 1];
            bb[i * 2] = fr * br - fi * bi; bb[i * 2 + 1] = fr * bi + fi * br; }
        __syncthreads();
        for (int o1 = tid; o1 < 1024; o1 += 512) {
            const int dl = o1 >> 6, h = 4 * part + ((o1 >> 4) & 3), h2 = o1 & 15, o = (dl * 16 + h) * 16 + h2; double s = 0.0;
            for (int p = 0; p < 64; ++p) { const double cr = cc[(h * 64 + p) * 2], ci = cc[(h * 64 + p) * 2 + 1], ar = pw[(dl * 64 + p) * 2], ai = pw[(dl * 64 + p) * 2 + 1];
                const double zr = cr * ar - ci * ai, zi = cr * ai + ci * ar; s += zr * bb[(p * 16 + h2) * 2] - zi * bb[(p * 16 + h2) * 2 + 1]; }
            kern[o] = (float)s; }
        __syncthreads();
        bf16_t* B2 = (bf16_t*)(ws + WS_S5B2) + (size_t)g * 256 * 384;
        for (int i = tid; i < 64 * 384 / 2; i += 512) {
            const int rr = i / 192, c0 = (i % 192) * 2, tau = rr >> 2, h = 4 * part + (rr & 3), row = tau * 16 + h; float v[2];
#pragma unroll
            for (int e = 0; e < 2; ++e) { const int col = c0 + e; float x;
                if (col < 256) { const int s = col >> 4, h2 = col & 15; x = (s <= tau) ? kern[((tau - s) * 16 + h) * 16 + h2] : 0.f; if (s == tau && h2 == h) x += P.s5_d[g * 16 + h]; }
                else { const int p = (col - 256) & 63; const double cr = cc[(h * 64 + p) * 2], ci = cc[(h * 64 + p) * 2 + 1], ar = pw[((tau + 1) * 64 + p) * 2], ai = pw[((tau + 1) * 64 + p) * 2 + 1];
                    x = (col < 320) ? (float)(cr * ar - ci * ai) : (float)(-(cr * ai + ci * ar)); }
                v[e] = x; }
            *(unsigned*)(B2 + (size_t)row * 384 + c0) = pk_bf16(v[0], v[1]); }
        bf16_t* B1 = (bf16_t*)(ws + WS_S5B1) + (size_t)g * 256 * 256;
        for (int i = tid; i < 64 * 256 / 2; i += 512) {
            const int n = 64 * part + (i >> 7), c0 = (i & 127) * 2; float v[2];
#pragma unroll
            for (int e = 0; e < 2; ++e) { const int col = c0 + e, s = col >> 4, h = col & 15; float x = 0.f;
                if (n < 128) { const int p = n & 63; const double ar = pw[((15 - s) * 64 + p) * 2], ai = pw[((15 - s) * 64 + p) * 2 + 1], br = bb[(p * 16 + h) * 2], bi = bb[(p * 16 + h) * 2 + 1];
                    x = (n < 64) ? (float)(ar * br - ai * bi) : (float)(ar * bi + ai * br); }
                v[e] = x; }
            *(unsigned*)(B1 + (size_t)n * 256 + c0) = pk_bf16(v[0], v[1]); }
    }
    __syncthreads();
    LAS float* tile = fl;
    tconv_tiles<1, true>(P.w_in, 7728, 2048, NPROJ, (bf16_t*)(ws + WS_WIN), tile, bx, G, 2048.f);
    tconv_tiles<0>(P.glu_w, 1024, 1024, 1024, (bf16_t*)(ws + WS_WGLU), tile, bx, G);
    tconv_tiles<0, true>(P.w_up_attn, 2048, 1024, 2048, (bf16_t*)(ws + WS_WUA), tile, bx, G, 1024.f);
    tconv_tiles<0, true>(P.w_up_ssm, 2048, 1024, 2048, (bf16_t*)(ws + WS_WUS), tile, bx, G, 1024.f);
    tconv_tiles<0, true>(P.w_out, 2048, 2048, 2048, (bf16_t*)(ws + WS_WOUT), tile, bx, G, 2048.f);
    tconv_tiles<0>(P.cmp_w1, 256, 2048, 256, (bf16_t*)(ws + WS_WC1), tile, bx, G);
    tconv_tiles<0>(P.cmp_w1 + 2048 * 256, 256, 2048, 256, (bf16_t*)(ws + WS_WC1) + 256 * 2048, tile, bx, G);
    __syncthreads();
    const size_t gt = (size_t)bx * 512 + tid, gs = (size_t)G * 512;
    conv_bf16_flat(P.peer_w_q, (bf16_t*)(ws + WS_WQ), (size_t)2048 * 2048 / 8, gt, gs);
    { bf16_t* kb = (bf16_t*)(ws + WS_KBD);
      for (size_t i = gt; i < (size_t)2048 * 2048 / 8; i += gs) { const int row = (int)(i >> 8), k0 = (int)(i & 255) * 8, hc = row >> 7, n = row & 127;
          if ((k0 >> 7) == hc) { const float* s = P.peer_sub_keys + ((size_t)(hc * 128 + n)) * 128 + (k0 & 127); store8_bf16(kb + i * 8, *(const f32x4*)s, *(const f32x4*)(s + 4)); }
          else *(u32x4*)(kb + i * 8) = (u32x4){0u, 0u, 0u, 0u}; } }
}

DI void phase_norm(const float* __restrict__ X, const float* __restrict__ gain, const float* __restrict__ mod, int sh_off, int sc_off, bf16_t* __restrict__ H) {
    const int lane = threadIdx.x & 63, wave = __builtin_amdgcn_readfirstlane(threadIdx.x >> 6);
    for (int row = blockIdx.x * 8 + wave; row < NT; row += gridDim.x * 8) {
        const float* xr = X + (size_t)row * 2048; f32x4 v[8]; float ss = 0.f;
#pragma unroll
        for (int k = 0; k < 8; ++k) { v[k] = *(const f32x4*)(xr + k * 256 + lane * 4); ss += v[k][0] * v[k][0] + v[k][1] * v[k][1] + v[k][2] * v[k][2] + v[k][3] * v[k][3]; }
        ss = wave_sum(ss); const float rs = rsqrtf(ss * (1.f / 2048.f) + 1e-6f);
        const float* mb = mod + (row >> 12) * 12288;
#pragma unroll
        for (int k = 0; k < 8; ++k) { const int d = k * 256 + lane * 4; const f32x4 g = *(const f32x4*)(gain + d), sc = *(const f32x4*)(mb + sc_off + d), sh = *(const f32x4*)(mb + sh_off + d);
            f32x4 o;
#pragma unroll
            for (int e = 0; e < 4; ++e) o[e] = v[k][e] * rs * g[e] * (1.f + sc[e]) + sh[e];
            u32x2 w; w[0] = pk_bf16(o[0], o[1]); w[1] = pk_bf16(o[2], o[3]); *(u32x2*)(H + (size_t)row * 2048 + d) = w; }
    }
}

DI void phase_norm_f8(const float* __restrict__ X, const float* __restrict__ gain, const float* __restrict__ mod, int sh_off, int sc_off, unsigned char* __restrict__ H8, float* __restrict__ hsc) {
    const int lane = threadIdx.x & 63, wave = __builtin_amdgcn_readfirstlane(threadIdx.x >> 6);
    for (int row = blockIdx.x * 8 + wave; row < NT; row += gridDim.x * 8) {
        const float* xr = X + (size_t)row * 2048; f32x4 v[8]; float ss = 0.f;
#pragma unroll
        for (int k = 0; k < 8; ++k) { v[k] = *(const f32x4*)(xr + k * 256 + lane * 4); ss += v[k][0] * v[k][0] + v[k][1] * v[k][1] + v[k][2] * v[k][2] + v[k][3] * v[k][3]; }
        ss = wave_sum(ss); const float rs = rsqrtf(ss * (1.f / 2048.f) + 1e-6f);
        const float* mb = mod + (row >> 12) * 12288; float am = 0.f;
#pragma unroll
        for (int k = 0; k < 8; ++k) { const int d = k * 256 + lane * 4; const f32x4 g = *(const f32x4*)(gain + d), sc = *(const f32x4*)(mb + sc_off + d), sh = *(const f32x4*)(mb + sh_off + d);
#pragma unroll
            for (int e = 0; e < 4; ++e) { v[k][e] = v[k][e] * rs * g[e] * (1.f + sc[e]) + sh[e]; am = fmaxf(am, fabsf(v[k][e])); } }
#pragma unroll
        for (int o = 32; o >= 1; o >>= 1) am = fmaxf(am, __shfl_xor(am, o));
        const float q = am > 0.f ? 448.f / am : 1.f;
#pragma unroll
        for (int k = 0; k < 8; ++k) { int p = __builtin_amdgcn_cvt_pk_fp8_f32(v[k][0] * q, v[k][1] * q, 0, false); p = __builtin_amdgcn_cvt_pk_fp8_f32(v[k][2] * q, v[k][3] * q, p, true);
            *(unsigned*)(H8 + (size_t)row * 2048 + k * 256 + lane * 4) = (unsigned)p; }
        if (lane == 0) hsc[row] = am > 0.f ? am * (1.f / 448.f) : 1.f;
    }
}

DI void phase_cmp2(const Params& P) {
    unsigned char* ws = P.ws; const bf16_t* hid = (const bf16_t*)(ws + WS_HID); bf16_t* ckv = (bf16_t*)(ws + WS_CKV);
    for (int o = blockIdx.x * 512 + threadIdx.x; o < 2 * 16 * 256 * 64; o += gridDim.x * 512) {
        const int dd = o & 63, row = o >> 6, i = row >> 12, n = row & 255;
        float s = 0.f;
        if (n < NCMP) { const bf16_t* hr = hid + (size_t)row * 256; const float* w2 = P.cmp_w2 + i * 256 * 64 + dd; s = P.cmp_b2[i * 64 + dd];
#pragma unroll 4
            for (int j = 0; j < 256; j += 8) { const u32x4 hv = *(const u32x4*)(hr + j);
#pragma unroll
                for (int e = 0; e < 4; ++e) { s += bf_lo(hv[e]) * w2[(j + 2 * e) * 64]; s += bf_hi(hv[e]) * w2[(j + 2 * e + 1) * 64]; } } }
        ckv[o] = f2bf(s);
    }
}
DI void phase_scan(const Params& P) {
    unsigned char* ws = P.ws; const int lane = threadIdx.x & 63, wave = __builtin_amdgcn_readfirstlane(threadIdx.x >> 6);
    if (wave != 0) return;
    for (int bg = blockIdx.x; bg < 256; bg += gridDim.x) {
        const int b = bg >> 6, g = bg & 63, p = lane;
        const float ar = ((const float*)(ws + WS_A16))[(g * 64 + p) * 2], ai = ((const float*)(ws + WS_A16))[(g * 64 + p) * 2 + 1];
        const float* xl = (const float*)(ws + WS_XL) + (size_t)(g * 1024 + b * 256) * 128; bf16_t* a2 = (bf16_t*)(ws + WS_A2) + (size_t)(g * 1024 + b * 256) * 384 + 256;
        float xr = 0.f, xi = 0.f;
        for (int c = 0; c < 256; c += 8) { float lr[8], li[8];
#pragma unroll
            for (int e = 0; e < 8; ++e) { lr[e] = xl[(size_t)(c + e) * 128 + p]; li[e] = xl[(size_t)(c + e) * 128 + 64 + p]; }
#pragma unroll
            for (int e = 0; e < 8; ++e) { a2[(size_t)(c + e) * 384 + p] = f2bf(xr); a2[(size_t)(c + e) * 384 + 64 + p] = f2bf(xi);
                const float nr = ar * xr - ai * xi + lr[e], ni = ar * xi + ai * xr + li[e]; xr = nr; xi = ni; } }
    }
}

constexpr int AT_K = 0, AT_V = 18432, AT_TB = 34816, AT_IMP = 43008, AT_END = 112640;
#define MFMA32(a, b, c) __builtin_amdgcn_mfma_f32_32x32x16_bf16((a), (b), (c), 0, 0, 0)

DI void attn_setup_tables(const Params& P, LAS unsigned char* lds) {
    LAS float* tb = (LAS float*)(lds + AT_TB);
    __syncthreads();
    for (int i = threadIdx.x; i < 16 * 128; i += 512) { const int hd = i >> 7, dist = i & 127; int bk = dist;
        if (dist >= 16) { const float lr = __logf((float)dist * (1.f / 16.f)) / 2.0794415417f; bk = min(16 + (int)(lr * 16.f), 31); }
        tb[i] = P.rel_bias[bk * 16 + hd] * LOG2E; }
    __syncthreads();
}

#define ATTN_BODY \
             \
            bf16x8 vfr[2][2][2]; \
            f32x16 sacc[2]; \
_Pragma("unroll") \
            for (int kb = 0; kb < 2; ++kb) { \
_Pragma("unroll") \
                for (int i = 0; i < 16; ++i) sacc[kb][i] = 0.f; \
_Pragma("unroll") \
                for (int s = 0; s < 4; ++s) { const bf16x8 kf = *(const LAS bf16x8*)(Kl + krd + kb * 32 * 144 + s * 32); sacc[kb] = MFMA32(kf, qf[s], sacc[kb]); } } \
            if (pass == 0 && MODE != 0) {                                             \
_Pragma("unroll") \
                for (int kb = 0; kb < 2; ++kb) \
_Pragma("unroll") \
                    for (int s2 = 0; s2 < 2; ++s2) \
_Pragma("unroll") \
                        for (int db = 0; db < 2; ++db) { const unsigned a0 = (unsigned)(32 * kb + 16 * s2) * 128u + vrow * 128u + vcol[db]; \
                            const s16x4 lo = __builtin_amdgcn_ds_read_tr16_b64_v4i16((LAS s16x4*)(Vl + a0)), hi = __builtin_amdgcn_ds_read_tr16_b64_v4i16((LAS s16x4*)(Vl + a0 + 8 * 128)); \
                            vfr[kb][s2][db] = __builtin_shufflevector(lo, hi, 0, 1, 2, 3, 4, 5, 6, 7); } \
            } \
             \
            const bool near = (MODE == 0) ? (1024 * j + 1152 > qb * 64) : ((qb - j <= 2) || (MODE == 2 && j == qb - 8));        \
            const bool lsel = (MODE != 1) || (((j < 32 ? (mlo >> j) : (mhi >> (j - 32))) & 1u) != 0u); \
            if (near) { \
                const int dq = (MODE == 0) ? (tq - 31 - 1024 * j) : (tq - 64 * j); \
_Pragma("unroll") \
                for (int kb = 0; kb < 2; ++kb) \
_Pragma("unroll") \
                    for (int i = 0; i < 16; ++i) { const int kl = 32 * kb + (i & 3) + 8 * (i >> 2) + 4 * h; const int dist = dq - ((MODE == 0) ? 16 * kl : kl); \
                        bool ok = (dist >= 0) && lsel; if (MODE == 2) ok = ok && (dist < 512); \
                        sacc[kb][i] = (sacc[kb][i] + tb[min(max(dist, 0), 127)]) + (ok ? 0.f : NEGBIG); if (i == 15) __builtin_amdgcn_sched_barrier(0); }      \
            } else { \
                const float cb = lsel ? farb : NEGBIG;                   \
_Pragma("unroll") \
                for (int kb = 0; kb < 2; ++kb) \
_Pragma("unroll") \
                    for (int i = 0; i < 16; ++i) sacc[kb][i] += cb; \
            } \
            bf16x8 pf[2][2]; \
            if (pass == 0) { \
                 \
                float mx = fmaxf(fmaxf(sacc[0][0], sacc[0][1]), sacc[1][0]); \
_Pragma("unroll") \
                for (int kb = 0; kb < 2; ++kb) \
_Pragma("unroll") \
                    for (int i = 0; i < 16; i += 2) mx = fmaxf(fmaxf(mx, sacc[kb][i]), sacc[kb][i + 1]); \
                mx = xor32_max(mx); \
                const float m_new = fmaxf(m_run, mx); \
                if (__any(m_new > m_run)) { const float alpha = __builtin_amdgcn_exp2f(m_run - m_new); l_run *= alpha; \
_Pragma("unroll") \
                    for (int i = 0; i < 16; ++i) { oacc[0][i] *= alpha; oacc[1][i] *= alpha; } } \
                m_run = m_new; \
                f32x2 ls2 = {0.f, 0.f}; const f32x2 mn2 = {m_new, m_new}; \
_Pragma("unroll") \
                for (int kb = 0; kb < 2; ++kb) \
_Pragma("unroll") \
                    for (int i = 0; i < 16; i += 2) { f32x2 d2 = (f32x2){sacc[kb][i], sacc[kb][i + 1]} - mn2; d2.x = __builtin_amdgcn_exp2f(d2.x); d2.y = __builtin_amdgcn_exp2f(d2.y); sacc[kb][i] = d2.x; sacc[kb][i + 1] = d2.y; ls2 += d2; } \
                l_run += ls2.x + ls2.y; \
            } else { \
_Pragma("unroll") \
                for (int kb = 0; kb < 2; ++kb) \
_Pragma("unroll") \
                    for (int i = 0; i < 16; ++i) sacc[kb][i] = __builtin_amdgcn_exp2f(sacc[kb][i] - m_fin) * inv_fin; \
            } \
_Pragma("unroll") \
            for (int kb = 0; kb < 2; ++kb) \
_Pragma("unroll") \
                for (int s2 = 0; s2 < 2; ++s2) { u32x4 w; \
_Pragma("unroll") \
                    for (int e = 0; e < 4; ++e) w[e] = pk_bf16(sacc[kb][8 * s2 + 2 * e], sacc[kb][8 * s2 + 2 * e + 1]); \
                    pf[kb][s2] = __builtin_bit_cast(bf16x8, w); } \
            if (pass == 0) { \
                 \
_Pragma("unroll") \
                for (int kb = 0; kb < 2; ++kb) \
_Pragma("unroll") \
                    for (int s2 = 0; s2 < 2; ++s2) \
_Pragma("unroll") \
                        for (int db = 0; db < 2; ++db) { \
                            if (MODE != 0) oacc[db] = MFMA32(vfr[kb][s2][db], pf[kb][s2], oacc[db]); \
                            else { const unsigned a0 = (unsigned)(32 * kb + 16 * s2) * 128u + vrow * 128u + vcol[db]; \
                                const s16x4 lo = __builtin_amdgcn_ds_read_tr16_b64_v4i16((LAS s16x4*)(Vl + a0)), hi = __builtin_amdgcn_ds_read_tr16_b64_v4i16((LAS s16x4*)(Vl + a0 + 8 * 128)); \
                                oacc[db] = MFMA32(__builtin_shufflevector(lo, hi, 0, 1, 2, 3, 4, 5, 6, 7), pf[kb][s2], oacc[db]); } } \
            } else { \
                 \
                bf16x8 mfrag[2][2]; \
_Pragma("unroll") \
                for (int kb = 0; kb < 2; ++kb) \
_Pragma("unroll") \
                    for (int s2 = 0; s2 < 2; ++s2) \
_Pragma("unroll") \
                        for (int jj = 0; jj < 8; ++jj) { const int key = 32 * kb + 16 * s2 + 8 * (jj >> 2) + 4 * h + (jj & 3); \
                            mfrag[kb][s2][jj] = (key == 4 * r - 1 || key == 4 * r + 3) ? (short)0x3F00 : ((key >= 4 * r && key <= 4 * r + 2) ? (short)0x3F80 : (short)0); } \
                f32x16 ia; \
_Pragma("unroll") \
                for (int i = 0; i < 16; ++i) ia[i] = 0.f; \
_Pragma("unroll") \
                for (int kb = 0; kb < 2; ++kb) \
_Pragma("unroll") \
                    for (int s2 = 0; s2 < 2; ++s2) ia = MFMA32(mfrag[kb][s2], pf[kb][s2], ia); \
                LAS float* ip = (LAS float*)(lds + AT_IMP) + (g * 64 + tq_loc) * 68 + 16 * j; \
_Pragma("unroll") \
                for (int i = 0; i < 9; ++i) { const int jp = (i & 3) + 8 * (i >> 2) + 4 * h; if (jp <= 16) ip[jp] += ia[i]; } \
            } \


template <int MODE> DI void attn_unit(const Params& P, LAS unsigned char* lds, int b, int k, int qb) {
    unsigned char* ws = P.ws;
    const int tid = threadIdx.x, lane = tid & 63, wave = __builtin_amdgcn_readfirstlane(tid >> 6);
    const int g = wave >> 1, th = wave & 1, r = lane & 31, h = lane >> 5;
    const int tq_loc = th * 32 + r, tq = qb * 64 + tq_loc, hd = k * 4 + g, bk = b * 4 + k;
    const LAS float* tb = (const LAS float*)(lds + AT_TB) + hd * 128;
    const float farb = tb[127];
    bf16x8 qf[4];
    { const bf16_t* qg = (const bf16_t*)(ws + WS_Q) + ((size_t)(b * 4096 + tq)) * 1024 + hd * 64 + 8 * h;
#pragma unroll
      for (int s = 0; s < 4; ++s) qf[s] = *(const bf16x8*)(qg + 16 * s); }
    const bf16_t *Kg, *Vg;
    if (MODE == 0) { Kg = (const bf16_t*)(ws + WS_CKV) + (size_t)bk * 256 * 64; Vg = Kg + 16 * 256 * 64; }
    else { Kg = (const bf16_t*)(ws + WS_KV) + (size_t)(MODE == 1 ? 2 : 4) * 4194304 + (size_t)bk * 4096 * 64; Vg = Kg + 4194304; }
    unsigned long long tiles; unsigned mlo = 0u, mhi = 0u;
    if (MODE == 0) { const int kmax = min(3, (4 * qb + 2) >> 6); tiles = (2ull << kmax) - 1ull; }
    else if (MODE == 2) { const int lo = max(0, qb - 8); tiles = ((2ull << qb) - 1ull) & ~((1ull << lo) - 1ull); }
    else { const unsigned* sm = (const unsigned*)(ws + WS_SELM) + ((size_t)(bk * 4096 + qb * 64)) * 2;
        mlo = sm[tq_loc * 2]; mhi = sm[tq_loc * 2 + 1];
        unsigned ulo = sm[lane * 2], uhi = sm[lane * 2 + 1];
#pragma unroll
        for (int o = 32; o >= 1; o >>= 1) { ulo |= __shfl_xor(ulo, o); uhi |= __shfl_xor(uhi, o); }
        tiles = (((unsigned long long)(unsigned)__builtin_amdgcn_readfirstlane(uhi) << 32) | (unsigned)__builtin_amdgcn_readfirstlane(ulo)) & ((2ull << qb) - 1ull); }
    const int ntile = __popcll(tiles);
    const int skey = tid >> 3, sch = tid & 7;
    const unsigned kst = (unsigned)(skey * 144 + sch * 16), vst = (unsigned)(skey * 128 + ((sch ^ (((skey >> 1) & 1) << 2)) * 16));
    const int q4 = (lane & 15) >> 2, pp = lane & 3, blk = (lane >> 4) & 1;
    const unsigned vrow = (unsigned)(4 * h + q4);
    unsigned vcol[2];
#pragma unroll
    for (int db = 0; db < 2; ++db) { const int ch = 4 * db + 2 * blk + (pp >> 1); vcol[db] = (unsigned)(((ch ^ (((q4 >> 1) & 1) << 2)) * 16) + (pp & 1) * 8); }
    const unsigned krd = (unsigned)(r * 144 + 16 * h);

    f32x16 oacc[2]; float m_run = NEGBIG, l_run = 0.f;
#pragma unroll
    for (int i = 0; i < 16; ++i) { oacc[0][i] = 0.f; oacc[1][i] = 0.f; }
    float m_fin = 0.f, inv_fin = 0.f;

#define ATTN_STEP(KR, VR, JV, PAR) { const int j = JV; \
            LAS unsigned char* Kl = lds + AT_K + (PAR) * 9216; LAS unsigned char* Vl = lds + AT_V + (PAR) * 8192; \
            *(LAS u32x4*)(Kl + kst) = KR; *(LAS u32x4*)(Vl + vst) = VR; \
            __syncthreads(); \
            { const int j2 = rem ? __ffsll((long long)rem) - 1 : JV; rem &= rem - 1ull; JV = j2; \
              KR = *(const u32x4*)(Kg + (size_t)(j2 * 64 + skey) * 64 + sch * 8); VR = *(const u32x4*)(Vg + (size_t)(j2 * 64 + skey) * 64 + sch * 8); } \
            ATTN_BODY }
#define ATTN_PASS(PASSC) { constexpr int pass = (PASSC); \
        if (MODE == 0 && pass == 1) {                                    \
            LAS float* imp = (LAS float*)(lds + AT_IMP); \
            for (int i = tid; i < 4 * 64 * 68; i += 512) imp[i] = 0.f; \
        } \
        __syncthreads();                                                 \
         \
        unsigned long long rem = tiles; int jA = __ffsll((long long)rem) - 1; rem &= rem - 1ull; int jB = rem ? __ffsll((long long)rem) - 1 : jA; rem &= rem - 1ull; \
        u32x4 kregA = *(const u32x4*)(Kg + (size_t)(jA * 64 + skey) * 64 + sch * 8), vregA = *(const u32x4*)(Vg + (size_t)(jA * 64 + skey) * 64 + sch * 8); \
        u32x4 kregB = *(const u32x4*)(Kg + (size_t)(jB * 64 + skey) * 64 + sch * 8), vregB = *(const u32x4*)(Vg + (size_t)(jB * 64 + skey) * 64 + sch * 8); \
        if constexpr (true) { rem = tiles & (tiles - 1ull);           \
            for (int it = 0; it < ntile; ++it) ATTN_STEP(kregA, vregA, jA, (it & 1)) \
        } else { \
            for (int it = 0; it < ntile; it += 2) { \
                ATTN_STEP(kregA, vregA, jA, 0) \
                if (it + 1 < ntile) ATTN_STEP(kregB, vregB, jB, 1) \
            } \
        } \
        if (pass == 0) { \
            const float lt = xor32_add(l_run); const bool live = m_run > -1e29f; const float inv = live ? 1.f / lt : 0.f; \
            m_fin = live ? m_run : 0.f; inv_fin = inv; \
             \
            int tqo = tq; asm volatile("" : "+v"(tqo)); \
            bf16_t* og = (bf16_t*)(ws + (MODE == 0 ? WS_OC : (MODE == 2 ? WS_OW : WS_OATT))) + ((size_t)(b * 4096 + tqo)) * 1024 + hd * 64; \
            float g0 = 0.f, g1 = 1.f, g2 = 0.f; const bf16_t *oc = nullptr, *ow = nullptr; \
            if (MODE == 1) { const float* gp = (const float*)(ws + WS_GATE) + (size_t)(b * 4096 + tqo) * 48 + hd * 3; g0 = gp[0]; g1 = gp[1]; g2 = gp[2]; \
                oc = (const bf16_t*)(ws + WS_OC) + ((size_t)(b * 4096 + tqo)) * 1024 + hd * 64; ow = (const bf16_t*)(ws + WS_OW) + ((size_t)(b * 4096 + tqo)) * 1024 + hd * 64; } \
_Pragma("unroll") \
            for (int db = 0; db < 2; ++db) \
_Pragma("unroll") \
                for (int a = 0; a < 4; ++a) { const int d0 = 32 * db + 8 * a + 4 * h; float v[4]; \
_Pragma("unroll") \
                    for (int e = 0; e < 4; ++e) v[e] = oacc[db][4 * a + e] * inv; \
                    if (MODE == 1) { const u32x2 c2 = *(const u32x2*)(oc + d0), w2 = *(const u32x2*)(ow + d0); \
                        v[0] = g1 * v[0] + g0 * bf_lo(c2[0]) + g2 * bf_lo(w2[0]); v[1] = g1 * v[1] + g0 * bf_hi(c2[0]) + g2 * bf_hi(w2[0]); \
                        v[2] = g1 * v[2] + g0 * bf_lo(c2[1]) + g2 * bf_lo(w2[1]); v[3] = g1 * v[3] + g0 * bf_hi(c2[1]) + g2 * bf_hi(w2[1]); } \
                    if (MODE == 1) { int p8 = __builtin_amdgcn_cvt_pk_fp8_f32(clamp448(v[0] * OATT_SCALE), clamp448(v[1] * OATT_SCALE), 0, false); p8 = __builtin_amdgcn_cvt_pk_fp8_f32(clamp448(v[2] * OATT_SCALE), clamp448(v[3] * OATT_SCALE), p8, true); \
                        *(int*)((unsigned char*)(ws + WS_OATT) + ((size_t)(b * 4096 + tqo)) * 1024 + hd * 64 + d0) = p8; } \
                    else { u32x2 w; w[0] = pk_bf16(v[0], v[1]); w[1] = pk_bf16(v[2], v[3]); *(u32x2*)(og + d0) = w; } } \
        } \
     }
    ATTN_PASS(0)
    if constexpr (MODE == 0) ATTN_PASS(1)
#undef ATTN_PASS
#undef ATTN_STEP
    if (MODE == 0) {
        __syncthreads();
        const LAS float* imp = (const LAS float*)(lds + AT_IMP); unsigned* sm = (unsigned*)(ws + WS_SELM) + ((size_t)(bk * 4096 + qb * 64)) * 2;
        const int cur = qb;
        for (int tk = 0; tk < 8; ++tk) { const int tok = wave * 8 + tk, jb = lane;
            const float v = imp[(0 * 64 + tok) * 68 + jb] + imp[(1 * 64 + tok) * 68 + jb] + imp[(2 * 64 + tok) * 68 + jb] + imp[(3 * 64 + tok) * 68 + jb];
            const bool valid = jb <= cur, forced = valid && (jb == 0 || jb == cur || jb == cur - 1);
            bool sel = forced;
            if (cur <= 15) sel = valid;
            else { unsigned key = (valid && !forced) ? ((__float_as_uint(fmaxf(v, 0.f)) & ~63u) | (unsigned)(63 - jb)) : 0u;
                for (int rd = 0; rd < 13; ++rd) { const unsigned w = wave_max_u32(key); const int win = 63 - (int)(w & 63u); if (jb == win && w != 0u) { sel = true; key = 0u; } } }
            const unsigned long long bal = __ballot(sel);
            if (lane == 0) { sm[tok * 2] = (unsigned)bal; sm[tok * 2 + 1] = (unsigned)(bal >> 32); } }
    }
}

constexpr float AT_THR = 6.f;
#define AP_QK(S, Kl_, C_) { _Pragma("unroll") for (int kb = 0; kb < 2; ++kb) { \
        _Pragma("unroll") for (int s = 0; s < 4; ++s) { const bf16x8 kf = *(const LAS bf16x8*)((Kl_) + krd + kb * 32 * 144 + s * 32); if (s == 0) S[kb] = MFMA32(kf, qf[0], C_); else S[kb] = MFMA32(kf, qf[s], S[kb]); } } }
#define AP_CSEL(C_, jt) f32x16 C_; { const int j_ = (jt); const bool lsel_ = (MODE != 1) || (((j_ < 32 ? (mlo >> j_) : (mhi >> (j_ - 32))) & 1u) != 0u); const bool near_ = (qb - j_ <= 2) || (MODE == 2 && j_ == qb - 8); \
        _Pragma("unroll") for (int i = 0; i < 16; ++i) C_[i] = (lsel_ || near_) ? cinit[i] : NEGBIG; }
#define AP_NEAR(S, jt) { const int j_ = (jt); const bool near_ = (qb - j_ <= 2) || (MODE == 2 && j_ == qb - 8); \
        if (near_) { const bool lsel_ = (MODE != 1) || (((j_ < 32 ? (mlo >> j_) : (mhi >> (j_ - 32))) & 1u) != 0u); const int dq = tq - 64 * j_; \
            _Pragma("unroll") for (int kb = 0; kb < 2; ++kb) _Pragma("unroll") for (int i = 0; i < 16; ++i) { const int kl = 32 * kb + (i & 3) + 8 * (i >> 2) + 4 * h; const int dist = dq - kl; \
                bool ok = (dist >= 0) && lsel_; if (MODE == 2) ok = ok && (dist < 512); \
                S[kb][i] = (S[kb][i] + (tb[min(max(dist, 0), 127)] - farb)) + (ok ? 0.f : NEGBIG); } } }
#define AP_STEP(SC, SN, PAR, HASNEXT) { \
        LAS unsigned char* Kn = lds + AT_K + ((PAR) ^ 1) * 9216; LAS unsigned char* Vc = lds + AT_V + (PAR) * 8192; \
        *(LAS u32x4*)(Kn + kst) = kreg; *(LAS u32x4*)(Vc + vst) = vreg; \
        __syncthreads(); \
        { vreg = *(const u32x4*)(Vg + (size_t)(jn * 64 + skey) * 64 + sch * 8); kreg = *(const u32x4*)(Kg + (size_t)(jnn * 64 + skey) * 64 + sch * 8); } \
        const bool hn_ = (HASNEXT); \
        float mx = fmaxf(fmaxf(SC[0][0], SC[0][1]), SC[1][0]); \
        _Pragma("unroll") for (int kb = 0; kb < 2; ++kb) _Pragma("unroll") for (int i = 0; i < 16; i += 2) mx = fmaxf(fmaxf(mx, SC[kb][i]), SC[kb][i + 1]); \
        mx = xor32_max(mx); \
        if (__any(mx > AT_THR || (mx < -24.f && mx > -1e29f))) {         \
            const float dl = (mx > -1e29f) ? mx : 0.f, alpha = __builtin_amdgcn_exp2f(-dl); m_run += dl; l_run *= alpha; \
            _Pragma("unroll") for (int i = 0; i < 16; ++i) { oacc[0][i] *= alpha; oacc[1][i] *= alpha; cinit[i] -= dl; SC[0][i] -= dl; SC[1][i] -= dl; } } \
        AP_CSEL(cn_, jn) \
        AP_QK(SN, Kn, cn_)        \
        float ls0 = 0.f, ls1 = 0.f; \
        _Pragma("unroll") for (int kb = 0; kb < 2; ++kb) _Pragma("unroll") for (int i = 0; i < 16; i += 2) { const float p0 = __builtin_amdgcn_exp2f(SC[kb][i]), p1 = __builtin_amdgcn_exp2f(SC[kb][i + 1]); SC[kb][i] = p0; SC[kb][i + 1] = p1; ls0 += p0; ls1 += p1; } \
        l_run += ls0 + ls1; \
        _Pragma("unroll") for (int kb = 0; kb < 2; ++kb) _Pragma("unroll") for (int s2 = 0; s2 < 2; ++s2) { u32x4 w; \
            _Pragma("unroll") for (int e = 0; e < 4; ++e) w[e] = pk_bf16(SC[kb][8 * s2 + 2 * e], SC[kb][8 * s2 + 2 * e + 1]); \
            const bf16x8 pf = __builtin_bit_cast(bf16x8, w); \
            _Pragma("unroll") for (int db = 0; db < 2; ++db) { const unsigned a0 = (unsigned)(32 * kb + 16 * s2) * 128u + vrow * 128u + vcol[db]; \
                const s16x4 lo = __builtin_amdgcn_ds_read_tr16_b64_v4i16((LAS s16x4*)(Vc + a0)), hi = __builtin_amdgcn_ds_read_tr16_b64_v4i16((LAS s16x4*)(Vc + a0 + 8 * 128)); \
                oacc[db] = MFMA32(__builtin_shufflevector(lo, hi, 0, 1, 2, 3, 4, 5, 6, 7), pf, oacc[db]); } } \
        if (hn_) AP_NEAR(SN, jn) \
        jn = jnn; jnn = rem ? __ffsll((long long)rem) - 1 : jnn; rem &= rem - 1ull; }

template <int MODE> DI void attn_unit_pipe(const Params& P, LAS unsigned char* lds, int b, int k, int qb) {
    unsigned char* ws = P.ws;
    const int tid = threadIdx.x, lane = tid & 63, wave = __builtin_amdgcn_readfirstlane(tid >> 6);
    const int g = wave >> 1, th = wave & 1, r = lane & 31, h = lane >> 5;
    const int tq_loc = th * 32 + r, tq = qb * 64 + tq_loc, hd = k * 4 + g, bk = b * 4 + k;
    const LAS float* tb = (const LAS float*)(lds + AT_TB) + hd * 128;
    const float farb = tb[127];
    bf16x8 qf[4];
    { const bf16_t* qg = (const bf16_t*)(ws + WS_Q) + ((size_t)(b * 4096 + tq)) * 1024 + hd * 64 + 8 * h;
#pragma unroll
      for (int s = 0; s < 4; ++s) qf[s] = *(const bf16x8*)(qg + 16 * s); }
    const bf16_t* Kg = (const bf16_t*)(ws + WS_KV) + (size_t)(MODE == 1 ? 2 : 4) * 4194304 + (size_t)bk * 4096 * 64; const bf16_t* Vg = Kg + 4194304;
    unsigned long long tiles; unsigned mlo = 0u, mhi = 0u;
    if (MODE == 2) { const int lo = max(0, qb - 8); tiles = ((2ull << qb) - 1ull) & ~((1ull << lo) - 1ull); }
    else { const unsigned* sm = (const unsigned*)(ws + WS_SELM) + ((size_t)(bk * 4096 + qb * 64)) * 2;
        mlo = sm[tq_loc * 2]; mhi = sm[tq_loc * 2 + 1];
        unsigned ulo = sm[lane * 2], uhi = sm[lane * 2 + 1];
#pragma unroll
        for (int o = 32; o >= 1; o >>= 1) { ulo |= __shfl_xor(ulo, o); uhi |= __shfl_xor(uhi, o); }
        tiles = (((unsigned long long)(unsigned)__builtin_amdgcn_readfirstlane(uhi) << 32) | (unsigned)__builtin_amdgcn_readfirstlane(ulo)) & ((2ull << qb) - 1ull); }
    const int ntile = __popcll(tiles);
    const int skey = tid >> 3, sch = tid & 7;
    const unsigned kst = (unsigned)(skey * 144 + sch * 16), vst = (unsigned)(skey * 128 + ((sch ^ (((skey >> 1) & 1) << 2)) * 16));
    const int q4 = (lane & 15) >> 2, pp = lane & 3, blk = (lane >> 4) & 1;
    const unsigned vrow = (unsigned)(4 * h + q4);
    unsigned vcol[2];
#pragma unroll
    for (int db = 0; db < 2; ++db) { const int ch = 4 * db + 2 * blk + (pp >> 1); vcol[db] = (unsigned)(((ch ^ (((q4 >> 1) & 1) << 2)) * 16) + (pp & 1) * 8); }
    const unsigned krd = (unsigned)(r * 144 + 16 * h);
    f32x16 oacc[2], sA[2], sB[2], cinit; float m_run = 0.f, l_run = 0.f;
#pragma unroll
    for (int i = 0; i < 16; ++i) { oacc[0][i] = 0.f; oacc[1][i] = 0.f; cinit[i] = farb; }
    unsigned long long rem = tiles; const int jc = __ffsll((long long)rem) - 1; rem &= rem - 1ull;
    int jn = rem ? __ffsll((long long)rem) - 1 : jc; rem &= rem - 1ull; int jnn = rem ? __ffsll((long long)rem) - 1 : jn; rem &= rem - 1ull;
    u32x4 kreg = *(const u32x4*)(Kg + (size_t)(jc * 64 + skey) * 64 + sch * 8), vreg = *(const u32x4*)(Vg + (size_t)(jc * 64 + skey) * 64 + sch * 8);
    __syncthreads();
    *(LAS u32x4*)(lds + AT_K + kst) = kreg;
    kreg = *(const u32x4*)(Kg + (size_t)(jn * 64 + skey) * 64 + sch * 8);
    __syncthreads();
    { AP_CSEL(c0_, jc) AP_QK(sA, lds + AT_K, c0_) AP_NEAR(sA, jc) }
    for (int it = 0; it < ntile; it += 2) {
        AP_STEP(sA, sB, 0, it + 1 < ntile)
        if (it + 1 < ntile) AP_STEP(sB, sA, 1, it + 2 < ntile)
    }
    const float lt = xor32_add(l_run); const float inv = lt > 0.f ? 1.f / lt : 0.f;
    int tqo = tq; asm volatile("" : "+v"(tqo));
    float g0 = 0.f, g1 = 1.f, g2 = 0.f; const bf16_t *oc = nullptr, *ow = nullptr;
    if (MODE == 1) { const float* gp = (const float*)(ws + WS_GATE) + (size_t)(b * 4096 + tqo) * 48 + hd * 3; g0 = gp[0]; g1 = gp[1]; g2 = gp[2];
        oc = (const bf16_t*)(ws + WS_OC) + ((size_t)(b * 4096 + tqo)) * 1024 + hd * 64; ow = (const bf16_t*)(ws + WS_OW) + ((size_t)(b * 4096 + tqo)) * 1024 + hd * 64; }
#pragma unroll
    for (int db = 0; db < 2; ++db)
#pragma unroll
        for (int a = 0; a < 4; ++a) { const int d0 = 32 * db + 8 * a + 4 * h; float v[4];
#pragma unroll
            for (int e = 0; e < 4; ++e) v[e] = oacc[db][4 * a + e] * inv;
            if (MODE == 1) { const u32x2 c2 = *(const u32x2*)(oc + d0), w2 = *(const u32x2*)(ow + d0);
                v[0] = g1 * v[0] + g0 * bf_lo(c2[0]) + g2 * bf_lo(w2[0]); v[1] = g1 * v[1] + g0 * bf_hi(c2[0]) + g2 * bf_hi(w2[0]);
                v[2] = g1 * v[2] + g0 * bf_lo(c2[1]) + g2 * bf_lo(w2[1]); v[3] = g1 * v[3] + g0 * bf_hi(c2[1]) + g2 * bf_hi(w2[1]);
                int p8 = __builtin_amdgcn_cvt_pk_fp8_f32(clamp448(v[0] * OATT_SCALE), clamp448(v[1] * OATT_SCALE), 0, false); p8 = __builtin_amdgcn_cvt_pk_fp8_f32(clamp448(v[2] * OATT_SCALE), clamp448(v[3] * OATT_SCALE), p8, true);
                *(int*)((unsigned char*)(ws + WS_OATT) + ((size_t)(b * 4096 + tqo)) * 1024 + hd * 64 + d0) = p8; }
            else { u32x2 w; w[0] = pk_bf16(v[0], v[1]); w[1] = pk_bf16(v[2], v[3]); *(u32x2*)((bf16_t*)(ws + WS_OW) + ((size_t)(b * 4096 + tqo)) * 1024 + hd * 64 + d0) = w; } }
}
#undef AP_STEP
#undef AP_NEAR
#undef AP_CSEL
#undef AP_QK

DI void phase_attn_win_early(const Params& P, LAS unsigned char* lds) {
    if (gridDim.x != 256) return;
    const int bx = blockIdx.x; if (bx >= 128 && bx < 160) return;
    attn_setup_tables(P, lds);
    const int nb = bx < 128 ? bx : bx - 32;
    for (int u = nb; u < 672; u += 224) { const int qb = u >> 4, bk = u & 15; attn_unit_pipe<2>(P, lds, bk >> 2, bk & 3, qb); }
}
DI void phase_attn_cmp_win(const Params& P, LAS unsigned char* lds) {
    attn_setup_tables(P, lds);
    for (int u = blockIdx.x; u < 1024; u += gridDim.x) { const int qb = 63 - (u >> 4), bk = u & 15; attn_unit<0>(P, lds, bk >> 2, bk & 3, qb); }
    for (int u = (gridDim.x == 256 ? 672 : 0) + blockIdx.x; u < 1024; u += gridDim.x) { const int qb = u >> 4, bk = u & 15; attn_unit_pipe<2>(P, lds, bk >> 2, bk & 3, qb); }
}
DI void phase_attn_sel(const Params& P, LAS unsigned char* lds) {
    attn_setup_tables(P, lds);
    for (int pr = blockIdx.x; pr < 512; pr += gridDim.x) { const int bk = pr >> 5, qp = pr & 31;
        attn_unit_pipe<1>(P, lds, bk >> 2, bk & 3, 63 - qp); attn_unit_pipe<1>(P, lds, bk >> 2, bk & 3, qp); }
}

DI unsigned row_max_u32(unsigned v) {
    asm volatile("s_nop 1\n\tv_max_u32_dpp %0, %0, %0 quad_perm:[1,0,3,2] row_mask:0xf bank_mask:0xf\n\ts_nop 1\n\tv_max_u32_dpp %0, %0, %0 quad_perm:[2,3,0,1] row_mask:0xf bank_mask:0xf\n\t"
                 "s_nop 1\n\tv_max_u32_dpp %0, %0, %0 row_half_mirror row_mask:0xf bank_mask:0xf\n\ts_nop 1\n\tv_max_u32_dpp %0, %0, %0 row_mirror row_mask:0xf bank_mask:0xf\n\ts_nop 1" : "+v"(v));
    return v; }
DI float row_max_f32(float v) {
    asm volatile("s_nop 1\n\tv_max_f32_dpp %0, %0, %0 quad_perm:[1,0,3,2] row_mask:0xf bank_mask:0xf\n\ts_nop 1\n\tv_max_f32_dpp %0, %0, %0 quad_perm:[2,3,0,1] row_mask:0xf bank_mask:0xf\n\t"
                 "s_nop 1\n\tv_max_f32_dpp %0, %0, %0 row_half_mirror row_mask:0xf bank_mask:0xf\n\ts_nop 1\n\tv_max_f32_dpp %0, %0, %0 row_mirror row_mask:0xf bank_mask:0xf\n\ts_nop 1" : "+v"(v));
    return v; }
DI float row_sum_f32(float v) {
    asm volatile("s_nop 1\n\tv_add_f32_dpp %0, %0, %0 quad_perm:[1,0,3,2] row_mask:0xf bank_mask:0xf\n\ts_nop 1\n\tv_add_f32_dpp %0, %0, %0 quad_perm:[2,3,0,1] row_mask:0xf bank_mask:0xf\n\t"
                 "s_nop 1\n\tv_add_f32_dpp %0, %0, %0 row_half_mirror row_mask:0xf bank_mask:0xf\n\ts_nop 1\n\tv_add_f32_dpp %0, %0, %0 row_mirror row_mask:0xf bank_mask:0xf\n\ts_nop 1" : "+v"(v));
    return v; }
DI float demono_f32(unsigned u) { return __uint_as_float((u & 0x80000000u) ? (u ^ 0x80000000u) : ~u); }

DI void phase_peer(const Params& P, LAS unsigned char* lds) {
    unsigned char* ws = P.ws; const int lane = threadIdx.x & 63, wave = __builtin_amdgcn_readfirstlane(threadIdx.x >> 6), rw = lane >> 4, li = lane & 15, p = lane & 31, hsel = lane >> 5;
    const float* SC = (const float*)(ws + WS_SC);
    LAS unsigned char* ptab = lds + 8192;
    LAS float* vs = (LAS float*)(lds + wave * 512); LAS int* ns = (LAS int*)(lds + wave * 512 + 256);
    __syncthreads();
    if (threadIdx.x == 0) { int q = 0; for (int a = 0; a < 16; ++a) for (int b = 0; b < 16 / (a + 1); ++b) ptab[q++] = (unsigned char)(a * 16 + b); for (; q < 64; ++q) ptab[q] = 0; }
    __syncthreads();
    const int q0 = p, q1 = p + 32; const int ab0 = ptab[q0], ab1 = ptab[q1 < 50 ? q1 : 0];
    for (int t = blockIdx.x * 8 + wave; t < NT; t += gridDim.x * 8) {
        for (int bt = 0; bt < 4; ++bt) {
            const float* sp = SC + (size_t)t * 2048 + (bt * 4 + rw) * 128 + li; unsigned k[8];
#pragma unroll
            for (int i = 0; i < 8; ++i) k[i] = (mono_u32(sp[16 * i]) & ~127u) | (unsigned)(127 - (li + 16 * i));
            unsigned win = 0u;
            for (int rd = 0; rd < 16; ++rd) {
                unsigned m = max(max(max(k[0], k[1]), max(k[2], k[3])), max(max(k[4], k[5]), max(k[6], k[7])));
                m = row_max_u32(m);
#pragma unroll
                for (int i = 0; i < 8; ++i) k[i] = (k[i] == m) ? 0u : k[i];
                if (li == rd) win = m; }
            vs[rw * 16 + li] = demono_f32(win & ~127u); ns[rw * 16 + li] = 127 - (int)(win & 127u);
            const LAS float* v1 = vs + hsel * 32; const LAS float* v2 = v1 + 16;
            const float c0 = v1[ab0 >> 4] + v2[ab0 & 15], c1 = v1[ab1 >> 4] + v2[ab1 & 15];
            unsigned k0 = (mono_u32(c0) & ~63u) | (unsigned)(63 - q0), k1 = (q1 < 50) ? ((mono_u32(c1) & ~63u) | (unsigned)(63 - q1)) : 0u;
            unsigned w2 = 0u;
            for (int rd = 0; rd < 16; ++rd) {
                unsigned m = row_max_u32(max(k0, k1));
                { const auto r_ = __builtin_amdgcn_permlane16_swap(m, m, false, false); m = max(r_[0], r_[1]); }
                k0 = (k0 == m) ? 0u : k0; k1 = (k1 == m) ? 0u : k1;
                if (p == rd) w2 = m; }
            if (p < 16) {
                const int ab = ptab[63 - (int)(w2 & 63u)], a = ab >> 4, b = ab & 15;
                const float tsv = v1[a] + v2[b]; const int ee = ns[hsel * 32 + a] * 128 + ns[hsel * 32 + 16 + b];
                const float mx = row_max_f32(tsv), ex = __expf(tsv - mx), sm = row16_sum(ex);
                const int slot = (2 * bt + hsel) * 16 + p;
                ((int*)(ws + WS_EX))[(size_t)t * 128 + slot] = ee;
                ((float*)(ws + WS_GT))[(size_t)t * 128 + slot] = (ex / sm) * ((const float*)(ws + WS_PSV))[ee]; ((float*)(ws + WS_SU))[(size_t)t * 128 + slot] = ((const float*)(ws + WS_PSU))[ee]; }
        }
    }
}

DI void peer_slice_map(const Params& P, LAS unsigned char* lds, int& vx, int& rank, int& nrank) {
    volatile LAS unsigned* misc = (volatile LAS unsigned*)(lds + LDS_MISC);
    const unsigned* bar = (const unsigned*)(P.ws + WS_BAR);
    const int xcc = (int)misc[4], rk = (int)misc[5];
    bool ok = true; int mine = 0;
#pragma unroll
    for (int j = 0; j < 16; ++j) { const unsigned c = __hip_atomic_load(bar + XB_XCNT(j), __ATOMIC_RELAXED, __HIP_MEMORY_SCOPE_AGENT); if (j < 8 ? c == 0u : c != 0u) ok = false; if (j == xcc) mine = (int)c; }
    if (ok && (P.ph_hi - P.ph_lo > 1)) { vx = xcc; rank = rk; nrank = mine; }
    else { vx = blockIdx.x & 7; rank = blockIdx.x >> 3; nrank = (gridDim.x + 7 - vx) >> 3; }
}
DI void phase_peer_a(const Params& P, LAS unsigned char* lds) {
    unsigned char* ws = P.ws; const int lane = threadIdx.x & 63, wave = __builtin_amdgcn_readfirstlane(threadIdx.x >> 6); int vx, rank, nrank; peer_slice_map(P, lds, vx, rank, nrank);
    const int gq = lane >> 4, li = lane & 15;
    LAS int* el = (LAS int*)(lds + wave * 1024);
    const unsigned char* PU = ws + WS_PU + (size_t)vx * 4194304; const unsigned li16 = (unsigned)li * 16u; const bf16_t* H2 = (const bf16_t*)(ws + WS_H2) + vx * 256 + li * 16;
    float* PA = (float*)(ws + WS_PA) + (size_t)vx * NT * 128;
    for (int t = rank * 8 + wave; t < NT; t += nrank * 8) {
        const int* exg = (const int*)(ws + WS_EX) + (size_t)t * 128;
        el[lane] = exg[lane]; el[64 + lane] = exg[64 + lane];
        unsigned hq[8];
        { const u32x4 ha = *(const u32x4*)(H2 + (size_t)t * 2048), hb = *(const u32x4*)(H2 + (size_t)t * 2048 + 8);
#pragma unroll
          for (int q = 0; q < 4; ++q) { hq[q] = ha[q]; hq[4 + q] = hb[q]; } }
#pragma unroll
        for (int jb = 0; jb < 32; jb += 8) {
            u32x4 rw[8];
#pragma unroll
            for (int i = 0; i < 8; ++i) { const unsigned ex = (unsigned)el[4 * (jb + i) + gq]; rw[i] = *(const u32x4*)(PU + (ex * 256u + li16)); }
            float pr[8];
#pragma unroll
            for (int i = 0; i < 8; ++i) { float a0 = 0.f, a1 = 0.f;
#pragma unroll
                for (int q = 0; q < 4; ++q) { a0 = __builtin_amdgcn_fdot2_f32_bf16(__builtin_amdgcn_cvt_scalef32_pk_bf16_fp8(rw[i][q], 1.0f, false), bf16pair(hq[2 * q]), a0, false);
                    a1 = __builtin_amdgcn_fdot2_f32_bf16(__builtin_amdgcn_cvt_scalef32_pk_bf16_fp8(rw[i][q], 1.0f, true), bf16pair(hq[2 * q + 1]), a1, false); }
                pr[i] = a0 + a1; }
            const float tot = reduce8_row16(pr, li);
            if (!(li & 1)) PA[(size_t)t * 128 + 4 * (jb + (li >> 1)) + gq] = tot;
        }
    }
}
DI void phase_peer_w(const Params& P) {
    unsigned char* ws = P.ws; const float* PA = (const float*)(ws + WS_PA); float* GT = (float*)(ws + WS_GT); const float* SU = (const float*)(ws + WS_SU);
    for (size_t i = (size_t)blockIdx.x * 512 + threadIdx.x; i < (size_t)NT * 128; i += (size_t)gridDim.x * 512) { float a = 0.f;
#pragma unroll
        for (int x = 0; x < 8; ++x) a += PA[(size_t)x * NT * 128 + i];
        GT[i] = GT[i] * gelu_tanh(a * SU[i]); }
}
DI void phase_peer_b(const Params& P, LAS unsigned char* lds) {
    unsigned char* ws = P.ws; const int lane = threadIdx.x & 63, wave = __builtin_amdgcn_readfirstlane(threadIdx.x >> 6); int vx, rank, nrank; peer_slice_map(P, lds, vx, rank, nrank);
    const int gq = lane >> 4, li = lane & 15;
    LAS int* el = (LAS int*)(lds + wave * 1024); LAS float* wl = (LAS float*)(lds + wave * 1024 + 512);
    const unsigned char* PV = ws + WS_PV + (size_t)vx * 4194304; const unsigned li16 = (unsigned)li * 16u;
    const float* X1 = (const float*)(ws + WS_X1); const float* mod = (const float*)(ws + WS_MOD);
    for (int t = rank * 8 + wave; t < NT; t += nrank * 8) {
        const int* exg = (const int*)(ws + WS_EX) + (size_t)t * 128; const float* gtg = (const float*)(ws + WS_GT) + (size_t)t * 128;
        el[lane] = exg[lane]; el[64 + lane] = exg[64 + lane]; wl[lane] = gtg[lane]; wl[64 + lane] = gtg[64 + lane];
        f32x2 oa[8];
#pragma unroll
        for (int i = 0; i < 8; ++i) oa[i] = (f32x2){0.f, 0.f};
#pragma unroll
        for (int jb = 0; jb < 32; jb += 8) {
            u32x4 rw[8]; float wv[8];
#pragma unroll
            for (int i = 0; i < 8; ++i) { const int slot = 4 * (jb + i) + gq; const unsigned ex = (unsigned)el[slot]; wv[i] = wl[slot]; rw[i] = *(const u32x4*)(PV + (ex * 256u + li16)); }
#pragma unroll
            for (int i = 0; i < 8; ++i) { const f32x2 w2 = {wv[i], wv[i]};
#pragma unroll
                for (int q = 0; q < 4; ++q) { oa[2 * q] += w2 * __builtin_amdgcn_cvt_pk_f32_fp8((int)rw[i][q], false); oa[2 * q + 1] += w2 * __builtin_amdgcn_cvt_pk_f32_fp8((int)rw[i][q], true); } }
        }
        float v16[16], w8[8], o4[4];
#pragma unroll
        for (int i = 0; i < 8; ++i) { v16[2 * i] = oa[i].x; v16[2 * i + 1] = oa[i].y; }
#pragma unroll
        for (int k = 0; k < 8; ++k) { const auto r = __builtin_amdgcn_permlane16_swap(__float_as_uint(v16[k]), __float_as_uint(v16[8 + k]), false, false); w8[k] = __uint_as_float(r[0]) + __uint_as_float(r[1]); }
#pragma unroll
        for (int k = 0; k < 4; ++k) { const auto r = __builtin_amdgcn_permlane32_swap(__float_as_uint(w8[k]), __float_as_uint(w8[4 + k]), false, false); o4[k] = __uint_as_float(r[0]) + __uint_as_float(r[1]); }
        const int cq = ((gq & 1) << 1) | (gq >> 1);
        const int d = vx * 256 + li * 16 + 4 * cq; const f32x4 xa = *(const f32x4*)(X1 + (size_t)t * 2048 + d), ga = *(const f32x4*)(mod + (t >> 12) * 12288 + 10240 + d);
        f32x4 y; float ss = 0.f;
#pragma unroll
        for (int e = 0; e < 4; ++e) { y[e] = xa[e] + ga[e] * o4[e]; ss += y[e] * y[e]; }
        *(f32x4*)(P.out + (size_t)t * 2048 + d) = y;
        ss = wave_sum(ss); if (lane == 0) ((float*)(ws + WS_SS))[(size_t)vx * NT + t] = ss;
    }
}
DI void phase_peer_norm(const Params& P) {
    unsigned char* ws = P.ws; const int lane = threadIdx.x & 63, wave = __builtin_amdgcn_readfirstlane(threadIdx.x >> 6); const float* SS = (const float*)(ws + WS_SS);
    for (int t = blockIdx.x * 8 + wave; t < NT; t += gridDim.x * 8) {
        float ss = 0.f;
#pragma unroll
        for (int x = 0; x < 8; ++x) ss += SS[(size_t)x * NT + t];
        const float rs = rsqrtf(ss * (1.f / 2048.f) + 1e-6f); float* o = P.out + (size_t)t * 2048;
#pragma unroll
        for (int k = 0; k < 8; ++k) { const int d = k * 256 + lane * 4; f32x4 v = *(const f32x4*)(o + d); const f32x4 g = *(const f32x4*)(P.final_g + d);
#pragma unroll
            for (int e = 0; e < 4; ++e) v[e] = v[e] * rs * g[e];
            *(f32x4*)(o + d) = v; }
    }
}


constexpr int N_PHASES = 16;
template <int K> DI void run_phase(const Params& P, LAS unsigned char* lds) {
    unsigned char* ws = P.ws; const int G = gridDim.x, bx = blockIdx.x, tid = threadIdx.x; (void)G; (void)bx; (void)tid;
    if constexpr (K == 0) { p0_prologue(P, lds); }
    if constexpr (K == 1) { phase_norm_f8(P.x, P.norm_mix_g, (const float*)(ws + WS_MOD), 0, 2048, ws + WS_H, (float*)(ws + WS_HSC)); }
    if constexpr (K == 2) {
        { pg8::Gemm g{(const bf16_t*)(ws + WS_H), (const bf16_t*)(ws + WS_WIN), 2048, 2048, 2048}; pg8::StaticOrder S; S.init(NT, NPROJ, G, bx); EpiProj E{ws, (const float*)(ws + WS_HSC)};
          pg8::gemm_phase<EpiProj, pg8::StaticOrder, true>(lds, g, S, E); }
        { pg8::Gemm g{(const bf16_t*)(ws + WS_KBD), (const bf16_t*)(ws + WS_WQ), 2048, 2048, 2048}; pg8::StaticOrder S; S.init(2048, 2048, G, (bx + 64) % G); EpiBf16Plain E{(bf16_t*)(ws + WS_WSC), 2048};
          pg8::gemm_phase<EpiBf16Plain, pg8::StaticOrder>(lds, g, S, E); }
    }
    if constexpr (K == 3) {
        { pg8::Gemm g{(const bf16_t*)(ws + WS_A2), (const bf16_t*)(ws + WS_S5B1), 384, 256, 256}; GroupOrder S{256, G, bx, 4}; EpiS5G1 E{(float*)(ws + WS_XL)};
          pg8::gemm_phase<EpiS5G1, GroupOrder>(lds, g, S, E); }
        { pg8::Gemm g{(const bf16_t*)(ws + WS_KV), (const bf16_t*)(ws + WS_WC1), 1024, 2048, 2048}; GroupOrder S{32, G, (bx + 128) % G, 16}; EpiCmp1 E{(bf16_t*)(ws + WS_HID), (const float*)(ws + WS_CB)};
          pg8::gemm_phase<EpiCmp1, GroupOrder>(lds, g, S, E); }
        phase_attn_win_early(P, lds);
    }
    if constexpr (K == 4) { phase_scan(P); phase_cmp2(P); }
    if constexpr (K == 5) {
        { pg8::Gemm g{(const bf16_t*)(ws + WS_A2), (const bf16_t*)(ws + WS_S5B2), 384, 384, 384}; GroupOrder S{256, G, bx, 4}; EpiS5G2 E{(bf16_t*)(ws + WS_YACT)};
          pg8::gemm_phase<EpiS5G2, GroupOrder>(lds, g, S, E); }
        phase_attn_cmp_win(P, lds);
    }
    if constexpr (K == 6) {
        { pg8::Gemm g{(const bf16_t*)(ws + WS_YACT), (const bf16_t*)(ws + WS_WGLU), 1024, 1024, 1024}; pg8::StaticOrder S; S.init(NT, 1024, G, bx); EpiGlu E{(const bf16_t*)(ws + WS_YACT), (bf16_t*)(ws + WS_Y2), P.glu_b};
          pg8::gemm_phase<EpiGlu, pg8::StaticOrder>(lds, g, S, E); }
        phase_attn_sel(P, lds);
    }
    if constexpr (K == 7) {
        { pg8::Gemm g{(const bf16_t*)(ws + WS_OATT), (const bf16_t*)(ws + WS_WUA), 1024, 1024, 1024}; pg8::StaticOrder S; S.init(NT, 2048, G, bx); EpiUp<0> E{(const bf16_t*)(ws + WS_MG), nullptr, (bf16_t*)(ws + WS_TMP), 1.f / (OATT_SCALE * 1024.f)};
          pg8::gemm_phase<EpiUp<0>, pg8::StaticOrder, true>(lds, g, S, E); }
        { pg8::Gemm g{(const bf16_t*)(ws + WS_Y2), (const bf16_t*)(ws + WS_WUS), 1024, 1024, 1024}; pg8::StaticOrder S; S.init(NT, 2048, G, bx); EpiUp<1> E{(const bf16_t*)(ws + WS_MG), (const bf16_t*)(ws + WS_TMP), (bf16_t*)(ws + WS_MIX), 1.f / (Y2_SCALE * 1024.f)};
          pg8::gemm_phase<EpiUp<1>, pg8::StaticOrder, true>(lds, g, S, E); }
    }
    if constexpr (K == 8) {
        pg8::Gemm g{(const bf16_t*)(ws + WS_MIX), (const bf16_t*)(ws + WS_WOUT), 2048, 2048, 2048}; pg8::StaticOrder S; S.init(NT, 2048, G, bx); EpiOut E{P.x, (const float*)(ws + WS_MOD), (float*)(ws + WS_X1)};
        pg8::gemm_phase<EpiOut, pg8::StaticOrder, true>(lds, g, S, E);
    }
    if constexpr (K == 9) {
        phase_norm((const float*)(ws + WS_X1), P.norm_ffn_g, (const float*)(ws + WS_MOD), 6144, 8192, (bf16_t*)(ws + WS_H2));
        conv_rows_fp8(P.peer_u, ws + WS_PU, (float*)(ws + WS_PSU), 16384);
        conv_rows_fp8(P.peer_v, ws + WS_PV, (float*)(ws + WS_PSV), 16384);
    }
    if constexpr (K == 10) {
        pg8::Gemm g{(const bf16_t*)(ws + WS_H2), (const bf16_t*)(ws + WS_WSC), 2048, 2048, 2048}; pg8::StaticOrder S; S.init(NT, 2048, G, bx); EpiF32Plain E{(float*)(ws + WS_SC), 2048};
        pg8::gemm_phase<EpiF32Plain, pg8::StaticOrder>(lds, g, S, E);
    }
    if constexpr (K == 11) { phase_peer(P, lds); }
    if constexpr (K == 12) { phase_peer_a(P, lds); }
    if constexpr (K == 13) { phase_peer_w(P); }
    if constexpr (K == 14) { phase_peer_b(P, lds); }
    if constexpr (K == 15) { phase_peer_norm(P); }
}

__global__ void __launch_bounds__(512, 2) mk_fwd(Params P) {
    extern __shared__ __attribute__((aligned(16))) unsigned char lds_raw[];
    LAS unsigned char* lds = (LAS unsigned char*)lds_raw;
    unsigned char* ws = P.ws;
    const int G = gridDim.x, bx = blockIdx.x, tid = threadIdx.x;
    volatile LAS unsigned* misc = (volatile LAS unsigned*)(lds + LDS_MISC);
    if (tid < 8) misc[tid] = 0u;
    __syncthreads();
    const int lo = P.ph_lo, hi = P.ph_hi;
    XcdBarrier bar; bar.bar = (unsigned*)(ws + WS_BAR); bar.x = 0; bar.st = misc;
    if (hi - lo > 1) bar = xcd_barrier_post((unsigned*)(ws + WS_BAR), misc);
    if (tid == 0) { const unsigned xcc = xb_xcc_id(); misc[4] = xcc; misc[5] = (hi - lo > 1) ? xb_add((unsigned*)(ws + WS_BAR) + 8192 + 64 * (xcc & 15u), 1u) : 0u; }
    __syncthreads();
#define IN(k) (lo <= (k) && (k) < hi)
#define SEAM(k) do { if (IN(k) && IN((k) + 1)) xcd_barrier(bar); } while (0)

    if (IN(0)) run_phase<0>(P, lds);
    SEAM(0);
    if (IN(1)) run_phase<1>(P, lds);
    SEAM(1);
    if (IN(2)) run_phase<2>(P, lds);
    SEAM(2);
    if (IN(3)) run_phase<3>(P, lds);
    SEAM(3);
    if (IN(4)) run_phase<4>(P, lds);
    SEAM(4);
    if (IN(5)) run_phase<5>(P, lds);
    SEAM(5);
    if (IN(6)) run_phase<6>(P, lds);
    SEAM(6);
    if (IN(7)) run_phase<7>(P, lds);
    SEAM(7);
    if (IN(8)) run_phase<8>(P, lds);
    SEAM(8);
    if (IN(9)) run_phase<9>(P, lds);
    SEAM(9);
    if (IN(10)) run_phase<10>(P, lds);
    SEAM(10);
    if (IN(11)) run_phase<11>(P, lds);
    SEAM(11);
    if (IN(12)) run_phase<12>(P, lds);
    SEAM(12);
    if (IN(13)) run_phase<13>(P, lds);
    SEAM(13);
    if (IN(14)) run_phase<14>(P, lds);
    SEAM(14);
    if (IN(15)) run_phase<15>(P, lds);
#undef IN
#undef SEAM
}

extern "C" void kernel_launch(void* const* d_in, const int* in_sizes, int n_in, void* d_out, int out_size, void* d_ws, size_t ws_size, hipStream_t stream) {
    static int grid = 0;
    if (grid == 0) {
        if (n_in != 31 || ws_size < WS_END) { fprintf(stderr, "kernel_launch: expected 31 inputs and >= %zu bytes of workspace (got %d, %zu)\n", (size_t)WS_END, n_in, ws_size); grid = -1; return; }
        int dev = 0, cus = 0, per_cu = 0;
        if (hipGetDevice(&dev) != hipSuccess || hipDeviceGetAttribute(&cus, hipDeviceAttributeMultiprocessorCount, dev) != hipSuccess) { grid = -1; return; }
        if (hipFuncSetAttribute((const void*)mk_fwd, hipFuncAttributeMaxDynamicSharedMemorySize, LDS_BYTES) != hipSuccess) { fprintf(stderr, "kernel_launch: hipFuncSetAttribute failed\n"); grid = -1; return; }
        if (hipOccupancyMaxActiveBlocksPerMultiprocessor(&per_cu, (const void*)mk_fwd, 512, LDS_BYTES) != hipSuccess || per_cu < 1) { fprintf(stderr, "kernel_launch: occupancy query reports %d blocks per CU\n", per_cu); (void)hipGetLastError(); grid = -1; return; }
        grid = cus;
    }
    if (grid < 0) return;
    (void)hipMemsetAsync((char*)d_ws + WS_BAR, 0, 65536, stream);
    Params p{};
    const float** f = (const float**)&p;
    for (int i = 0; i < 31; ++i) f[i] = (const float*)d_in[i];
    p.out = (float*)d_out; p.ws = (unsigned char*)d_ws;
#if MK_PER_PHASE
    for (int ph = 0; ph < N_PHASES; ++ph) { p.ph_lo = ph; p.ph_hi = ph + 1; hipLaunchKernelGGL(mk_fwd, dim3(grid), dim3(512), LDS_BYTES, stream, p); }
#else
    p.ph_lo = 0; p.ph_hi = N_PHASES; hipLaunchKernelGGL(mk_fwd, dim3(grid), dim3(512), LDS_BYTES, stream, p);
#endif
}
```

```cpp
#include <hip/hip_runtime.h>
#include <stdint.h>
#include <stdio.h>
#include <math.h>
#include <type_traits>


#ifndef MK_PER_PHASE
#define MK_PER_PHASE 0
#endif

#define XB_TMO      128
#define XB_XCNT(j)  (256  + 64 * (j))
#define XB_XSUB(j)  (1280 + 64 * (j))
#define XB_XGEN(j)  (2304 + 64 * (j))
#define XB_TOP      3328
#define XB_TOPGEN   3392
#define XCD_BAR_WORDS 3456
#define XB_SPIN_CAP (1u << 18)
#define LAS __attribute__((address_space(3)))

__device__ __forceinline__ unsigned xb_ld(unsigned* p)              { return __hip_atomic_load(p, __ATOMIC_RELAXED, __HIP_MEMORY_SCOPE_AGENT); }
__device__ __forceinline__ unsigned xb_add(unsigned* p, unsigned v) { return __hip_atomic_fetch_add(p, v, __ATOMIC_RELAXED, __HIP_MEMORY_SCOPE_AGENT); }
__device__ __forceinline__ unsigned xb_xcc_id() { return (unsigned)__builtin_amdgcn_s_getreg((3 << 11) | 20) & 0xFu; }
#define XB_SPIN(cond, bar) do { unsigned _sp = 0; while (cond) { __builtin_amdgcn_s_sleep(1); \
    if ((++_sp & 255u) == 0u) { if (xb_ld(&(bar)[XB_TMO])) break; if (_sp > XB_SPIN_CAP) { atomicAdd(&(bar)[XB_TMO], 1u); break; } } } } while (0)

struct XcdBarrier {
    unsigned* bar; unsigned x;
    volatile LAS unsigned* st;
};

__device__ __forceinline__ XcdBarrier xcd_barrier_post(unsigned* bar, volatile LAS unsigned* st) {
    XcdBarrier b; b.bar = bar; b.x = xb_xcc_id(); b.st = st;
    if (threadIdx.x == 0) (void)xb_add(&bar[XB_XCNT(b.x)], 1u);
    return b;
}
__device__ __forceinline__ void xcd_barrier_complete(unsigned* bar, unsigned x, unsigned& nloc, unsigned& nx) {
    const unsigned G = gridDim.x * gridDim.y * gridDim.z;
    unsigned sum, cnt, mine, sp = 0u;
    for (;;) {
        sum = 0u; cnt = 0u; mine = 0u;
#pragma unroll
        for (unsigned j = 0; j < 16; ++j) { const unsigned c = xb_ld(&bar[XB_XCNT(j)]); sum += c; cnt += (c > 0u) ? 1u : 0u; mine = (j == x) ? c : mine; }
        if (sum == G) break;
        __builtin_amdgcn_s_sleep(1);
        if ((++sp & 255u) == 0u) { if (xb_ld(&bar[XB_TMO])) break; if (sp > XB_SPIN_CAP) { atomicAdd(&bar[XB_TMO], 1u); break; } }
    }
    nloc = mine > 0u ? mine : 1u; nx = cnt > 0u ? cnt : 1u;
}

__device__ __forceinline__ void xcd_barrier(const XcdBarrier& b) {
    asm volatile("s_waitcnt vmcnt(0)" ::: "memory");
    __syncthreads();
    if (threadIdx.x == 0) {
        unsigned* bar = b.bar;
        __builtin_amdgcn_s_waitcnt(0);
        unsigned nloc = b.st[0], nx = b.st[1];
        if (nloc == 0u) { xcd_barrier_complete(bar, b.x, nloc, nx); b.st[0] = nloc; b.st[1] = nx; }
        const unsigned old = xb_add(&bar[XB_XSUB(b.x)], 1u);
        const unsigned gen = old / nloc;
        if (old + 1u == (gen + 1u) * nloc) {
            __builtin_amdgcn_fence(__ATOMIC_RELEASE, "agent");
            asm volatile("s_waitcnt vmcnt(0)" ::: "memory");
            const unsigned og = xb_add(&bar[XB_TOP], 1u);
            const unsigned tg = og / nx;
            if (og + 1u == (tg + 1u) * nx) xb_add(&bar[XB_TOPGEN], 1u);
            else XB_SPIN(xb_ld(&bar[XB_TOPGEN]) == tg, bar);
            __builtin_amdgcn_fence(__ATOMIC_ACQUIRE, "agent");
            xb_add(&bar[XB_XGEN(b.x)], 1u);
            asm volatile("s_waitcnt vmcnt(0)" ::: "memory");
        } else {
            XB_SPIN(xb_ld(&bar[XB_XGEN(b.x)]) == gen, bar);
            __builtin_amdgcn_fence(__ATOMIC_ACQUIRE, "agent");
            asm volatile("s_waitcnt vmcnt(0)" ::: "memory");
        }
    }
    __syncthreads();
}


namespace pg8 {
#define PG8_LAS __attribute__((address_space(3)))
typedef unsigned short bf16_t;
typedef short bf16x8 __attribute__((ext_vector_type(8)));
typedef float f32x4 __attribute__((ext_vector_type(4)));
typedef unsigned u32x4 __attribute__((ext_vector_type(4)));
constexpr int BM = 256, BK = 64, HALF = 128, HTB = HALF * BK * 2  , STAGE_BYTES = 8 * HTB, NXCD = 8, WGM = 8;

__host__ __device__ __forceinline__ int lds_byte(int r, int c) { const int st = (r >> 4) * 2 + (c >> 5), rr = r & 15, cc = c & 31, ob = rr * 64 + cc * 2; return st * 1024 + (ob ^ (((ob >> 9) & 1) << 5)); }
__host__ __device__ __forceinline__ void stage_rc(int b, int& R, int& C) { const int st = b / 1024, sb = b % 1024, swz = sb ^ (((sb >> 9) & 1) << 5); R = (st >> 1) * 16 + swz / 64; C = (st & 1) * 32 + (swz % 64) / 2; }
__host__ __device__ __forceinline__ int perm32(int rho) { const int n = rho >> 4, i = rho & 15; return 8 * (i >> 2) + 4 * n + (i & 3); }

struct Unit { int pm, pn; };
struct Gemm { const bf16_t* A; const bf16_t* Bt; int lda, ldb, K; int kdiag = 0; };
struct StaticOrder {
    int nM, nN, nwg, G, c;
    __host__ __device__ void init(int M, int N, int G_, int c_) { nM = M / BM; nN = N / BM; nwg = nM * nN; G = G_; c = c_; }
    __host__ __device__ bool next(int i, Unit& u) const {
        const long L = (long)i * G + c; if (L >= nwg) return false;
        int wgid = (int)L; { const int q = nwg / NXCD, r = nwg % NXCD, xcd = wgid % NXCD, off = wgid / NXCD; wgid = (xcd < r ? xcd * (q + 1) : r * (q + 1) + (xcd - r) * q) + off; }
        const int nig = WGM * nN, gid = wgid / nig, fm = gid * WGM, gsz = (nM - fm) < WGM ? (nM - fm) : WGM;
        u.pm = fm + ((wgid % nig) % gsz); u.pn = (wgid % nig) / gsz; return true;
    }
    __device__ __forceinline__ void a_ready(const Unit&) const {}
    __device__ __forceinline__ void done(const Unit&) const {}
};
typedef int pg8_i4 __attribute__((ext_vector_type(4)));
typedef int pg8_i8 __attribute__((ext_vector_type(8)));
template <bool F8> struct FragSel { struct T { bf16x8 k[2]; }; };
template <> struct FragSel<true> { typedef pg8_i8 T; };
template <class Epi, class Sched, bool F8 = false>
__device__ __forceinline__ void gemm_phase(PG8_LAS unsigned char* lds, const Gemm g, const Sched& S, const Epi& E) {
    const int tid = threadIdx.x, wid = __builtin_amdgcn_readfirstlane(tid >> 6), lane = tid & 63, wr = wid >> 2, wc = wid & 3, fr = lane & 15, fq = lane >> 4;
    constexpr int ES = F8 ? 1 : 2;
    const int K = g.K, nt = K * ES / 128;
    unsigned voffA[2], voffB[2];
#pragma unroll
    for (int i = 0; i < 2; ++i) { int R, C; stage_rc(tid * 16 + i * 8192, R, C); const int Rb = Epi::PERM ? ((R & ~31) + perm32(R & 31)) : R;
        voffA[i] = (unsigned)(R * g.lda * ES + C * 2); voffB[i] = (unsigned)(Rb * g.ldb * ES + C * 2); }
    const size_t kstep = (size_t)(BK * 2);
    const size_t hstepA = (size_t)HALF * g.lda * ES, hstepB = (size_t)HALF * g.ldb * ES;
    const size_t tstepA = 2 * hstepA, tstepB = 2 * hstepB;
    const unsigned ldsw = (unsigned)wid * 1024u;
    const int aoff = lds_byte(wr * 64 + fr, fq * 8), boff = lds_byte(wc * 32 + fr, fq * 8);
#define PG8_SA(b, h) (((b) * 2 + (h)) * HTB)
#define PG8_SB(b, h) ((4 + (b) * 2 + (h)) * HTB)
#define PG8_STAGE(bufoff, gbase, voff) do { _Pragma("unroll") for (int _i = 0; _i < 2; ++_i) \
        __builtin_amdgcn_global_load_lds((const unsigned*)((const char*)(gbase) + (voff)[_i]), (PG8_LAS unsigned*)(lds + (bufoff) + ldsw + _i * 8192), 16, 0, 0); } while (0)
#define PG8_LDF(d_, p_) do { if constexpr (F8) d_ = __builtin_shufflevector(*(const PG8_LAS pg8_i4*)(p_), *(const PG8_LAS pg8_i4*)((p_) + 1024), 0, 1, 2, 3, 4, 5, 6, 7); \
        else { d_.k[0] = *(const PG8_LAS bf16x8*)(p_); d_.k[1] = *(const PG8_LAS bf16x8*)((p_) + 1024); } } while (0)
#define PG8_LDA(dst, b, h) do { _Pragma("unroll") for (int m = 0; m < 4; ++m) PG8_LDF(dst[m], lds + PG8_SA(b, h) + aoff + m * 2048); } while (0)
#define PG8_LDB(dst, b, h) do { _Pragma("unroll") for (int n = 0; n < 2; ++n) PG8_LDF(dst[n], lds + PG8_SB(b, h) + boff + n * 2048); } while (0)
#define PG8_MMA(ai, bj, At, Bt) do { __builtin_amdgcn_s_setprio(1); _Pragma("unroll") for (int m = 0; m < 4; ++m) _Pragma("unroll") for (int n = 0; n < 2; ++n) { \
        if constexpr (F8) asm volatile("v_mfma_scale_f32_16x16x128_f8f6f4 %0, %1, %2, %0, %3, %3 op_sel_hi:[0,0,0]" : "+v"(acc[ai][bj][m][n]) : "v"(Bt[n]), "v"(At[m]), "v"(sc1_));     \
        else { _Pragma("unroll") for (int k = 0; k < 2; ++k) acc[ai][bj][m][n] = __builtin_amdgcn_mfma_f32_16x16x32_bf16(Bt[n].k[k], At[m].k[k], acc[ai][bj][m][n], 0, 0, 0); } } __builtin_amdgcn_s_setprio(0); } while (0)
#define PG8_WAIT_V(n) asm volatile("s_waitcnt vmcnt(" #n ")" ::: "memory")
#define PG8_WAIT_L(n) asm volatile("s_waitcnt lgkmcnt(" #n ")" ::: "memory")
#define PG8_BAR __builtin_amdgcn_s_barrier()
#define PG8_SCHED __builtin_amdgcn_sched_barrier(0)
    Unit cur, nxt; int ui = 0;
    if (!S.next(0, cur)) return;
    f32x4 acc[2][2][4][2];
#pragma unroll
    for (int a = 0; a < 2; ++a)
#pragma unroll
        for (int b = 0; b < 2; ++b)
#pragma unroll
            for (int m = 0; m < 4; ++m)
#pragma unroll
                for (int n = 0; n < 2; ++n) acc[a][b][m][n] = (f32x4){0.f, 0.f, 0.f, 0.f};
    typedef typename FragSel<F8>::T frag_t;
    frag_t At[4], B0[2], B1[2];
    int sc1_ = 0x7F7F7F7F; if constexpr (F8) asm volatile("" : "+v"(sc1_));
    const char* cA = (const char*)g.A + (size_t)cur.pm * tstepA + (size_t)cur.pm * g.kdiag; const char* cB = (const char*)g.Bt + (size_t)cur.pn * tstepB + (size_t)cur.pm * g.kdiag;
    S.a_ready(cur);
    PG8_STAGE(PG8_SB(0, 0), cB, voffB); PG8_STAGE(PG8_SA(0, 0), cA, voffA); PG8_STAGE(PG8_SB(0, 1), cB + hstepB, voffB); PG8_STAGE(PG8_SA(0, 1), cA + hstepA, voffA);
    if (wr == 1) PG8_BAR;
    PG8_WAIT_V(4); PG8_BAR;
    PG8_STAGE(PG8_SB(1, 0), cB + kstep, voffB); PG8_STAGE(PG8_SA(1, 0), cA + kstep, voffA); PG8_STAGE(PG8_SB(1, 1), cB + hstepB + kstep, voffB);
    PG8_WAIT_V(6); PG8_BAR;
    for (;;) {
        const bool has_next = S.next(ui + 1, nxt);
        const char* nA = has_next ? (const char*)g.A + (size_t)nxt.pm * tstepA + (size_t)nxt.pm * g.kdiag : cA; const char* nB = has_next ? (const char*)g.Bt + (size_t)nxt.pn * tstepB + (size_t)nxt.pm * g.kdiag : cB;
        for (int t = 0; t < nt; t += 2) {
            const bool last = (t == nt - 2);
            const char* a1 = cA + (size_t)(t + 1) * kstep;
            const char* a2 = last ? nA : cA + (size_t)(t + 2) * kstep; const char* b2 = last ? nB : cB + (size_t)(t + 2) * kstep;
            const char* a3 = a2 + kstep; const char* b3 = b2 + kstep;
            if (last && has_next) S.a_ready(nxt);
            if constexpr (Epi::MIDK > 0) { if (t == Epi::MIDK) {
                if constexpr (F8) asm volatile("s_nop 15\n\ts_nop 7" ::: "memory");
                int fr_ = fr, fq_ = fq; asm volatile("" : "+v"(fr_), "+v"(fq_));
                E.mid(acc, cur, wr, wc, fr_, fq_);
                asm volatile("s_waitcnt vmcnt(0)\n\ts_nop 7" ::: "memory"); } }
            PG8_LDB(B0, 0, 0); PG8_SCHED; PG8_LDA(At, 0, 0); PG8_STAGE(PG8_SA(1, 1), a1 + hstepA, voffA);
            PG8_WAIT_L(8); PG8_BAR; PG8_WAIT_L(0); PG8_MMA(0, 0, At, B0); PG8_BAR; PG8_SCHED;
            PG8_LDB(B1, 0, 1); PG8_STAGE(PG8_SB(0, 0), b2, voffB);
            PG8_BAR; PG8_WAIT_L(0); PG8_MMA(0, 1, At, B1); PG8_BAR;
            PG8_LDA(At, 0, 1); PG8_STAGE(PG8_SA(0, 0), a2, voffA);
            PG8_BAR; PG8_WAIT_L(0); PG8_MMA(1, 0, At, B0); PG8_BAR; PG8_SCHED;
            PG8_STAGE(PG8_SB(0, 1), b2 + hstepB, voffB);
            PG8_WAIT_V(6); PG8_BAR; PG8_MMA(1, 1, At, B1); PG8_BAR;
            PG8_LDB(B0, 1, 0); PG8_SCHED; PG8_LDA(At, 1, 0); PG8_STAGE(PG8_SA(0, 1), a2 + hstepA, voffA);
            PG8_WAIT_L(8); PG8_BAR; PG8_WAIT_L(0); PG8_MMA(0, 0, At, B0); PG8_BAR; PG8_SCHED;
            PG8_LDB(B1, 1, 1); PG8_STAGE(PG8_SB(1, 0), b3, voffB);
            PG8_BAR; PG8_WAIT_L(0); PG8_MMA(0, 1, At, B1); PG8_BAR;
            PG8_LDA(At, 1, 1); PG8_STAGE(PG8_SA(1, 0), a3, voffA);
            PG8_BAR; PG8_WAIT_L(0); PG8_MMA(1, 0, At, B0); PG8_BAR; PG8_SCHED;
            PG8_STAGE(PG8_SB(1, 1), b3 + hstepB, voffB);
            PG8_WAIT_V(6); PG8_BAR; PG8_MMA(1, 1, At, B1); PG8_BAR;
        }
        if constexpr (F8) asm volatile("s_nop 15\n\ts_nop 7" ::: "memory");
        if constexpr (!Epi::AFTER_DRAIN) { int fr_ = fr, fq_ = fq; asm volatile("" : "+v"(fr_), "+v"(fq_));
            E(acc, cur, wr, wc, fr_, fq_); S.done(cur); }
        if (!has_next) break;
#pragma unroll
        for (int a = 0; a < 2; ++a)
#pragma unroll
            for (int b = 0; b < 2; ++b)
#pragma unroll
                for (int m = 0; m < 4; ++m)
#pragma unroll
                    for (int n = 0; n < 2; ++n) acc[a][b][m][n] = (f32x4){0.f, 0.f, 0.f, 0.f};
        cur = nxt; cA = nA; cB = nB; ++ui;
    }
    PG8_WAIT_V(0);
    if (wr == 0) PG8_BAR;
    PG8_BAR;
    if constexpr (Epi::AFTER_DRAIN) { E.fused(acc, cur, wr, wc, fr, fq, lds, wid, lane); S.done(cur); }
#undef PG8_SA
#undef PG8_SB
#undef PG8_STAGE
#undef PG8_LDF
#undef PG8_LDA
#undef PG8_LDB
#undef PG8_MMA
#undef PG8_WAIT_V
#undef PG8_WAIT_L
#undef PG8_BAR
#undef PG8_SCHED
}
}

typedef unsigned short bf16_t;
typedef short bf16x8 __attribute__((ext_vector_type(8)));
typedef short s16x4 __attribute__((ext_vector_type(4)));
typedef float f32x2 __attribute__((ext_vector_type(2)));
typedef float f32x4 __attribute__((ext_vector_type(4)));
typedef float f32x16 __attribute__((ext_vector_type(16)));
typedef unsigned u32x2 __attribute__((ext_vector_type(2)));
typedef unsigned u32x4 __attribute__((ext_vector_type(4)));
typedef __bf16 bf16v2 __attribute__((ext_vector_type(2)));

constexpr int NB = 4, SEQ = 4096, NT = NB * SEQ, DM = 2048;
constexpr int NPROJ = 7936;
constexpr int NCMP = 255;
constexpr float QSCALE = 0.125f * 1.4426950408889634f;
constexpr float LOG2E = 1.4426950408889634f;
constexpr float NEGBIG = -1e30f;
constexpr float OATT_SCALE = 64.f, Y2_SCALE = 16.f, MIX_SCALE = 64.f; constexpr int UA_LD = 2048;

constexpr size_t WS_BAR   = 0;
constexpr size_t WS_MOD   = 65536;
constexpr size_t WS_CB    = WS_MOD + 196608;
constexpr size_t WS_A16   = WS_CB + 2048;
constexpr size_t WS_W     = 327680;
constexpr size_t WS_WIN   = WS_W;
constexpr size_t WS_WGLU  = WS_WIN + (size_t)NPROJ * 2048 * 2;
constexpr size_t WS_WUA   = WS_WGLU + 2097152;
constexpr size_t WS_WUS   = WS_WUA + 4194304;
constexpr size_t WS_WOUT  = WS_WUS + 4194304;
constexpr size_t WS_WQ    = WS_WOUT + 8388608;
constexpr size_t WS_KBD   = WS_WQ + 8388608;
constexpr size_t WS_WSC   = WS_KBD + 8388608;
constexpr size_t WS_WC1   = WS_WSC + 8388608;
constexpr size_t WS_S5B1  = WS_WC1 + 2097152;
constexpr size_t WS_S5B2  = WS_S5B1 + 8388608;
constexpr size_t WS_HID   = WS_S5B2 + 12582912;
constexpr size_t WS_CKV   = WS_HID + 4194304;
constexpr size_t WS_GATE  = WS_CKV + 1048576;
constexpr size_t WS_SELM  = WS_GATE + 3145728;
constexpr size_t WS_RA    = WS_SELM + 524288;
constexpr size_t WS_RB    = WS_RA + 67108864;
constexpr size_t WS_RC    = WS_RB + 134217728;
constexpr size_t WS_RD    = WS_RC + 134217728;
constexpr size_t WS_END   = WS_RD + 134217728;
constexpr size_t WS_H = WS_RA, WS_HSC = WS_RD + 104857600  , WS_OC = WS_RA, WS_OW = WS_RA + 33554432, WS_MIX = WS_RA, WS_H2 = WS_RA;
constexpr size_t WS_MG = WS_RB, WS_SC = WS_RB;
constexpr size_t WS_Q = WS_RC, WS_KV = WS_RC + 33554432, WS_A2 = WS_KV + 6 * 8388608, WS_X1 = WS_RC, WS_H2I8 = WS_RC + 67108864  ;
constexpr size_t WS_XL = WS_RD, WS_YACT = WS_RD + 33554432, WS_OATT = WS_RD + 67108864  , WS_Y2 = WS_OATT + 1024, WS_TMP = WS_RD, WS_PU = WS_RD, WS_PV = WS_RD + 33554432, WS_PSU = WS_RD + 67108864, WS_PSV = WS_RD + 67108864 + 65536, WS_EX = WS_RD + 68157440, WS_GT = WS_EX + 8388608, WS_SS = WS_GT + 8388608, WS_SU = WS_SS + 1048576  , WS_W8 = WS_SU + 1048576  , WS_WT = WS_SU + 4194304  , WS_PA = WS_RB;

constexpr int LDS_BYTES = 147456;
constexpr int LDS_MISC = 131072;

struct Params {
    const float* x; const float* c; const float* ada_w; const float* ada_b; const float* norm_mix_g; const float* norm_ffn_g; const float* w_in;
    const float* cmp_pos; const float* cmp_w1; const float* cmp_b1; const float* cmp_w2; const float* cmp_b2; const float* rel_bias;
    const float* s5_lam_re; const float* s5_lam_im; const float* s5_log_step; const float* s5_b_re; const float* s5_b_im; const float* s5_c_re; const float* s5_c_im; const float* s5_d;
    const float* glu_w; const float* glu_b; const float* w_up_attn; const float* w_up_ssm; const float* w_out; const float* peer_w_q; const float* peer_sub_keys;
    const float* peer_u; const float* peer_v; const float* final_g;
    float* out; unsigned char* ws; int ph_lo, ph_hi;
};

#define DI __device__ __forceinline__
DI unsigned pk_bf16(float lo, float hi) { bf16v2 v; v[0] = (__bf16)lo; v[1] = (__bf16)hi; return __builtin_bit_cast(unsigned, v); }
DI bf16_t f2bf(float x) { return (bf16_t)(pk_bf16(x, 0.f) & 0xffffu); }
DI float bf_lo(unsigned u) { return __uint_as_float(u << 16); }
DI float bf_hi(unsigned u) { return __uint_as_float(u & 0xffff0000u); }
DI float bf2f(bf16_t b) { return __uint_as_float(((unsigned)b) << 16); }
DI bf16v2 bf16pair(unsigned w) { return __builtin_bit_cast(bf16v2, w); }
DI float dot2_bf16(unsigned w, unsigned x, float acc) { return __builtin_amdgcn_fdot2_f32_bf16(__builtin_bit_cast(bf16v2, w), __builtin_bit_cast(bf16v2, x), acc, false); }
DI float sigm(float x) { return __builtin_amdgcn_rcpf(1.f + __builtin_amdgcn_exp2f(-1.4426950408889634f * x)); }
DI float gelu_tanh(float x) { const float u = 1.5957691216f * (x + 0.044715f * x * x * x); return x * __builtin_amdgcn_rcpf(1.f + __builtin_amdgcn_exp2f(-1.4426950408889634f * u)); }
DI float xor32_add(float x) { const auto r = __builtin_amdgcn_permlane32_swap(__float_as_uint(x), __float_as_uint(x), false, false); return __uint_as_float(r[0]) + __uint_as_float(r[1]); }
DI float xor16_add(float x) { const auto r = __builtin_amdgcn_permlane16_swap(__float_as_uint(x), __float_as_uint(x), false, false); return __uint_as_float(r[0]) + __uint_as_float(r[1]); }
DI float xor32_max(float x) { const auto r = __builtin_amdgcn_permlane32_swap(__float_as_uint(x), __float_as_uint(x), false, false); return fmaxf(__uint_as_float(r[0]), __uint_as_float(r[1])); }
DI float row16_sum(float v) {
    asm volatile("s_nop 1\n\tv_add_f32_dpp %0, %0, %0 quad_perm:[1,0,3,2] row_mask:0xf bank_mask:0xf\n\ts_nop 1\n\tv_add_f32_dpp %0, %0, %0 quad_perm:[2,3,0,1] row_mask:0xf bank_mask:0xf\n\t"
                 "s_nop 1\n\tv_add_f32_dpp %0, %0, %0 row_half_mirror row_mask:0xf bank_mask:0xf\n\ts_nop 1\n\tv_add_f32_dpp %0, %0, %0 row_mirror row_mask:0xf bank_mask:0xf\n\ts_nop 1" : "+v"(v));
    return v; }
DI float wave_sum(float v) { return xor32_add(xor16_add(row16_sum(v))); }
DI float reduce8_row16(const float (&v)[8], int li) {
    const bool b3 = (li & 8) != 0, b2 = (li & 4) != 0, b1 = (li & 2) != 0; float t[4], u[2], w, z;
#pragma unroll
    for (int k = 0; k < 4; ++k) { const float keep = b3 ? v[4 + k] : v[k], send = b3 ? v[k] : v[4 + k];
        asm volatile("s_nop 1\n\tv_add_f32_dpp %0, %1, %2 row_mirror row_mask:0xf bank_mask:0xf" : "=v"(t[k]) : "v"(send), "v"(keep)); }
#pragma unroll
    for (int k = 0; k < 2; ++k) { const float keep = b2 ? t[2 + k] : t[k], send = b2 ? t[k] : t[2 + k];
        asm volatile("s_nop 1\n\tv_add_f32_dpp %0, %1, %2 row_half_mirror row_mask:0xf bank_mask:0xf" : "=v"(u[k]) : "v"(send), "v"(keep)); }
    { const float keep = b1 ? u[1] : u[0], send = b1 ? u[0] : u[1];
      asm volatile("s_nop 1\n\tv_add_f32_dpp %0, %1, %2 quad_perm:[3,2,1,0] row_mask:0xf bank_mask:0xf" : "=v"(w) : "v"(send), "v"(keep)); }
    asm volatile("s_nop 1\n\tv_add_f32_dpp %0, %1, %1 quad_perm:[1,0,3,2] row_mask:0xf bank_mask:0xf" : "=v"(z) : "v"(w));
    return z; }
DI unsigned row16_max_u32(unsigned v) {
    asm volatile("s_nop 1\n\tv_max_u32_dpp %0, %0, %0 quad_perm:[1,0,3,2] row_mask:0xf bank_mask:0xf\n\ts_nop 1\n\tv_max_u32_dpp %0, %0, %0 quad_perm:[2,3,0,1] row_mask:0xf bank_mask:0xf\n\t"
                 "s_nop 1\n\tv_max_u32_dpp %0, %0, %0 row_half_mirror row_mask:0xf bank_mask:0xf\n\ts_nop 1\n\tv_max_u32_dpp %0, %0, %0 row_mirror row_mask:0xf bank_mask:0xf\n\ts_nop 1" : "+v"(v));
    return v; }
DI unsigned wave_max_u32(unsigned v) {
    v = row16_max_u32(v);
    { const auto r = __builtin_amdgcn_permlane16_swap(v, v, false, false); v = max(r[0], r[1]); }
    { const auto r = __builtin_amdgcn_permlane32_swap(v, v, false, false); v = max(r[0], r[1]); }
    return (unsigned)__builtin_amdgcn_readfirstlane((int)v); }
DI unsigned mono_u32(float x) { const unsigned b = __float_as_uint(x); return b ^ (((int)b >> 31) | 0x80000000u); }
DI void store8_bf16(bf16_t* p, f32x4 a, f32x4 b) { u32x4 w; w[0] = pk_bf16(a[0], a[1]); w[1] = pk_bf16(a[2], a[3]); w[2] = pk_bf16(b[0], b[1]); w[3] = pk_bf16(b[2], b[3]); *(u32x4*)p = w; }
DI float clamp448(float x) { return __builtin_amdgcn_fmed3f(x, -448.f, 448.f); }
DI void store8_fp8(unsigned char* p, f32x4 a, f32x4 b, float sc) {
    int p0 = __builtin_amdgcn_cvt_pk_fp8_f32(clamp448(a[0] * sc), clamp448(a[1] * sc), 0, false); p0 = __builtin_amdgcn_cvt_pk_fp8_f32(clamp448(a[2] * sc), clamp448(a[3] * sc), p0, true);
    int p1 = __builtin_amdgcn_cvt_pk_fp8_f32(clamp448(b[0] * sc), clamp448(b[1] * sc), 0, false); p1 = __builtin_amdgcn_cvt_pk_fp8_f32(clamp448(b[2] * sc), clamp448(b[3] * sc), p1, true);
    u32x2 w; w[0] = (unsigned)p0; w[1] = (unsigned)p1; *(u32x2*)p = w; }
DI void load8_bf16(const bf16_t* p, f32x4& a, f32x4& b) { const u32x4 w = *(const u32x4*)p; a = (f32x4){bf_lo(w[0]), bf_hi(w[0]), bf_lo(w[1]), bf_hi(w[1])}; b = (f32x4){bf_lo(w[2]), bf_hi(w[2]), bf_lo(w[3]), bf_hi(w[3])}; }

#define EPI_ROWS(ai, m) for (int ai = 0; ai < 2; ++ai) for (int m = 0; m < 4; ++m)
struct EpiProj {
    static constexpr bool PERM = true, AFTER_DRAIN = false; static constexpr int MIDK = 0;
    unsigned char* ws; const float* hsc;
    DI void operator()(const f32x4 (&acc)[2][2][4][2], const pg8::Unit& u, int wr, int wc, int fr, int fq) const {
        const int pn = u.pn;
#pragma unroll
        for (int ai = 0; ai < 2; ++ai)
#pragma unroll
            for (int m = 0; m < 4; ++m) {
                const int row = u.pm * 256 + ai * 128 + wr * 64 + m * 16 + fr;
                const int b = row >> 12, t = row & 4095; const float rsc = hsc[row] * (1.f / 2048.f);
#pragma unroll
                for (int bj = 0; bj < 2; ++bj) {
                    const int c8 = bj * 128 + wc * 32 + fq * 8;
                    f32x4 v0 = acc[ai][bj][m][0] * rsc, v1 = acc[ai][bj][m][1] * rsc;
                    if (pn < 4) {
                        store8_bf16((bf16_t*)(ws + WS_Q) + (size_t)row * 1024 + pn * 256 + c8, v0 * QSCALE, v1 * QSCALE);
                    } else if (pn < 10) {
                        const int k = c8 >> 6, dd = c8 & 63;
                        store8_bf16((bf16_t*)(ws + WS_KV) + (size_t)(pn - 4) * 4194304 + ((size_t)((b * 4 + k) * 4096 + t)) * 64 + dd, v0, v1);
                    } else if (pn < 14) {
                        const int cu = (pn - 10) * 256 + c8, g = cu >> 4, h0 = cu & 15;
                        store8_bf16((bf16_t*)(ws + WS_A2) + ((size_t)(g * 1024 + b * 256 + (t >> 4))) * 384 + (t & 15) * 16 + h0, v0, v1);
                    } else if (pn < 30) {
                        unsigned w0 = 0u, w1 = 0u;
#pragma unroll
                        for (int e = 0; e < 4; ++e) { w0 = __builtin_amdgcn_cvt_pk_u8_f32(__builtin_rintf(sigm(v0[e]) * 255.f), e, w0); w1 = __builtin_amdgcn_cvt_pk_u8_f32(__builtin_rintf(sigm(v1[e]) * 255.f), e, w1); }
                        u32x2 w; w[0] = w0; w[1] = w1; *(u32x2*)(ws + WS_MG + (size_t)row * 4096 + (pn - 14) * 256 + c8) = w;
                    } else {
                        if (c8 < 48) { float* gp = (float*)(ws + WS_GATE) + (size_t)row * 48 + c8; f32x4 s0, s1;
#pragma unroll
                            for (int e = 0; e < 4; ++e) { s0[e] = sigm(v0[e]); s1[e] = sigm(v1[e]); }
                            *(f32x4*)gp = s0; *(f32x4*)(gp + 4) = s1; }
                    }
                }
            }
    }
};
struct EpiBf16Plain {
    static constexpr bool PERM = true, AFTER_DRAIN = false; static constexpr int MIDK = 0;
    bf16_t* O; int ldc;
    DI void operator()(const f32x4 (&acc)[2][2][4][2], const pg8::Unit& u, int wr, int wc, int fr, int fq) const {
#pragma unroll
        for (int ai = 0; ai < 2; ++ai)
#pragma unroll
            for (int m = 0; m < 4; ++m) { const int row = u.pm * 256 + ai * 128 + wr * 64 + m * 16 + fr;
#pragma unroll
                for (int bj = 0; bj < 2; ++bj) { const int col = u.pn * 256 + bj * 128 + wc * 32 + fq * 8; store8_bf16(O + (size_t)row * ldc + col, acc[ai][bj][m][0], acc[ai][bj][m][1]); } }
    }
};
struct EpiCmp1 {
    static constexpr bool PERM = true, AFTER_DRAIN = false; static constexpr int MIDK = 0;
    bf16_t* O; const float* bias;
    DI void operator()(const f32x4 (&acc)[2][2][4][2], const pg8::Unit& u, int wr, int wc, int fr, int fq) const {
        const float* bi = bias + (u.pm >> 4) * 256;
#pragma unroll
        for (int ai = 0; ai < 2; ++ai)
#pragma unroll
            for (int m = 0; m < 4; ++m) { const int row = u.pm * 256 + ai * 128 + wr * 64 + m * 16 + fr;
#pragma unroll
                for (int bj = 0; bj < 2; ++bj) { const int col = bj * 128 + wc * 32 + fq * 8; f32x4 v0 = acc[ai][bj][m][0] + *(const f32x4*)(bi + col), v1 = acc[ai][bj][m][1] + *(const f32x4*)(bi + col + 4);
#pragma unroll
                    for (int e = 0; e < 4; ++e) { v0[e] = gelu_tanh(v0[e]); v1[e] = gelu_tanh(v1[e]); }
                    store8_bf16(O + (size_t)row * 256 + col, v0, v1); } }
    }
};
struct EpiS5G1 {
    static constexpr bool PERM = false, AFTER_DRAIN = false; static constexpr int MIDK = 0;
    float* X;
    DI void operator()(const f32x4 (&acc)[2][2][4][2], const pg8::Unit& u, int wr, int wc, int fr, int fq) const {
#pragma unroll
        for (int ai = 0; ai < 2; ++ai)
#pragma unroll
            for (int m = 0; m < 4; ++m) { const int row = u.pm * 256 + ai * 128 + wr * 64 + m * 16 + fr;
#pragma unroll
                for (int n = 0; n < 2; ++n) { const int col = wc * 32 + n * 16 + fq * 4; *(f32x4*)(X + (size_t)row * 128 + col) = acc[ai][0][m][n]; } }
    }
};
struct EpiS5G2 {
    static constexpr bool PERM = true, AFTER_DRAIN = false; static constexpr int MIDK = 0;
    bf16_t* Y;
    DI void operator()(const f32x4 (&acc)[2][2][4][2], const pg8::Unit& u, int wr, int wc, int fr, int fq) const {
        const int g = u.pm >> 2;
#pragma unroll
        for (int ai = 0; ai < 2; ++ai)
#pragma unroll
            for (int m = 0; m < 4; ++m) { const int rg = (u.pm & 3) * 256 + ai * 128 + wr * 64 + m * 16 + fr;
                const int b = rg >> 8, ch = rg & 255;
#pragma unroll
                for (int bj = 0; bj < 2; ++bj) { const int c8 = bj * 128 + wc * 32 + fq * 8, tau = c8 >> 4, h0 = c8 & 15; f32x4 v0 = acc[ai][bj][m][0], v1 = acc[ai][bj][m][1];
#pragma unroll
                    for (int e = 0; e < 4; ++e) { v0[e] = gelu_tanh(v0[e]); v1[e] = gelu_tanh(v1[e]); }
                    store8_bf16(Y + ((size_t)(b * 4096 + ch * 16 + tau)) * 1024 + g * 16 + h0, v0, v1); } }
    }
};
struct EpiGlu {
    static constexpr bool PERM = true, AFTER_DRAIN = false; static constexpr int MIDK = 0;
    const bf16_t* Y; bf16_t* O; const float* bias;
    DI void operator()(const f32x4 (&acc)[2][2][4][2], const pg8::Unit& u, int wr, int wc, int fr, int fq) const {
#pragma unroll
        for (int bj = 0; bj < 2; ++bj) { const int col = u.pn * 256 + bj * 128 + wc * 32 + fq * 8; const f32x4 b0 = *(const f32x4*)(bias + col), b1 = *(const f32x4*)(bias + col + 4);
            u32x4 yv[8];
#pragma unroll
            for (int q = 0; q < 8; ++q) { const int row = u.pm * 256 + (q >> 2) * 128 + wr * 64 + (q & 3) * 16 + fr; yv[q] = *(const u32x4*)(Y + (size_t)row * 1024 + col); }
#pragma unroll
            for (int q = 0; q < 8; ++q) { const int ai = q >> 2, m = q & 3, row = u.pm * 256 + ai * 128 + wr * 64 + m * 16 + fr;
                const f32x4 y0 = (f32x4){bf_lo(yv[q][0]), bf_hi(yv[q][0]), bf_lo(yv[q][1]), bf_hi(yv[q][1])}, y1 = (f32x4){bf_lo(yv[q][2]), bf_hi(yv[q][2]), bf_lo(yv[q][3]), bf_hi(yv[q][3])};
                f32x4 v0 = acc[ai][bj][m][0] + b0, v1 = acc[ai][bj][m][1] + b1;
#pragma unroll
                for (int e = 0; e < 4; ++e) { v0[e] = y0[e] * sigm(v0[e]); v1[e] = y1[e] * sigm(v1[e]); }
                store8_fp8((unsigned char*)O + (size_t)row * UA_LD + col, v0, v1, Y2_SCALE); } }
    }
};
DI f32x4 u8x4_f32(unsigned w) { return (f32x4){(float)(w & 0xFFu), (float)((w >> 8) & 0xFFu), (float)((w >> 16) & 0xFFu), (float)(w >> 24)}; }
struct EpiUpF {
    static constexpr bool PERM = true, AFTER_DRAIN = false; static constexpr int MIDK = 8;
    const unsigned char* MG; unsigned char* O;
    DI void mid(f32x4 (&acc)[2][2][4][2], const pg8::Unit& u, int wr, int wc, int fr, int fq) const {
#pragma unroll
        for (int bj = 0; bj < 2; ++bj) { const int col = u.pn * 256 + bj * 128 + wc * 32 + fq * 8;
            u32x2 ga[8], gb[8];
#pragma unroll
            for (int q = 0; q < 8; ++q) { const int row = u.pm * 256 + (q >> 2) * 128 + wr * 64 + (q & 3) * 16 + fr; ga[q] = *(const u32x2*)(MG + (size_t)row * 4096 + col); gb[q] = *(const u32x2*)(MG + (size_t)row * 4096 + 2048 + col); }
#pragma unroll
            for (int q = 0; q < 8; ++q) { const int ai = q >> 2, m = q & 3;
#pragma unroll
                for (int h = 0; h < 2; ++h) { const f32x4 a = u8x4_f32(ga[q][h]), b = u8x4_f32(gb[q][h]); f32x4 r;
#pragma unroll
                    for (int e = 0; e < 4; ++e) r[e] = a[e] * __builtin_amdgcn_rcpf(fmaxf(b[e], 1e-30f));
                    acc[ai][bj][m][h] = acc[ai][bj][m][h] * (r * (Y2_SCALE / OATT_SCALE)); } } }
    }
    DI void operator()(const f32x4 (&acc)[2][2][4][2], const pg8::Unit& u, int wr, int wc, int fr, int fq) const {
#pragma unroll
        for (int bj = 0; bj < 2; ++bj) { const int col = u.pn * 256 + bj * 128 + wc * 32 + fq * 8;
            u32x2 gv[8];
#pragma unroll
            for (int q = 0; q < 8; ++q) { const int row = u.pm * 256 + (q >> 2) * 128 + wr * 64 + (q & 3) * 16 + fr; gv[q] = *(const u32x2*)(MG + (size_t)row * 4096 + 2048 + col); }
#pragma unroll
            for (int q = 0; q < 8; ++q) { const int ai = q >> 2, m = q & 3, row = u.pm * 256 + ai * 128 + wr * 64 + m * 16 + fr;
                f32x4 g0 = u8x4_f32(gv[q][0]), g1 = u8x4_f32(gv[q][1]);
#pragma unroll
                for (int e = 0; e < 4; ++e) { g0[e] = fmaxf(g0[e], 1e-30f); g1[e] = fmaxf(g1[e], 1e-30f); }
                const f32x4 v0 = acc[ai][bj][m][0] * (g0 * (1.f / (255.f * Y2_SCALE * 1024.f))), v1 = acc[ai][bj][m][1] * (g1 * (1.f / (255.f * Y2_SCALE * 1024.f)));
                store8_fp8(O + (size_t)row * 2048 + col, v0, v1, MIX_SCALE); } }
    }
};
struct EpiOut {
    static constexpr bool PERM = true, AFTER_DRAIN = false; static constexpr int MIDK = 0;
    const float* X; const float* mod; bf16_t* O;
    DI void operator()(const f32x4 (&acc)[2][2][4][2], const pg8::Unit& u, int wr, int wc, int fr, int fq) const {
        const float* g1 = mod + ((u.pm * 256) >> 12) * 12288 + 4096;
#pragma unroll
        for (int bj = 0; bj < 2; ++bj) { const int col = u.pn * 256 + bj * 128 + wc * 32 + fq * 8;
            const f32x4 g0 = *(const f32x4*)(g1 + col) * (1.f / (MIX_SCALE * 2048.f)), g4 = *(const f32x4*)(g1 + col + 4) * (1.f / (MIX_SCALE * 2048.f));
#pragma unroll
            for (int ai = 0; ai < 2; ++ai) { f32x4 xv[4][2];
#pragma unroll
                for (int m = 0; m < 4; ++m) { const int row = u.pm * 256 + ai * 128 + wr * 64 + m * 16 + fr; xv[m][0] = *(const f32x4*)(X + (size_t)row * 2048 + col); xv[m][1] = *(const f32x4*)(X + (size_t)row * 2048 + col + 4); }
#pragma unroll
                for (int m = 0; m < 4; ++m) { const int row = u.pm * 256 + ai * 128 + wr * 64 + m * 16 + fr;
                    const f32x4 a = xv[m][0] + g0 * acc[ai][bj][m][0], b = xv[m][1] + g4 * acc[ai][bj][m][1];
                    u32x4 w; w[0] = pk_bf16(a[0], a[1]); w[1] = pk_bf16(a[2], a[3]); w[2] = pk_bf16(b[0], b[1]); w[3] = pk_bf16(b[2], b[3]);
                    *(u32x4*)(O + (size_t)row * 2048 + col) = w; } } }
    }
};
struct EpiF32Plain {
    static constexpr bool PERM = true, AFTER_DRAIN = false; static constexpr int MIDK = 0;
    float* C; int ldc;
    DI void operator()(const f32x4 (&acc)[2][2][4][2], const pg8::Unit& u, int wr, int wc, int fr, int fq) const {
#pragma unroll
        for (int ai = 0; ai < 2; ++ai)
#pragma unroll
            for (int m = 0; m < 4; ++m) { const int row = u.pm * 256 + ai * 128 + wr * 64 + m * 16 + fr;
#pragma unroll
                for (int bj = 0; bj < 2; ++bj) { const int col = u.pn * 256 + bj * 128 + wc * 32 + fq * 8; *(f32x4*)(C + (size_t)row * ldc + col) = acc[ai][bj][m][0]; *(f32x4*)(C + (size_t)row * ldc + col + 4) = acc[ai][bj][m][1]; } }
    }
};
DI unsigned pk_f16(float lo, float hi) { typedef _Float16 f16v2 __attribute__((ext_vector_type(2))); f16v2 v; v[0] = (_Float16)lo; v[1] = (_Float16)hi; return __builtin_bit_cast(unsigned, v); }
struct EpiF16Plain {
    static constexpr bool PERM = true, AFTER_DRAIN = false; static constexpr int MIDK = 0;
    unsigned short* C; int ldc;
    DI void operator()(const f32x4 (&acc)[2][2][4][2], const pg8::Unit& u, int wr, int wc, int fr, int fq) const {
#pragma unroll
        for (int ai = 0; ai < 2; ++ai)
#pragma unroll
            for (int m = 0; m < 4; ++m) { const int row = u.pm * 256 + ai * 128 + wr * 64 + m * 16 + fr;
#pragma unroll
                for (int bj = 0; bj < 2; ++bj) { const int col = u.pn * 256 + bj * 128 + wc * 32 + fq * 8; const f32x4 a = acc[ai][bj][m][0], b = acc[ai][bj][m][1];
                    u32x4 w; w[0] = pk_f16(a[0], a[1]); w[1] = pk_f16(a[2], a[3]); w[2] = pk_f16(b[0], b[1]); w[3] = pk_f16(b[2], b[3]);
                    *(u32x4*)(C + (size_t)row * ldc + col) = w; } }
    }
};
struct GroupOrder {
    int n, G, c, div;
    DI bool next(int i, pg8::Unit& u) const { const int L = i * G + c; if (L >= n) return false; u.pm = L; u.pn = L / div; return true; }
    DI void a_ready(const pg8::Unit&) const {}
    DI void done(const pg8::Unit&) const {}
};

template <int MODE> DI int src_col(int n) {
    if (MODE == 0) return n;
    if (n < 2560) return n; if (n < 7680) return n + 48; if (n < 7728) return n - 7680 + 2560; return -1; }
template <int MODE, bool F8OUT = false> DI void tconv_tiles(const float* __restrict__ src, int ld, int K, int Nd, bf16_t* __restrict__ dst, LAS float* tile, int& off, int bx, int G, float f8scale = 1.f, int ldd = 0) {
    const int tid = threadIdx.x, ntk = K >> 6, ntot = ntk * (Nd >> 8), LD = ldd ? ldd : K;
    const int first = (bx + G - (off % G)) % G; off += ntot;
    for (int it = first; it < ntot; it += G) {
        const int n0 = (it / ntk) << 8, k0 = (it % ntk) << 6;
        __syncthreads();
        { const int j = tid & 63, i0 = tid >> 6; float w[4][8];
#pragma unroll
          for (int c = 0; c < 4; ++c) { const int sc = src_col<MODE>(n0 + 64 * c + j);
#pragma unroll
              for (int rr = 0; rr < 8; ++rr) w[c][rr] = sc >= 0 ? src[(size_t)(k0 + i0 + 8 * rr) * ld + sc] : 0.f; }
#pragma unroll
          for (int c = 0; c < 4; ++c)
#pragma unroll
              for (int rr = 0; rr < 8; ++rr) tile[c * 4160 + (i0 + 8 * rr) * 65 + j] = w[c][rr]; }
        __syncthreads();
#pragma unroll
        for (int c = 0; c < 4; ++c) { const int jj = tid >> 3, ii0 = (tid & 7) * 8; float v[8];
#pragma unroll
          for (int e = 0; e < 8; ++e) v[e] = tile[c * 4160 + (ii0 + e) * 65 + jj];
          if constexpr (F8OUT) { int p0 = __builtin_amdgcn_cvt_pk_fp8_f32(clamp448(v[0] * f8scale), clamp448(v[1] * f8scale), 0, false); p0 = __builtin_amdgcn_cvt_pk_fp8_f32(clamp448(v[2] * f8scale), clamp448(v[3] * f8scale), p0, true);
              int p1 = __builtin_amdgcn_cvt_pk_fp8_f32(clamp448(v[4] * f8scale), clamp448(v[5] * f8scale), 0, false); p1 = __builtin_amdgcn_cvt_pk_fp8_f32(clamp448(v[6] * f8scale), clamp448(v[7] * f8scale), p1, true);
              u32x2 w; w[0] = (unsigned)p0; w[1] = (unsigned)p1; *(u32x2*)((unsigned char*)dst + (size_t)(n0 + 64 * c + jj) * LD + k0 + ii0) = w; }
          else { u32x4 w; w[0] = pk_bf16(v[0], v[1]); w[1] = pk_bf16(v[2], v[3]); w[2] = pk_bf16(v[4], v[5]); w[3] = pk_bf16(v[6], v[7]);
              *(u32x4*)(dst + (size_t)(n0 + 64 * c + jj) * LD + k0 + ii0) = w; } }
    }
}
DI void conv_bf16_flat(const float* __restrict__ src, bf16_t* __restrict__ dst, size_t n8  , size_t first, size_t stride) {
    for (size_t i = first; i < n8; i += stride) { const f32x4 a = *(const f32x4*)(src + i * 8), b = *(const f32x4*)(src + i * 8 + 4); store8_bf16(dst + i * 8, a, b); }
}

DI void conv_rows_fp8(const float* __restrict__ src, unsigned char* __restrict__ dst, float* __restrict__ inv_scale, int nrows) {
    const int lane = threadIdx.x & 63, wave = __builtin_amdgcn_readfirstlane(threadIdx.x >> 6);
    for (int row = blockIdx.x * 8 + wave; row < nrows; row += gridDim.x * 8) {
        const float* sr = src + (size_t)row * 2048; f32x4 v[8]; float am = 0.f;
#pragma unroll
        for (int k = 0; k < 8; ++k) { v[k] = *(const f32x4*)(sr + k * 256 + lane * 4); am = fmaxf(am, fmaxf(fmaxf(fabsf(v[k][0]), fabsf(v[k][1])), fmaxf(fabsf(v[k][2]), fabsf(v[k][3])))); }
#pragma unroll
        for (int o = 32; o >= 1; o >>= 1) am = fmaxf(am, __shfl_xor(am, o));
        const float sc = am > 0.f ? 448.f / am : 1.f;
#pragma unroll
        for (int k = 0; k < 8; ++k) { int p = __builtin_amdgcn_cvt_pk_fp8_f32(v[k][0] * sc, v[k][1] * sc, 0, false); p = __builtin_amdgcn_cvt_pk_fp8_f32(v[k][2] * sc, v[k][3] * sc, p, true);
            *(unsigned*)(dst + (size_t)k * 4194304 + (size_t)row * 256 + lane * 4) = (unsigned)p; }
        if (lane == 0) inv_scale[row] = am > 0.f ? am / 448.f : 1.f;
    }
}

DI void p0_prologue(const Params& P, LAS unsigned char* lds) {
    unsigned char* ws = P.ws; const int tid = threadIdx.x, G = gridDim.x, bx = blockIdx.x;
    LAS float* fl = (LAS float*)lds;
    {
        LAS float* sc = fl;
        LAS float* red = fl + 8192;
        for (int i = tid; i < 8192; i += 512) { const float v = P.c[i]; sc[i] = v / (1.f + __expf(-v)); }
        __syncthreads();
        for (int it = bx; it < 192 + 8; it += G) {
            const bool is_cb = it >= 192;
            const int col = tid & 63, kg = tid >> 6;
            float a0 = 0.f, a1 = 0.f, a2 = 0.f, a3 = 0.f;
            if (!is_cb) {
                const float* wp = P.ada_w + (size_t)(kg * 256) * 12288 + it * 64 + col;
                for (int j0 = 0; j0 < 256; j0 += 32) { float w[32];
#pragma unroll
                    for (int j = 0; j < 32; ++j) w[j] = wp[(size_t)(j0 + j) * 12288];
#pragma unroll
                    for (int j = 0; j < 32; ++j) { const int jj = kg * 256 + j0 + j; a0 += sc[jj] * w[j]; a1 += sc[2048 + jj] * w[j]; a2 += sc[4096 + jj] * w[j]; a3 += sc[6144 + jj] * w[j]; } }
            } else {
                const int i = (it - 192) >> 2, c0 = ((it - 192) & 3) * 64;
                const float* wp = P.cmp_w1 + (size_t)i * 2048 * 256 + (size_t)(kg * 256) * 256 + c0 + col; const float* pp = P.cmp_pos + i * 2048 + kg * 256;
                for (int j0 = 0; j0 < 256; j0 += 32) { float w[32];
#pragma unroll
                    for (int j = 0; j < 32; ++j) w[j] = wp[(size_t)(j0 + j) * 256];
#pragma unroll
                    for (int j = 0; j < 32; ++j) a0 += pp[j0 + j] * w[j]; }
            }
            red[(kg * 4 + 0) * 64 + col] = a0; red[(kg * 4 + 1) * 64 + col] = a1; red[(kg * 4 + 2) * 64 + col] = a2; red[(kg * 4 + 3) * 64 + col] = a3;
            __syncthreads();
            if (tid < 256) { const int b = tid >> 6, cc = tid & 63; float s = 0.f;
#pragma unroll
                for (int q = 0; q < 8; ++q) s += red[(q * 4 + b) * 64 + cc];
                if (!is_cb) ((float*)(ws + WS_MOD))[b * 12288 + it * 64 + cc] = s + P.ada_b[it * 64 + cc];
                else if (b == 0) { const int i = (it - 192) >> 2, c0 = ((it - 192) & 3) * 64; ((float*)(ws + WS_CB))[i * 256 + c0 + cc] = s + P.cmp_b1[i * 256 + c0 + cc]; } }
            __syncthreads();
        }
    }
    for (int g4 = bx; g4 < 256; g4 += G) {
        const int g = g4 >> 2, part = g4 & 3;
        LAS double* pw = (LAS double*)lds;
        LAS double* ff = pw + 17 * 64 * 2;
        LAS double* bb = ff + 128;
        LAS float* cc = (LAS float*)(bb + 2048);
        LAS float* kern = cc + 2048;
        __syncthreads();
        const double step = exp((double)P.s5_log_step[g]);
        for (int i = tid; i < 17 * 64; i += 512) { const int p = i & 63, dl = i >> 6; const double lr = P.s5_lam_re[g * 64 + p], li = P.s5_lam_im[g * 64 + p];
            const double mag = exp(dl * lr * step), ang = dl * li * step; const double cr = mag * cos(ang), ci = mag * sin(ang);
            pw[i * 2] = cr; pw[i * 2 + 1] = ci;
            if (dl == 1) { const double nr = cr - 1.0, den = lr * lr + li * li; ff[p * 2] = (nr * lr + ci * li) / den; ff[p * 2 + 1] = (ci * lr - nr * li) / den; }
            if (dl == 16 && part == 0) { float* a16 = (float*)(ws + WS_A16) + (g * 64 + p) * 2; a16[0] = (float)cr; a16[1] = (float)ci; } }
        for (int i = tid; i < 1024; i += 512) { const int h = i >> 6, p = i & 63; cc[i * 2] = P.s5_c_re[(g * 16 + h) * 64 + p]; cc[i * 2 + 1] = P.s5_c_im[(g * 16 + h) * 64 + p]; }
        __syncthreads();
        for (int i = tid; i < 1024; i += 512) { const int p = i >> 4; const double br = P.s5_b_re[g * 1024 + i], bi = P.s5_b_im[g * 1024 + i], fr = ff[p * 2], fi = ff[p * 2 + 1];
            bb[i * 2] = fr * br - fi * bi; bb[i * 2 + 1] = fr * bi + fi * br; }
        __syncthreads();
        for (int o1 = tid; o1 < 1024; o1 += 512) {
            const int dl = o1 >> 6, h = 4 * part + ((o1 >> 4) & 3), h2 = o1 & 15, o = (dl * 16 + h) * 16 + h2; double s = 0.0;
            for (int p = 0; p < 64; ++p) { const double cr = cc[(h * 64 + p) * 2], ci = cc[(h * 64 + p) * 2 + 1], ar = pw[(dl * 64 + p) * 2], ai = pw[(dl * 64 + p) * 2 + 1];
                const double zr = cr * ar - ci * ai, zi = cr * ai + ci * ar; s += zr * bb[(p * 16 + h2) * 2] - zi * bb[(p * 16 + h2) * 2 + 1]; }
            kern[o] = (float)s; }
        __syncthreads();
        bf16_t* B2 = (bf16_t*)(ws + WS_S5B2) + (size_t)g * 256 * 384;
        for (int i = tid; i < 64 * 384 / 2; i += 512) {
            const int rr = i / 192, c0 = (i % 192) * 2, tau = rr >> 2, h = 4 * part + (rr & 3), row = tau * 16 + h; float v[2];
#pragma unroll
            for (int e = 0; e < 2; ++e) { const int col = c0 + e; float x;
                if (col < 256) { const int s = col >> 4, h2 = col & 15; x = (s <= tau) ? kern[((tau - s) * 16 + h) * 16 + h2] : 0.f; if (s == tau && h2 == h) x += P.s5_d[g * 16 + h]; }
                else { const int p = (col - 256) & 63; const double cr = cc[(h * 64 + p) * 2], ci = cc[(h * 64 + p) * 2 + 1], ar = pw[((tau + 1) * 64 + p) * 2], ai = pw[((tau + 1) * 64 + p) * 2 + 1];
                    x = (col < 320) ? (float)(cr * ar - ci * ai) : (float)(-(cr * ai + ci * ar)); }
                v[e] = x; }
            *(unsigned*)(B2 + (size_t)row * 384 + c0) = pk_bf16(v[0], v[1]); }
        bf16_t* B1 = (bf16_t*)(ws + WS_S5B1) + (size_t)g * 256 * 256;
        for (int i = tid; i < 64 * 256 / 2; i += 512) {
            const int n = 64 * part + (i >> 7), c0 = (i & 127) * 2; float v[2];
#pragma unroll
            for (int e = 0; e < 2; ++e) { const int col = c0 + e, s = col >> 4, h = col & 15; float x = 0.f;
                if (n < 128) { const int p = n & 63; const double ar = pw[((15 - s) * 64 + p) * 2], ai = pw[((15 - s) * 64 + p) * 2 + 1], br = bb[(p * 16 + h) * 2], bi = bb[(p * 16 + h) * 2 + 1];
                    x = (n < 64) ? (float)(ar * br - ai * bi) : (float)(ar * bi + ai * br); }
                v[e] = x; }
            *(unsigned*)(B1 + (size_t)n * 256 + c0) = pk_bf16(v[0], v[1]); }
    }
    __syncthreads();
    LAS float* tile = fl;
    int toff = 0;
    tconv_tiles<1, true>(P.w_in, 7728, 2048, NPROJ, (bf16_t*)(ws + WS_WIN), tile, toff, bx, G, 2048.f);
    tconv_tiles<0>(P.glu_w, 1024, 1024, 1024, (bf16_t*)(ws + WS_WGLU), tile, toff, bx, G);
    tconv_tiles<0, true>(P.w_up_attn, 2048, 1024, 2048, (bf16_t*)(ws + WS_WUA), tile, toff, bx, G, 1024.f, 2048);
    tconv_tiles<0, true>(P.w_up_ssm, 2048, 1024, 2048, (bf16_t*)(ws + WS_WUA + 1024), tile, toff, bx, G, 1024.f, 2048);
    tconv_tiles<0, true>(P.w_out, 2048, 2048, 2048, (bf16_t*)(ws + WS_WOUT), tile, toff, bx, G, 2048.f);
    tconv_tiles<0>(P.cmp_w1, 256, 2048, 256, (bf16_t*)(ws + WS_WC1), tile, toff, bx, G);
    tconv_tiles<0>(P.cmp_w1 + 2048 * 256, 256, 2048, 256, (bf16_t*)(ws + WS_WC1) + 256 * 2048, tile, toff, bx, G);
    __syncthreads();
    const size_t gt = (size_t)bx * 512 + tid, gs = (size_t)G * 512;
    conv_bf16_flat(P.peer_w_q, (bf16_t*)(ws + WS_WQ), (size_t)2048 * 2048 / 8, gt, gs);
    { bf16_t* kb = (bf16_t*)(ws + WS_KBD);
      for (size_t i = gt; i < (size_t)2048 * 2048 / 8; i += gs) { const int row = (int)(i >> 8), k0 = (int)(i & 255) * 8, hc = row >> 7, n = row & 127;
          if ((k0 >> 7) == hc) { const float* s = P.peer_sub_keys + ((size_t)(hc * 128 + n)) * 128 + (k0 & 127); store8_bf16(kb + i * 8, *(const f32x4*)s, *(const f32x4*)(s + 4)); }
          else *(u32x4*)(kb + i * 8) = (u32x4){0u, 0u, 0u, 0u}; } }
}

DI void phase_norm(const bf16_t* __restrict__ X, const float* __restrict__ gain, const float* __restrict__ mod, int sh_off, int sc_off, bf16_t* __restrict__ H, unsigned char* __restrict__ H8, float* __restrict__ HS) {
    const int lane = threadIdx.x & 63, wave = __builtin_amdgcn_readfirstlane(threadIdx.x >> 6);
    for (int row = blockIdx.x * 8 + wave; row < NT; row += gridDim.x * 8) {
        const bf16_t* xr = X + (size_t)row * 2048; f32x4 v[8]; float ss = 0.f;
#pragma unroll
        for (int k = 0; k < 8; ++k) { const u32x2 xw = *(const u32x2*)(xr + k * 256 + lane * 4); v[k][0] = bf_lo(xw[0]); v[k][1] = bf_hi(xw[0]); v[k][2] = bf_lo(xw[1]); v[k][3] = bf_hi(xw[1]);
            ss += v[k][0] * v[k][0] + v[k][1] * v[k][1] + v[k][2] * v[k][2] + v[k][3] * v[k][3]; }
        ss = wave_sum(ss); const float rs = rsqrtf(ss * (1.f / 2048.f) + 1e-6f);
        const float* mb = mod + (row >> 12) * 12288;
#pragma unroll
        for (int k = 0; k < 8; ++k) { const int d = k * 256 + lane * 4; const f32x4 g = *(const f32x4*)(gain + d), sc = *(const f32x4*)(mb + sc_off + d), sh = *(const f32x4*)(mb + sh_off + d);
            f32x4 o; float am = 0.f;
#pragma unroll
            for (int e = 0; e < 4; ++e) { o[e] = v[k][e] * rs * g[e] * (1.f + sc[e]) + sh[e]; am = fmaxf(am, fabsf(o[e])); }
            u32x2 w; w[0] = pk_bf16(o[0], o[1]); w[1] = pk_bf16(o[2], o[3]); *(u32x2*)(H + (size_t)row * 2048 + d) = w;
            am = __uint_as_float(wave_max_u32(__float_as_uint(am)));
            const float q = am > 0.f ? 127.f / am : 1.f; unsigned pk = 0u;
#pragma unroll
            for (int e = 0; e < 4; ++e) pk = __builtin_amdgcn_cvt_pk_u8_f32(__builtin_rintf(o[e] * q) + 128.f, e, pk);
            *(unsigned*)(H8 + (size_t)row * 2048 + d) = pk ^ 0x80808080u;
            if (lane == 0) HS[(size_t)row * 8 + k] = am > 0.f ? am * (1.f / 127.f) : 1.f; }
    }
}

DI void phase_norm_f8(const float* __restrict__ X, const float* __restrict__ gain, const float* __restrict__ mod, int sh_off, int sc_off, unsigned char* __restrict__ H8, float* __restrict__ hsc) {
    const int lane = threadIdx.x & 63, wave = __builtin_amdgcn_readfirstlane(threadIdx.x >> 6);
    for (int row = blockIdx.x * 8 + wave; row < NT; row += gridDim.x * 8) {
        const float* xr = X + (size_t)row * 2048; f32x4 v[8]; float ss = 0.f;
#pragma unroll
        for (int k = 0; k < 8; ++k) { v[k] = *(const f32x4*)(xr + k * 256 + lane * 4); ss += v[k][0] * v[k][0] + v[k][1] * v[k][1] + v[k][2] * v[k][2] + v[k][3] * v[k][3]; }
        ss = wave_sum(ss); const float rs = rsqrtf(ss * (1.f / 2048.f) + 1e-6f);
        const float* mb = mod + (row >> 12) * 12288; float am = 0.f;
#pragma unroll
        for (int k = 0; k < 8; ++k) { const int d = k * 256 + lane * 4; const f32x4 g = *(const f32x4*)(gain + d), sc = *(const f32x4*)(mb + sc_off + d), sh = *(const f32x4*)(mb + sh_off + d);
#pragma unroll
            for (int e = 0; e < 4; ++e) { v[k][e] = v[k][e] * rs * g[e] * (1.f + sc[e]) + sh[e]; am = fmaxf(am, fabsf(v[k][e])); } }
#pragma unroll
        for (int o = 32; o >= 1; o >>= 1) am = fmaxf(am, __shfl_xor(am, o));
        const float q = am > 0.f ? 448.f / am : 1.f;
#pragma unroll
        for (int k = 0; k < 8; ++k) { int p = __builtin_amdgcn_cvt_pk_fp8_f32(v[k][0] * q, v[k][1] * q, 0, false); p = __builtin_amdgcn_cvt_pk_fp8_f32(v[k][2] * q, v[k][3] * q, p, true);
            *(unsigned*)(H8 + (size_t)row * 2048 + k * 256 + lane * 4) = (unsigned)p; }
        if (lane == 0) hsc[row] = am > 0.f ? am * (1.f / 448.f) : 1.f;
    }
}

DI void phase_cmp2(const Params& P) {
    unsigned char* ws = P.ws; const bf16_t* hid = (const bf16_t*)(ws + WS_HID); bf16_t* ckv = (bf16_t*)(ws + WS_CKV);
    for (int o = blockIdx.x * 512 + threadIdx.x; o < 2 * 16 * 256 * 64; o += gridDim.x * 512) {
        const int dd = o & 63, row = o >> 6, i = row >> 12, n = row & 255;
        float s = 0.f;
        if (n < NCMP) { const bf16_t* hr = hid + (size_t)row * 256; const float* w2 = P.cmp_w2 + i * 256 * 64 + dd; s = P.cmp_b2[i * 64 + dd];
#pragma unroll 4
            for (int j = 0; j < 256; j += 8) { const u32x4 hv = *(const u32x4*)(hr + j);
#pragma unroll
                for (int e = 0; e < 4; ++e) { s += bf_lo(hv[e]) * w2[(j + 2 * e) * 64]; s += bf_hi(hv[e]) * w2[(j + 2 * e + 1) * 64]; } } }
        ckv[o] = f2bf(s);
    }
}
DI void phase_scan(const Params& P) {
    unsigned char* ws = P.ws; const int lane = threadIdx.x & 63, wave = __builtin_amdgcn_readfirstlane(threadIdx.x >> 6);
    if (wave != 0) return;
    for (int bg = blockIdx.x; bg < 256; bg += gridDim.x) {
        const int b = bg >> 6, g = bg & 63, p = lane;
        const float ar = ((const float*)(ws + WS_A16))[(g * 64 + p) * 2], ai = ((const float*)(ws + WS_A16))[(g * 64 + p) * 2 + 1];
        const float* xl = (const float*)(ws + WS_XL) + (size_t)(g * 1024 + b * 256) * 128; bf16_t* a2 = (bf16_t*)(ws + WS_A2) + (size_t)(g * 1024 + b * 256) * 384 + 256;
        float xr = 0.f, xi = 0.f;
        for (int c = 0; c < 256; c += 8) { float lr[8], li[8];
#pragma unroll
            for (int e = 0; e < 8; ++e) { lr[e] = xl[(size_t)(c + e) * 128 + p]; li[e] = xl[(size_t)(c + e) * 128 + 64 + p]; }
#pragma unroll
            for (int e = 0; e < 8; ++e) { a2[(size_t)(c + e) * 384 + p] = f2bf(xr); a2[(size_t)(c + e) * 384 + 64 + p] = f2bf(xi);
                const float nr = ar * xr - ai * xi + lr[e], ni = ar * xi + ai * xr + li[e]; xr = nr; xi = ni; } }
    }
}

constexpr int AT_K = 0, AT_V = 18432, AT_TB = 34816, AT_IMP = 43008, AT_END = 112640;
#define MFMA32(a, b, c) __builtin_amdgcn_mfma_f32_32x32x16_bf16((a), (b), (c), 0, 0, 0)

DI void attn_setup_tables(const Params& P, LAS unsigned char* lds) {
    LAS float* tb = (LAS float*)(lds + AT_TB);
    __syncthreads();
    for (int i = threadIdx.x; i < 16 * 128; i += 512) { const int hd = i >> 7, dist = i & 127; int bk = dist;
        if (dist >= 16) { const float lr = __logf((float)dist * (1.f / 16.f)) / 2.0794415417f; bk = min(16 + (int)(lr * 16.f), 31); }
        tb[i] = P.rel_bias[bk * 16 + hd] * LOG2E; }
    __syncthreads();
}

#define ATTN_BODY \
             \
            bf16x8 vfr[2][2][2]; \
            f32x16 sacc[2]; \
_Pragma("unroll") \
            for (int kb = 0; kb < 2; ++kb) { \
_Pragma("unroll") \
                for (int i = 0; i < 16; ++i) sacc[kb][i] = 0.f; \
_Pragma("unroll") \
                for (int s = 0; s < 4; ++s) { const bf16x8 kf = *(const LAS bf16x8*)(Kl + krd + kb * 32 * 144 + s * 32); sacc[kb] = MFMA32(kf, qf[s], sacc[kb]); } } \
            if (pass == 0 && MODE != 0) {                                             \
_Pragma("unroll") \
                for (int kb = 0; kb < 2; ++kb) \
_Pragma("unroll") \
                    for (int s2 = 0; s2 < 2; ++s2) \
_Pragma("unroll") \
                        for (int db = 0; db < 2; ++db) { const unsigned a0 = (unsigned)(32 * kb + 16 * s2) * 128u + vrow * 128u + vcol[db]; \
                            const s16x4 lo = __builtin_amdgcn_ds_read_tr16_b64_v4i16((LAS s16x4*)(Vl + a0)), hi = __builtin_amdgcn_ds_read_tr16_b64_v4i16((LAS s16x4*)(Vl + a0 + 8 * 128)); \
                            vfr[kb][s2][db] = __builtin_shufflevector(lo, hi, 0, 1, 2, 3, 4, 5, 6, 7); } \
            } \
             \
            const bool near = (MODE == 0) ? (1024 * j + 1152 > qb * 64) : ((qb - j <= 2) || (MODE == 2 && j == qb - 8));        \
            const bool lsel = (MODE != 1) || (((j < 32 ? (mlo >> j) : (mhi >> (j - 32))) & 1u) != 0u); \
            if (near) { \
                const int dq = (MODE == 0) ? (tq - 31 - 1024 * j) : (tq - 64 * j); \
_Pragma("unroll") \
                for (int kb = 0; kb < 2; ++kb) \
_Pragma("unroll") \
                    for (int i = 0; i < 16; ++i) { const int kl = 32 * kb + (i & 3) + 8 * (i >> 2) + 4 * h; const int dist = dq - ((MODE == 0) ? 16 * kl : kl); \
                        bool ok = (dist >= 0) && lsel; if (MODE == 2) ok = ok && (dist < 512); \
                        sacc[kb][i] = (sacc[kb][i] + tb[min(max(dist, 0), 127)]) + (ok ? 0.f : NEGBIG); if (i == 15) __builtin_amdgcn_sched_barrier(0); }      \
            } else { \
                const float cb = lsel ? farb : NEGBIG;                   \
_Pragma("unroll") \
                for (int kb = 0; kb < 2; ++kb) \
_Pragma("unroll") \
                    for (int i = 0; i < 16; ++i) sacc[kb][i] += cb; \
            } \
            bf16x8 pf[2][2]; \
            if (pass == 0) { \
                 \
                float mx = fmaxf(fmaxf(sacc[0][0], sacc[0][1]), sacc[1][0]); \
_Pragma("unroll") \
                for (int kb = 0; kb < 2; ++kb) \
_Pragma("unroll") \
                    for (int i = 0; i < 16; i += 2) mx = fmaxf(fmaxf(mx, sacc[kb][i]), sacc[kb][i + 1]); \
                mx = xor32_max(mx); \
                const float m_new = fmaxf(m_run, mx); \
                if (__any(m_new > m_run)) { const float alpha = __builtin_amdgcn_exp2f(m_run - m_new); l_run *= alpha; \
_Pragma("unroll") \
                    for (int i = 0; i < 16; ++i) { oacc[0][i] *= alpha; oacc[1][i] *= alpha; } } \
                m_run = m_new; \
                f32x2 ls2 = {0.f, 0.f}; const f32x2 mn2 = {m_new, m_new}; \
_Pragma("unroll") \
                for (int kb = 0; kb < 2; ++kb) \
_Pragma("unroll") \
                    for (int i = 0; i < 16; i += 2) { f32x2 d2 = (f32x2){sacc[kb][i], sacc[kb][i + 1]} - mn2; d2.x = __builtin_amdgcn_exp2f(d2.x); d2.y = __builtin_amdgcn_exp2f(d2.y); sacc[kb][i] = d2.x; sacc[kb][i + 1] = d2.y; ls2 += d2; } \
                l_run += ls2.x + ls2.y; \
            } else { \
_Pragma("unroll") \
                for (int kb = 0; kb < 2; ++kb) \
_Pragma("unroll") \
                    for (int i = 0; i < 16; ++i) sacc[kb][i] = __builtin_amdgcn_exp2f(sacc[kb][i] - m_fin) * inv_fin; \
            } \
_Pragma("unroll") \
            for (int kb = 0; kb < 2; ++kb) \
_Pragma("unroll") \
                for (int s2 = 0; s2 < 2; ++s2) { u32x4 w; \
_Pragma("unroll") \
                    for (int e = 0; e < 4; ++e) w[e] = pk_bf16(sacc[kb][8 * s2 + 2 * e], sacc[kb][8 * s2 + 2 * e + 1]); \
                    pf[kb][s2] = __builtin_bit_cast(bf16x8, w); } \
            if (pass == 0) { \
                 \
_Pragma("unroll") \
                for (int kb = 0; kb < 2; ++kb) \
_Pragma("unroll") \
                    for (int s2 = 0; s2 < 2; ++s2) \
_Pragma("unroll") \
                        for (int db = 0; db < 2; ++db) { \
                            if (MODE != 0) oacc[db] = MFMA32(vfr[kb][s2][db], pf[kb][s2], oacc[db]); \
                            else { const unsigned a0 = (unsigned)(32 * kb + 16 * s2) * 128u + vrow * 128u + vcol[db]; \
                                const s16x4 lo = __builtin_amdgcn_ds_read_tr16_b64_v4i16((LAS s16x4*)(Vl + a0)), hi = __builtin_amdgcn_ds_read_tr16_b64_v4i16((LAS s16x4*)(Vl + a0 + 8 * 128)); \
                                oacc[db] = MFMA32(__builtin_shufflevector(lo, hi, 0, 1, 2, 3, 4, 5, 6, 7), pf[kb][s2], oacc[db]); } } \
            } else { \
                 \
                bf16x8 mfrag[2][2]; \
_Pragma("unroll") \
                for (int kb = 0; kb < 2; ++kb) \
_Pragma("unroll") \
                    for (int s2 = 0; s2 < 2; ++s2) \
_Pragma("unroll") \
                        for (int jj = 0; jj < 8; ++jj) { const int key = 32 * kb + 16 * s2 + 8 * (jj >> 2) + 4 * h + (jj & 3); \
                            mfrag[kb][s2][jj] = (key == 4 * r - 1 || key == 4 * r + 3) ? (short)0x3F00 : ((key >= 4 * r && key <= 4 * r + 2) ? (short)0x3F80 : (short)0); } \
                f32x16 ia; \
_Pragma("unroll") \
                for (int i = 0; i < 16; ++i) ia[i] = 0.f; \
_Pragma("unroll") \
                for (int kb = 0; kb < 2; ++kb) \
_Pragma("unroll") \
                    for (int s2 = 0; s2 < 2; ++s2) ia = MFMA32(mfrag[kb][s2], pf[kb][s2], ia); \
                LAS float* ip = (LAS float*)(lds + AT_IMP) + (g * 64 + tq_loc) * 68 + 16 * j; \
_Pragma("unroll") \
                for (int i = 0; i < 9; ++i) { const int jp = (i & 3) + 8 * (i >> 2) + 4 * h; if (jp <= 16) ip[jp] += ia[i]; } \
            } \


template <int MODE> DI void attn_unit(const Params& P, LAS unsigned char* lds, int b, int k, int qb) {
    unsigned char* ws = P.ws;
    const int tid = threadIdx.x, lane = tid & 63, wave = __builtin_amdgcn_readfirstlane(tid >> 6);
    const int g = wave >> 1, th = wave & 1, r = lane & 31, h = lane >> 5;
    const int tq_loc = th * 32 + r, tq = qb * 64 + tq_loc, hd = k * 4 + g, bk = b * 4 + k;
    const LAS float* tb = (const LAS float*)(lds + AT_TB) + hd * 128;
    const float farb = tb[127];
    bf16x8 qf[4];
    { const bf16_t* qg = (const bf16_t*)(ws + WS_Q) + ((size_t)(b * 4096 + tq)) * 1024 + hd * 64 + 8 * h;
#pragma unroll
      for (int s = 0; s < 4; ++s) qf[s] = *(const bf16x8*)(qg + 16 * s); }
    const bf16_t *Kg, *Vg;
    if (MODE == 0) { Kg = (const bf16_t*)(ws + WS_CKV) + (size_t)bk * 256 * 64; Vg = Kg + 16 * 256 * 64; }
    else { Kg = (const bf16_t*)(ws + WS_KV) + (size_t)(MODE == 1 ? 2 : 4) * 4194304 + (size_t)bk * 4096 * 64; Vg = Kg + 4194304; }
    unsigned long long tiles; unsigned mlo = 0u, mhi = 0u;
    if (MODE == 0) { const int kmax = min(3, (4 * qb + 2) >> 6); tiles = (2ull << kmax) - 1ull; }
    else if (MODE == 2) { const int lo = max(0, qb - 8); tiles = ((2ull << qb) - 1ull) & ~((1ull << lo) - 1ull); }
    else { const unsigned* sm = (const unsigned*)(ws + WS_SELM) + ((size_t)(bk * 4096 + qb * 64)) * 2;
        mlo = sm[tq_loc * 2]; mhi = sm[tq_loc * 2 + 1];
        unsigned ulo = sm[lane * 2], uhi = sm[lane * 2 + 1];
#pragma unroll
        for (int o = 32; o >= 1; o >>= 1) { ulo |= __shfl_xor(ulo, o); uhi |= __shfl_xor(uhi, o); }
        tiles = (((unsigned long long)(unsigned)__builtin_amdgcn_readfirstlane(uhi) << 32) | (unsigned)__builtin_amdgcn_readfirstlane(ulo)) & ((2ull << qb) - 1ull); }
    const int ntile = __popcll(tiles);
    const int skey = tid >> 3, sch = tid & 7;
    const unsigned kst = (unsigned)(skey * 144 + sch * 16), vst = (unsigned)(skey * 128 + ((sch ^ (((skey >> 1) & 1) << 2)) * 16));
    const int q4 = (lane & 15) >> 2, pp = lane & 3, blk = (lane >> 4) & 1;
    const unsigned vrow = (unsigned)(4 * h + q4);
    unsigned vcol[2];
#pragma unroll
    for (int db = 0; db < 2; ++db) { const int ch = 4 * db + 2 * blk + (pp >> 1); vcol[db] = (unsigned)(((ch ^ (((q4 >> 1) & 1) << 2)) * 16) + (pp & 1) * 8); }
    const unsigned krd = (unsigned)(r * 144 + 16 * h);

    f32x16 oacc[2]; float m_run = NEGBIG, l_run = 0.f;
#pragma unroll
    for (int i = 0; i < 16; ++i) { oacc[0][i] = 0.f; oacc[1][i] = 0.f; }
    float m_fin = 0.f, inv_fin = 0.f;

#define ATTN_STEP(KR, VR, JV, PAR) { const int j = JV; \
            LAS unsigned char* Kl = lds + AT_K + (PAR) * 9216; LAS unsigned char* Vl = lds + AT_V + (PAR) * 8192; \
            *(LAS u32x4*)(Kl + kst) = KR; *(LAS u32x4*)(Vl + vst) = VR; \
            __syncthreads(); \
            { const int j2 = rem ? __ffsll((long long)rem) - 1 : JV; rem &= rem - 1ull; JV = j2; \
              KR = *(const u32x4*)(Kg + (size_t)(j2 * 64 + skey) * 64 + sch * 8); VR = *(const u32x4*)(Vg + (size_t)(j2 * 64 + skey) * 64 + sch * 8); } \
            ATTN_BODY }
#define ATTN_PASS(PASSC) { constexpr int pass = (PASSC); \
        if (MODE == 0 && pass == 1) {                                    \
            LAS float* imp = (LAS float*)(lds + AT_IMP); \
            for (int i = tid; i < 4 * 64 * 68; i += 512) imp[i] = 0.f; \
        } \
        __syncthreads();                                                 \
         \
        unsigned long long rem = tiles; int jA = __ffsll((long long)rem) - 1; rem &= rem - 1ull; int jB = rem ? __ffsll((long long)rem) - 1 : jA; rem &= rem - 1ull; \
        u32x4 kregA = *(const u32x4*)(Kg + (size_t)(jA * 64 + skey) * 64 + sch * 8), vregA = *(const u32x4*)(Vg + (size_t)(jA * 64 + skey) * 64 + sch * 8); \
        u32x4 kregB = *(const u32x4*)(Kg + (size_t)(jB * 64 + skey) * 64 + sch * 8), vregB = *(const u32x4*)(Vg + (size_t)(jB * 64 + skey) * 64 + sch * 8); \
        if constexpr (true) { rem = tiles & (tiles - 1ull);           \
            for (int it = 0; it < ntile; ++it) ATTN_STEP(kregA, vregA, jA, (it & 1)) \
        } else { \
            for (int it = 0; it < ntile; it += 2) { \
                ATTN_STEP(kregA, vregA, jA, 0) \
                if (it + 1 < ntile) ATTN_STEP(kregB, vregB, jB, 1) \
            } \
        } \
        if (pass == 0) { \
            const float lt = xor32_add(l_run); const bool live = m_run > -1e29f; const float inv = live ? 1.f / lt : 0.f; \
            m_fin = live ? m_run : 0.f; inv_fin = inv; \
             \
            int tqo = tq; asm volatile("" : "+v"(tqo)); \
            bf16_t* og = (bf16_t*)(ws + (MODE == 0 ? WS_OC : (MODE == 2 ? WS_OW : WS_OATT))) + ((size_t)(b * 4096 + tqo)) * 1024 + hd * 64; \
            float g0 = 0.f, g1 = 1.f, g2 = 0.f; const bf16_t *oc = nullptr, *ow = nullptr; \
            if (MODE == 1) { const float* gp = (const float*)(ws + WS_GATE) + (size_t)(b * 4096 + tqo) * 48 + hd * 3; g0 = gp[0]; g1 = gp[1]; g2 = gp[2]; \
                oc = (const bf16_t*)(ws + WS_OC) + ((size_t)(b * 4096 + tqo)) * 1024 + hd * 64; ow = (const bf16_t*)(ws + WS_OW) + ((size_t)(b * 4096 + tqo)) * 1024 + hd * 64; } \
_Pragma("unroll") \
            for (int db = 0; db < 2; ++db) \
_Pragma("unroll") \
                for (int a = 0; a < 4; ++a) { const int d0 = 32 * db + 8 * a + 4 * h; float v[4]; \
_Pragma("unroll") \
                    for (int e = 0; e < 4; ++e) v[e] = oacc[db][4 * a + e] * inv; \
                    if (MODE == 1) { const u32x2 c2 = *(const u32x2*)(oc + d0), w2 = *(const u32x2*)(ow + d0); \
                        v[0] = g1 * v[0] + g0 * bf_lo(c2[0]) + g2 * bf_lo(w2[0]); v[1] = g1 * v[1] + g0 * bf_hi(c2[0]) + g2 * bf_hi(w2[0]); \
                        v[2] = g1 * v[2] + g0 * bf_lo(c2[1]) + g2 * bf_lo(w2[1]); v[3] = g1 * v[3] + g0 * bf_hi(c2[1]) + g2 * bf_hi(w2[1]); } \
                    if (MODE == 1) { int p8 = __builtin_amdgcn_cvt_pk_fp8_f32(clamp448(v[0] * OATT_SCALE), clamp448(v[1] * OATT_SCALE), 0, false); p8 = __builtin_amdgcn_cvt_pk_fp8_f32(clamp448(v[2] * OATT_SCALE), clamp448(v[3] * OATT_SCALE), p8, true); \
                        *(int*)((unsigned char*)(ws + WS_OATT) + ((size_t)(b * 4096 + tqo)) * UA_LD + hd * 64 + d0) = p8; } \
                    else { u32x2 w; w[0] = pk_bf16(v[0], v[1]); w[1] = pk_bf16(v[2], v[3]); *(u32x2*)(og + d0) = w; } } \
        } \
     }
    ATTN_PASS(0)
    if constexpr (MODE == 0) ATTN_PASS(1)
#undef ATTN_PASS
#undef ATTN_STEP
    if (MODE == 0) {
        __syncthreads();
        const LAS float* imp = (const LAS float*)(lds + AT_IMP); unsigned* sm = (unsigned*)(ws + WS_SELM) + ((size_t)(bk * 4096 + qb * 64)) * 2;
        const int cur = qb;
        for (int tk = 0; tk < 8; ++tk) { const int tok = wave * 8 + tk, jb = lane;
            const float v = imp[(0 * 64 + tok) * 68 + jb] + imp[(1 * 64 + tok) * 68 + jb] + imp[(2 * 64 + tok) * 68 + jb] + imp[(3 * 64 + tok) * 68 + jb];
            const bool valid = jb <= cur, forced = valid && (jb == 0 || jb == cur || jb == cur - 1);
            bool sel = forced;
            if (cur <= 15) sel = valid;
            else { unsigned key = (valid && !forced) ? ((__float_as_uint(fmaxf(v, 0.f)) & ~63u) | (unsigned)(63 - jb)) : 0u;
                for (int rd = 0; rd < 13; ++rd) { const unsigned w = wave_max_u32(key); const int win = 63 - (int)(w & 63u); if (jb == win && w != 0u) { sel = true; key = 0u; } } }
            const unsigned long long bal = __ballot(sel);
            if (lane == 0) { sm[tok * 2] = (unsigned)bal; sm[tok * 2 + 1] = (unsigned)(bal >> 32); } }
    }
}

constexpr float AT_THR = 6.f;
#define AP_QK(S, Kl_, C_) { _Pragma("unroll") for (int kb = 0; kb < 2; ++kb) { \
        _Pragma("unroll") for (int s = 0; s < 4; ++s) { const bf16x8 kf = *(const LAS bf16x8*)((Kl_) + krd + kb * 32 * 144 + s * 32); if (s == 0) S[kb] = MFMA32(kf, qf[0], C_); else S[kb] = MFMA32(kf, qf[s], S[kb]); } } }
#define AP_CSEL(C_, jt) f32x16 C_; { const int j_ = (jt); const bool lsel_ = (MODE != 1) || (((j_ < 32 ? (mlo >> j_) : (mhi >> (j_ - 32))) & 1u) != 0u); const bool near_ = (qb - j_ <= 2) || (MODE == 2 && j_ == qb - 8); \
        _Pragma("unroll") for (int i = 0; i < 16; ++i) C_[i] = (lsel_ || near_) ? cinit[i] : NEGBIG; }
#define AP_NEAR(S, jt) { const int j_ = (jt); const bool near_ = (qb - j_ <= 2) || (MODE == 2 && j_ == qb - 8); \
        if (near_) { const bool lsel_ = (MODE != 1) || (((j_ < 32 ? (mlo >> j_) : (mhi >> (j_ - 32))) & 1u) != 0u); const int dq = tq - 64 * j_; \
            _Pragma("unroll") for (int kb = 0; kb < 2; ++kb) _Pragma("unroll") for (int i = 0; i < 16; ++i) { const int kl = 32 * kb + (i & 3) + 8 * (i >> 2) + 4 * h; const int dist = dq - kl; \
                bool ok = (dist >= 0) && lsel_; if (MODE == 2) ok = ok && (dist < 512); \
                S[kb][i] = (S[kb][i] + (tb[min(max(dist, 0), 127)] - farb)) + (ok ? 0.f : NEGBIG); } } }
#define AP_STEP(SC, SN, PAR, HASNEXT) { \
        LAS unsigned char* Kn = lds + AT_K + ((PAR) ^ 1) * 9216; LAS unsigned char* Vc = lds + AT_V + (PAR) * 8192; \
        *(LAS u32x4*)(Kn + kst) = kreg; *(LAS u32x4*)(Vc + vst) = vreg; \
        __syncthreads(); \
        { vreg = *(const u32x4*)(Vg + (size_t)(jn * 64 + skey) * 64 + sch * 8); kreg = *(const u32x4*)(Kg + (size_t)(jnn * 64 + skey) * 64 + sch * 8); } \
        const bool hn_ = (HASNEXT); \
        float mx = fmaxf(fmaxf(SC[0][0], SC[0][1]), SC[1][0]); \
        _Pragma("unroll") for (int kb = 0; kb < 2; ++kb) _Pragma("unroll") for (int i = 0; i < 16; i += 2) mx = fmaxf(fmaxf(mx, SC[kb][i]), SC[kb][i + 1]); \
        mx = xor32_max(mx); \
        if (__any(mx > AT_THR || (mx < -24.f && mx > -1e29f))) {         \
            const float dl = (mx > -1e29f) ? mx : 0.f, alpha = __builtin_amdgcn_exp2f(-dl); m_run += dl; l_run *= alpha; \
            _Pragma("unroll") for (int i = 0; i < 16; ++i) { oacc[0][i] *= alpha; oacc[1][i] *= alpha; cinit[i] -= dl; SC[0][i] -= dl; SC[1][i] -= dl; } } \
        AP_CSEL(cn_, jn) \
        AP_QK(SN, Kn, cn_)        \
        float ls0 = 0.f, ls1 = 0.f; \
        _Pragma("unroll") for (int kb = 0; kb < 2; ++kb) _Pragma("unroll") for (int i = 0; i < 16; i += 2) { const float p0 = __builtin_amdgcn_exp2f(SC[kb][i]), p1 = __builtin_amdgcn_exp2f(SC[kb][i + 1]); SC[kb][i] = p0; SC[kb][i + 1] = p1; ls0 += p0; ls1 += p1; } \
        l_run += ls0 + ls1; \
        _Pragma("unroll") for (int kb = 0; kb < 2; ++kb) _Pragma("unroll") for (int s2 = 0; s2 < 2; ++s2) { u32x4 w; \
            _Pragma("unroll") for (int e = 0; e < 4; ++e) w[e] = pk_bf16(SC[kb][8 * s2 + 2 * e], SC[kb][8 * s2 + 2 * e + 1]); \
            const bf16x8 pf = __builtin_bit_cast(bf16x8, w); \
            _Pragma("unroll") for (int db = 0; db < 2; ++db) { const unsigned a0 = (unsigned)(32 * kb + 16 * s2) * 128u + vrow * 128u + vcol[db]; \
                const s16x4 lo = __builtin_amdgcn_ds_read_tr16_b64_v4i16((LAS s16x4*)(Vc + a0)), hi = __builtin_amdgcn_ds_read_tr16_b64_v4i16((LAS s16x4*)(Vc + a0 + 8 * 128)); \
                oacc[db] = MFMA32(__builtin_shufflevector(lo, hi, 0, 1, 2, 3, 4, 5, 6, 7), pf, oacc[db]); } } \
        if (hn_) AP_NEAR(SN, jn) \
        jn = jnn; jnn = rem ? __ffsll((long long)rem) - 1 : jnn; rem &= rem - 1ull; }

template <int MODE> DI void attn_unit_pipe(const Params& P, LAS unsigned char* lds, int b, int k, int qb) {
    unsigned char* ws = P.ws;
    const int tid = threadIdx.x, lane = tid & 63, wave = __builtin_amdgcn_readfirstlane(tid >> 6);
    const int g = wave >> 1, th = wave & 1, r = lane & 31, h = lane >> 5;
    const int tq_loc = th * 32 + r, tq = qb * 64 + tq_loc, hd = k * 4 + g, bk = b * 4 + k;
    const LAS float* tb = (const LAS float*)(lds + AT_TB) + hd * 128;
    const float farb = tb[127];
    bf16x8 qf[4];
    { const bf16_t* qg = (const bf16_t*)(ws + WS_Q) + ((size_t)(b * 4096 + tq)) * 1024 + hd * 64 + 8 * h;
#pragma unroll
      for (int s = 0; s < 4; ++s) qf[s] = *(const bf16x8*)(qg + 16 * s); }
    const bf16_t* Kg = (const bf16_t*)(ws + WS_KV) + (size_t)(MODE == 1 ? 2 : 4) * 4194304 + (size_t)bk * 4096 * 64; const bf16_t* Vg = Kg + 4194304;
    unsigned long long tiles; unsigned mlo = 0u, mhi = 0u;
    if (MODE == 2) { const int lo = max(0, qb - 8); tiles = ((2ull << qb) - 1ull) & ~((1ull << lo) - 1ull); }
    else { const unsigned* sm = (const unsigned*)(ws + WS_SELM) + ((size_t)(bk * 4096 + qb * 64)) * 2;
        mlo = sm[tq_loc * 2]; mhi = sm[tq_loc * 2 + 1];
        unsigned ulo = sm[lane * 2], uhi = sm[lane * 2 + 1];
#pragma unroll
        for (int o = 32; o >= 1; o >>= 1) { ulo |= __shfl_xor(ulo, o); uhi |= __shfl_xor(uhi, o); }
        tiles = (((unsigned long long)(unsigned)__builtin_amdgcn_readfirstlane(uhi) << 32) | (unsigned)__builtin_amdgcn_readfirstlane(ulo)) & ((2ull << qb) - 1ull); }
    const int ntile = __popcll(tiles);
    const int skey = tid >> 3, sch = tid & 7;
    const unsigned kst = (unsigned)(skey * 144 + sch * 16), vst = (unsigned)(skey * 128 + ((sch ^ (((skey >> 1) & 1) << 2)) * 16));
    const int q4 = (lane & 15) >> 2, pp = lane & 3, blk = (lane >> 4) & 1;
    const unsigned vrow = (unsigned)(4 * h + q4);
    unsigned vcol[2];
#pragma unroll
    for (int db = 0; db < 2; ++db) { const int ch = 4 * db + 2 * blk + (pp >> 1); vcol[db] = (unsigned)(((ch ^ (((q4 >> 1) & 1) << 2)) * 16) + (pp & 1) * 8); }
    const unsigned krd = (unsigned)(r * 144 + 16 * h);
    f32x16 oacc[2], sA[2], sB[2], cinit; float m_run = 0.f, l_run = 0.f;
#pragma unroll
    for (int i = 0; i < 16; ++i) { oacc[0][i] = 0.f; oacc[1][i] = 0.f; cinit[i] = farb; }
    unsigned long long rem = tiles; const int jc = __ffsll((long long)rem) - 1; rem &= rem - 1ull;
    int jn = rem ? __ffsll((long long)rem) - 1 : jc; rem &= rem - 1ull; int jnn = rem ? __ffsll((long long)rem) - 1 : jn; rem &= rem - 1ull;
    u32x4 kreg = *(const u32x4*)(Kg + (size_t)(jc * 64 + skey) * 64 + sch * 8), vreg = *(const u32x4*)(Vg + (size_t)(jc * 64 + skey) * 64 + sch * 8);
    __syncthreads();
    *(LAS u32x4*)(lds + AT_K + kst) = kreg;
    kreg = *(const u32x4*)(Kg + (size_t)(jn * 64 + skey) * 64 + sch * 8);
    __syncthreads();
    { AP_CSEL(c0_, jc) AP_QK(sA, lds + AT_K, c0_) AP_NEAR(sA, jc) }
    for (int it = 0; it < ntile; it += 2) {
        AP_STEP(sA, sB, 0, it + 1 < ntile)
        if (it + 1 < ntile) AP_STEP(sB, sA, 1, it + 2 < ntile)
    }
    const float lt = xor32_add(l_run); const float inv = lt > 0.f ? 1.f / lt : 0.f;
    int tqo = tq; asm volatile("" : "+v"(tqo));
    float g0 = 0.f, g1 = 1.f, g2 = 0.f; const bf16_t *oc = nullptr, *ow = nullptr;
    if (MODE == 1) { const float* gp = (const float*)(ws + WS_GATE) + (size_t)(b * 4096 + tqo) * 48 + hd * 3; g0 = gp[0]; g1 = gp[1]; g2 = gp[2];
        oc = (const bf16_t*)(ws + WS_OC) + ((size_t)(b * 4096 + tqo)) * 1024 + hd * 64; ow = (const bf16_t*)(ws + WS_OW) + ((size_t)(b * 4096 + tqo)) * 1024 + hd * 64; }
#pragma unroll
    for (int db = 0; db < 2; ++db)
#pragma unroll
        for (int a = 0; a < 4; ++a) { const int d0 = 32 * db + 8 * a + 4 * h; float v[4];
#pragma unroll
            for (int e = 0; e < 4; ++e) v[e] = oacc[db][4 * a + e] * inv;
            if (MODE == 1) { const u32x2 c2 = *(const u32x2*)(oc + d0), w2 = *(const u32x2*)(ow + d0);
                v[0] = g1 * v[0] + g0 * bf_lo(c2[0]) + g2 * bf_lo(w2[0]); v[1] = g1 * v[1] + g0 * bf_hi(c2[0]) + g2 * bf_hi(w2[0]);
                v[2] = g1 * v[2] + g0 * bf_lo(c2[1]) + g2 * bf_lo(w2[1]); v[3] = g1 * v[3] + g0 * bf_hi(c2[1]) + g2 * bf_hi(w2[1]);
                int p8 = __builtin_amdgcn_cvt_pk_fp8_f32(clamp448(v[0] * OATT_SCALE), clamp448(v[1] * OATT_SCALE), 0, false); p8 = __builtin_amdgcn_cvt_pk_fp8_f32(clamp448(v[2] * OATT_SCALE), clamp448(v[3] * OATT_SCALE), p8, true);
                *(int*)((unsigned char*)(ws + WS_OATT) + ((size_t)(b * 4096 + tqo)) * UA_LD + hd * 64 + d0) = p8; }
            else { u32x2 w; w[0] = pk_bf16(v[0], v[1]); w[1] = pk_bf16(v[2], v[3]); *(u32x2*)((bf16_t*)(ws + WS_OW) + ((size_t)(b * 4096 + tqo)) * 1024 + hd * 64 + d0) = w; } }
}
#undef AP_STEP
#undef AP_NEAR
#undef AP_CSEL
#undef AP_QK

DI void phase_attn_win_early(const Params& P, LAS unsigned char* lds) {
    if (gridDim.x != 256) return;
    const int bx = blockIdx.x; if (bx >= 128 && bx < 160) return;
    attn_setup_tables(P, lds);
    const int nb = bx < 128 ? bx : bx - 32;
    for (int u = nb; u < 672; u += 224) { const int qb = u >> 4, bk = u & 15; attn_unit_pipe<2>(P, lds, bk >> 2, bk & 3, qb); }
}
DI void phase_attn_cmp_win(const Params& P, LAS unsigned char* lds) {
    attn_setup_tables(P, lds);
    for (int u = blockIdx.x; u < 1024; u += gridDim.x) { const int qb = 63 - (u >> 4), bk = u & 15; attn_unit<0>(P, lds, bk >> 2, bk & 3, qb); }
    for (int u = (gridDim.x == 256 ? 672 : 0) + blockIdx.x; u < 1024; u += gridDim.x) { const int qb = u >> 4, bk = u & 15; attn_unit_pipe<2>(P, lds, bk >> 2, bk & 3, qb); }
}
DI void phase_attn_sel(const Params& P, LAS unsigned char* lds) {
    attn_setup_tables(P, lds);
    for (int pr = blockIdx.x; pr < 512; pr += gridDim.x) { const int bk = pr >> 5, qp = pr & 31;
        attn_unit_pipe<1>(P, lds, bk >> 2, bk & 3, 63 - qp); attn_unit_pipe<1>(P, lds, bk >> 2, bk & 3, qp); }
}

DI unsigned row_max_u32(unsigned v) {
    asm volatile("s_nop 1\n\tv_max_u32_dpp %0, %0, %0 quad_perm:[1,0,3,2] row_mask:0xf bank_mask:0xf\n\ts_nop 1\n\tv_max_u32_dpp %0, %0, %0 quad_perm:[2,3,0,1] row_mask:0xf bank_mask:0xf\n\t"
                 "s_nop 1\n\tv_max_u32_dpp %0, %0, %0 row_half_mirror row_mask:0xf bank_mask:0xf\n\ts_nop 1\n\tv_max_u32_dpp %0, %0, %0 row_mirror row_mask:0xf bank_mask:0xf\n\ts_nop 1" : "+v"(v));
    return v; }
DI float row_max_f32(float v) {
    asm volatile("s_nop 1\n\tv_max_f32_dpp %0, %0, %0 quad_perm:[1,0,3,2] row_mask:0xf bank_mask:0xf\n\ts_nop 1\n\tv_max_f32_dpp %0, %0, %0 quad_perm:[2,3,0,1] row_mask:0xf bank_mask:0xf\n\t"
                 "s_nop 1\n\tv_max_f32_dpp %0, %0, %0 row_half_mirror row_mask:0xf bank_mask:0xf\n\ts_nop 1\n\tv_max_f32_dpp %0, %0, %0 row_mirror row_mask:0xf bank_mask:0xf\n\ts_nop 1" : "+v"(v));
    return v; }
DI float row_sum_f32(float v) {
    asm volatile("s_nop 1\n\tv_add_f32_dpp %0, %0, %0 quad_perm:[1,0,3,2] row_mask:0xf bank_mask:0xf\n\ts_nop 1\n\tv_add_f32_dpp %0, %0, %0 quad_perm:[2,3,0,1] row_mask:0xf bank_mask:0xf\n\t"
                 "s_nop 1\n\tv_add_f32_dpp %0, %0, %0 row_half_mirror row_mask:0xf bank_mask:0xf\n\ts_nop 1\n\tv_add_f32_dpp %0, %0, %0 row_mirror row_mask:0xf bank_mask:0xf\n\ts_nop 1" : "+v"(v));
    return v; }
DI float demono_f32(unsigned u) { return __uint_as_float((u & 0x80000000u) ? (u ^ 0x80000000u) : ~u); }

#define PK_CE(x, y) do { const unsigned hi_ = max(x, y), lo_ = min(x, y); x = hi_; y = lo_; } while (0)
DI void peer_stage1(const u32x4& sh, int li, LAS float* vsr, LAS int* nsr) {
    unsigned s[8];
#pragma unroll
    for (int e = 0; e < 8; ++e) { const unsigned hb = (e & 1) ? (sh[e >> 1] & 0xFFFF0000u) : (sh[e >> 1] << 16);
        s[e] = ((hb ^ (((int)hb >> 31) | 0x80000000u)) & 0xFFFF0000u) | (unsigned)(127 - (8 * li + e)); }
    PK_CE(s[0], s[1]); PK_CE(s[2], s[3]); PK_CE(s[4], s[5]); PK_CE(s[6], s[7]); PK_CE(s[0], s[2]); PK_CE(s[1], s[3]); PK_CE(s[4], s[6]); PK_CE(s[5], s[7]); PK_CE(s[1], s[2]); PK_CE(s[5], s[6]);
    PK_CE(s[0], s[4]); PK_CE(s[1], s[5]); PK_CE(s[2], s[6]); PK_CE(s[3], s[7]); PK_CE(s[2], s[4]); PK_CE(s[3], s[5]); PK_CE(s[1], s[2]); PK_CE(s[3], s[4]); PK_CE(s[5], s[6]);
    unsigned win = 0u;
    for (int rd = 0; rd < 16; ++rd) {
        const unsigned m = row_max_u32(s[0]); const bool w = s[0] == m;
#pragma unroll
        for (int i = 0; i < 7; ++i) s[i] = w ? s[i + 1] : s[i];
        s[7] = w ? 0u : s[7];
        if (li == rd) win = m; }
    { const unsigned u = win & 0xFFFF0000u, hb = (u & 0x80000000u) ? (u ^ 0x80000000u) : (~u & 0xFFFF0000u);
      vsr[li] = (float)__builtin_bit_cast(_Float16, (unsigned short)(hb >> 16)); nsr[li] = 127 - (int)(win & 127u); }
}
DI void conv_row_store(const Params& P, int crow, int lane, const f32x4 (&v)[8]) {
    unsigned char* ws = P.ws; float am = 0.f;
#pragma unroll
    for (int k8 = 0; k8 < 8; ++k8) am = fmaxf(am, fmaxf(fmaxf(fabsf(v[k8][0]), fabsf(v[k8][1])), fmaxf(fabsf(v[k8][2]), fabsf(v[k8][3]))));
    am = __uint_as_float(wave_max_u32(__float_as_uint(am)));
    unsigned char* dst = ws + WS_PU + (size_t)(crow >> 14) * 33554432 + (size_t)(crow & 16383) * 256 + lane * 4;
    const float sc = am > 0.f ? 127.f / am : 1.f;
#pragma unroll
    for (int k8 = 0; k8 < 8; ++k8) { unsigned pk = 0u;
#pragma unroll
        for (int e = 0; e < 4; ++e) pk = __builtin_amdgcn_cvt_pk_u8_f32(__builtin_rintf(v[k8][e] * sc) + 128.f, e, pk);
        *(unsigned*)(dst + (size_t)k8 * 4194304) = pk ^ 0x80808080u; }
    if (lane == 0) ((float*)(ws + WS_PSU))[crow] = am > 0.f ? am / 127.f : 1.f;
}
DI void phase_peer(const Params& P, LAS unsigned char* lds) {
    unsigned char* ws = P.ws; const int lane = threadIdx.x & 63, wave = __builtin_amdgcn_readfirstlane(threadIdx.x >> 6), rw = lane >> 4, li = lane & 15;
    const unsigned short* SC = (const unsigned short*)(ws + WS_SC);
    LAS unsigned char* ptab = lds + 8192;
    LAS float* vs = (LAS float*)(lds + wave * 1024); LAS int* ns = (LAS int*)(lds + wave * 1024 + 512);
    __syncthreads();
    if (threadIdx.x == 0) { int q = 0; for (int a = 0; a < 16; ++a) for (int b = 0; b < 16 / (a + 1); ++b) ptab[q++] = (unsigned char)(a * 16 + b); for (; q < 64; ++q) ptab[q] = 0; }
    __syncthreads();
    int abq[4];
#pragma unroll
    for (int j = 0; j < 4; ++j) abq[j] = ptab[li + 16 * j];
    const int w0 = blockIdx.x * 8 + wave, wstep = gridDim.x * 8;
    const int nit = ((NT - w0 + wstep - 1) / wstep) * 2;
    int crow = w0;
    const unsigned short* sp0 = SC + (size_t)w0 * 2048 + rw * 128 + li * 8;
    u32x4 sa = *(const u32x4*)sp0, sc_ = *(const u32x4*)(sp0 + 512);
    for (int it = 0; it < nit; ++it) {
        const int t = w0 + (it >> 1) * wstep, bp = it & 1;
        const int itn = it + 1 < nit ? it + 1 : it; const unsigned short* spn = SC + (size_t)(w0 + (itn >> 1) * wstep) * 2048 + ((itn & 1) * 8 + rw) * 128 + li * 8;
        const u32x4 na = *(const u32x4*)spn, nc = *(const u32x4*)(spn + 512);
        asm volatile("" : "+v"(sa), "+v"(sc_));
        const bool cv = crow < 32768;
        f32x4 v[8];
        if (cv) { const float* sr = (crow < 16384 ? P.peer_u : P.peer_v) + (size_t)(crow & 16383) * 2048 + lane * 4;
#pragma unroll
            for (int k = 0; k < 8; ++k) v[k] = *(const f32x4*)(sr + k * 256); }
        peer_stage1(sa, li, vs + rw * 16, ns + rw * 16);
        peer_stage1(sc_, li, vs + 64 + rw * 16, ns + 64 + rw * 16);
        const LAS float* v1 = vs + rw * 32; const LAS float* v2 = v1 + 16;
        unsigned k[4];
#pragma unroll
        for (int j = 0; j < 4; ++j) { const int q = li + 16 * j; const float c = v1[abq[j] >> 4] + v2[abq[j] & 15]; k[j] = (q < 50) ? ((mono_u32(c) & ~63u) | (unsigned)(63 - q)) : 0u; }
        PK_CE(k[0], k[1]); PK_CE(k[2], k[3]); PK_CE(k[0], k[2]); PK_CE(k[1], k[3]); PK_CE(k[1], k[2]);
        unsigned w2 = 0u;
        for (int rd = 0; rd < 16; ++rd) {
            const unsigned m = row_max_u32(k[0]); const bool w = k[0] == m;
            k[0] = w ? k[1] : k[0]; k[1] = w ? k[2] : k[1]; k[2] = w ? k[3] : k[2]; k[3] = w ? 0u : k[3];
            if (li == rd) w2 = m; }
        {
            const int ab = ptab[63 - (int)(w2 & 63u)], a = ab >> 4, b = ab & 15;
            const float tsv = v1[a] + v2[b]; const int ee = ns[rw * 32 + a] * 128 + ns[rw * 32 + 16 + b];
            const float mx = row_max_f32(tsv), ex = __expf(tsv - mx), sm = row16_sum(ex);
            const int slot = (4 * bp + rw) * 16 + li;
            ((int*)(ws + WS_EX))[(size_t)t * 128 + slot] = ee; ((float*)(ws + WS_GT))[(size_t)t * 128 + slot] = ex / sm; }
        if (cv) { conv_row_store(P, crow, lane, v); crow += wstep; }
        sa = na; sc_ = nc;
    }
    for (; crow < 32768; crow += wstep) { const float* sr = (crow < 16384 ? P.peer_u : P.peer_v) + (size_t)(crow & 16383) * 2048 + lane * 4; f32x4 v[8];
#pragma unroll
        for (int k8 = 0; k8 < 8; ++k8) v[k8] = *(const f32x4*)(sr + k8 * 256);
        conv_row_store(P, crow, lane, v); }
}
#undef PK_CE

DI void peer_slice_map(const Params& P, LAS unsigned char* lds, int& vx, int& rank, int& nrank) {
    volatile LAS unsigned* misc = (volatile LAS unsigned*)(lds + LDS_MISC);
    const unsigned* bar = (const unsigned*)(P.ws + WS_BAR);
    const int xcc = (int)misc[4], rk = (int)misc[5];
    bool ok = true; int mine = 0;
#pragma unroll
    for (int j = 0; j < 16; ++j) { const unsigned c = __hip_atomic_load(bar + XB_XCNT(j), __ATOMIC_RELAXED, __HIP_MEMORY_SCOPE_AGENT); if (j < 8 ? c == 0u : c != 0u) ok = false; if (j == xcc) mine = (int)c; }
    if (ok && (P.ph_hi - P.ph_lo > 1)) { vx = xcc; rank = rk; nrank = mine; }
    else { vx = blockIdx.x & 7; rank = blockIdx.x >> 3; nrank = (gridDim.x + 7 - vx) >> 3; }
}
DI void phase_peer_a(const Params& P, LAS unsigned char* lds) {
    unsigned char* ws = P.ws; const int lane = threadIdx.x & 63, wave = __builtin_amdgcn_readfirstlane(threadIdx.x >> 6); int vx, rank, nrank; peer_slice_map(P, lds, vx, rank, nrank);
    const int gq = lane >> 4, li = lane & 15;
    LAS int* el = (LAS int*)(lds + wave * 1024);
    const unsigned char* PU = ws + WS_PU + (size_t)vx * 4194304; const unsigned li16 = (unsigned)li * 16u; const unsigned char* H8 = ws + WS_H2I8 + vx * 256 + li * 16;
    const float* HS = (const float*)(ws + WS_SU);
    _Float16* PA = (_Float16*)(ws + WS_PA) + (size_t)vx * NT * 128;
    int e0 = 0, e1 = 0; u32x4 hn = {0u, 0u, 0u, 0u}; float hsn = 0.f;
    { const int t0 = rank * 8 + wave; if (t0 < NT) { const int* exg = (const int*)(ws + WS_EX) + (size_t)t0 * 128; e0 = exg[lane]; e1 = exg[64 + lane]; hn = *(const u32x4*)(H8 + (size_t)t0 * 2048); hsn = HS[(size_t)t0 * 8 + vx]; } }
    for (int t = rank * 8 + wave; t < NT; t += nrank * 8) {
        el[lane] = e0; el[64 + lane] = e1;
        const u32x4 hq = hn; const float hs = hsn;
        { const int tn = t + nrank * 8 < NT ? t + nrank * 8 : t; const int* exg = (const int*)(ws + WS_EX) + (size_t)tn * 128; e0 = exg[lane]; e1 = exg[64 + lane]; hn = *(const u32x4*)(H8 + (size_t)tn * 2048); hsn = HS[(size_t)tn * 8 + vx]; }
#pragma unroll
        for (int jb = 0; jb < 32; jb += 8) {
            u32x4 rw[8];
#pragma unroll
            for (int i = 0; i < 8; ++i) { const unsigned ex = (unsigned)el[4 * (jb + i) + gq]; rw[i] = *(const u32x4*)(PU + (ex * 256u + li16)); }
            float pr[8];
#pragma unroll
            for (int i = 0; i < 8; ++i) { int a = 0;
#pragma unroll
                for (int q = 0; q < 4; ++q) a = __builtin_amdgcn_sdot4((int)rw[i][q], (int)hq[q], a, false);
                pr[i] = (float)a; }
            const float tot = reduce8_row16(pr, li);
            if (!(li & 1)) PA[(size_t)t * 128 + 4 * (jb + (li >> 1)) + gq] = (_Float16)(tot * hs);
        }
    }
}
DI float xor16_max(float x) { const auto r = __builtin_amdgcn_permlane16_swap(__float_as_uint(x), __float_as_uint(x), false, false); return fmaxf(__uint_as_float(r[0]), __uint_as_float(r[1])); }
DI void phase_peer_w(const Params& P) {
    unsigned char* ws = P.ws; const _Float16* PA = (const _Float16*)(ws + WS_PA); const float* GT = (const float*)(ws + WS_GT); const int* EX = (const int*)(ws + WS_EX); const float* PS = (const float*)(ws + WS_PSU);
    const int lane = threadIdx.x & 63, wave = __builtin_amdgcn_readfirstlane(threadIdx.x >> 6), d = lane & 31, gq = d >> 3;
    for (int t2 = (blockIdx.x * 8 + wave) * 2; t2 < NT; t2 += gridDim.x * 16) { const int t = t2 + (lane >> 5);
        float w[4], m = 0.f;
#pragma unroll
        for (int k = 0; k < 4; ++k) { const size_t i = (size_t)t * 128 + 16 * (d & 7) + 4 * k + gq; float a = 0.f;
#pragma unroll
            for (int x = 0; x < 8; ++x) a += (float)PA[(size_t)x * NT * 128 + i];
            const int ee = EX[i];
            w[k] = GT[i] * PS[16384 + ee] * gelu_tanh(a * PS[ee]); m = fmaxf(m, fabsf(w[k])); }
        m = xor16_max(row_max_f32(m));
        const float qs = m > 0.f ? 127.f / m : 0.f; unsigned pk = 0u;
#pragma unroll
        for (int k = 0; k < 4; ++k) pk = __builtin_amdgcn_cvt_pk_u8_f32(__builtin_rintf(w[k] * qs) + 128.f, k, pk);
        ((unsigned*)(ws + WS_W8))[(size_t)t * 32 + d] = pk ^ 0x80808080u;
        if (d == 0) ((float*)(ws + WS_WT))[t] = m * (1.f / 127.f);
    }
    for (size_t i = (size_t)blockIdx.x * 512 + threadIdx.x; i < (size_t)NT * 8; i += (size_t)gridDim.x * 512) ((unsigned*)(ws + WS_SS))[i] = 0xFFFFFFFFu;
}
DI void peer_b_finish(unsigned* SSN, float* out, int tp, const f32x4& yp, unsigned sv, const f32x4& fg, int d, int lane) {
    while (__builtin_amdgcn_ballot_w64(sv == 0xFFFFFFFFu) != 0ull) { __builtin_amdgcn_s_sleep(1); sv = lane < 8 ? xb_ld(SSN + (size_t)tp * 8 + lane) : 0u; }
    const float tot = __builtin_amdgcn_readfirstlane(row16_sum(__uint_as_float(sv)));
    const float rs = rsqrtf(tot * (1.f / 2048.f) + 1e-6f);
    f32x4 o;
#pragma unroll
    for (int e = 0; e < 4; ++e) o[e] = yp[e] * rs * fg[e];
    *(f32x4*)(out + (size_t)tp * 2048 + d) = o;
}
DI void phase_peer_b(const Params& P, LAS unsigned char* lds) {
    unsigned char* ws = P.ws; const int lane = threadIdx.x & 63, wave = __builtin_amdgcn_readfirstlane(threadIdx.x >> 6); int vx, rank, nrank; peer_slice_map(P, lds, vx, rank, nrank);
    const int gq = lane >> 4, li = lane & 15;
    LAS int* el = (LAS int*)(lds + wave * 1024);
    const unsigned char* PV = ws + WS_PV + (size_t)vx * 4194304; const unsigned li16 = (unsigned)li * 16u;
    const bf16_t* X1 = (const bf16_t*)(ws + WS_X1); const float* mod = (const float*)(ws + WS_MOD);
    const unsigned char* W8 = ws + WS_W8 + gq * 32; const float* WT = (const float*)(ws + WS_WT);
    unsigned* SSN = (unsigned*)(ws + WS_SS);
    const int cq = ((gq & 1) << 1) | (gq >> 1); const int d = vx * 256 + li * 16 + 4 * cq;
    const f32x4 fg = *(const f32x4*)(P.final_g + d);
    f32x4 yA = {0.f, 0.f, 0.f, 0.f}, yB = {0.f, 0.f, 0.f, 0.f}; int tA = -1, tB = -1;
    int e0 = 0, e1 = 0; u32x2 wn[4]; float wtn = 0.f;
#pragma unroll
    for (int j = 0; j < 4; ++j) wn[j] = (u32x2){0u, 0u};
    { const int t0 = rank * 8 + wave; if (t0 < NT) { const int* exg = (const int*)(ws + WS_EX) + (size_t)t0 * 128; e0 = exg[lane]; e1 = exg[64 + lane];
#pragma unroll
        for (int j = 0; j < 4; ++j) wn[j] = *(const u32x2*)(W8 + (size_t)t0 * 128 + 8 * j);
        wtn = WT[t0]; } }
    for (int t = rank * 8 + wave; t < NT; t += nrank * 8) {
        el[lane] = e0; el[64 + lane] = e1;
        u32x2 wq[4];
#pragma unroll
        for (int j = 0; j < 4; ++j) wq[j] = wn[j];
        const float wt = wtn;
        { const int tn = t + nrank * 8 < NT ? t + nrank * 8 : t; const int* exg = (const int*)(ws + WS_EX) + (size_t)tn * 128; e0 = exg[lane]; e1 = exg[64 + lane];
#pragma unroll
          for (int j = 0; j < 4; ++j) wn[j] = *(const u32x2*)(W8 + (size_t)tn * 128 + 8 * j);
          wtn = WT[tn]; }
        const u32x2 xw = *(const u32x2*)(X1 + (size_t)t * 2048 + d); const f32x4 ga = *(const f32x4*)(mod + (t >> 12) * 12288 + 10240 + d);
        int acc[16]; unsigned sv = 0u;
        if (tA >= 0 && lane < 8) sv = xb_ld(SSN + (size_t)tA * 8 + lane);
#pragma unroll
        for (int i = 0; i < 16; ++i) acc[i] = 0;
#pragma unroll
        for (int jb = 0; jb < 32; jb += 8) {
            u32x4 rw[8];
#pragma unroll
            for (int i = 0; i < 8; ++i) { const unsigned ex = (unsigned)el[4 * (jb + i) + gq]; rw[i] = *(const u32x4*)(PV + (ex * 256u + li16)); }
#pragma unroll
            for (int h = 0; h < 2; ++h) { const int w4 = (int)wq[jb >> 3][h];
#pragma unroll
                for (int q = 0; q < 4; ++q) { const unsigned e0 = rw[4 * h][q], e1 = rw[4 * h + 1][q], e2 = rw[4 * h + 2][q], e3 = rw[4 * h + 3][q];
                    const unsigned t0 = __builtin_amdgcn_perm(e1, e0, 0x05010400u), t1 = __builtin_amdgcn_perm(e1, e0, 0x07030602u), t2 = __builtin_amdgcn_perm(e3, e2, 0x05010400u), t3 = __builtin_amdgcn_perm(e3, e2, 0x07030602u);
                    acc[4 * q + 0] = __builtin_amdgcn_sdot4((int)__builtin_amdgcn_perm(t2, t0, 0x05040100u), w4, acc[4 * q + 0], false);
                    acc[4 * q + 1] = __builtin_amdgcn_sdot4((int)__builtin_amdgcn_perm(t2, t0, 0x07060302u), w4, acc[4 * q + 1], false);
                    acc[4 * q + 2] = __builtin_amdgcn_sdot4((int)__builtin_amdgcn_perm(t3, t1, 0x05040100u), w4, acc[4 * q + 2], false);
                    acc[4 * q + 3] = __builtin_amdgcn_sdot4((int)__builtin_amdgcn_perm(t3, t1, 0x07060302u), w4, acc[4 * q + 3], false); } }
        }
        float v16[16], w8[8], o4[4];
#pragma unroll
        for (int i = 0; i < 16; ++i) v16[i] = (float)acc[i] * wt;
#pragma unroll
        for (int k = 0; k < 8; ++k) { const auto r = __builtin_amdgcn_permlane16_swap(__float_as_uint(v16[k]), __float_as_uint(v16[8 + k]), false, false); w8[k] = __uint_as_float(r[0]) + __uint_as_float(r[1]); }
#pragma unroll
        for (int k = 0; k < 4; ++k) { const auto r = __builtin_amdgcn_permlane32_swap(__float_as_uint(w8[k]), __float_as_uint(w8[4 + k]), false, false); o4[k] = __uint_as_float(r[0]) + __uint_as_float(r[1]); }
        const f32x4 xa = {bf_lo(xw[0]), bf_hi(xw[0]), bf_lo(xw[1]), bf_hi(xw[1])};
        f32x4 y; float ss = 0.f;
#pragma unroll
        for (int e = 0; e < 4; ++e) { y[e] = xa[e] + ga[e] * o4[e]; ss += y[e] * y[e]; }
        ss = wave_sum(ss); if (lane == 0) { unsigned sb_ = __float_as_uint(ss); sb_ = sb_ == 0xFFFFFFFFu ? 0x7FC00000u : sb_;
            __hip_atomic_store(SSN + (size_t)t * 8 + vx, sb_, __ATOMIC_RELAXED, __HIP_MEMORY_SCOPE_AGENT); }
        if (tA >= 0) peer_b_finish(SSN, P.out, tA, yA, sv, fg, d, lane);
        tA = tB; yA = yB; tB = t; yB = y;
    }
    if (tA >= 0) peer_b_finish(SSN, P.out, tA, yA, 0xFFFFFFFFu, fg, d, lane);
    if (tB >= 0) peer_b_finish(SSN, P.out, tB, yB, 0xFFFFFFFFu, fg, d, lane);
}


constexpr int N_PHASES = 15;
template <int K> DI void run_phase(const Params& P, LAS unsigned char* lds) {
    unsigned char* ws = P.ws; const int G = gridDim.x, bx = blockIdx.x, tid = threadIdx.x; (void)G; (void)bx; (void)tid;
    if constexpr (K == 0) { p0_prologue(P, lds); }
    if constexpr (K == 1) { phase_norm_f8(P.x, P.norm_mix_g, (const float*)(ws + WS_MOD), 0, 2048, ws + WS_H, (float*)(ws + WS_HSC)); }
    if constexpr (K == 2) {
        { pg8::Gemm g{(const bf16_t*)(ws + WS_H), (const bf16_t*)(ws + WS_WIN), 2048, 2048, 2048}; pg8::StaticOrder S; S.init(NT, NPROJ, G, bx); EpiProj E{ws, (const float*)(ws + WS_HSC)};
          pg8::gemm_phase<EpiProj, pg8::StaticOrder, true>(lds, g, S, E); }
        { pg8::Gemm g{(const bf16_t*)(ws + WS_KBD), (const bf16_t*)(ws + WS_WQ), 2048, 2048, 256, 512}; pg8::StaticOrder S; S.init(2048, 2048, G, (bx + 64) % G); EpiBf16Plain E{(bf16_t*)(ws + WS_WSC), 2048};
          pg8::gemm_phase<EpiBf16Plain, pg8::StaticOrder>(lds, g, S, E); }
    }
    if constexpr (K == 3) {
        { pg8::Gemm g{(const bf16_t*)(ws + WS_A2), (const bf16_t*)(ws + WS_S5B1), 384, 256, 256}; GroupOrder S{256, G, bx, 4}; EpiS5G1 E{(float*)(ws + WS_XL)};
          pg8::gemm_phase<EpiS5G1, GroupOrder>(lds, g, S, E); }
        { pg8::Gemm g{(const bf16_t*)(ws + WS_KV), (const bf16_t*)(ws + WS_WC1), 1024, 2048, 2048}; GroupOrder S{32, G, (bx + 128) % G, 16}; EpiCmp1 E{(bf16_t*)(ws + WS_HID), (const float*)(ws + WS_CB)};
          pg8::gemm_phase<EpiCmp1, GroupOrder>(lds, g, S, E); }
        phase_attn_win_early(P, lds);
    }
    if constexpr (K == 4) { phase_scan(P); phase_cmp2(P); }
    if constexpr (K == 5) {
        { pg8::Gemm g{(const bf16_t*)(ws + WS_A2), (const bf16_t*)(ws + WS_S5B2), 384, 384, 384}; GroupOrder S{256, G, bx, 4}; EpiS5G2 E{(bf16_t*)(ws + WS_YACT)};
          pg8::gemm_phase<EpiS5G2, GroupOrder>(lds, g, S, E); }
        phase_attn_cmp_win(P, lds);
    }
    if constexpr (K == 6) {
        { pg8::Gemm g{(const bf16_t*)(ws + WS_YACT), (const bf16_t*)(ws + WS_WGLU), 1024, 1024, 1024}; pg8::StaticOrder S; S.init(NT, 1024, G, bx); EpiGlu E{(const bf16_t*)(ws + WS_YACT), (bf16_t*)(ws + WS_Y2), P.glu_b};
          pg8::gemm_phase<EpiGlu, pg8::StaticOrder>(lds, g, S, E); }
        phase_attn_sel(P, lds);
    }
    if constexpr (K == 7) {
        pg8::Gemm g{(const bf16_t*)(ws + WS_OATT), (const bf16_t*)(ws + WS_WUA), 2048, 2048, 2048}; pg8::StaticOrder S; S.init(NT, 2048, G, bx); EpiUpF E{ws + WS_MG, ws + WS_MIX};
        pg8::gemm_phase<EpiUpF, pg8::StaticOrder, true>(lds, g, S, E);
    }
    if constexpr (K == 8) {
        pg8::Gemm g{(const bf16_t*)(ws + WS_MIX), (const bf16_t*)(ws + WS_WOUT), 2048, 2048, 2048}; pg8::StaticOrder S; S.init(NT, 2048, G, bx); EpiOut E{P.x, (const float*)(ws + WS_MOD), (bf16_t*)(ws + WS_X1)};
        pg8::gemm_phase<EpiOut, pg8::StaticOrder, true>(lds, g, S, E);
    }
    if constexpr (K == 9) {
        phase_norm((const bf16_t*)(ws + WS_X1), P.norm_ffn_g, (const float*)(ws + WS_MOD), 6144, 8192, (bf16_t*)(ws + WS_H2), ws + WS_H2I8, (float*)(ws + WS_SU));
    }
    if constexpr (K == 10) {
        pg8::Gemm g{(const bf16_t*)(ws + WS_H2), (const bf16_t*)(ws + WS_WSC), 2048, 2048, 2048}; pg8::StaticOrder S; S.init(NT, 2048, G, bx); EpiF16Plain E{(unsigned short*)(ws + WS_SC), 2048};
        pg8::gemm_phase<EpiF16Plain, pg8::StaticOrder>(lds, g, S, E);
    }
    if constexpr (K == 11) { phase_peer(P, lds); }
    if constexpr (K == 12) { phase_peer_a(P, lds); }
    if constexpr (K == 13) { phase_peer_w(P); }
    if constexpr (K == 14) { phase_peer_b(P, lds); }
}

__global__ void __launch_bounds__(512, 2) mk_fwd(Params P) {
    extern __shared__ __attribute__((aligned(16))) unsigned char lds_raw[];
    LAS unsigned char* lds = (LAS unsigned char*)lds_raw;
    unsigned char* ws = P.ws;
    const int G = gridDim.x, bx = blockIdx.x, tid = threadIdx.x;
    volatile LAS unsigned* misc = (volatile LAS unsigned*)(lds + LDS_MISC);
    if (tid < 8) misc[tid] = 0u;
    __syncthreads();
    const int lo = P.ph_lo, hi = P.ph_hi;
    XcdBarrier bar; bar.bar = (unsigned*)(ws + WS_BAR); bar.x = 0; bar.st = misc;
    if (hi - lo > 1) bar = xcd_barrier_post((unsigned*)(ws + WS_BAR), misc);
    if (tid == 0) { const unsigned xcc = xb_xcc_id(); misc[4] = xcc; misc[5] = (hi - lo > 1) ? xb_add((unsigned*)(ws + WS_BAR) + 8192 + 64 * (xcc & 15u), 1u) : 0u; }
    __syncthreads();
#define IN(k) (lo <= (k) && (k) < hi)
#define SEAM(k) do { if (IN(k) && IN((k) + 1)) xcd_barrier(bar); } while (0)

    if (IN(0)) run_phase<0>(P, lds);
    SEAM(0);
    if (IN(1)) run_phase<1>(P, lds);
    SEAM(1);
    if (IN(2)) run_phase<2>(P, lds);
    SEAM(2);
    if (IN(3)) run_phase<3>(P, lds);
    SEAM(3);
    if (IN(4)) run_phase<4>(P, lds);
    SEAM(4);
    if (IN(5)) run_phase<5>(P, lds);
    SEAM(5);
    if (IN(6)) run_phase<6>(P, lds);
    SEAM(6);
    if (IN(7)) run_phase<7>(P, lds);
    SEAM(7);
    if (IN(8)) run_phase<8>(P, lds);
    SEAM(8);
    if (IN(9)) run_phase<9>(P, lds);
    SEAM(9);
    if (IN(10)) run_phase<10>(P, lds);
    SEAM(10);
    if (IN(11)) run_phase<11>(P, lds);
    SEAM(11);
    if (IN(12)) run_phase<12>(P, lds);
    SEAM(12);
    if (IN(13)) run_phase<13>(P, lds);
    SEAM(13);
    if (IN(14)) run_phase<14>(P, lds);
#undef IN
#undef SEAM
}

extern "C" void kernel_launch(void* const* d_in, const int* in_sizes, int n_in, void* d_out, int out_size, void* d_ws, size_t ws_size, hipStream_t stream) {
    static int grid = 0;
    if (grid == 0) {
        if (n_in != 31 || ws_size < WS_END) { fprintf(stderr, "kernel_launch: expected 31 inputs and >= %zu bytes of workspace (got %d, %zu)\n", (size_t)WS_END, n_in, ws_size); grid = -1; return; }
        int dev = 0, cus = 0, per_cu = 0;
        if (hipGetDevice(&dev) != hipSuccess || hipDeviceGetAttribute(&cus, hipDeviceAttributeMultiprocessorCount, dev) != hipSuccess) { grid = -1; return; }
        if (hipFuncSetAttribute((const void*)mk_fwd, hipFuncAttributeMaxDynamicSharedMemorySize, LDS_BYTES) != hipSuccess) { fprintf(stderr, "kernel_launch: hipFuncSetAttribute failed\n"); grid = -1; return; }
        if (hipOccupancyMaxActiveBlocksPerMultiprocessor(&per_cu, (const void*)mk_fwd, 512, LDS_BYTES) != hipSuccess || per_cu < 1) { fprintf(stderr, "kernel_launch: occupancy query reports %d blocks per CU\n", per_cu); (void)hipGetLastError(); grid = -1; return; }
        grid = cus;
    }
    if (grid < 0) return;
    (void)hipMemsetAsync((char*)d_ws + WS_BAR, 0, 65536, stream);
    Params p{};
    const float** f = (const float**)&p;
    for (int i = 0; i < 31; ++i) f[i] = (const float*)d_in[i];
    p.out = (float*)d_out; p.ws = (unsigned char*)d_ws;
#if MK_PER_PHASE
    for (int ph = 0; ph < N_PHASES; ++ph) { p.ph_lo = ph; p.ph_hi = ph + 1; hipLaunchKernelGGL(mk_fwd, dim3(grid), dim3(512), LDS_BYTES, stream, p); }
#else
    p.ph_lo = 0; p.ph_hi = N_PHASES; hipLaunchKernelGGL(mk_fwd, dim3(grid), dim3(512), LDS_BYTES, stream, p);
#endif
}
```

```cpp
#include <hip/hip_runtime.h>
#include <stdint.h>
#include <stdio.h>
#include <math.h>
#include <type_traits>


#ifndef MK_PER_PHASE
#define MK_PER_PHASE 0
#endif

#define XB_TMO      128
#define XB_XCNT(j)  (256  + 64 * (j))
#define XB_XSUB(j)  (1280 + 64 * (j))
#define XB_XGEN(j)  (2304 + 64 * (j))
#define XB_TOP      3328
#define XB_TOPGEN   3392
#define XCD_BAR_WORDS 3456
#define XB_SPIN_CAP (1u << 18)
#define LAS __attribute__((address_space(3)))

__device__ __forceinline__ unsigned xb_ld(unsigned* p)              { return __hip_atomic_load(p, __ATOMIC_RELAXED, __HIP_MEMORY_SCOPE_AGENT); }
__device__ __forceinline__ unsigned xb_add(unsigned* p, unsigned v) { return __hip_atomic_fetch_add(p, v, __ATOMIC_RELAXED, __HIP_MEMORY_SCOPE_AGENT); }
__device__ __forceinline__ unsigned xb_xcc_id() { return (unsigned)__builtin_amdgcn_s_getreg((3 << 11) | 20) & 0xFu; }
#define XB_SPIN(cond, bar) do { unsigned _sp = 0; while (cond) { __builtin_amdgcn_s_sleep(1); \
    if ((++_sp & 255u) == 0u) { if (xb_ld(&(bar)[XB_TMO])) break; if (_sp > XB_SPIN_CAP) { atomicAdd(&(bar)[XB_TMO], 1u); break; } } } } while (0)

struct XcdBarrier {
    unsigned* bar; unsigned x;
    volatile LAS unsigned* st;
};

__device__ __forceinline__ XcdBarrier xcd_barrier_post(unsigned* bar, volatile LAS unsigned* st) {
    XcdBarrier b; b.bar = bar; b.x = xb_xcc_id(); b.st = st;
    if (threadIdx.x == 0) (void)xb_add(&bar[XB_XCNT(b.x)], 1u);
    return b;
}
__device__ __forceinline__ void xcd_barrier_complete(unsigned* bar, unsigned x, unsigned& nloc, unsigned& nx) {
    const unsigned G = gridDim.x * gridDim.y * gridDim.z;
    unsigned sum, cnt, mine, sp = 0u;
    for (;;) {
        sum = 0u; cnt = 0u; mine = 0u;
#pragma unroll
        for (unsigned j = 0; j < 16; ++j) { const unsigned c = xb_ld(&bar[XB_XCNT(j)]); sum += c; cnt += (c > 0u) ? 1u : 0u; mine = (j == x) ? c : mine; }
        if (sum == G) break;
        __builtin_amdgcn_s_sleep(1);
        if ((++sp & 255u) == 0u) { if (xb_ld(&bar[XB_TMO])) break; if (sp > XB_SPIN_CAP) { atomicAdd(&bar[XB_TMO], 1u); break; } }
    }
    nloc = mine > 0u ? mine : 1u; nx = cnt > 0u ? cnt : 1u;
}

__device__ __forceinline__ void xcd_barrier(const XcdBarrier& b) {
    asm volatile("s_waitcnt vmcnt(0)" ::: "memory");
    __syncthreads();
    if (threadIdx.x == 0) {
        unsigned* bar = b.bar;
        __builtin_amdgcn_s_waitcnt(0);
        unsigned nloc = b.st[0], nx = b.st[1];
        if (nloc == 0u) { xcd_barrier_complete(bar, b.x, nloc, nx); b.st[0] = nloc; b.st[1] = nx; }
        const unsigned old = xb_add(&bar[XB_XSUB(b.x)], 1u);
        const unsigned gen = old / nloc;
        if (old + 1u == (gen + 1u) * nloc) {
            __builtin_amdgcn_fence(__ATOMIC_RELEASE, "agent");
            asm volatile("s_waitcnt vmcnt(0)" ::: "memory");
            const unsigned og = xb_add(&bar[XB_TOP], 1u);
            const unsigned tg = og / nx;
            if (og + 1u == (tg + 1u) * nx) xb_add(&bar[XB_TOPGEN], 1u);
            else XB_SPIN(xb_ld(&bar[XB_TOPGEN]) == tg, bar);
            __builtin_amdgcn_fence(__ATOMIC_ACQUIRE, "agent");
            xb_add(&bar[XB_XGEN(b.x)], 1u);
            asm volatile("s_waitcnt vmcnt(0)" ::: "memory");
        } else {
            XB_SPIN(xb_ld(&bar[XB_XGEN(b.x)]) == gen, bar);
            __builtin_amdgcn_fence(__ATOMIC_ACQUIRE, "agent");
            asm volatile("s_waitcnt vmcnt(0)" ::: "memory");
        }
    }
    __syncthreads();
}


namespace pg8 {
#define PG8_LAS __attribute__((address_space(3)))
typedef unsigned short bf16_t;
typedef short bf16x8 __attribute__((ext_vector_type(8)));
typedef float f32x4 __attribute__((ext_vector_type(4)));
typedef unsigned u32x4 __attribute__((ext_vector_type(4)));
constexpr int BM = 256, BK = 64, HALF = 128, HTB = HALF * BK * 2  , STAGE_BYTES = 8 * HTB, NXCD = 8, WGM = 8;

__host__ __device__ __forceinline__ int lds_byte(int r, int c) { const int st = (r >> 4) * 2 + (c >> 5), rr = r & 15, cc = c & 31, ob = rr * 64 + cc * 2; return st * 1024 + (ob ^ (((ob >> 9) & 1) << 5)); }
__host__ __device__ __forceinline__ void stage_rc(int b, int& R, int& C) { const int st = b / 1024, sb = b % 1024, swz = sb ^ (((sb >> 9) & 1) << 5); R = (st >> 1) * 16 + swz / 64; C = (st & 1) * 32 + (swz % 64) / 2; }
__host__ __device__ __forceinline__ int perm32(int rho) { const int n = rho >> 4, i = rho & 15; return 8 * (i >> 2) + 4 * n + (i & 3); }

struct Unit { int pm, pn; };
struct Gemm { const bf16_t* A; const bf16_t* Bt; int lda, ldb, K; int kdiag = 0; };
struct StaticOrder {
    int nM, nN, nwg, G, c;
    __host__ __device__ void init(int M, int N, int G_, int c_) { nM = M / BM; nN = N / BM; nwg = nM * nN; G = G_; c = c_; }
    __host__ __device__ bool next(int i, Unit& u) const {
        const long L = (long)i * G + c; if (L >= nwg) return false;
        int wgid = (int)L; { const int q = nwg / NXCD, r = nwg % NXCD, xcd = wgid % NXCD, off = wgid / NXCD; wgid = (xcd < r ? xcd * (q + 1) : r * (q + 1) + (xcd - r) * q) + off; }
        const int nig = WGM * nN, gid = wgid / nig, fm = gid * WGM, gsz = (nM - fm) < WGM ? (nM - fm) : WGM;
        u.pm = fm + ((wgid % nig) % gsz); u.pn = (wgid % nig) / gsz; return true;
    }
    __device__ __forceinline__ void a_ready(const Unit&) const {}
    __device__ __forceinline__ void done(const Unit&) const {}
};
typedef int pg8_i4 __attribute__((ext_vector_type(4)));
typedef int pg8_i8 __attribute__((ext_vector_type(8)));
template <bool F8> struct FragSel { struct T { bf16x8 k[2]; }; };
template <> struct FragSel<true> { typedef pg8_i8 T; };
template <class Epi, class Sched, bool F8 = false>
__device__ __forceinline__ void gemm_phase(PG8_LAS unsigned char* lds, const Gemm g, const Sched& S, const Epi& E) {
    const int tid = threadIdx.x, wid = __builtin_amdgcn_readfirstlane(tid >> 6), lane = tid & 63, wr = wid >> 2, wc = wid & 3, fr = lane & 15, fq = lane >> 4;
    constexpr int ES = F8 ? 1 : 2;
    const int K = g.K, nt = K * ES / 128;
    unsigned voffA[2], voffB[2];
#pragma unroll
    for (int i = 0; i < 2; ++i) { int R, C; stage_rc(tid * 16 + i * 8192, R, C); const int Rb = Epi::PERM ? ((R & ~31) + perm32(R & 31)) : R;
        voffA[i] = (unsigned)(R * g.lda * ES + C * 2); voffB[i] = (unsigned)(Rb * g.ldb * ES + C * 2); }
    const size_t kstep = (size_t)(BK * 2);
    const size_t hstepA = (size_t)HALF * g.lda * ES, hstepB = (size_t)HALF * g.ldb * ES;
    const size_t tstepA = 2 * hstepA, tstepB = 2 * hstepB;
    const unsigned ldsw = (unsigned)wid * 1024u;
    const int aoff = lds_byte(wr * 64 + fr, fq * 8), boff = lds_byte(wc * 32 + fr, fq * 8);
#define PG8_SA(b, h) (((b) * 2 + (h)) * HTB)
#define PG8_SB(b, h) ((4 + (b) * 2 + (h)) * HTB)
#define PG8_STAGE(bufoff, gbase, voff) do { _Pragma("unroll") for (int _i = 0; _i < 2; ++_i) \
        __builtin_amdgcn_global_load_lds((const unsigned*)((const char*)(gbase) + (voff)[_i]), (PG8_LAS unsigned*)(lds + (bufoff) + ldsw + _i * 8192), 16, 0, 0); } while (0)
#define PG8_LDF(d_, p_) do { if constexpr (F8) d_ = __builtin_shufflevector(*(const PG8_LAS pg8_i4*)(p_), *(const PG8_LAS pg8_i4*)((p_) + 1024), 0, 1, 2, 3, 4, 5, 6, 7); \
        else { d_.k[0] = *(const PG8_LAS bf16x8*)(p_); d_.k[1] = *(const PG8_LAS bf16x8*)((p_) + 1024); } } while (0)
#define PG8_LDA(dst, b, h) do { _Pragma("unroll") for (int m = 0; m < 4; ++m) PG8_LDF(dst[m], lds + PG8_SA(b, h) + aoff + m * 2048); } while (0)
#define PG8_LDB(dst, b, h) do { _Pragma("unroll") for (int n = 0; n < 2; ++n) PG8_LDF(dst[n], lds + PG8_SB(b, h) + boff + n * 2048); } while (0)
#define PG8_MMA(ai, bj, At, Bt) do { __builtin_amdgcn_s_setprio(1); _Pragma("unroll") for (int m = 0; m < 4; ++m) _Pragma("unroll") for (int n = 0; n < 2; ++n) { \
        if constexpr (F8) asm volatile("v_mfma_scale_f32_16x16x128_f8f6f4 %0, %1, %2, %0, %3, %3 op_sel_hi:[0,0,0]" : "+v"(acc[ai][bj][m][n]) : "v"(Bt[n]), "v"(At[m]), "v"(sc1_));     \
        else { _Pragma("unroll") for (int k = 0; k < 2; ++k) acc[ai][bj][m][n] = __builtin_amdgcn_mfma_f32_16x16x32_bf16(Bt[n].k[k], At[m].k[k], acc[ai][bj][m][n], 0, 0, 0); } } __builtin_amdgcn_s_setprio(0); } while (0)
#define PG8_WAIT_V(n) asm volatile("s_waitcnt vmcnt(" #n ")" ::: "memory")
#define PG8_WAIT_L(n) asm volatile("s_waitcnt lgkmcnt(" #n ")" ::: "memory")
#define PG8_BAR __builtin_amdgcn_s_barrier()
#define PG8_SCHED __builtin_amdgcn_sched_barrier(0)
    Unit cur, nxt; int ui = 0;
    if (!S.next(0, cur)) return;
    f32x4 acc[2][2][4][2];
#pragma unroll
    for (int a = 0; a < 2; ++a)
#pragma unroll
        for (int b = 0; b < 2; ++b)
#pragma unroll
            for (int m = 0; m < 4; ++m)
#pragma unroll
                for (int n = 0; n < 2; ++n) acc[a][b][m][n] = (f32x4){0.f, 0.f, 0.f, 0.f};
    typedef typename FragSel<F8>::T frag_t;
    frag_t At[4], B0[2], B1[2];
    int sc1_ = 0x7F7F7F7F; if constexpr (F8) asm volatile("" : "+v"(sc1_));
    const char* cA = (const char*)g.A + (size_t)cur.pm * tstepA + (size_t)cur.pm * g.kdiag; const char* cB = (const char*)g.Bt + (size_t)cur.pn * tstepB + (size_t)cur.pm * g.kdiag;
    S.a_ready(cur);
    PG8_STAGE(PG8_SB(0, 0), cB, voffB); PG8_STAGE(PG8_SA(0, 0), cA, voffA); PG8_STAGE(PG8_SB(0, 1), cB + hstepB, voffB); PG8_STAGE(PG8_SA(0, 1), cA + hstepA, voffA);
    if (wr == 1) PG8_BAR;
    PG8_WAIT_V(4); PG8_BAR;
    PG8_STAGE(PG8_SB(1, 0), cB + kstep, voffB); PG8_STAGE(PG8_SA(1, 0), cA + kstep, voffA); PG8_STAGE(PG8_SB(1, 1), cB + hstepB + kstep, voffB);
    PG8_WAIT_V(6); PG8_BAR;
    for (;;) {
        const bool has_next = S.next(ui + 1, nxt);
        const char* nA = has_next ? (const char*)g.A + (size_t)nxt.pm * tstepA + (size_t)nxt.pm * g.kdiag : cA; const char* nB = has_next ? (const char*)g.Bt + (size_t)nxt.pn * tstepB + (size_t)nxt.pm * g.kdiag : cB;
        for (int t = 0; t < nt; t += 2) {
            const bool last = (t == nt - 2);
            const char* a1 = cA + (size_t)(t + 1) * kstep;
            const char* a2 = last ? nA : cA + (size_t)(t + 2) * kstep; const char* b2 = last ? nB : cB + (size_t)(t + 2) * kstep;
            const char* a3 = a2 + kstep; const char* b3 = b2 + kstep;
            if (last && has_next) S.a_ready(nxt);
            if constexpr (Epi::MIDK > 0) { if (t == Epi::MIDK) {
                if constexpr (F8) asm volatile("s_nop 15\n\ts_nop 7" ::: "memory");
                int fr_ = fr, fq_ = fq; asm volatile("" : "+v"(fr_), "+v"(fq_));
                E.mid(acc, cur, wr, wc, fr_, fq_);
                asm volatile("s_waitcnt vmcnt(0)\n\ts_nop 7" ::: "memory"); } }
            PG8_LDB(B0, 0, 0); PG8_SCHED; PG8_LDA(At, 0, 0); PG8_STAGE(PG8_SA(1, 1), a1 + hstepA, voffA);
            PG8_WAIT_L(8); PG8_BAR; PG8_WAIT_L(0); PG8_MMA(0, 0, At, B0); PG8_BAR; PG8_SCHED;
            PG8_LDB(B1, 0, 1); PG8_STAGE(PG8_SB(0, 0), b2, voffB);
            PG8_BAR; PG8_WAIT_L(0); PG8_MMA(0, 1, At, B1); PG8_BAR;
            PG8_LDA(At, 0, 1); PG8_STAGE(PG8_SA(0, 0), a2, voffA);
            PG8_BAR; PG8_WAIT_L(0); PG8_MMA(1, 0, At, B0); PG8_BAR; PG8_SCHED;
            PG8_STAGE(PG8_SB(0, 1), b2 + hstepB, voffB);
            PG8_WAIT_V(6); PG8_BAR; PG8_MMA(1, 1, At, B1); PG8_BAR;
            PG8_LDB(B0, 1, 0); PG8_SCHED; PG8_LDA(At, 1, 0); PG8_STAGE(PG8_SA(0, 1), a2 + hstepA, voffA);
            PG8_WAIT_L(8); PG8_BAR; PG8_WAIT_L(0); PG8_MMA(0, 0, At, B0); PG8_BAR; PG8_SCHED;
            PG8_LDB(B1, 1, 1); PG8_STAGE(PG8_SB(1, 0), b3, voffB);
            PG8_BAR; PG8_WAIT_L(0); PG8_MMA(0, 1, At, B1); PG8_BAR;
            PG8_LDA(At, 1, 1); PG8_STAGE(PG8_SA(1, 0), a3, voffA);
            PG8_BAR; PG8_WAIT_L(0); PG8_MMA(1, 0, At, B0); PG8_BAR; PG8_SCHED;
            PG8_STAGE(PG8_SB(1, 1), b3 + hstepB, voffB);
            PG8_WAIT_V(6); PG8_BAR; PG8_MMA(1, 1, At, B1); PG8_BAR;
        }
        if constexpr (F8) asm volatile("s_nop 15\n\ts_nop 7" ::: "memory");
        if constexpr (!Epi::AFTER_DRAIN) { int fr_ = fr, fq_ = fq; asm volatile("" : "+v"(fr_), "+v"(fq_));
            E(acc, cur, wr, wc, fr_, fq_); S.done(cur); }
        if (!has_next) break;
#pragma unroll
        for (int a = 0; a < 2; ++a)
#pragma unroll
            for (int b = 0; b < 2; ++b)
#pragma unroll
                for (int m = 0; m < 4; ++m)
#pragma unroll
                    for (int n = 0; n < 2; ++n) acc[a][b][m][n] = (f32x4){0.f, 0.f, 0.f, 0.f};
        cur = nxt; cA = nA; cB = nB; ++ui;
    }
    PG8_WAIT_V(0);
    if (wr == 0) PG8_BAR;
    PG8_BAR;
    if constexpr (Epi::AFTER_DRAIN) { E.fused(acc, cur, wr, wc, fr, fq, lds, wid, lane); S.done(cur); }
#undef PG8_SA
#undef PG8_SB
#undef PG8_STAGE
#undef PG8_LDF
#undef PG8_LDA
#undef PG8_LDB
#undef PG8_MMA
#undef PG8_WAIT_V
#undef PG8_WAIT_L
#undef PG8_BAR
#undef PG8_SCHED
}
}

typedef unsigned short bf16_t;
typedef short bf16x8 __attribute__((ext_vector_type(8)));
typedef short s16x4 __attribute__((ext_vector_type(4)));
typedef float f32x2 __attribute__((ext_vector_type(2)));
typedef float f32x4 __attribute__((ext_vector_type(4)));
typedef float f32x16 __attribute__((ext_vector_type(16)));
typedef unsigned u32x2 __attribute__((ext_vector_type(2)));
typedef unsigned u32x4 __attribute__((ext_vector_type(4)));
typedef __bf16 bf16v2 __attribute__((ext_vector_type(2)));

constexpr int NB = 4, SEQ = 4096, NT = NB * SEQ, DM = 2048;
constexpr int NPROJ = 7936;
constexpr int NCMP = 255;
constexpr float QSCALE = 0.125f * 1.4426950408889634f;
constexpr float LOG2E = 1.4426950408889634f;
constexpr float NEGBIG = -1e30f;
constexpr float OATT_SCALE = 64.f, Y2_SCALE = 16.f, MIX_SCALE = 64.f; constexpr int UA_LD = 2048;

constexpr size_t WS_BAR   = 0;
constexpr size_t WS_MOD   = 65536;
constexpr size_t WS_CB    = WS_MOD + 196608;
constexpr size_t WS_A16   = WS_CB + 2048;
constexpr size_t WS_W     = 327680;
constexpr size_t WS_WIN   = WS_W;
constexpr size_t WS_WGLU  = WS_WIN + (size_t)NPROJ * 2048 * 2;
constexpr size_t WS_WUA   = WS_WGLU + 2097152;
constexpr size_t WS_WUS   = WS_WUA + 4194304;
constexpr size_t WS_WOUT  = WS_WUS + 4194304;
constexpr size_t WS_WQ    = WS_WOUT + 8388608;
constexpr size_t WS_KBD   = WS_WQ + 8388608;
constexpr size_t WS_WSC   = WS_KBD + 8388608;
constexpr size_t WS_WC1   = WS_WSC + 8388608;
constexpr size_t WS_S5B1  = WS_WC1 + 2097152;
constexpr size_t WS_S5B2  = WS_S5B1 + 8388608;
constexpr size_t WS_HID   = WS_S5B2 + 12582912;
constexpr size_t WS_CKV   = WS_HID + 4194304;
constexpr size_t WS_GATE  = WS_CKV + 1048576;
constexpr size_t WS_SELM  = WS_GATE + 3145728;
constexpr size_t WS_RA    = WS_SELM + 524288;
constexpr size_t WS_RB    = WS_RA + 67108864;
constexpr size_t WS_RC    = WS_RB + 134217728;
constexpr size_t WS_RD    = WS_RC + 134217728;
constexpr size_t WS_END   = WS_RD + 134217728;
constexpr size_t WS_H = WS_RA, WS_HSC = WS_RD + 104857600  , WS_OC = WS_RA, WS_OW = WS_RA + 33554432, WS_MIX = WS_RA, WS_H2 = WS_RA;
constexpr size_t WS_MG = WS_RB, WS_SC = WS_RB;
constexpr size_t WS_Q = WS_RC, WS_KV = WS_RC + 33554432, WS_A2 = WS_KV + 6 * 8388608, WS_X1 = WS_RC, WS_H2I8 = WS_RC + 67108864  ;
constexpr size_t WS_XL = WS_RD, WS_YACT = WS_RD + 33554432, WS_OATT = WS_RD + 67108864  , WS_Y2 = WS_OATT + 1024, WS_TMP = WS_RD, WS_PU = WS_RD, WS_PV = WS_RD + 33554432, WS_PSU = WS_RD + 67108864, WS_PSV = WS_RD + 67108864 + 65536, WS_EX = WS_RD + 68157440, WS_GT = WS_EX + 8388608, WS_SS = WS_GT + 8388608, WS_SU = WS_SS + 1048576  , WS_W8 = WS_SU + 1048576  , WS_WT = WS_SU + 4194304  , WS_PA = WS_RB;

constexpr int LDS_BYTES = 147456;
constexpr int LDS_MISC = 131072;

struct Params {
    const float* x; const float* c; const float* ada_w; const float* ada_b; const float* norm_mix_g; const float* norm_ffn_g; const float* w_in;
    const float* cmp_pos; const float* cmp_w1; const float* cmp_b1; const float* cmp_w2; const float* cmp_b2; const float* rel_bias;
    const float* s5_lam_re; const float* s5_lam_im; const float* s5_log_step; const float* s5_b_re; const float* s5_b_im; const float* s5_c_re; const float* s5_c_im; const float* s5_d;
    const float* glu_w; const float* glu_b; const float* w_up_attn; const float* w_up_ssm; const float* w_out; const float* peer_w_q; const float* peer_sub_keys;
    const float* peer_u; const float* peer_v; const float* final_g;
    float* out; unsigned char* ws; int ph_lo, ph_hi;
};

#define DI __device__ __forceinline__
DI unsigned pk_bf16(float lo, float hi) { bf16v2 v; v[0] = (__bf16)lo; v[1] = (__bf16)hi; return __builtin_bit_cast(unsigned, v); }
DI bf16_t f2bf(float x) { return (bf16_t)(pk_bf16(x, 0.f) & 0xffffu); }
DI float bf_lo(unsigned u) { return __uint_as_float(u << 16); }
DI float bf_hi(unsigned u) { return __uint_as_float(u & 0xffff0000u); }
DI float bf2f(bf16_t b) { return __uint_as_float(((unsigned)b) << 16); }
DI bf16v2 bf16pair(unsigned w) { return __builtin_bit_cast(bf16v2, w); }
DI float dot2_bf16(unsigned w, unsigned x, float acc) { return __builtin_amdgcn_fdot2_f32_bf16(__builtin_bit_cast(bf16v2, w), __builtin_bit_cast(bf16v2, x), acc, false); }
DI float sigm(float x) { return __builtin_amdgcn_rcpf(1.f + __builtin_amdgcn_exp2f(-1.4426950408889634f * x)); }
DI float gelu_tanh(float x) { const float u = 1.5957691216f * (x + 0.044715f * x * x * x); return x * __builtin_amdgcn_rcpf(1.f + __builtin_amdgcn_exp2f(-1.4426950408889634f * u)); }
DI float xor32_add(float x) { const auto r = __builtin_amdgcn_permlane32_swap(__float_as_uint(x), __float_as_uint(x), false, false); return __uint_as_float(r[0]) + __uint_as_float(r[1]); }
DI float xor16_add(float x) { const auto r = __builtin_amdgcn_permlane16_swap(__float_as_uint(x), __float_as_uint(x), false, false); return __uint_as_float(r[0]) + __uint_as_float(r[1]); }
DI float xor32_max(float x) { const auto r = __builtin_amdgcn_permlane32_swap(__float_as_uint(x), __float_as_uint(x), false, false); return fmaxf(__uint_as_float(r[0]), __uint_as_float(r[1])); }
DI float row16_sum(float v) {
    asm volatile("s_nop 1\n\tv_add_f32_dpp %0, %0, %0 quad_perm:[1,0,3,2] row_mask:0xf bank_mask:0xf\n\ts_nop 1\n\tv_add_f32_dpp %0, %0, %0 quad_perm:[2,3,0,1] row_mask:0xf bank_mask:0xf\n\t"
                 "s_nop 1\n\tv_add_f32_dpp %0, %0, %0 row_half_mirror row_mask:0xf bank_mask:0xf\n\ts_nop 1\n\tv_add_f32_dpp %0, %0, %0 row_mirror row_mask:0xf bank_mask:0xf\n\ts_nop 1" : "+v"(v));
    return v; }
DI float wave_sum(float v) { return xor32_add(xor16_add(row16_sum(v))); }
DI float reduce8_row16(const float (&v)[8], int li) {
    const bool b3 = (li & 8) != 0, b2 = (li & 4) != 0, b1 = (li & 2) != 0; float t[4], u[2], w, z;
#pragma unroll
    for (int k = 0; k < 4; ++k) { const float keep = b3 ? v[4 + k] : v[k], send = b3 ? v[k] : v[4 + k];
        asm volatile("s_nop 1\n\tv_add_f32_dpp %0, %1, %2 row_mirror row_mask:0xf bank_mask:0xf" : "=v"(t[k]) : "v"(send), "v"(keep)); }
#pragma unroll
    for (int k = 0; k < 2; ++k) { const float keep = b2 ? t[2 + k] : t[k], send = b2 ? t[k] : t[2 + k];
        asm volatile("s_nop 1\n\tv_add_f32_dpp %0, %1, %2 row_half_mirror row_mask:0xf bank_mask:0xf" : "=v"(u[k]) : "v"(send), "v"(keep)); }
    { const float keep = b1 ? u[1] : u[0], send = b1 ? u[0] : u[1];
      asm volatile("s_nop 1\n\tv_add_f32_dpp %0, %1, %2 quad_perm:[3,2,1,0] row_mask:0xf bank_mask:0xf" : "=v"(w) : "v"(send), "v"(keep)); }
    asm volatile("s_nop 1\n\tv_add_f32_dpp %0, %1, %1 quad_perm:[1,0,3,2] row_mask:0xf bank_mask:0xf" : "=v"(z) : "v"(w));
    return z; }
DI unsigned row16_max_u32(unsigned v) {
    asm volatile("s_nop 1\n\tv_max_u32_dpp %0, %0, %0 quad_perm:[1,0,3,2] row_mask:0xf bank_mask:0xf\n\ts_nop 1\n\tv_max_u32_dpp %0, %0, %0 quad_perm:[2,3,0,1] row_mask:0xf bank_mask:0xf\n\t"
                 "s_nop 1\n\tv_max_u32_dpp %0, %0, %0 row_half_mirror row_mask:0xf bank_mask:0xf\n\ts_nop 1\n\tv_max_u32_dpp %0, %0, %0 row_mirror row_mask:0xf bank_mask:0xf\n\ts_nop 1" : "+v"(v));
    return v; }
DI unsigned wave_max_u32(unsigned v) {
    v = row16_max_u32(v);
    { const auto r = __builtin_amdgcn_permlane16_swap(v, v, false, false); v = max(r[0], r[1]); }
    { const auto r = __builtin_amdgcn_permlane32_swap(v, v, false, false); v = max(r[0], r[1]); }
    return (unsigned)__builtin_amdgcn_readfirstlane((int)v); }
DI unsigned mono_u32(float x) { const unsigned b = __float_as_uint(x); return b ^ (((int)b >> 31) | 0x80000000u); }
DI void store8_bf16(bf16_t* p, f32x4 a, f32x4 b) { u32x4 w; w[0] = pk_bf16(a[0], a[1]); w[1] = pk_bf16(a[2], a[3]); w[2] = pk_bf16(b[0], b[1]); w[3] = pk_bf16(b[2], b[3]); *(u32x4*)p = w; }
DI float clamp448(float x) { return __builtin_amdgcn_fmed3f(x, -448.f, 448.f); }
DI void store8_fp8(unsigned char* p, f32x4 a, f32x4 b, float sc) {
    int p0 = __builtin_amdgcn_cvt_pk_fp8_f32(clamp448(a[0] * sc), clamp448(a[1] * sc), 0, false); p0 = __builtin_amdgcn_cvt_pk_fp8_f32(clamp448(a[2] * sc), clamp448(a[3] * sc), p0, true);
    int p1 = __builtin_amdgcn_cvt_pk_fp8_f32(clamp448(b[0] * sc), clamp448(b[1] * sc), 0, false); p1 = __builtin_amdgcn_cvt_pk_fp8_f32(clamp448(b[2] * sc), clamp448(b[3] * sc), p1, true);
    u32x2 w; w[0] = (unsigned)p0; w[1] = (unsigned)p1; *(u32x2*)p = w; }
DI void load8_bf16(const bf16_t* p, f32x4& a, f32x4& b) { const u32x4 w = *(const u32x4*)p; a = (f32x4){bf_lo(w[0]), bf_hi(w[0]), bf_lo(w[1]), bf_hi(w[1])}; b = (f32x4){bf_lo(w[2]), bf_hi(w[2]), bf_lo(w[3]), bf_hi(w[3])}; }

#define EPI_ROWS(ai, m) for (int ai = 0; ai < 2; ++ai) for (int m = 0; m < 4; ++m)
struct EpiProj {
    static constexpr bool PERM = true, AFTER_DRAIN = false; static constexpr int MIDK = 0;
    unsigned char* ws; const float* hsc;
    DI void operator()(const f32x4 (&acc)[2][2][4][2], const pg8::Unit& u, int wr, int wc, int fr, int fq) const {
        const int pn = u.pn;
#pragma unroll
        for (int ai = 0; ai < 2; ++ai)
#pragma unroll
            for (int m = 0; m < 4; ++m) {
                const int row = u.pm * 256 + ai * 128 + wr * 64 + m * 16 + fr;
                const int b = row >> 12, t = row & 4095; const float rsc = hsc[row] * (1.f / 2048.f);
#pragma unroll
                for (int bj = 0; bj < 2; ++bj) {
                    const int c8 = bj * 128 + wc * 32 + fq * 8;
                    f32x4 v0 = acc[ai][bj][m][0] * rsc, v1 = acc[ai][bj][m][1] * rsc;
                    if (pn < 4) {
                        store8_bf16((bf16_t*)(ws + WS_Q) + (size_t)row * 1024 + pn * 256 + c8, v0 * QSCALE, v1 * QSCALE);
                    } else if (pn < 10) {
                        const int k = c8 >> 6, dd = c8 & 63;
                        store8_bf16((bf16_t*)(ws + WS_KV) + (size_t)(pn - 4) * 4194304 + ((size_t)((b * 4 + k) * 4096 + t)) * 64 + dd, v0, v1);
                    } else if (pn < 14) {
                        const int cu = (pn - 10) * 256 + c8, g = cu >> 4, h0 = cu & 15;
                        store8_bf16((bf16_t*)(ws + WS_A2) + ((size_t)(g * 1024 + b * 256 + (t >> 4))) * 384 + (t & 15) * 16 + h0, v0, v1);
                    } else if (pn < 30) {
                        unsigned w0 = 0u, w1 = 0u;
#pragma unroll
                        for (int e = 0; e < 4; ++e) { w0 = __builtin_amdgcn_cvt_pk_u8_f32(__builtin_rintf(sigm(v0[e]) * 255.f), e, w0); w1 = __builtin_amdgcn_cvt_pk_u8_f32(__builtin_rintf(sigm(v1[e]) * 255.f), e, w1); }
                        u32x2 w; w[0] = w0; w[1] = w1; *(u32x2*)(ws + WS_MG + (size_t)row * 4096 + (pn - 14) * 256 + c8) = w;
                    } else {
                        if (c8 < 48) { float* gp = (float*)(ws + WS_GATE) + (size_t)row * 48 + c8; f32x4 s0, s1;
#pragma unroll
                            for (int e = 0; e < 4; ++e) { s0[e] = sigm(v0[e]); s1[e] = sigm(v1[e]); }
                            *(f32x4*)gp = s0; *(f32x4*)(gp + 4) = s1; }
                    }
                }
            }
    }
};
struct EpiBf16Plain {
    static constexpr bool PERM = true, AFTER_DRAIN = false; static constexpr int MIDK = 0;
    bf16_t* O; int ldc;
    DI void operator()(const f32x4 (&acc)[2][2][4][2], const pg8::Unit& u, int wr, int wc, int fr, int fq) const {
#pragma unroll
        for (int ai = 0; ai < 2; ++ai)
#pragma unroll
            for (int m = 0; m < 4; ++m) { const int row = u.pm * 256 + ai * 128 + wr * 64 + m * 16 + fr;
#pragma unroll
                for (int bj = 0; bj < 2; ++bj) { const int col = u.pn * 256 + bj * 128 + wc * 32 + fq * 8; store8_bf16(O + (size_t)row * ldc + col, acc[ai][bj][m][0], acc[ai][bj][m][1]); } }
    }
};
struct EpiCmp1 {
    static constexpr bool PERM = true, AFTER_DRAIN = false; static constexpr int MIDK = 0;
    bf16_t* O; const float* bias;
    DI void operator()(const f32x4 (&acc)[2][2][4][2], const pg8::Unit& u, int wr, int wc, int fr, int fq) const {
        const float* bi = bias + (u.pm >> 4) * 256;
#pragma unroll
        for (int ai = 0; ai < 2; ++ai)
#pragma unroll
            for (int m = 0; m < 4; ++m) { const int row = u.pm * 256 + ai * 128 + wr * 64 + m * 16 + fr;
#pragma unroll
                for (int bj = 0; bj < 2; ++bj) { const int col = bj * 128 + wc * 32 + fq * 8; f32x4 v0 = acc[ai][bj][m][0] + *(const f32x4*)(bi + col), v1 = acc[ai][bj][m][1] + *(const f32x4*)(bi + col + 4);
#pragma unroll
                    for (int e = 0; e < 4; ++e) { v0[e] = gelu_tanh(v0[e]); v1[e] = gelu_tanh(v1[e]); }
                    store8_bf16(O + (size_t)row * 256 + col, v0, v1); } }
    }
};
struct EpiS5G1 {
    static constexpr bool PERM = false, AFTER_DRAIN = false; static constexpr int MIDK = 0;
    float* X;
    DI void operator()(const f32x4 (&acc)[2][2][4][2], const pg8::Unit& u, int wr, int wc, int fr, int fq) const {
#pragma unroll
        for (int ai = 0; ai < 2; ++ai)
#pragma unroll
            for (int m = 0; m < 4; ++m) { const int row = u.pm * 256 + ai * 128 + wr * 64 + m * 16 + fr;
#pragma unroll
                for (int n = 0; n < 2; ++n) { const int col = wc * 32 + n * 16 + fq * 4; *(f32x4*)(X + (size_t)row * 128 + col) = acc[ai][0][m][n]; } }
    }
};
struct EpiS5G2 {
    static constexpr bool PERM = true, AFTER_DRAIN = false; static constexpr int MIDK = 0;
    bf16_t* Y;
    DI void operator()(const f32x4 (&acc)[2][2][4][2], const pg8::Unit& u, int wr, int wc, int fr, int fq) const {
        const int g = u.pm >> 2;
#pragma unroll
        for (int ai = 0; ai < 2; ++ai)
#pragma unroll
            for (int m = 0; m < 4; ++m) { const int rg = (u.pm & 3) * 256 + ai * 128 + wr * 64 + m * 16 + fr;
                const int b = rg >> 8, ch = rg & 255;
#pragma unroll
                for (int bj = 0; bj < 2; ++bj) { const int c8 = bj * 128 + wc * 32 + fq * 8, tau = c8 >> 4, h0 = c8 & 15; f32x4 v0 = acc[ai][bj][m][0], v1 = acc[ai][bj][m][1];
#pragma unroll
                    for (int e = 0; e < 4; ++e) { v0[e] = gelu_tanh(v0[e]); v1[e] = gelu_tanh(v1[e]); }
                    store8_bf16(Y + ((size_t)(b * 4096 + ch * 16 + tau)) * 1024 + g * 16 + h0, v0, v1); } }
    }
};
struct EpiGlu {
    static constexpr bool PERM = true, AFTER_DRAIN = false; static constexpr int MIDK = 0;
    const bf16_t* Y; bf16_t* O; const float* bias;
    DI void operator()(const f32x4 (&acc)[2][2][4][2], const pg8::Unit& u, int wr, int wc, int fr, int fq) const {
#pragma unroll
        for (int bj = 0; bj < 2; ++bj) { const int col = u.pn * 256 + bj * 128 + wc * 32 + fq * 8; const f32x4 b0 = *(const f32x4*)(bias + col), b1 = *(const f32x4*)(bias + col + 4);
            u32x4 yv[8];
#pragma unroll
            for (int q = 0; q < 8; ++q) { const int row = u.pm * 256 + (q >> 2) * 128 + wr * 64 + (q & 3) * 16 + fr; yv[q] = *(const u32x4*)(Y + (size_t)row * 1024 + col); }
#pragma unroll
            for (int q = 0; q < 8; ++q) { const int ai = q >> 2, m = q & 3, row = u.pm * 256 + ai * 128 + wr * 64 + m * 16 + fr;
                const f32x4 y0 = (f32x4){bf_lo(yv[q][0]), bf_hi(yv[q][0]), bf_lo(yv[q][1]), bf_hi(yv[q][1])}, y1 = (f32x4){bf_lo(yv[q][2]), bf_hi(yv[q][2]), bf_lo(yv[q][3]), bf_hi(yv[q][3])};
                f32x4 v0 = acc[ai][bj][m][0] + b0, v1 = acc[ai][bj][m][1] + b1;
#pragma unroll
                for (int e = 0; e < 4; ++e) { v0[e] = y0[e] * sigm(v0[e]); v1[e] = y1[e] * sigm(v1[e]); }
                store8_fp8((unsigned char*)O + (size_t)row * UA_LD + col, v0, v1, Y2_SCALE); } }
    }
};
DI f32x4 u8x4_f32(unsigned w) { return (f32x4){(float)(w & 0xFFu), (float)((w >> 8) & 0xFFu), (float)((w >> 16) & 0xFFu), (float)(w >> 24)}; }
struct EpiUpF {
    static constexpr bool PERM = true, AFTER_DRAIN = false; static constexpr int MIDK = 8;
    const unsigned char* MG; unsigned char* O;
    DI void mid(f32x4 (&acc)[2][2][4][2], const pg8::Unit& u, int wr, int wc, int fr, int fq) const {
#pragma unroll
        for (int bj = 0; bj < 2; ++bj) { const int col = u.pn * 256 + bj * 128 + wc * 32 + fq * 8;
            u32x2 ga[8], gb[8];
#pragma unroll
            for (int q = 0; q < 8; ++q) { const int row = u.pm * 256 + (q >> 2) * 128 + wr * 64 + (q & 3) * 16 + fr; ga[q] = *(const u32x2*)(MG + (size_t)row * 4096 + col); gb[q] = *(const u32x2*)(MG + (size_t)row * 4096 + 2048 + col); }
#pragma unroll
            for (int q = 0; q < 8; ++q) { const int ai = q >> 2, m = q & 3;
#pragma unroll
                for (int h = 0; h < 2; ++h) { const f32x4 a = u8x4_f32(ga[q][h]), b = u8x4_f32(gb[q][h]); f32x4 r;
#pragma unroll
                    for (int e = 0; e < 4; ++e) r[e] = a[e] * __builtin_amdgcn_rcpf(fmaxf(b[e], 1e-30f));
                    acc[ai][bj][m][h] = acc[ai][bj][m][h] * (r * (Y2_SCALE / OATT_SCALE)); } } }
    }
    DI void operator()(const f32x4 (&acc)[2][2][4][2], const pg8::Unit& u, int wr, int wc, int fr, int fq) const {
#pragma unroll
        for (int bj = 0; bj < 2; ++bj) { const int col = u.pn * 256 + bj * 128 + wc * 32 + fq * 8;
            u32x2 gv[8];
#pragma unroll
            for (int q = 0; q < 8; ++q) { const int row = u.pm * 256 + (q >> 2) * 128 + wr * 64 + (q & 3) * 16 + fr; gv[q] = *(const u32x2*)(MG + (size_t)row * 4096 + 2048 + col); }
#pragma unroll
            for (int q = 0; q < 8; ++q) { const int ai = q >> 2, m = q & 3, row = u.pm * 256 + ai * 128 + wr * 64 + m * 16 + fr;
                f32x4 g0 = u8x4_f32(gv[q][0]), g1 = u8x4_f32(gv[q][1]);
#pragma unroll
                for (int e = 0; e < 4; ++e) { g0[e] = fmaxf(g0[e], 1e-30f); g1[e] = fmaxf(g1[e], 1e-30f); }
                const f32x4 v0 = acc[ai][bj][m][0] * (g0 * (1.f / (255.f * Y2_SCALE * 1024.f))), v1 = acc[ai][bj][m][1] * (g1 * (1.f / (255.f * Y2_SCALE * 1024.f)));
                store8_fp8(O + (size_t)row * 2048 + col, v0, v1, MIX_SCALE); } }
    }
};
struct EpiOut {
    static constexpr bool PERM = true, AFTER_DRAIN = false; static constexpr int MIDK = 0;
    const float* X; const float* mod; bf16_t* O;
    DI void operator()(const f32x4 (&acc)[2][2][4][2], const pg8::Unit& u, int wr, int wc, int fr, int fq) const {
        const float* g1 = mod + ((u.pm * 256) >> 12) * 12288 + 4096;
#pragma unroll
        for (int bj = 0; bj < 2; ++bj) { const int col = u.pn * 256 + bj * 128 + wc * 32 + fq * 8;
            const f32x4 g0 = *(const f32x4*)(g1 + col) * (1.f / (MIX_SCALE * 2048.f)), g4 = *(const f32x4*)(g1 + col + 4) * (1.f / (MIX_SCALE * 2048.f));
#pragma unroll
            for (int ai = 0; ai < 2; ++ai) { f32x4 xv[4][2];
#pragma unroll
                for (int m = 0; m < 4; ++m) { const int row = u.pm * 256 + ai * 128 + wr * 64 + m * 16 + fr; xv[m][0] = *(const f32x4*)(X + (size_t)row * 2048 + col); xv[m][1] = *(const f32x4*)(X + (size_t)row * 2048 + col + 4); }
#pragma unroll
                for (int m = 0; m < 4; ++m) { const int row = u.pm * 256 + ai * 128 + wr * 64 + m * 16 + fr;
                    const f32x4 a = xv[m][0] + g0 * acc[ai][bj][m][0], b = xv[m][1] + g4 * acc[ai][bj][m][1];
                    u32x4 w; w[0] = pk_bf16(a[0], a[1]); w[1] = pk_bf16(a[2], a[3]); w[2] = pk_bf16(b[0], b[1]); w[3] = pk_bf16(b[2], b[3]);
                    *(u32x4*)(O + (size_t)row * 2048 + col) = w; } } }
    }
};
struct EpiF32Plain {
    static constexpr bool PERM = true, AFTER_DRAIN = false; static constexpr int MIDK = 0;
    float* C; int ldc;
    DI void operator()(const f32x4 (&acc)[2][2][4][2], const pg8::Unit& u, int wr, int wc, int fr, int fq) const {
#pragma unroll
        for (int ai = 0; ai < 2; ++ai)
#pragma unroll
            for (int m = 0; m < 4; ++m) { const int row = u.pm * 256 + ai * 128 + wr * 64 + m * 16 + fr;
#pragma unroll
                for (int bj = 0; bj < 2; ++bj) { const int col = u.pn * 256 + bj * 128 + wc * 32 + fq * 8; *(f32x4*)(C + (size_t)row * ldc + col) = acc[ai][bj][m][0]; *(f32x4*)(C + (size_t)row * ldc + col + 4) = acc[ai][bj][m][1]; } }
    }
};
DI unsigned pk_f16(float lo, float hi) { typedef _Float16 f16v2 __attribute__((ext_vector_type(2))); f16v2 v; v[0] = (_Float16)lo; v[1] = (_Float16)hi; return __builtin_bit_cast(unsigned, v); }
struct EpiF16Plain {
    static constexpr bool PERM = true, AFTER_DRAIN = false; static constexpr int MIDK = 0;
    unsigned short* C; int ldc;
    DI void operator()(const f32x4 (&acc)[2][2][4][2], const pg8::Unit& u, int wr, int wc, int fr, int fq) const {
#pragma unroll
        for (int ai = 0; ai < 2; ++ai)
#pragma unroll
            for (int m = 0; m < 4; ++m) { const int row = u.pm * 256 + ai * 128 + wr * 64 + m * 16 + fr;
#pragma unroll
                for (int bj = 0; bj < 2; ++bj) { const int col = u.pn * 256 + bj * 128 + wc * 32 + fq * 8; const f32x4 a = acc[ai][bj][m][0], b = acc[ai][bj][m][1];
                    u32x4 w; w[0] = pk_f16(a[0], a[1]); w[1] = pk_f16(a[2], a[3]); w[2] = pk_f16(b[0], b[1]); w[3] = pk_f16(b[2], b[3]);
                    *(u32x4*)(C + (size_t)row * ldc + col) = w; } }
    }
};
struct GroupOrder {
    int n, G, c, div;
    DI bool next(int i, pg8::Unit& u) const { const int L = i * G + c; if (L >= n) return false; u.pm = L; u.pn = L / div; return true; }
    DI void a_ready(const pg8::Unit&) const {}
    DI void done(const pg8::Unit&) const {}
};

template <int MODE> DI int src_col(int n) {
    if (MODE == 0) return n;
    if (n < 2560) return n; if (n < 7680) return n + 48; if (n < 7728) return n - 7680 + 2560; return -1; }
template <int MODE, bool F8OUT = false> DI void tconv_tiles(const float* __restrict__ src, int ld, int K, int Nd, bf16_t* __restrict__ dst, LAS float* tile, int& off, int bx, int G, float f8scale = 1.f, int ldd = 0) {
    const int tid = threadIdx.x, ntk = K >> 6, ntot = ntk * (Nd >> 8), LD = ldd ? ldd : K;
    const int first = (bx + G - (off % G)) % G; off += ntot;
    for (int it = first; it < ntot; it += G) {
        const int n0 = (it / ntk) << 8, k0 = (it % ntk) << 6;
        __syncthreads();
        { const int j = tid & 63, i0 = tid >> 6; float w[4][8];
#pragma unroll
          for (int c = 0; c < 4; ++c) { const int sc = src_col<MODE>(n0 + 64 * c + j);
#pragma unroll
              for (int rr = 0; rr < 8; ++rr) w[c][rr] = sc >= 0 ? src[(size_t)(k0 + i0 + 8 * rr) * ld + sc] : 0.f; }
#pragma unroll
          for (int c = 0; c < 4; ++c)
#pragma unroll
              for (int rr = 0; rr < 8; ++rr) tile[c * 4160 + (i0 + 8 * rr) * 65 + j] = w[c][rr]; }
        __syncthreads();
#pragma unroll
        for (int c = 0; c < 4; ++c) { const int jj = tid >> 3, ii0 = (tid & 7) * 8; float v[8];
#pragma unroll
          for (int e = 0; e < 8; ++e) v[e] = tile[c * 4160 + (ii0 + e) * 65 + jj];
          if constexpr (F8OUT) { int p0 = __builtin_amdgcn_cvt_pk_fp8_f32(clamp448(v[0] * f8scale), clamp448(v[1] * f8scale), 0, false); p0 = __builtin_amdgcn_cvt_pk_fp8_f32(clamp448(v[2] * f8scale), clamp448(v[3] * f8scale), p0, true);
              int p1 = __builtin_amdgcn_cvt_pk_fp8_f32(clamp448(v[4] * f8scale), clamp448(v[5] * f8scale), 0, false); p1 = __builtin_amdgcn_cvt_pk_fp8_f32(clamp448(v[6] * f8scale), clamp448(v[7] * f8scale), p1, true);
              u32x2 w; w[0] = (unsigned)p0; w[1] = (unsigned)p1; *(u32x2*)((unsigned char*)dst + (size_t)(n0 + 64 * c + jj) * LD + k0 + ii0) = w; }
          else { u32x4 w; w[0] = pk_bf16(v[0], v[1]); w[1] = pk_bf16(v[2], v[3]); w[2] = pk_bf16(v[4], v[5]); w[3] = pk_bf16(v[6], v[7]);
              *(u32x4*)(dst + (size_t)(n0 + 64 * c + jj) * LD + k0 + ii0) = w; } }
    }
}
DI void conv_bf16_flat(const float* __restrict__ src, bf16_t* __restrict__ dst, size_t n8  , size_t first, size_t stride) {
    for (size_t i = first; i < n8; i += stride) { const f32x4 a = *(const f32x4*)(src + i * 8), b = *(const f32x4*)(src + i * 8 + 4); store8_bf16(dst + i * 8, a, b); }
}

DI void conv_rows_fp8(const float* __restrict__ src, unsigned char* __restrict__ dst, float* __restrict__ inv_scale, int nrows) {
    const int lane = threadIdx.x & 63, wave = __builtin_amdgcn_readfirstlane(threadIdx.x >> 6);
    for (int row = blockIdx.x * 8 + wave; row < nrows; row += gridDim.x * 8) {
        const float* sr = src + (size_t)row * 2048; f32x4 v[8]; float am = 0.f;
#pragma unroll
        for (int k = 0; k < 8; ++k) { v[k] = *(const f32x4*)(sr + k * 256 + lane * 4); am = fmaxf(am, fmaxf(fmaxf(fabsf(v[k][0]), fabsf(v[k][1])), fmaxf(fabsf(v[k][2]), fabsf(v[k][3])))); }
#pragma unroll
        for (int o = 32; o >= 1; o >>= 1) am = fmaxf(am, __shfl_xor(am, o));
        const float sc = am > 0.f ? 448.f / am : 1.f;
#pragma unroll
        for (int k = 0; k < 8; ++k) { int p = __builtin_amdgcn_cvt_pk_fp8_f32(v[k][0] * sc, v[k][1] * sc, 0, false); p = __builtin_amdgcn_cvt_pk_fp8_f32(v[k][2] * sc, v[k][3] * sc, p, true);
            *(unsigned*)(dst + (size_t)k * 4194304 + (size_t)row * 256 + lane * 4) = (unsigned)p; }
        if (lane == 0) inv_scale[row] = am > 0.f ? am / 448.f : 1.f;
    }
}

DI void p0_prologue(const Params& P, LAS unsigned char* lds) {
    unsigned char* ws = P.ws; const int tid = threadIdx.x, G = gridDim.x, bx = blockIdx.x;
    LAS float* fl = (LAS float*)lds;
    {
        LAS float* sc = fl;
        LAS float* red = fl + 8192;
        for (int i = tid; i < 8192; i += 512) { const float v = P.c[i]; sc[i] = v / (1.f + __expf(-v)); }
        __syncthreads();
        for (int it = bx; it < 192 + 8; it += G) {
            const bool is_cb = it >= 192;
            const int col = tid & 63, kg = tid >> 6;
            float a0 = 0.f, a1 = 0.f, a2 = 0.f, a3 = 0.f;
            if (!is_cb) {
                const float* wp = P.ada_w + (size_t)(kg * 256) * 12288 + it * 64 + col;
                for (int j0 = 0; j0 < 256; j0 += 32) { float w[32];
#pragma unroll
                    for (int j = 0; j < 32; ++j) w[j] = wp[(size_t)(j0 + j) * 12288];
#pragma unroll
                    for (int j = 0; j < 32; ++j) { const int jj = kg * 256 + j0 + j; a0 += sc[jj] * w[j]; a1 += sc[2048 + jj] * w[j]; a2 += sc[4096 + jj] * w[j]; a3 += sc[6144 + jj] * w[j]; } }
            } else {
                const int i = (it - 192) >> 2, c0 = ((it - 192) & 3) * 64;
                const float* wp = P.cmp_w1 + (size_t)i * 2048 * 256 + (size_t)(kg * 256) * 256 + c0 + col; const float* pp = P.cmp_pos + i * 2048 + kg * 256;
                for (int j0 = 0; j0 < 256; j0 += 32) { float w[32];
#pragma unroll
                    for (int j = 0; j < 32; ++j) w[j] = wp[(size_t)(j0 + j) * 256];
#pragma unroll
                    for (int j = 0; j < 32; ++j) a0 += pp[j0 + j] * w[j]; }
            }
            red[(kg * 4 + 0) * 64 + col] = a0; red[(kg * 4 + 1) * 64 + col] = a1; red[(kg * 4 + 2) * 64 + col] = a2; red[(kg * 4 + 3) * 64 + col] = a3;
            __syncthreads();
            if (tid < 256) { const int b = tid >> 6, cc = tid & 63; float s = 0.f;
#pragma unroll
                for (int q = 0; q < 8; ++q) s += red[(q * 4 + b) * 64 + cc];
                if (!is_cb) ((float*)(ws + WS_MOD))[b * 12288 + it * 64 + cc] = s + P.ada_b[it * 64 + cc];
                else if (b == 0) { const int i = (it - 192) >> 2, c0 = ((it - 192) & 3) * 64; ((float*)(ws + WS_CB))[i * 256 + c0 + cc] = s + P.cmp_b1[i * 256 + c0 + cc]; } }
            __syncthreads();
        }
    }
    for (int g4 = bx; g4 < 256; g4 += G) {
        const int g = g4 >> 2, part = g4 & 3;
        LAS double* pw = (LAS double*)lds;
        LAS double* ff = pw + 17 * 64 * 2;
        LAS double* bb = ff + 128;
        LAS float* cc = (LAS float*)(bb + 2048);
        LAS float* kern = cc + 2048;
        __syncthreads();
        const double step = exp((double)P.s5_log_step[g]);
        for (int i = tid; i < 17 * 64; i += 512) { const int p = i & 63, dl = i >> 6; const double lr = P.s5_lam_re[g * 64 + p], li = P.s5_lam_im[g * 64 + p];
            const double mag = exp(dl * lr * step), ang = dl * li * step; const double cr = mag * cos(ang), ci = mag * sin(ang);
            pw[i * 2] = cr; pw[i * 2 + 1] = ci;
            if (dl == 1) { const double nr = cr - 1.0, den = lr * lr + li * li; ff[p * 2] = (nr * lr + ci * li) / den; ff[p * 2 + 1] = (ci * lr - nr * li) / den; }
            if (dl == 16 && part == 0) { float* a16 = (float*)(ws + WS_A16) + (g * 64 + p) * 2; a16[0] = (float)cr; a16[1] = (float)ci; } }
        for (int i = tid; i < 1024; i += 512) { const int h = i >> 6, p = i & 63; cc[i * 2] = P.s5_c_re[(g * 16 + h) * 64 + p]; cc[i * 2 + 1] = P.s5_c_im[(g * 16 + h) * 64 + p]; }
        __syncthreads();
        for (int i = tid; i < 1024; i += 512) { const int p = i >> 4; const double br = P.s5_b_re[g * 1024 + i], bi = P.s5_b_im[g * 1024 + i], fr = ff[p * 2], fi = ff[p * 2 + 1];
            bb[i * 2] = fr * br - fi * bi; bb[i * 2 + 1] = fr * bi + fi * br; }
        __syncthreads();
        for (int o1 = tid; o1 < 1024; o1 += 512) {
            const int dl = o1 >> 6, h = 4 * part + ((o1 >> 4) & 3), h2 = o1 & 15, o = (dl * 16 + h) * 16 + h2; double s = 0.0;
            for (int p = 0; p < 64; ++p) { const double cr = cc[(h * 64 + p) * 2], ci = cc[(h * 64 + p) * 2 + 1], ar = pw[(dl * 64 + p) * 2], ai = pw[(dl * 64 + p) * 2 + 1];
                const double zr = cr * ar - ci * ai, zi = cr * ai + ci * ar; s += zr * bb[(p * 16 + h2) * 2] - zi * bb[(p * 16 + h2) * 2 + 1]; }
            kern[o] = (float)s; }
        __syncthreads();
        bf16_t* B2 = (bf16_t*)(ws + WS_S5B2) + (size_t)g * 256 * 384;
        for (int i = tid; i < 64 * 384 / 2; i += 512) {
            const int rr = i / 192, c0 = (i % 192) * 2, tau = rr >> 2, h = 4 * part + (rr & 3), row = tau * 16 + h; float v[2];
#pragma unroll
            for (int e = 0; e < 2; ++e) { const int col = c0 + e; float x;
                if (col < 256) { const int s = col >> 4, h2 = col & 15; x = (s <= tau) ? kern[((tau - s) * 16 + h) * 16 + h2] : 0.f; if (s == tau && h2 == h) x += P.s5_d[g * 16 + h]; }
                else { const int p = (col - 256) & 63; const double cr = cc[(h * 64 + p) * 2], ci = cc[(h * 64 + p) * 2 + 1], ar = pw[((tau + 1) * 64 + p) * 2], ai = pw[((tau + 1) * 64 + p) * 2 + 1];
                    x = (col < 320) ? (float)(cr * ar - ci * ai) : (float)(-(cr * ai + ci * ar)); }
                v[e] = x; }
            *(unsigned*)(B2 + (size_t)row * 384 + c0) = pk_bf16(v[0], v[1]); }
        bf16_t* B1 = (bf16_t*)(ws + WS_S5B1) + (size_t)g * 256 * 256;
        for (int i = tid; i < 64 * 256 / 2; i += 512) {
            const int n = 64 * part + (i >> 7), c0 = (i & 127) * 2; float v[2];
#pragma unroll
            for (int e = 0; e < 2; ++e) { const int col = c0 + e, s = col >> 4, h = col & 15; float x = 0.f;
                if (n < 128) { const int p = n & 63; const double ar = pw[((15 - s) * 64 + p) * 2], ai = pw[((15 - s) * 64 + p) * 2 + 1], br = bb[(p * 16 + h) * 2], bi = bb[(p * 16 + h) * 2 + 1];
                    x = (n < 64) ? (float)(ar * br - ai * bi) : (float)(ar * bi + ai * br); }
                v[e] = x; }
            *(unsigned*)(B1 + (size_t)n * 256 + c0) = pk_bf16(v[0], v[1]); }
    }
    __syncthreads();
    LAS float* tile = fl;
    int toff = 0;
    tconv_tiles<1, true>(P.w_in, 7728, 2048, NPROJ, (bf16_t*)(ws + WS_WIN), tile, toff, bx, G, 2048.f);
    tconv_tiles<0>(P.glu_w, 1024, 1024, 1024, (bf16_t*)(ws + WS_WGLU), tile, toff, bx, G);
    tconv_tiles<0, true>(P.w_up_attn, 2048, 1024, 2048, (bf16_t*)(ws + WS_WUA), tile, toff, bx, G, 1024.f, 2048);
    tconv_tiles<0, true>(P.w_up_ssm, 2048, 1024, 2048, (bf16_t*)(ws + WS_WUA + 1024), tile, toff, bx, G, 1024.f, 2048);
    tconv_tiles<0, true>(P.w_out, 2048, 2048, 2048, (bf16_t*)(ws + WS_WOUT), tile, toff, bx, G, 2048.f);
    tconv_tiles<0>(P.cmp_w1, 256, 2048, 256, (bf16_t*)(ws + WS_WC1), tile, toff, bx, G);
    tconv_tiles<0>(P.cmp_w1 + 2048 * 256, 256, 2048, 256, (bf16_t*)(ws + WS_WC1) + 256 * 2048, tile, toff, bx, G);
    __syncthreads();
    const size_t gt = (size_t)bx * 512 + tid, gs = (size_t)G * 512;
    conv_bf16_flat(P.peer_w_q, (bf16_t*)(ws + WS_WQ), (size_t)2048 * 2048 / 8, gt, gs);
    { bf16_t* kb = (bf16_t*)(ws + WS_KBD);
      for (size_t i = gt; i < (size_t)2048 * 2048 / 8; i += gs) { const int row = (int)(i >> 8), k0 = (int)(i & 255) * 8, hc = row >> 7, n = row & 127;
          if ((k0 >> 7) == hc) { const float* s = P.peer_sub_keys + ((size_t)(hc * 128 + n)) * 128 + (k0 & 127); store8_bf16(kb + i * 8, *(const f32x4*)s, *(const f32x4*)(s + 4)); }
          else *(u32x4*)(kb + i * 8) = (u32x4){0u, 0u, 0u, 0u}; } }
}

DI void phase_norm(const bf16_t* __restrict__ X, const float* __restrict__ gain, const float* __restrict__ mod, int sh_off, int sc_off, bf16_t* __restrict__ H, unsigned char* __restrict__ H8, float* __restrict__ HS) {
    const int lane = threadIdx.x & 63, wave = __builtin_amdgcn_readfirstlane(threadIdx.x >> 6);
    for (int row = blockIdx.x * 8 + wave; row < NT; row += gridDim.x * 8) {
        const bf16_t* xr = X + (size_t)row * 2048; f32x4 v[8]; float ss = 0.f;
#pragma unroll
        for (int k = 0; k < 8; ++k) { const u32x2 xw = *(const u32x2*)(xr + k * 256 + lane * 4); v[k][0] = bf_lo(xw[0]); v[k][1] = bf_hi(xw[0]); v[k][2] = bf_lo(xw[1]); v[k][3] = bf_hi(xw[1]);
            ss += v[k][0] * v[k][0] + v[k][1] * v[k][1] + v[k][2] * v[k][2] + v[k][3] * v[k][3]; }
        ss = wave_sum(ss); const float rs = rsqrtf(ss * (1.f / 2048.f) + 1e-6f);
        const float* mb = mod + (row >> 12) * 12288;
#pragma unroll
        for (int k = 0; k < 8; ++k) { const int d = k * 256 + lane * 4; const f32x4 g = *(const f32x4*)(gain + d), sc = *(const f32x4*)(mb + sc_off + d), sh = *(const f32x4*)(mb + sh_off + d);
            f32x4 o; float am = 0.f;
#pragma unroll
            for (int e = 0; e < 4; ++e) { o[e] = v[k][e] * rs * g[e] * (1.f + sc[e]) + sh[e]; am = fmaxf(am, fabsf(o[e])); }
            u32x2 w; w[0] = pk_bf16(o[0], o[1]); w[1] = pk_bf16(o[2], o[3]); *(u32x2*)(H + (size_t)row * 2048 + d) = w;
            am = __uint_as_float(wave_max_u32(__float_as_uint(am)));
            const float q = am > 0.f ? 127.f / am : 1.f; unsigned pk = 0u;
#pragma unroll
            for (int e = 0; e < 4; ++e) pk = __builtin_amdgcn_cvt_pk_u8_f32(__builtin_rintf(o[e] * q) + 128.f, e, pk);
            *(unsigned*)(H8 + (size_t)row * 2048 + d) = pk ^ 0x80808080u;
            if (lane == 0) HS[(size_t)row * 8 + k] = am > 0.f ? am * (1.f / 127.f) : 1.f; }
    }
}

DI void phase_norm_f8(const float* __restrict__ X, const float* __restrict__ gain, const float* __restrict__ mod, int sh_off, int sc_off, unsigned char* __restrict__ H8, float* __restrict__ hsc) {
    const int lane = threadIdx.x & 63, wave = __builtin_amdgcn_readfirstlane(threadIdx.x >> 6);
    for (int row = blockIdx.x * 8 + wave; row < NT; row += gridDim.x * 8) {
        const float* xr = X + (size_t)row * 2048; f32x4 v[8]; float ss = 0.f;
#pragma unroll
        for (int k = 0; k < 8; ++k) { v[k] = *(const f32x4*)(xr + k * 256 + lane * 4); ss += v[k][0] * v[k][0] + v[k][1] * v[k][1] + v[k][2] * v[k][2] + v[k][3] * v[k][3]; }
        ss = wave_sum(ss); const float rs = rsqrtf(ss * (1.f / 2048.f) + 1e-6f);
        const float* mb = mod + (row >> 12) * 12288; float am = 0.f;
#pragma unroll
        for (int k = 0; k < 8; ++k) { const int d = k * 256 + lane * 4; const f32x4 g = *(const f32x4*)(gain + d), sc = *(const f32x4*)(mb + sc_off + d), sh = *(const f32x4*)(mb + sh_off + d);
#pragma unroll
            for (int e = 0; e < 4; ++e) { v[k][e] = v[k][e] * rs * g[e] * (1.f + sc[e]) + sh[e]; am = fmaxf(am, fabsf(v[k][e])); } }
#pragma unroll
        for (int o = 32; o >= 1; o >>= 1) am = fmaxf(am, __shfl_xor(am, o));
        const float q = am > 0.f ? 448.f / am : 1.f;
#pragma unroll
        for (int k = 0; k < 8; ++k) { int p = __builtin_amdgcn_cvt_pk_fp8_f32(v[k][0] * q, v[k][1] * q, 0, false); p = __builtin_amdgcn_cvt_pk_fp8_f32(v[k][2] * q, v[k][3] * q, p, true);
            *(unsigned*)(H8 + (size_t)row * 2048 + k * 256 + lane * 4) = (unsigned)p; }
        if (lane == 0) hsc[row] = am > 0.f ? am * (1.f / 448.f) : 1.f;
    }
}

DI void phase_cmp2(const Params& P) {
    unsigned char* ws = P.ws; const bf16_t* hid = (const bf16_t*)(ws + WS_HID); bf16_t* ckv = (bf16_t*)(ws + WS_CKV);
    for (int o = blockIdx.x * 512 + threadIdx.x; o < 2 * 16 * 256 * 64; o += gridDim.x * 512) {
        const int dd = o & 63, row = o >> 6, i = row >> 12, n = row & 255;
        float s = 0.f;
        if (n < NCMP) { const bf16_t* hr = hid + (size_t)row * 256; const float* w2 = P.cmp_w2 + i * 256 * 64 + dd; s = P.cmp_b2[i * 64 + dd];
#pragma unroll 4
            for (int j = 0; j < 256; j += 8) { const u32x4 hv = *(const u32x4*)(hr + j);
#pragma unroll
                for (int e = 0; e < 4; ++e) { s += bf_lo(hv[e]) * w2[(j + 2 * e) * 64]; s += bf_hi(hv[e]) * w2[(j + 2 * e + 1) * 64]; } } }
        ckv[o] = f2bf(s);
    }
}
DI void phase_scan(const Params& P) {
    unsigned char* ws = P.ws; const int lane = threadIdx.x & 63, wave = __builtin_amdgcn_readfirstlane(threadIdx.x >> 6);
    if (wave != 0) return;
    for (int bg = blockIdx.x; bg < 256; bg += gridDim.x) {
        const int b = bg >> 6, g = bg & 63, p = lane;
        const float ar = ((const float*)(ws + WS_A16))[(g * 64 + p) * 2], ai = ((const float*)(ws + WS_A16))[(g * 64 + p) * 2 + 1];
        const float* xl = (const float*)(ws + WS_XL) + (size_t)(g * 1024 + b * 256) * 128; bf16_t* a2 = (bf16_t*)(ws + WS_A2) + (size_t)(g * 1024 + b * 256) * 384 + 256;
        float xr = 0.f, xi = 0.f;
        for (int c = 0; c < 256; c += 8) { float lr[8], li[8];
#pragma unroll
            for (int e = 0; e < 8; ++e) { lr[e] = xl[(size_t)(c + e) * 128 + p]; li[e] = xl[(size_t)(c + e) * 128 + 64 + p]; }
#pragma unroll
            for (int e = 0; e < 8; ++e) { a2[(size_t)(c + e) * 384 + p] = f2bf(xr); a2[(size_t)(c + e) * 384 + 64 + p] = f2bf(xi);
                const float nr = ar * xr - ai * xi + lr[e], ni = ar * xi + ai * xr + li[e]; xr = nr; xi = ni; } }
    }
}

constexpr int AT_K = 0, AT_V = 18432, AT_TB = 34816, AT_IMP = 43008, AT_END = 112640;
#define MFMA32(a, b, c) __builtin_amdgcn_mfma_f32_32x32x16_bf16((a), (b), (c), 0, 0, 0)

DI void attn_setup_tables(const Params& P, LAS unsigned char* lds) {
    LAS float* tb = (LAS float*)(lds + AT_TB);
    __syncthreads();
    for (int i = threadIdx.x; i < 16 * 128; i += 512) { const int hd = i >> 7, dist = i & 127; int bk = dist;
        if (dist >= 16) { const float lr = __logf((float)dist * (1.f / 16.f)) / 2.0794415417f; bk = min(16 + (int)(lr * 16.f), 31); }
        tb[i] = P.rel_bias[bk * 16 + hd] * LOG2E; }
    __syncthreads();
}

#define ATTN_BODY \
             \
            bf16x8 vfr[2][2][2]; \
            f32x16 sacc[2]; \
_Pragma("unroll") \
            for (int kb = 0; kb < 2; ++kb) { \
_Pragma("unroll") \
                for (int i = 0; i < 16; ++i) sacc[kb][i] = 0.f; \
_Pragma("unroll") \
                for (int s = 0; s < 4; ++s) { const bf16x8 kf = *(const LAS bf16x8*)(Kl + krd + kb * 32 * 144 + s * 32); sacc[kb] = MFMA32(kf, qf[s], sacc[kb]); } } \
            if (pass == 0 && MODE != 0) {                                             \
_Pragma("unroll") \
                for (int kb = 0; kb < 2; ++kb) \
_Pragma("unroll") \
                    for (int s2 = 0; s2 < 2; ++s2) \
_Pragma("unroll") \
                        for (int db = 0; db < 2; ++db) { const unsigned a0 = (unsigned)(32 * kb + 16 * s2) * 128u + vrow * 128u + vcol[db]; \
                            const s16x4 lo = __builtin_amdgcn_ds_read_tr16_b64_v4i16((LAS s16x4*)(Vl + a0)), hi = __builtin_amdgcn_ds_read_tr16_b64_v4i16((LAS s16x4*)(Vl + a0 + 8 * 128)); \
                            vfr[kb][s2][db] = __builtin_shufflevector(lo, hi, 0, 1, 2, 3, 4, 5, 6, 7); } \
            } \
             \
            const bool near = (MODE == 0) ? (1024 * j + 1152 > qb * 64) : ((qb - j <= 2) || (MODE == 2 && j == qb - 8));        \
            const bool lsel = (MODE != 1) || (((j < 32 ? (mlo >> j) : (mhi >> (j - 32))) & 1u) != 0u); \
            if (near) { \
                const int dq = (MODE == 0) ? (tq - 31 - 1024 * j) : (tq - 64 * j); \
_Pragma("unroll") \
                for (int kb = 0; kb < 2; ++kb) \
_Pragma("unroll") \
                    for (int i = 0; i < 16; ++i) { const int kl = 32 * kb + (i & 3) + 8 * (i >> 2) + 4 * h; const int dist = dq - ((MODE == 0) ? 16 * kl : kl); \
                        bool ok = (dist >= 0) && lsel; if (MODE == 2) ok = ok && (dist < 512); \
                        sacc[kb][i] = (sacc[kb][i] + tb[min(max(dist, 0), 127)]) + (ok ? 0.f : NEGBIG); if (i == 15) __builtin_amdgcn_sched_barrier(0); }      \
            } else { \
                const float cb = lsel ? farb : NEGBIG;                   \
_Pragma("unroll") \
                for (int kb = 0; kb < 2; ++kb) \
_Pragma("unroll") \
                    for (int i = 0; i < 16; ++i) sacc[kb][i] += cb; \
            } \
            bf16x8 pf[2][2]; \
            if (pass == 0) { \
                 \
                float mx = fmaxf(fmaxf(sacc[0][0], sacc[0][1]), sacc[1][0]); \
_Pragma("unroll") \
                for (int kb = 0; kb < 2; ++kb) \
_Pragma("unroll") \
                    for (int i = 0; i < 16; i += 2) mx = fmaxf(fmaxf(mx, sacc[kb][i]), sacc[kb][i + 1]); \
                mx = xor32_max(mx); \
                const float m_new = fmaxf(m_run, mx); \
                if (__any(m_new > m_run)) { const float alpha = __builtin_amdgcn_exp2f(m_run - m_new); l_run *= alpha; \
_Pragma("unroll") \
                    for (int i = 0; i < 16; ++i) { oacc[0][i] *= alpha; oacc[1][i] *= alpha; } } \
                m_run = m_new; \
                f32x2 ls2 = {0.f, 0.f}; const f32x2 mn2 = {m_new, m_new}; \
_Pragma("unroll") \
                for (int kb = 0; kb < 2; ++kb) \
_Pragma("unroll") \
                    for (int i = 0; i < 16; i += 2) { f32x2 d2 = (f32x2){sacc[kb][i], sacc[kb][i + 1]} - mn2; d2.x = __builtin_amdgcn_exp2f(d2.x); d2.y = __builtin_amdgcn_exp2f(d2.y); sacc[kb][i] = d2.x; sacc[kb][i + 1] = d2.y; ls2 += d2; } \
                l_run += ls2.x + ls2.y; \
            } else { \
_Pragma("unroll") \
                for (int kb = 0; kb < 2; ++kb) \
_Pragma("unroll") \
                    for (int i = 0; i < 16; ++i) sacc[kb][i] = __builtin_amdgcn_exp2f(sacc[kb][i] - m_fin) * inv_fin; \
            } \
_Pragma("unroll") \
            for (int kb = 0; kb < 2; ++kb) \
_Pragma("unroll") \
                for (int s2 = 0; s2 < 2; ++s2) { u32x4 w; \
_Pragma("unroll") \
                    for (int e = 0; e < 4; ++e) w[e] = pk_bf16(sacc[kb][8 * s2 + 2 * e], sacc[kb][8 * s2 + 2 * e + 1]); \
                    pf[kb][s2] = __builtin_bit_cast(bf16x8, w); } \
            if (pass == 0) { \
                 \
_Pragma("unroll") \
                for (int kb = 0; kb < 2; ++kb) \
_Pragma("unroll") \
                    for (int s2 = 0; s2 < 2; ++s2) \
_Pragma("unroll") \
                        for (int db = 0; db < 2; ++db) { \
                            if (MODE != 0) oacc[db] = MFMA32(vfr[kb][s2][db], pf[kb][s2], oacc[db]); \
                            else { const unsigned a0 = (unsigned)(32 * kb + 16 * s2) * 128u + vrow * 128u + vcol[db]; \
                                const s16x4 lo = __builtin_amdgcn_ds_read_tr16_b64_v4i16((LAS s16x4*)(Vl + a0)), hi = __builtin_amdgcn_ds_read_tr16_b64_v4i16((LAS s16x4*)(Vl + a0 + 8 * 128)); \
                                oacc[db] = MFMA32(__builtin_shufflevector(lo, hi, 0, 1, 2, 3, 4, 5, 6, 7), pf[kb][s2], oacc[db]); } } \
            } else { \
                 \
                bf16x8 mfrag[2][2]; \
_Pragma("unroll") \
                for (int kb = 0; kb < 2; ++kb) \
_Pragma("unroll") \
                    for (int s2 = 0; s2 < 2; ++s2) \
_Pragma("unroll") \
                        for (int jj = 0; jj < 8; ++jj) { const int key = 32 * kb + 16 * s2 + 8 * (jj >> 2) + 4 * h + (jj & 3); \
                            mfrag[kb][s2][jj] = (key == 4 * r - 1 || key == 4 * r + 3) ? (short)0x3F00 : ((key >= 4 * r && key <= 4 * r + 2) ? (short)0x3F80 : (short)0); } \
                f32x16 ia; \
_Pragma("unroll") \
                for (int i = 0; i < 16; ++i) ia[i] = 0.f; \
_Pragma("unroll") \
                for (int kb = 0; kb < 2; ++kb) \
_Pragma("unroll") \
                    for (int s2 = 0; s2 < 2; ++s2) ia = MFMA32(mfrag[kb][s2], pf[kb][s2], ia); \
                LAS float* ip = (LAS float*)(lds + AT_IMP) + (g * 64 + tq_loc) * 68 + 16 * j; \
_Pragma("unroll") \
                for (int i = 0; i < 9; ++i) { const int jp = (i & 3) + 8 * (i >> 2) + 4 * h; if (jp <= 16) ip[jp] += ia[i]; } \
            } \


template <int MODE> DI void attn_unit(const Params& P, LAS unsigned char* lds, int b, int k, int qb) {
    unsigned char* ws = P.ws;
    const int tid = threadIdx.x, lane = tid & 63, wave = __builtin_amdgcn_readfirstlane(tid >> 6);
    const int g = wave >> 1, th = wave & 1, r = lane & 31, h = lane >> 5;
    const int tq_loc = th * 32 + r, tq = qb * 64 + tq_loc, hd = k * 4 + g, bk = b * 4 + k;
    const LAS float* tb = (const LAS float*)(lds + AT_TB) + hd * 128;
    const float farb = tb[127];
    bf16x8 qf[4];
    { const bf16_t* qg = (const bf16_t*)(ws + WS_Q) + ((size_t)(b * 4096 + tq)) * 1024 + hd * 64 + 8 * h;
#pragma unroll
      for (int s = 0; s < 4; ++s) qf[s] = *(const bf16x8*)(qg + 16 * s); }
    const bf16_t *Kg, *Vg;
    if (MODE == 0) { Kg = (const bf16_t*)(ws + WS_CKV) + (size_t)bk * 256 * 64; Vg = Kg + 16 * 256 * 64; }
    else { Kg = (const bf16_t*)(ws + WS_KV) + (size_t)(MODE == 1 ? 2 : 4) * 4194304 + (size_t)bk * 4096 * 64; Vg = Kg + 4194304; }
    unsigned long long tiles; unsigned mlo = 0u, mhi = 0u;
    if (MODE == 0) { const int kmax = min(3, (4 * qb + 2) >> 6); tiles = (2ull << kmax) - 1ull; }
    else if (MODE == 2) { const int lo = max(0, qb - 8); tiles = ((2ull << qb) - 1ull) & ~((1ull << lo) - 1ull); }
    else { const unsigned* sm = (const unsigned*)(ws + WS_SELM) + ((size_t)(bk * 4096 + qb * 64)) * 2;
        mlo = sm[tq_loc * 2]; mhi = sm[tq_loc * 2 + 1];
        unsigned ulo = sm[lane * 2], uhi = sm[lane * 2 + 1];
#pragma unroll
        for (int o = 32; o >= 1; o >>= 1) { ulo |= __shfl_xor(ulo, o); uhi |= __shfl_xor(uhi, o); }
        tiles = (((unsigned long long)(unsigned)__builtin_amdgcn_readfirstlane(uhi) << 32) | (unsigned)__builtin_amdgcn_readfirstlane(ulo)) & ((2ull << qb) - 1ull); }
    const int ntile = __popcll(tiles);
    const int skey = tid >> 3, sch = tid & 7;
    const unsigned kst = (unsigned)(skey * 144 + sch * 16), vst = (unsigned)(skey * 128 + ((sch ^ (((skey >> 1) & 1) << 2)) * 16));
    const int q4 = (lane & 15) >> 2, pp = lane & 3, blk = (lane >> 4) & 1;
    const unsigned vrow = (unsigned)(4 * h + q4);
    unsigned vcol[2];
#pragma unroll
    for (int db = 0; db < 2; ++db) { const int ch = 4 * db + 2 * blk + (pp >> 1); vcol[db] = (unsigned)(((ch ^ (((q4 >> 1) & 1) << 2)) * 16) + (pp & 1) * 8); }
    const unsigned krd = (unsigned)(r * 144 + 16 * h);

    f32x16 oacc[2]; float m_run = NEGBIG, l_run = 0.f;
#pragma unroll
    for (int i = 0; i < 16; ++i) { oacc[0][i] = 0.f; oacc[1][i] = 0.f; }
    float m_fin = 0.f, inv_fin = 0.f;

#define ATTN_STEP(KR, VR, JV, PAR) { const int j = JV; \
            LAS unsigned char* Kl = lds + AT_K + (PAR) * 9216; LAS unsigned char* Vl = lds + AT_V + (PAR) * 8192; \
            *(LAS u32x4*)(Kl + kst) = KR; *(LAS u32x4*)(Vl + vst) = VR; \
            __syncthreads(); \
            { const int j2 = rem ? __ffsll((long long)rem) - 1 : JV; rem &= rem - 1ull; JV = j2; \
              KR = *(const u32x4*)(Kg + (size_t)(j2 * 64 + skey) * 64 + sch * 8); VR = *(const u32x4*)(Vg + (size_t)(j2 * 64 + skey) * 64 + sch * 8); } \
            ATTN_BODY }
#define ATTN_PASS(PASSC) { constexpr int pass = (PASSC); \
        if (MODE == 0 && pass == 1) {                                    \
            LAS float* imp = (LAS float*)(lds + AT_IMP); \
            for (int i = tid; i < 4 * 64 * 68; i += 512) imp[i] = 0.f; \
        } \
        __syncthreads();                                                 \
         \
        unsigned long long rem = tiles; int jA = __ffsll((long long)rem) - 1; rem &= rem - 1ull; int jB = rem ? __ffsll((long long)rem) - 1 : jA; rem &= rem - 1ull; \
        u32x4 kregA = *(const u32x4*)(Kg + (size_t)(jA * 64 + skey) * 64 + sch * 8), vregA = *(const u32x4*)(Vg + (size_t)(jA * 64 + skey) * 64 + sch * 8); \
        u32x4 kregB = *(const u32x4*)(Kg + (size_t)(jB * 64 + skey) * 64 + sch * 8), vregB = *(const u32x4*)(Vg + (size_t)(jB * 64 + skey) * 64 + sch * 8); \
        if constexpr (true) { rem = tiles & (tiles - 1ull);           \
            for (int it = 0; it < ntile; ++it) ATTN_STEP(kregA, vregA, jA, (it & 1)) \
        } else { \
            for (int it = 0; it < ntile; it += 2) { \
                ATTN_STEP(kregA, vregA, jA, 0) \
                if (it + 1 < ntile) ATTN_STEP(kregB, vregB, jB, 1) \
            } \
        } \
        if (pass == 0) { \
            const float lt = xor32_add(l_run); const bool live = m_run > -1e29f; const float inv = live ? 1.f / lt : 0.f; \
            m_fin = live ? m_run : 0.f; inv_fin = inv; \
             \
            int tqo = tq; asm volatile("" : "+v"(tqo)); \
            bf16_t* og = (bf16_t*)(ws + (MODE == 0 ? WS_OC : (MODE == 2 ? WS_OW : WS_OATT))) + ((size_t)(b * 4096 + tqo)) * 1024 + hd * 64; \
            float g0 = 0.f, g1 = 1.f, g2 = 0.f; const bf16_t *oc = nullptr, *ow = nullptr; \
            if (MODE == 1) { const float* gp = (const float*)(ws + WS_GATE) + (size_t)(b * 4096 + tqo) * 48 + hd * 3; g0 = gp[0]; g1 = gp[1]; g2 = gp[2]; \
                oc = (const bf16_t*)(ws + WS_OC) + ((size_t)(b * 4096 + tqo)) * 1024 + hd * 64; ow = (const bf16_t*)(ws + WS_OW) + ((size_t)(b * 4096 + tqo)) * 1024 + hd * 64; } \
_Pragma("unroll") \
            for (int db = 0; db < 2; ++db) \
_Pragma("unroll") \
                for (int a = 0; a < 4; ++a) { const int d0 = 32 * db + 8 * a + 4 * h; float v[4]; \
_Pragma("unroll") \
                    for (int e = 0; e < 4; ++e) v[e] = oacc[db][4 * a + e] * inv; \
                    if (MODE == 1) { const u32x2 c2 = *(const u32x2*)(oc + d0), w2 = *(const u32x2*)(ow + d0); \
                        v[0] = g1 * v[0] + g0 * bf_lo(c2[0]) + g2 * bf_lo(w2[0]); v[1] = g1 * v[1] + g0 * bf_hi(c2[0]) + g2 * bf_hi(w2[0]); \
                        v[2] = g1 * v[2] + g0 * bf_lo(c2[1]) + g2 * bf_lo(w2[1]); v[3] = g1 * v[3] + g0 * bf_hi(c2[1]) + g2 * bf_hi(w2[1]); } \
                    if (MODE == 1) { int p8 = __builtin_amdgcn_cvt_pk_fp8_f32(clamp448(v[0] * OATT_SCALE), clamp448(v[1] * OATT_SCALE), 0, false); p8 = __builtin_amdgcn_cvt_pk_fp8_f32(clamp448(v[2] * OATT_SCALE), clamp448(v[3] * OATT_SCALE), p8, true); \
                        *(int*)((unsigned char*)(ws + WS_OATT) + ((size_t)(b * 4096 + tqo)) * UA_LD + hd * 64 + d0) = p8; } \
                    else { u32x2 w; w[0] = pk_bf16(v[0], v[1]); w[1] = pk_bf16(v[2], v[3]); *(u32x2*)(og + d0) = w; } } \
        } \
     }
    ATTN_PASS(0)
    if constexpr (MODE == 0) ATTN_PASS(1)
#undef ATTN_PASS
#undef ATTN_STEP
    if (MODE == 0) {
        __syncthreads();
        const LAS float* imp = (const LAS float*)(lds + AT_IMP); unsigned* sm = (unsigned*)(ws + WS_SELM) + ((size_t)(bk * 4096 + qb * 64)) * 2;
        const int cur = qb;
        for (int tk = 0; tk < 8; ++tk) { const int tok = wave * 8 + tk, jb = lane;
            const float v = imp[(0 * 64 + tok) * 68 + jb] + imp[(1 * 64 + tok) * 68 + jb] + imp[(2 * 64 + tok) * 68 + jb] + imp[(3 * 64 + tok) * 68 + jb];
            const bool valid = jb <= cur, forced = valid && (jb == 0 || jb == cur || jb == cur - 1);
            bool sel = forced;
            if (cur <= 15) sel = valid;
            else { unsigned key = (valid && !forced) ? ((__float_as_uint(fmaxf(v, 0.f)) & ~63u) | (unsigned)(63 - jb)) : 0u;
                for (int rd = 0; rd < 13; ++rd) { const unsigned w = wave_max_u32(key); const int win = 63 - (int)(w & 63u); if (jb == win && w != 0u) { sel = true; key = 0u; } } }
            const unsigned long long bal = __ballot(sel);
            if (lane == 0) { sm[tok * 2] = (unsigned)bal; sm[tok * 2 + 1] = (unsigned)(bal >> 32); } }
    }
}

constexpr float AT_THR = 6.f;
#define AP_QK(S, Kl_, C_) { const f32x16 z16_ = {0.f, 0.f, 0.f, 0.f, 0.f, 0.f, 0.f, 0.f, 0.f, 0.f, 0.f, 0.f, 0.f, 0.f, 0.f, 0.f}; _Pragma("unroll") for (int kb = 0; kb < 2; ++kb) { S[kb] = MFMA32(kones, C_, z16_);        \
        _Pragma("unroll") for (int s = 0; s < 4; ++s) { const bf16x8 kf = *(const LAS bf16x8*)((Kl_) + krd + kb * 32 * 144 + s * 32); S[kb] = MFMA32(kf, qf[s], S[kb]); } } }
#define AP_CSEL(C_, jt) bf16x8 C_; { const int j_ = (jt); const bool lsel_ = (MODE != 1) || (((j_ < 32 ? (mlo >> j_) : (mhi >> (j_ - 32))) & 1u) != 0u); const bool near_ = (qb - j_ <= 2) || (MODE == 2 && j_ == qb - 8); \
        const float cs_ = (lsel_ || near_) ? cref : NEGBIG; u32x4 cw_ = {0u, 0u, 0u, 0u}; cw_[0] = (h == 0) ? (__float_as_uint(cs_) >> 16) : 0u; C_ = __builtin_bit_cast(bf16x8, cw_); }
#define AP_NEAR(S, jt) { const int j_ = (jt); const bool near_ = (qb - j_ <= 2) || (MODE == 2 && j_ == qb - 8); \
        if (near_) { const bool lsel_ = (MODE != 1) || (((j_ < 32 ? (mlo >> j_) : (mhi >> (j_ - 32))) & 1u) != 0u); const int dq = tq - 64 * j_; \
            _Pragma("unroll") for (int kb = 0; kb < 2; ++kb) _Pragma("unroll") for (int i = 0; i < 16; ++i) { const int kl = 32 * kb + (i & 3) + 8 * (i >> 2) + 4 * h; const int dist = dq - kl; \
                bool ok = (dist >= 0) && lsel_; if (MODE == 2) ok = ok && (dist < 512); \
                S[kb][i] = (S[kb][i] + (tb[min(max(dist, 0), 127)] - farb)) + (ok ? 0.f : NEGBIG); } } }
#define AP_STEP(SC, SN, PAR, HASNEXT) { \
        LAS unsigned char* Kn = lds + AT_K + ((PAR) ^ 1) * 9216; LAS unsigned char* Vc = lds + AT_V + (PAR) * 8192; \
        *(LAS u32x4*)(Kn + kst) = kreg; *(LAS u32x4*)(Vc + vst) = vreg; \
        __syncthreads(); \
        { vreg = *(const u32x4*)(Vg + (size_t)(jn * 64 + skey) * 64 + sch * 8); kreg = *(const u32x4*)(Kg + (size_t)(jnn * 64 + skey) * 64 + sch * 8); } \
        const bool hn_ = (HASNEXT); \
        float mx = fmaxf(fmaxf(SC[0][0], SC[0][1]), SC[1][0]); \
        _Pragma("unroll") for (int kb = 0; kb < 2; ++kb) _Pragma("unroll") for (int i = 0; i < 16; i += 2) mx = fmaxf(fmaxf(mx, SC[kb][i]), SC[kb][i + 1]); \
        mx = xor32_max(mx); \
        if (__any(mx > AT_THR || (mx < -24.f && mx > -1e29f))) {         \
            const float dw = (mx > -1e29f) ? mx : 0.f, cnew = __uint_as_float(pk_bf16(cref - dw, 0.f) << 16), dl = cref - cnew, alpha = __builtin_amdgcn_exp2f(-dl); cref = cnew; m_run += dl; l_run *= alpha;        \
            _Pragma("unroll") for (int i = 0; i < 16; ++i) { oacc[0][i] *= alpha; oacc[1][i] *= alpha; SC[0][i] -= dl; SC[1][i] -= dl; } } \
        AP_CSEL(cn_, jn) \
        AP_QK(SN, Kn, cn_)        \
        float ls0 = 0.f, ls1 = 0.f; \
        _Pragma("unroll") for (int kb = 0; kb < 2; ++kb) _Pragma("unroll") for (int i = 0; i < 16; i += 2) { const float p0 = __builtin_amdgcn_exp2f(SC[kb][i]), p1 = __builtin_amdgcn_exp2f(SC[kb][i + 1]); SC[kb][i] = p0; SC[kb][i + 1] = p1; ls0 += p0; ls1 += p1; } \
        l_run += ls0 + ls1; \
        _Pragma("unroll") for (int kb = 0; kb < 2; ++kb) _Pragma("unroll") for (int s2 = 0; s2 < 2; ++s2) { u32x4 w; \
            _Pragma("unroll") for (int e = 0; e < 4; ++e) w[e] = pk_bf16(SC[kb][8 * s2 + 2 * e], SC[kb][8 * s2 + 2 * e + 1]); \
            const bf16x8 pf = __builtin_bit_cast(bf16x8, w); \
            _Pragma("unroll") for (int db = 0; db < 2; ++db) { const unsigned a0 = (unsigned)(32 * kb + 16 * s2) * 128u + vrow * 128u + vcol[db]; \
                const s16x4 lo = __builtin_amdgcn_ds_read_tr16_b64_v4i16((LAS s16x4*)(Vc + a0)), hi = __builtin_amdgcn_ds_read_tr16_b64_v4i16((LAS s16x4*)(Vc + a0 + 8 * 128)); \
                oacc[db] = MFMA32(__builtin_shufflevector(lo, hi, 0, 1, 2, 3, 4, 5, 6, 7), pf, oacc[db]); } } \
        if (hn_) AP_NEAR(SN, jn) \
        jn = jnn; jnn = rem ? __ffsll((long long)rem) - 1 : jnn; rem &= rem - 1ull; }

template <int MODE> DI void attn_unit_pipe(const Params& P, LAS unsigned char* lds, int b, int k, int qb) {
    unsigned char* ws = P.ws;
    const int tid = threadIdx.x, lane = tid & 63, wave = __builtin_amdgcn_readfirstlane(tid >> 6);
    const int g = wave >> 1, th = wave & 1, r = lane & 31, h = lane >> 5;
    const int tq_loc = th * 32 + r, tq = qb * 64 + tq_loc, hd = k * 4 + g, bk = b * 4 + k;
    const LAS float* tb = (const LAS float*)(lds + AT_TB) + hd * 128;
    const float farb = tb[127];
    bf16x8 qf[4];
    { const bf16_t* qg = (const bf16_t*)(ws + WS_Q) + ((size_t)(b * 4096 + tq)) * 1024 + hd * 64 + 8 * h;
#pragma unroll
      for (int s = 0; s < 4; ++s) qf[s] = *(const bf16x8*)(qg + 16 * s); }
    const bf16_t* Kg = (const bf16_t*)(ws + WS_KV) + (size_t)(MODE == 1 ? 2 : 4) * 4194304 + (size_t)bk * 4096 * 64; const bf16_t* Vg = Kg + 4194304;
    unsigned long long tiles; unsigned mlo = 0u, mhi = 0u;
    if (MODE == 2) { const int lo = max(0, qb - 8); tiles = ((2ull << qb) - 1ull) & ~((1ull << lo) - 1ull); }
    else { const unsigned* sm = (const unsigned*)(ws + WS_SELM) + ((size_t)(bk * 4096 + qb * 64)) * 2;
        mlo = sm[tq_loc * 2]; mhi = sm[tq_loc * 2 + 1];
        unsigned ulo = sm[lane * 2], uhi = sm[lane * 2 + 1];
#pragma unroll
        for (int o = 32; o >= 1; o >>= 1) { ulo |= __shfl_xor(ulo, o); uhi |= __shfl_xor(uhi, o); }
        tiles = (((unsigned long long)(unsigned)__builtin_amdgcn_readfirstlane(uhi) << 32) | (unsigned)__builtin_amdgcn_readfirstlane(ulo)) & ((2ull << qb) - 1ull); }
    const int ntile = __popcll(tiles);
    const int skey = tid >> 3, sch = tid & 7;
    const unsigned kst = (unsigned)(skey * 144 + sch * 16), vst = (unsigned)(skey * 128 + ((sch ^ (((skey >> 1) & 1) << 2)) * 16));
    const int q4 = (lane & 15) >> 2, pp = lane & 3, blk = (lane >> 4) & 1;
    const unsigned vrow = (unsigned)(4 * h + q4);
    unsigned vcol[2];
#pragma unroll
    for (int db = 0; db < 2; ++db) { const int ch = 4 * db + 2 * blk + (pp >> 1); vcol[db] = (unsigned)(((ch ^ (((q4 >> 1) & 1) << 2)) * 16) + (pp & 1) * 8); }
    const unsigned krd = (unsigned)(r * 144 + 16 * h);
    f32x16 oacc[2], sA[2], sB[2]; float m_run = 0.f, l_run = 0.f;
    float cref = __uint_as_float(pk_bf16(farb, 0.f) << 16);
    bf16x8 kones; { u32x4 kw_ = {0u, 0u, 0u, 0u}; kw_[0] = (h == 0) ? 0x3F80u : 0u; kones = __builtin_bit_cast(bf16x8, kw_); }
#pragma unroll
    for (int i = 0; i < 16; ++i) { oacc[0][i] = 0.f; oacc[1][i] = 0.f; }
    unsigned long long rem = tiles; const int jc = __ffsll((long long)rem) - 1; rem &= rem - 1ull;
    int jn = rem ? __ffsll((long long)rem) - 1 : jc; rem &= rem - 1ull; int jnn = rem ? __ffsll((long long)rem) - 1 : jn; rem &= rem - 1ull;
    u32x4 kreg = *(const u32x4*)(Kg + (size_t)(jc * 64 + skey) * 64 + sch * 8), vreg = *(const u32x4*)(Vg + (size_t)(jc * 64 + skey) * 64 + sch * 8);
    __syncthreads();
    *(LAS u32x4*)(lds + AT_K + kst) = kreg;
    kreg = *(const u32x4*)(Kg + (size_t)(jn * 64 + skey) * 64 + sch * 8);
    __syncthreads();
    { AP_CSEL(c0_, jc) AP_QK(sA, lds + AT_K, c0_) AP_NEAR(sA, jc) }
    for (int it = 0; it < ntile; it += 2) {
        AP_STEP(sA, sB, 0, it + 1 < ntile)
        if (it + 1 < ntile) AP_STEP(sB, sA, 1, it + 2 < ntile)
    }
    const float lt = xor32_add(l_run); const float inv = lt > 0.f ? 1.f / lt : 0.f;
    int tqo = tq; asm volatile("" : "+v"(tqo));
    float g0 = 0.f, g1 = 1.f, g2 = 0.f; const bf16_t *oc = nullptr, *ow = nullptr;
    if (MODE == 1) { const float* gp = (const float*)(ws + WS_GATE) + (size_t)(b * 4096 + tqo) * 48 + hd * 3; g0 = gp[0]; g1 = gp[1]; g2 = gp[2];
        oc = (const bf16_t*)(ws + WS_OC) + ((size_t)(b * 4096 + tqo)) * 1024 + hd * 64; ow = (const bf16_t*)(ws + WS_OW) + ((size_t)(b * 4096 + tqo)) * 1024 + hd * 64; }
#pragma unroll
    for (int db = 0; db < 2; ++db)
#pragma unroll
        for (int a = 0; a < 4; ++a) { const int d0 = 32 * db + 8 * a + 4 * h; float v[4];
#pragma unroll
            for (int e = 0; e < 4; ++e) v[e] = oacc[db][4 * a + e] * inv;
            if (MODE == 1) { const u32x2 c2 = *(const u32x2*)(oc + d0), w2 = *(const u32x2*)(ow + d0);
                v[0] = g1 * v[0] + g0 * bf_lo(c2[0]) + g2 * bf_lo(w2[0]); v[1] = g1 * v[1] + g0 * bf_hi(c2[0]) + g2 * bf_hi(w2[0]);
                v[2] = g1 * v[2] + g0 * bf_lo(c2[1]) + g2 * bf_lo(w2[1]); v[3] = g1 * v[3] + g0 * bf_hi(c2[1]) + g2 * bf_hi(w2[1]);
                int p8 = __builtin_amdgcn_cvt_pk_fp8_f32(clamp448(v[0] * OATT_SCALE), clamp448(v[1] * OATT_SCALE), 0, false); p8 = __builtin_amdgcn_cvt_pk_fp8_f32(clamp448(v[2] * OATT_SCALE), clamp448(v[3] * OATT_SCALE), p8, true);
                *(int*)((unsigned char*)(ws + WS_OATT) + ((size_t)(b * 4096 + tqo)) * UA_LD + hd * 64 + d0) = p8; }
            else { u32x2 w; w[0] = pk_bf16(v[0], v[1]); w[1] = pk_bf16(v[2], v[3]); *(u32x2*)((bf16_t*)(ws + WS_OW) + ((size_t)(b * 4096 + tqo)) * 1024 + hd * 64 + d0) = w; } }
}
#undef AP_STEP
#undef AP_NEAR
#undef AP_CSEL
#undef AP_QK

DI void phase_attn_win_early(const Params& P, LAS unsigned char* lds) {
    if (gridDim.x != 256) return;
    const int bx = blockIdx.x; if (bx >= 128 && bx < 160) return;
    attn_setup_tables(P, lds);
    const int nb = bx < 128 ? bx : bx - 32;
    for (int u = nb; u < 672; u += 224) { const int qb = u >> 4, bk = u & 15; attn_unit_pipe<2>(P, lds, bk >> 2, bk & 3, qb); }
}
DI void phase_attn_cmp_win(const Params& P, LAS unsigned char* lds) {
    attn_setup_tables(P, lds);
    for (int u = blockIdx.x; u < 1024; u += gridDim.x) { const int qb = 63 - (u >> 4), bk = u & 15; attn_unit<0>(P, lds, bk >> 2, bk & 3, qb); }
    for (int u = (gridDim.x == 256 ? 672 : 0) + blockIdx.x; u < 1024; u += gridDim.x) { const int qb = u >> 4, bk = u & 15; attn_unit_pipe<2>(P, lds, bk >> 2, bk & 3, qb); }
}
DI void phase_attn_sel(const Params& P, LAS unsigned char* lds) {
    attn_setup_tables(P, lds);
    for (int pr = blockIdx.x; pr < 512; pr += gridDim.x) { const int bk = pr >> 5, qp = pr & 31;
        attn_unit_pipe<1>(P, lds, bk >> 2, bk & 3, 63 - qp); attn_unit_pipe<1>(P, lds, bk >> 2, bk & 3, qp); }
}

DI unsigned row_max_u32(unsigned v) {
    asm volatile("s_nop 1\n\tv_max_u32_dpp %0, %0, %0 quad_perm:[1,0,3,2] row_mask:0xf bank_mask:0xf\n\ts_nop 1\n\tv_max_u32_dpp %0, %0, %0 quad_perm:[2,3,0,1] row_mask:0xf bank_mask:0xf\n\t"
                 "s_nop 1\n\tv_max_u32_dpp %0, %0, %0 row_half_mirror row_mask:0xf bank_mask:0xf\n\ts_nop 1\n\tv_max_u32_dpp %0, %0, %0 row_mirror row_mask:0xf bank_mask:0xf\n\ts_nop 1" : "+v"(v));
    return v; }
DI float row_max_f32(float v) {
    asm volatile("s_nop 1\n\tv_max_f32_dpp %0, %0, %0 quad_perm:[1,0,3,2] row_mask:0xf bank_mask:0xf\n\ts_nop 1\n\tv_max_f32_dpp %0, %0, %0 quad_perm:[2,3,0,1] row_mask:0xf bank_mask:0xf\n\t"
                 "s_nop 1\n\tv_max_f32_dpp %0, %0, %0 row_half_mirror row_mask:0xf bank_mask:0xf\n\ts_nop 1\n\tv_max_f32_dpp %0, %0, %0 row_mirror row_mask:0xf bank_mask:0xf\n\ts_nop 1" : "+v"(v));
    return v; }
DI float row_sum_f32(float v) {
    asm volatile("s_nop 1\n\tv_add_f32_dpp %0, %0, %0 quad_perm:[1,0,3,2] row_mask:0xf bank_mask:0xf\n\ts_nop 1\n\tv_add_f32_dpp %0, %0, %0 quad_perm:[2,3,0,1] row_mask:0xf bank_mask:0xf\n\t"
                 "s_nop 1\n\tv_add_f32_dpp %0, %0, %0 row_half_mirror row_mask:0xf bank_mask:0xf\n\ts_nop 1\n\tv_add_f32_dpp %0, %0, %0 row_mirror row_mask:0xf bank_mask:0xf\n\ts_nop 1" : "+v"(v));
    return v; }
DI float demono_f32(unsigned u) { return __uint_as_float((u & 0x80000000u) ? (u ^ 0x80000000u) : ~u); }

#define PK_CE(x, y) do { const unsigned hi_ = max(x, y), lo_ = min(x, y); x = hi_; y = lo_; } while (0)
DI void peer_stage1(const u32x4& sh, int li, LAS float* vsr, LAS int* nsr) {
    unsigned s[8];
#pragma unroll
    for (int e = 0; e < 8; ++e) { const unsigned hb = (e & 1) ? (sh[e >> 1] & 0xFFFF0000u) : (sh[e >> 1] << 16);
        s[e] = ((hb ^ (((int)hb >> 31) | 0x80000000u)) & 0xFFFF0000u) | (unsigned)(127 - (8 * li + e)); }
    PK_CE(s[0], s[1]); PK_CE(s[2], s[3]); PK_CE(s[4], s[5]); PK_CE(s[6], s[7]); PK_CE(s[0], s[2]); PK_CE(s[1], s[3]); PK_CE(s[4], s[6]); PK_CE(s[5], s[7]); PK_CE(s[1], s[2]); PK_CE(s[5], s[6]);
    PK_CE(s[0], s[4]); PK_CE(s[1], s[5]); PK_CE(s[2], s[6]); PK_CE(s[3], s[7]); PK_CE(s[2], s[4]); PK_CE(s[3], s[5]); PK_CE(s[1], s[2]); PK_CE(s[3], s[4]); PK_CE(s[5], s[6]);
    unsigned win = 0u;
    for (int rd = 0; rd < 16; ++rd) {
        const unsigned m = row_max_u32(s[0]); const bool w = s[0] == m;
#pragma unroll
        for (int i = 0; i < 7; ++i) s[i] = w ? s[i + 1] : s[i];
        s[7] = w ? 0u : s[7];
        if (li == rd) win = m; }
    { const unsigned u = win & 0xFFFF0000u, hb = (u & 0x80000000u) ? (u ^ 0x80000000u) : (~u & 0xFFFF0000u);
      vsr[li] = (float)__builtin_bit_cast(_Float16, (unsigned short)(hb >> 16)); nsr[li] = 127 - (int)(win & 127u); }
}
DI void conv_row_store(const Params& P, int crow, int lane, const f32x4 (&v)[8]) {
    unsigned char* ws = P.ws; float am = 0.f;
#pragma unroll
    for (int k8 = 0; k8 < 8; ++k8) am = fmaxf(am, fmaxf(fmaxf(fabsf(v[k8][0]), fabsf(v[k8][1])), fmaxf(fabsf(v[k8][2]), fabsf(v[k8][3]))));
    am = __uint_as_float(wave_max_u32(__float_as_uint(am)));
    unsigned char* dst = ws + WS_PU + (size_t)(crow >> 14) * 33554432 + (size_t)(crow & 16383) * 256 + lane * 4;
    const float sc = am > 0.f ? 127.f / am : 1.f;
#pragma unroll
    for (int k8 = 0; k8 < 8; ++k8) { unsigned pk = 0u;
#pragma unroll
        for (int e = 0; e < 4; ++e) pk = __builtin_amdgcn_cvt_pk_u8_f32(__builtin_rintf(v[k8][e] * sc) + 128.f, e, pk);
        *(unsigned*)(dst + (size_t)k8 * 4194304) = pk ^ 0x80808080u; }
    if (lane == 0) ((float*)(ws + WS_PSU))[crow] = am > 0.f ? am / 127.f : 1.f;
}
DI void phase_peer(const Params& P, LAS unsigned char* lds) {
    unsigned char* ws = P.ws; const int lane = threadIdx.x & 63, wave = __builtin_amdgcn_readfirstlane(threadIdx.x >> 6), rw = lane >> 4, li = lane & 15;
    const unsigned short* SC = (const unsigned short*)(ws + WS_SC);
    LAS unsigned char* ptab = lds + 8192;
    LAS float* vs = (LAS float*)(lds + wave * 1024); LAS int* ns = (LAS int*)(lds + wave * 1024 + 512);
    __syncthreads();
    if (threadIdx.x == 0) { int q = 0; for (int a = 0; a < 16; ++a) for (int b = 0; b < 16 / (a + 1); ++b) ptab[q++] = (unsigned char)(a * 16 + b); for (; q < 64; ++q) ptab[q] = 0; }
    __syncthreads();
    int abq[4];
#pragma unroll
    for (int j = 0; j < 4; ++j) abq[j] = ptab[li + 16 * j];
    const int w0 = blockIdx.x * 8 + wave, wstep = gridDim.x * 8;
    const int nit = ((NT - w0 + wstep - 1) / wstep) * 2;
    int crow = w0;
    const unsigned short* sp0 = SC + (size_t)w0 * 2048 + rw * 128 + li * 8;
    u32x4 sa = *(const u32x4*)sp0, sc_ = *(const u32x4*)(sp0 + 512);
    for (int it = 0; it < nit; ++it) {
        const int t = w0 + (it >> 1) * wstep, bp = it & 1;
        const int itn = it + 1 < nit ? it + 1 : it; const unsigned short* spn = SC + (size_t)(w0 + (itn >> 1) * wstep) * 2048 + ((itn & 1) * 8 + rw) * 128 + li * 8;
        const u32x4 na = *(const u32x4*)spn, nc = *(const u32x4*)(spn + 512);
        asm volatile("" : "+v"(sa), "+v"(sc_));
        const bool cv = crow < 32768;
        f32x4 v[8];
        if (cv) { const float* sr = (crow < 16384 ? P.peer_u : P.peer_v) + (size_t)(crow & 16383) * 2048 + lane * 4;
#pragma unroll
            for (int k = 0; k < 8; ++k) v[k] = *(const f32x4*)(sr + k * 256); }
        peer_stage1(sa, li, vs + rw * 16, ns + rw * 16);
        peer_stage1(sc_, li, vs + 64 + rw * 16, ns + 64 + rw * 16);
        const LAS float* v1 = vs + rw * 32; const LAS float* v2 = v1 + 16;
        unsigned k[4];
#pragma unroll
        for (int j = 0; j < 4; ++j) { const int q = li + 16 * j; const float c = v1[abq[j] >> 4] + v2[abq[j] & 15]; k[j] = (q < 50) ? ((mono_u32(c) & ~63u) | (unsigned)(63 - q)) : 0u; }
        PK_CE(k[0], k[1]); PK_CE(k[2], k[3]); PK_CE(k[0], k[2]); PK_CE(k[1], k[3]); PK_CE(k[1], k[2]);
        unsigned w2 = 0u;
        for (int rd = 0; rd < 16; ++rd) {
            const unsigned m = row_max_u32(k[0]); const bool w = k[0] == m;
            k[0] = w ? k[1] : k[0]; k[1] = w ? k[2] : k[1]; k[2] = w ? k[3] : k[2]; k[3] = w ? 0u : k[3];
            if (li == rd) w2 = m; }
        {
            const int ab = ptab[63 - (int)(w2 & 63u)], a = ab >> 4, b = ab & 15;
            const float tsv = v1[a] + v2[b]; const int ee = ns[rw * 32 + a] * 128 + ns[rw * 32 + 16 + b];
            const float mx = row_max_f32(tsv), ex = __expf(tsv - mx), sm = row16_sum(ex);
            const int slot = (4 * bp + rw) * 16 + li;
            ((int*)(ws + WS_EX))[(size_t)t * 128 + slot] = ee; ((float*)(ws + WS_GT))[(size_t)t * 128 + slot] = ex / sm; }
        if (cv) { conv_row_store(P, crow, lane, v); crow += wstep; }
        sa = na; sc_ = nc;
    }
    for (; crow < 32768; crow += wstep) { const float* sr = (crow < 16384 ? P.peer_u : P.peer_v) + (size_t)(crow & 16383) * 2048 + lane * 4; f32x4 v[8];
#pragma unroll
        for (int k8 = 0; k8 < 8; ++k8) v[k8] = *(const f32x4*)(sr + k8 * 256);
        conv_row_store(P, crow, lane, v); }
}
#undef PK_CE

DI void peer_slice_map(const Params& P, LAS unsigned char* lds, int& vx, int& rank, int& nrank) {
    volatile LAS unsigned* misc = (volatile LAS unsigned*)(lds + LDS_MISC);
    const unsigned* bar = (const unsigned*)(P.ws + WS_BAR);
    const int xcc = (int)misc[4], rk = (int)misc[5];
    bool ok = true; int mine = 0;
#pragma unroll
    for (int j = 0; j < 16; ++j) { const unsigned c = __hip_atomic_load(bar + XB_XCNT(j), __ATOMIC_RELAXED, __HIP_MEMORY_SCOPE_AGENT); if (j < 8 ? c == 0u : c != 0u) ok = false; if (j == xcc) mine = (int)c; }
    if (ok && (P.ph_hi - P.ph_lo > 1)) { vx = xcc; rank = rk; nrank = mine; }
    else { vx = blockIdx.x & 7; rank = blockIdx.x >> 3; nrank = (gridDim.x + 7 - vx) >> 3; }
}
DI void phase_peer_a(const Params& P, LAS unsigned char* lds) {
    unsigned char* ws = P.ws; const int lane = threadIdx.x & 63, wave = __builtin_amdgcn_readfirstlane(threadIdx.x >> 6); int vx, rank, nrank; peer_slice_map(P, lds, vx, rank, nrank);
    const int gq = lane >> 4, li = lane & 15;
    LAS int* el = (LAS int*)(lds + wave * 1024);
    const unsigned char* PU = ws + WS_PU + (size_t)vx * 4194304; const unsigned li16 = (unsigned)li * 16u; const unsigned char* H8 = ws + WS_H2I8 + vx * 256 + li * 16;
    const float* HS = (const float*)(ws + WS_SU);
    float* PA = (float*)(ws + WS_PA) + (size_t)vx * NT * 128;
    int e0 = 0, e1 = 0; u32x4 hn = {0u, 0u, 0u, 0u}; float hsn = 0.f;
    { const int t0 = rank * 8 + wave; if (t0 < NT) { const int* exg = (const int*)(ws + WS_EX) + (size_t)t0 * 128; e0 = exg[lane]; e1 = exg[64 + lane]; hn = *(const u32x4*)(H8 + (size_t)t0 * 2048); hsn = HS[(size_t)t0 * 8 + vx]; } }
    for (int t = rank * 8 + wave; t < NT; t += nrank * 8) {
        el[lane] = e0; el[64 + lane] = e1;
        const u32x4 hq = hn; const float hs = hsn;
        { const int tn = t + nrank * 8 < NT ? t + nrank * 8 : t; const int* exg = (const int*)(ws + WS_EX) + (size_t)tn * 128; e0 = exg[lane]; e1 = exg[64 + lane]; hn = *(const u32x4*)(H8 + (size_t)tn * 2048); hsn = HS[(size_t)tn * 8 + vx]; }
#pragma unroll
        for (int jb = 0; jb < 32; jb += 8) {
            u32x4 rw[8];
#pragma unroll
            for (int i = 0; i < 8; ++i) { const unsigned ex = (unsigned)el[4 * (jb + i) + gq]; rw[i] = *(const u32x4*)(PU + (ex * 256u + li16)); }
            float pr[8];
#pragma unroll
            for (int i = 0; i < 8; ++i) { int a = 0;
#pragma unroll
                for (int q = 0; q < 4; ++q) a = __builtin_amdgcn_sdot4((int)rw[i][q], (int)hq[q], a, false);
                pr[i] = (float)a; }
            const float tot = reduce8_row16(pr, li);
            if (!(li & 1)) PA[(size_t)t * 128 + 4 * (jb + (li >> 1)) + gq] = tot * hs;
        }
    }
}
DI float xor16_max(float x) { const auto r = __builtin_amdgcn_permlane16_swap(__float_as_uint(x), __float_as_uint(x), false, false); return fmaxf(__uint_as_float(r[0]), __uint_as_float(r[1])); }
DI void phase_peer_w(const Params& P) {
    unsigned char* ws = P.ws; const float* PA = (const float*)(ws + WS_PA); const float* GT = (const float*)(ws + WS_GT); const int* EX = (const int*)(ws + WS_EX); const float* PS = (const float*)(ws + WS_PSU);
    const int lane = threadIdx.x & 63, wave = __builtin_amdgcn_readfirstlane(threadIdx.x >> 6), d = lane & 31, gq = d >> 3;
    for (int t2 = (blockIdx.x * 8 + wave) * 2; t2 < NT; t2 += gridDim.x * 16) { const int t = t2 + (lane >> 5);
        float w[4], m = 0.f;
#pragma unroll
        for (int k = 0; k < 4; ++k) { const size_t i = (size_t)t * 128 + 16 * (d & 7) + 4 * k + gq; float a = 0.f;
#pragma unroll
            for (int x = 0; x < 8; ++x) a += PA[(size_t)x * NT * 128 + i];
            const int ee = EX[i];
            w[k] = GT[i] * PS[16384 + ee] * gelu_tanh(a * PS[ee]); m = fmaxf(m, fabsf(w[k])); }
        m = xor16_max(row_max_f32(m));
        const float qs = m > 0.f ? 127.f / m : 0.f; unsigned pk = 0u;
#pragma unroll
        for (int k = 0; k < 4; ++k) pk = __builtin_amdgcn_cvt_pk_u8_f32(__builtin_rintf(w[k] * qs) + 128.f, k, pk);
        ((unsigned*)(ws + WS_W8))[(size_t)t * 32 + d] = pk ^ 0x80808080u;
        if (d == 0) ((float*)(ws + WS_WT))[t] = m * (1.f / 127.f);
    }
    for (size_t i = (size_t)blockIdx.x * 512 + threadIdx.x; i < (size_t)NT * 8; i += (size_t)gridDim.x * 512) ((unsigned*)(ws + WS_SS))[i] = 0xFFFFFFFFu;
}
DI void peer_b_finish(unsigned* SSN, float* out, int tp, const f32x4& yp, unsigned sv, const f32x4& fg, int d, int lane) {
    while (__builtin_amdgcn_ballot_w64(sv == 0xFFFFFFFFu) != 0ull) { __builtin_amdgcn_s_sleep(1); sv = lane < 8 ? xb_ld(SSN + (size_t)tp * 8 + lane) : 0u; }
    const float tot = __builtin_amdgcn_readfirstlane(row16_sum(__uint_as_float(sv)));
    const float rs = rsqrtf(tot * (1.f / 2048.f) + 1e-6f);
    f32x4 o;
#pragma unroll
    for (int e = 0; e < 4; ++e) o[e] = yp[e] * rs * fg[e];
    *(f32x4*)(out + (size_t)tp * 2048 + d) = o;
}
DI void phase_peer_b(const Params& P, LAS unsigned char* lds) {
    unsigned char* ws = P.ws; const int lane = threadIdx.x & 63, wave = __builtin_amdgcn_readfirstlane(threadIdx.x >> 6); int vx, rank, nrank; peer_slice_map(P, lds, vx, rank, nrank);
    const int gq = lane >> 4, li = lane & 15;
    LAS int* el = (LAS int*)(lds + wave * 1024);
    const unsigned char* PV = ws + WS_PV + (size_t)vx * 4194304; const unsigned li16 = (unsigned)li * 16u;
    const bf16_t* X1 = (const bf16_t*)(ws + WS_X1); const float* mod = (const float*)(ws + WS_MOD);
    const unsigned char* W8 = ws + WS_W8 + gq * 32; const float* WT = (const float*)(ws + WS_WT);
    unsigned* SSN = (unsigned*)(ws + WS_SS);
    const int cq = ((gq & 1) << 1) | (gq >> 1); const int d = vx * 256 + li * 16 + 4 * cq;
    const f32x4 fg = *(const f32x4*)(P.final_g + d);
    f32x4 yA = {0.f, 0.f, 0.f, 0.f}, yB = {0.f, 0.f, 0.f, 0.f}; int tA = -1, tB = -1;
    int e0 = 0, e1 = 0; u32x2 wn[4]; float wtn = 0.f;
#pragma unroll
    for (int j = 0; j < 4; ++j) wn[j] = (u32x2){0u, 0u};
    { const int t0 = rank * 8 + wave; if (t0 < NT) { const int* exg = (const int*)(ws + WS_EX) + (size_t)t0 * 128; e0 = exg[lane]; e1 = exg[64 + lane];
#pragma unroll
        for (int j = 0; j < 4; ++j) wn[j] = *(const u32x2*)(W8 + (size_t)t0 * 128 + 8 * j);
        wtn = WT[t0]; } }
    for (int t = rank * 8 + wave; t < NT; t += nrank * 8) {
        el[lane] = e0; el[64 + lane] = e1;
        u32x2 wq[4];
#pragma unroll
        for (int j = 0; j < 4; ++j) wq[j] = wn[j];
        const float wt = wtn;
        { const int tn = t + nrank * 8 < NT ? t + nrank * 8 : t; const int* exg = (const int*)(ws + WS_EX) + (size_t)tn * 128; e0 = exg[lane]; e1 = exg[64 + lane];
#pragma unroll
          for (int j = 0; j < 4; ++j) wn[j] = *(const u32x2*)(W8 + (size_t)tn * 128 + 8 * j);
          wtn = WT[tn]; }
        const u32x2 xw = *(const u32x2*)(X1 + (size_t)t * 2048 + d); const f32x4 ga = *(const f32x4*)(mod + (t >> 12) * 12288 + 10240 + d);
        int acc[16]; unsigned sv = 0u;
        if (tA >= 0 && lane < 8) sv = xb_ld(SSN + (size_t)tA * 8 + lane);
#pragma unroll
        for (int i = 0; i < 16; ++i) acc[i] = 0;
#pragma unroll
        for (int jb = 0; jb < 32; jb += 8) {
            u32x4 rw[8];
#pragma unroll
            for (int i = 0; i < 8; ++i) { const unsigned ex = (unsigned)el[4 * (jb + i) + gq]; rw[i] = *(const u32x4*)(PV + (ex * 256u + li16)); }
#pragma unroll
            for (int h = 0; h < 2; ++h) { const int w4 = (int)wq[jb >> 3][h];
#pragma unroll
                for (int q = 0; q < 4; ++q) { const unsigned e0 = rw[4 * h][q], e1 = rw[4 * h + 1][q], e2 = rw[4 * h + 2][q], e3 = rw[4 * h + 3][q];
                    const unsigned t0 = __builtin_amdgcn_perm(e1, e0, 0x05010400u), t1 = __builtin_amdgcn_perm(e1, e0, 0x07030602u), t2 = __builtin_amdgcn_perm(e3, e2, 0x05010400u), t3 = __builtin_amdgcn_perm(e3, e2, 0x07030602u);
                    acc[4 * q + 0] = __builtin_amdgcn_sdot4((int)__builtin_amdgcn_perm(t2, t0, 0x05040100u), w4, acc[4 * q + 0], false);
                    acc[4 * q + 1] = __builtin_amdgcn_sdot4((int)__builtin_amdgcn_perm(t2, t0, 0x07060302u), w4, acc[4 * q + 1], false);
                    acc[4 * q + 2] = __builtin_amdgcn_sdot4((int)__builtin_amdgcn_perm(t3, t1, 0x05040100u), w4, acc[4 * q + 2], false);
                    acc[4 * q + 3] = __builtin_amdgcn_sdot4((int)__builtin_amdgcn_perm(t3, t1, 0x07060302u), w4, acc[4 * q + 3], false); } }
        }
        float v16[16], w8[8], o4[4];
#pragma unroll
        for (int i = 0; i < 16; ++i) v16[i] = (float)acc[i] * wt;
#pragma unroll
        for (int k = 0; k < 8; ++k) { const auto r = __builtin_amdgcn_permlane16_swap(__float_as_uint(v16[k]), __float_as_uint(v16[8 + k]), false, false); w8[k] = __uint_as_float(r[0]) + __uint_as_float(r[1]); }
#pragma unroll
        for (int k = 0; k < 4; ++k) { const auto r = __builtin_amdgcn_permlane32_swap(__float_as_uint(w8[k]), __float_as_uint(w8[4 + k]), false, false); o4[k] = __uint_as_float(r[0]) + __uint_as_float(r[1]); }
        const f32x4 xa = {bf_lo(xw[0]), bf_hi(xw[0]), bf_lo(xw[1]), bf_hi(xw[1])};
        f32x4 y; float ss = 0.f;
#pragma unroll
        for (int e = 0; e < 4; ++e) { y[e] = xa[e] + ga[e] * o4[e]; ss += y[e] * y[e]; }
        ss = wave_sum(ss); if (lane == 0) { unsigned sb_ = __float_as_uint(ss); sb_ = sb_ == 0xFFFFFFFFu ? 0x7FC00000u : sb_;
            __hip_atomic_store(SSN + (size_t)t * 8 + vx, sb_, __ATOMIC_RELAXED, __HIP_MEMORY_SCOPE_AGENT); }
        if (tA >= 0) peer_b_finish(SSN, P.out, tA, yA, sv, fg, d, lane);
        tA = tB; yA = yB; tB = t; yB = y;
    }
    if (tA >= 0) peer_b_finish(SSN, P.out, tA, yA, 0xFFFFFFFFu, fg, d, lane);
    if (tB >= 0) peer_b_finish(SSN, P.out, tB, yB, 0xFFFFFFFFu, fg, d, lane);
}


constexpr int N_PHASES = 15;
template <int K> DI void run_phase(const Params& P, LAS unsigned char* lds) {
    unsigned char* ws = P.ws; const int G = gridDim.x, bx = blockIdx.x, tid = threadIdx.x; (void)G; (void)bx; (void)tid;
    if constexpr (K == 0) { p0_prologue(P, lds); }
    if constexpr (K == 1) { phase_norm_f8(P.x, P.norm_mix_g, (const float*)(ws + WS_MOD), 0, 2048, ws + WS_H, (float*)(ws + WS_HSC)); }
    if constexpr (K == 2) {
        { pg8::Gemm g{(const bf16_t*)(ws + WS_H), (const bf16_t*)(ws + WS_WIN), 2048, 2048, 2048}; pg8::StaticOrder S; S.init(NT, NPROJ, G, bx); EpiProj E{ws, (const float*)(ws + WS_HSC)};
          pg8::gemm_phase<EpiProj, pg8::StaticOrder, true>(lds, g, S, E); }
        { pg8::Gemm g{(const bf16_t*)(ws + WS_KBD), (const bf16_t*)(ws + WS_WQ), 2048, 2048, 256, 512}; pg8::StaticOrder S; S.init(2048, 2048, G, (bx + 64) % G); EpiBf16Plain E{(bf16_t*)(ws + WS_WSC), 2048};
          pg8::gemm_phase<EpiBf16Plain, pg8::StaticOrder>(lds, g, S, E); }
    }
    if constexpr (K == 3) {
        { pg8::Gemm g{(const bf16_t*)(ws + WS_A2), (const bf16_t*)(ws + WS_S5B1), 384, 256, 256}; GroupOrder S{256, G, bx, 4}; EpiS5G1 E{(float*)(ws + WS_XL)};
          pg8::gemm_phase<EpiS5G1, GroupOrder>(lds, g, S, E); }
        { pg8::Gemm g{(const bf16_t*)(ws + WS_KV), (const bf16_t*)(ws + WS_WC1), 1024, 2048, 2048}; GroupOrder S{32, G, (bx + 128) % G, 16}; EpiCmp1 E{(bf16_t*)(ws + WS_HID), (const float*)(ws + WS_CB)};
          pg8::gemm_phase<EpiCmp1, GroupOrder>(lds, g, S, E); }
        phase_attn_win_early(P, lds);
    }
    if constexpr (K == 4) { phase_scan(P); phase_cmp2(P); }
    if constexpr (K == 5) {
        { pg8::Gemm g{(const bf16_t*)(ws + WS_A2), (const bf16_t*)(ws + WS_S5B2), 384, 384, 384}; GroupOrder S{256, G, bx, 4}; EpiS5G2 E{(bf16_t*)(ws + WS_YACT)};
          pg8::gemm_phase<EpiS5G2, GroupOrder>(lds, g, S, E); }
        phase_attn_cmp_win(P, lds);
    }
    if constexpr (K == 6) {
        { pg8::Gemm g{(const bf16_t*)(ws + WS_YACT), (const bf16_t*)(ws + WS_WGLU), 1024, 1024, 1024}; pg8::StaticOrder S; S.init(NT, 1024, G, bx); EpiGlu E{(const bf16_t*)(ws + WS_YACT), (bf16_t*)(ws + WS_Y2), P.glu_b};
          pg8::gemm_phase<EpiGlu, pg8::StaticOrder>(lds, g, S, E); }
        phase_attn_sel(P, lds);
    }
    if constexpr (K == 7) {
        pg8::Gemm g{(const bf16_t*)(ws + WS_OATT), (const bf16_t*)(ws + WS_WUA), 2048, 2048, 2048}; pg8::StaticOrder S; S.init(NT, 2048, G, bx); EpiUpF E{ws + WS_MG, ws + WS_MIX};
        pg8::gemm_phase<EpiUpF, pg8::StaticOrder, true>(lds, g, S, E);
    }
    if constexpr (K == 8) {
        pg8::Gemm g{(const bf16_t*)(ws + WS_MIX), (const bf16_t*)(ws + WS_WOUT), 2048, 2048, 2048}; pg8::StaticOrder S; S.init(NT, 2048, G, bx); EpiOut E{P.x, (const float*)(ws + WS_MOD), (bf16_t*)(ws + WS_X1)};
        pg8::gemm_phase<EpiOut, pg8::StaticOrder, true>(lds, g, S, E);
    }
    if constexpr (K == 9) {
        phase_norm((const bf16_t*)(ws + WS_X1), P.norm_ffn_g, (const float*)(ws + WS_MOD), 6144, 8192, (bf16_t*)(ws + WS_H2), ws + WS_H2I8, (float*)(ws + WS_SU));
    }
    if constexpr (K == 10) {
        pg8::Gemm g{(const bf16_t*)(ws + WS_H2), (const bf16_t*)(ws + WS_WSC), 2048, 2048, 2048}; pg8::StaticOrder S; S.init(NT, 2048, G, bx); EpiF16Plain E{(unsigned short*)(ws + WS_SC), 2048};
        pg8::gemm_phase<EpiF16Plain, pg8::StaticOrder>(lds, g, S, E);
    }
    if constexpr (K == 11) { phase_peer(P, lds); }
    if constexpr (K == 12) { phase_peer_a(P, lds); }
    if constexpr (K == 13) { phase_peer_w(P); }
    if constexpr (K == 14) { phase_peer_b(P, lds); }
}

__global__ void __launch_bounds__(512, 2) mk_fwd(Params P) {
    extern __shared__ __attribute__((aligned(16))) unsigned char lds_raw[];
    LAS unsigned char* lds = (LAS unsigned char*)lds_raw;
    unsigned char* ws = P.ws;
    const int G = gridDim.x, bx = blockIdx.x, tid = threadIdx.x;
    volatile LAS unsigned* misc = (volatile LAS unsigned*)(lds + LDS_MISC);
    if (tid < 8) misc[tid] = 0u;
    __syncthreads();
    const int lo = P.ph_lo, hi = P.ph_hi;
    XcdBarrier bar; bar.bar = (unsigned*)(ws + WS_BAR); bar.x = 0; bar.st = misc;
    if (hi - lo > 1) bar = xcd_barrier_post((unsigned*)(ws + WS_BAR), misc);
    if (tid == 0) { const unsigned xcc = xb_xcc_id(); misc[4] = xcc; misc[5] = (hi - lo > 1) ? xb_add((unsigned*)(ws + WS_BAR) + 8192 + 64 * (xcc & 15u), 1u) : 0u; }
    __syncthreads();
#define IN(k) (lo <= (k) && (k) < hi)
#define SEAM(k) do { if (IN(k) && IN((k) + 1)) xcd_barrier(bar); } while (0)

    if (IN(0)) run_phase<0>(P, lds);
    SEAM(0);
    if (IN(1)) run_phase<1>(P, lds);
    SEAM(1);
    if (IN(2)) run_phase<2>(P, lds);
    SEAM(2);
    if (IN(3)) run_phase<3>(P, lds);
    SEAM(3);
    if (IN(4)) run_phase<4>(P, lds);
    SEAM(4);
    if (IN(5)) run_phase<5>(P, lds);
    SEAM(5);
    if (IN(6)) run_phase<6>(P, lds);
    SEAM(6);
    if (IN(7)) run_phase<7>(P, lds);
    SEAM(7);
    if (IN(8)) run_phase<8>(P, lds);
    SEAM(8);
    if (IN(9)) run_phase<9>(P, lds);
    SEAM(9);
    if (IN(10)) run_phase<10>(P, lds);
    SEAM(10);
    if (IN(11)) run_phase<11>(P, lds);
    SEAM(11);
    if (IN(12)) run_phase<12>(P, lds);
    SEAM(12);
    if (IN(13)) run_phase<13>(P, lds);
    SEAM(13);
    if (IN(14)) run_phase<14>(P, lds);
#undef IN
#undef SEAM
}

extern "C" void kernel_launch(void* const* d_in, const int* in_sizes, int n_in, void* d_out, int out_size, void* d_ws, size_t ws_size, hipStream_t stream) {
    static int grid = 0;
    if (grid == 0) {
        if (n_in != 31 || ws_size < WS_END) { fprintf(stderr, "kernel_launch: expected 31 inputs and >= %zu bytes of workspace (got %d, %zu)\n", (size_t)WS_END, n_in, ws_size); grid = -1; return; }
        int dev = 0, cus = 0, per_cu = 0;
        if (hipGetDevice(&dev) != hipSuccess || hipDeviceGetAttribute(&cus, hipDeviceAttributeMultiprocessorCount, dev) != hipSuccess) { grid = -1; return; }
        if (hipFuncSetAttribute((const void*)mk_fwd, hipFuncAttributeMaxDynamicSharedMemorySize, LDS_BYTES) != hipSuccess) { fprintf(stderr, "kernel_launch: hipFuncSetAttribute failed\n"); grid = -1; return; }
        if (hipOccupancyMaxActiveBlocksPerMultiprocessor(&per_cu, (const void*)mk_fwd, 512, LDS_BYTES) != hipSuccess || per_cu < 1) { fprintf(stderr, "kernel_launch: occupancy query reports %d blocks per CU\n", per_cu); (void)hipGetLastError(); grid = -1; return; }
        grid = cus;
    }
    if (grid < 0) return;
    (void)hipMemsetAsync((char*)d_ws + WS_BAR, 0, 65536, stream);
    Params p{};
    const float** f = (const float**)&p;
    for (int i = 0; i < 31; ++i) f[i] = (const float*)d_in[i];
    p.out = (float*)d_out; p.ws = (unsigned char*)d_ws;
#if MK_PER_PHASE
    for (int ph = 0; ph < N_PHASES; ++ph) { p.ph_lo = ph; p.ph_hi = ph + 1; hipLaunchKernelGGL(mk_fwd, dim3(grid), dim3(512), LDS_BYTES, stream, p); }
#else
    p.ph_lo = 0; p.ph_hi = N_PHASES; hipLaunchKernelGGL(mk_fwd, dim3(grid), dim3(512), LDS_BYTES, stream, p);
#endif
}
```

```cpp
#include <hip/hip_runtime.h>
#include <stdint.h>
#include <stdio.h>
#include <math.h>
#include <type_traits>


#ifndef MK_PER_PHASE
#define MK_PER_PHASE 0
#endif

#define XB_TMO      128
#define XB_XCNT(j)  (256  + 64 * (j))
#define XB_XSUB(j)  (1280 + 64 * (j))
#define XB_XGEN(j)  (2304 + 64 * (j))
#define XB_TOP      3328
#define XB_TOPGEN   3392
#define XCD_BAR_WORDS 3456
#define XB_SPIN_CAP (1u << 18)
#define LAS __attribute__((address_space(3)))

__device__ __forceinline__ unsigned xb_ld(unsigned* p)              { return __hip_atomic_load(p, __ATOMIC_RELAXED, __HIP_MEMORY_SCOPE_AGENT); }
__device__ __forceinline__ unsigned xb_add(unsigned* p, unsigned v) { return __hip_atomic_fetch_add(p, v, __ATOMIC_RELAXED, __HIP_MEMORY_SCOPE_AGENT); }
__device__ __forceinline__ unsigned xb_xcc_id() { return (unsigned)__builtin_amdgcn_s_getreg((3 << 11) | 20) & 0xFu; }
#define XB_SPIN(cond, bar) do { unsigned _sp = 0; while (cond) { __builtin_amdgcn_s_sleep(1); \
    if ((++_sp & 255u) == 0u) { if (xb_ld(&(bar)[XB_TMO])) break; if (_sp > XB_SPIN_CAP) { atomicAdd(&(bar)[XB_TMO], 1u); break; } } } } while (0)

struct XcdBarrier {
    unsigned* bar; unsigned x;
    volatile LAS unsigned* st;
};

__device__ __forceinline__ XcdBarrier xcd_barrier_post(unsigned* bar, volatile LAS unsigned* st) {
    XcdBarrier b; b.bar = bar; b.x = xb_xcc_id(); b.st = st;
    if (threadIdx.x == 0) (void)xb_add(&bar[XB_XCNT(b.x)], 1u);
    return b;
}
__device__ __forceinline__ void xcd_barrier_complete(unsigned* bar, unsigned x, unsigned& nloc, unsigned& nx) {
    const unsigned G = gridDim.x * gridDim.y * gridDim.z;
    unsigned sum, cnt, mine, sp = 0u;
    for (;;) {
        sum = 0u; cnt = 0u; mine = 0u;
#pragma unroll
        for (unsigned j = 0; j < 16; ++j) { const unsigned c = xb_ld(&bar[XB_XCNT(j)]); sum += c; cnt += (c > 0u) ? 1u : 0u; mine = (j == x) ? c : mine; }
        if (sum == G) break;
        __builtin_amdgcn_s_sleep(1);
        if ((++sp & 255u) == 0u) { if (xb_ld(&bar[XB_TMO])) break; if (sp > XB_SPIN_CAP) { atomicAdd(&bar[XB_TMO], 1u); break; } }
    }
    nloc = mine > 0u ? mine : 1u; nx = cnt > 0u ? cnt : 1u;
}

__device__ __forceinline__ void xcd_barrier(const XcdBarrier& b) {
    asm volatile("s_waitcnt vmcnt(0)" ::: "memory");
    __syncthreads();
    if (threadIdx.x == 0) {
        unsigned* bar = b.bar;
        __builtin_amdgcn_s_waitcnt(0);
        unsigned nloc = b.st[0], nx = b.st[1];
        if (nloc == 0u) { xcd_barrier_complete(bar, b.x, nloc, nx); b.st[0] = nloc; b.st[1] = nx; }
        const unsigned old = xb_add(&bar[XB_XSUB(b.x)], 1u);
        const unsigned gen = old / nloc;
        if (old + 1u == (gen + 1u) * nloc) {
            __builtin_amdgcn_fence(__ATOMIC_RELEASE, "agent");
            asm volatile("s_waitcnt vmcnt(0)" ::: "memory");
            const unsigned og = xb_add(&bar[XB_TOP], 1u);
            const unsigned tg = og / nx;
            if (og + 1u == (tg + 1u) * nx) xb_add(&bar[XB_TOPGEN], 1u);
            else XB_SPIN(xb_ld(&bar[XB_TOPGEN]) == tg, bar);
            __builtin_amdgcn_fence(__ATOMIC_ACQUIRE, "agent");
            xb_add(&bar[XB_XGEN(b.x)], 1u);
            asm volatile("s_waitcnt vmcnt(0)" ::: "memory");
        } else {
            XB_SPIN(xb_ld(&bar[XB_XGEN(b.x)]) == gen, bar);
            __builtin_amdgcn_fence(__ATOMIC_ACQUIRE, "agent");
            asm volatile("s_waitcnt vmcnt(0)" ::: "memory");
        }
    }
    __syncthreads();
}


namespace pg8 {
#define PG8_LAS __attribute__((address_space(3)))
typedef unsigned short bf16_t;
typedef short bf16x8 __attribute__((ext_vector_type(8)));
typedef float f32x4 __attribute__((ext_vector_type(4)));
typedef unsigned u32x4 __attribute__((ext_vector_type(4)));
constexpr int BM = 256, BK = 64, HALF = 128, HTB = HALF * BK * 2  , STAGE_BYTES = 8 * HTB, NXCD = 8, WGM = 8;

__host__ __device__ __forceinline__ int lds_byte(int r, int c) { const int st = (r >> 4) * 2 + (c >> 5), rr = r & 15, cc = c & 31, ob = rr * 64 + cc * 2; return st * 1024 + (ob ^ (((ob >> 9) & 1) << 5)); }
__host__ __device__ __forceinline__ void stage_rc(int b, int& R, int& C) { const int st = b / 1024, sb = b % 1024, swz = sb ^ (((sb >> 9) & 1) << 5); R = (st >> 1) * 16 + swz / 64; C = (st & 1) * 32 + (swz % 64) / 2; }
__host__ __device__ __forceinline__ int perm32(int rho) { const int n = rho >> 4, i = rho & 15; return 8 * (i >> 2) + 4 * n + (i & 3); }

struct Unit { int pm, pn; };
struct Gemm { const bf16_t* A; const bf16_t* Bt; int lda, ldb, K; int kdiag = 0; };
struct StaticOrder {
    int nM, nN, nwg, G, c;
    __host__ __device__ void init(int M, int N, int G_, int c_) { nM = M / BM; nN = N / BM; nwg = nM * nN; G = G_; c = c_; }
    __host__ __device__ bool next(int i, Unit& u) const {
        const long L = (long)i * G + c; if (L >= nwg) return false;
        int wgid = (int)L; { const int q = nwg / NXCD, r = nwg % NXCD, xcd = wgid % NXCD, off = wgid / NXCD; wgid = (xcd < r ? xcd * (q + 1) : r * (q + 1) + (xcd - r) * q) + off; }
        const int nig = WGM * nN, gid = wgid / nig, fm = gid * WGM, gsz = (nM - fm) < WGM ? (nM - fm) : WGM;
        u.pm = fm + ((wgid % nig) % gsz); u.pn = (wgid % nig) / gsz; return true;
    }
    __device__ __forceinline__ void a_ready(const Unit&) const {}
    __device__ __forceinline__ void done(const Unit&) const {}
};
typedef int pg8_i4 __attribute__((ext_vector_type(4)));
typedef int pg8_i8 __attribute__((ext_vector_type(8)));
template <bool F8> struct FragSel { struct T { bf16x8 k[2]; }; };
template <> struct FragSel<true> { typedef pg8_i8 T; };
template <class Epi, class Sched, bool F8 = false>
__device__ __forceinline__ void gemm_phase(PG8_LAS unsigned char* lds, const Gemm g, const Sched& S, const Epi& E) {
    const int tid = threadIdx.x, wid = __builtin_amdgcn_readfirstlane(tid >> 6), lane = tid & 63, wr = wid >> 2, wc = wid & 3, fr = lane & 15, fq = lane >> 4;
    constexpr int ES = F8 ? 1 : 2;
    const int K = g.K, nt = K * ES / 128;
    unsigned voffA[2], voffB[2];
#pragma unroll
    for (int i = 0; i < 2; ++i) { int R, C; stage_rc(tid * 16 + i * 8192, R, C); const int Rb = Epi::PERM ? ((R & ~31) + perm32(R & 31)) : R;
        voffA[i] = (unsigned)(R * g.lda * ES + C * 2); voffB[i] = (unsigned)(Rb * g.ldb * ES + C * 2); }
    const size_t kstep = (size_t)(BK * 2);
    const size_t hstepA = (size_t)HALF * g.lda * ES, hstepB = (size_t)HALF * g.ldb * ES;
    const size_t tstepA = 2 * hstepA, tstepB = 2 * hstepB;
    const unsigned ldsb = (unsigned)(size_t)lds;
    const unsigned ldsw = (unsigned)wid * 1024u;
    const int aoff = lds_byte(wr * 64 + fr, fq * 8), boff = lds_byte(wc * 32 + fr, fq * 8);
#define PG8_SA(b, h) (((b) * 2 + (h)) * HTB)
#define PG8_SB(b, h) ((4 + (b) * 2 + (h)) * HTB)
#define PG8_STAGE(bufoff, gbase, voff) do { _Pragma("unroll") for (int _i = 0; _i < 2; ++_i) { const unsigned la_ = ldsb + (unsigned)(bufoff) + ldsw + (unsigned)(_i * 8192); \
        asm volatile("s_mov_b32 m0, %2\n\ts_nop 0\n\tglobal_load_lds_dwordx4 %0, %1" :: "v"((voff)[_i]), "s"((const char*)(gbase)), "s"(la_) : "memory", "m0"); } } while (0)
#define PG8_LDF(d_, p_) do { if constexpr (F8) d_ = __builtin_shufflevector(*(const PG8_LAS pg8_i4*)(p_), *(const PG8_LAS pg8_i4*)((p_) + 1024), 0, 1, 2, 3, 4, 5, 6, 7); \
        else { d_.k[0] = *(const PG8_LAS bf16x8*)(p_); d_.k[1] = *(const PG8_LAS bf16x8*)((p_) + 1024); } } while (0)
#define PG8_LDA(dst, b, h) do { _Pragma("unroll") for (int m = 0; m < 4; ++m) PG8_LDF(dst[m], lds + PG8_SA(b, h) + aoff + m * 2048); } while (0)
#define PG8_LDB(dst, b, h) do { _Pragma("unroll") for (int n = 0; n < 2; ++n) PG8_LDF(dst[n], lds + PG8_SB(b, h) + boff + n * 2048); } while (0)
#define PG8_MMA(ai, bj, At, Bt) do { __builtin_amdgcn_s_setprio(1); _Pragma("unroll") for (int m = 0; m < 4; ++m) _Pragma("unroll") for (int n = 0; n < 2; ++n) { \
        if constexpr (F8) asm volatile("v_mfma_scale_f32_16x16x128_f8f6f4 %0, %1, %2, %0, %3, %3 op_sel_hi:[0,0,0]" : "+v"(acc[ai][bj][m][n]) : "v"(Bt[n]), "v"(At[m]), "v"(sc1_));     \
        else { _Pragma("unroll") for (int k = 0; k < 2; ++k) acc[ai][bj][m][n] = __builtin_amdgcn_mfma_f32_16x16x32_bf16(Bt[n].k[k], At[m].k[k], acc[ai][bj][m][n], 0, 0, 0); } } __builtin_amdgcn_s_setprio(0); } while (0)
#define PG8_WAIT_V(n) asm volatile("s_waitcnt vmcnt(" #n ")" ::: "memory")
#define PG8_WAIT_L(n) asm volatile("s_waitcnt lgkmcnt(" #n ")" ::: "memory")
#define PG8_BAR __builtin_amdgcn_s_barrier()
#define PG8_SCHED __builtin_amdgcn_sched_barrier(0)
    Unit cur, nxt; int ui = 0;
    if (!S.next(0, cur)) return;
    f32x4 acc[2][2][4][2];
#pragma unroll
    for (int a = 0; a < 2; ++a)
#pragma unroll
        for (int b = 0; b < 2; ++b)
#pragma unroll
            for (int m = 0; m < 4; ++m)
#pragma unroll
                for (int n = 0; n < 2; ++n) acc[a][b][m][n] = (f32x4){0.f, 0.f, 0.f, 0.f};
    typedef typename FragSel<F8>::T frag_t;
    frag_t At[4], B0[2], B1[2];
    int sc1_ = 0x7F7F7F7F; if constexpr (F8) asm volatile("" : "+v"(sc1_));
    const char* cA = (const char*)g.A + (size_t)cur.pm * tstepA + (size_t)cur.pm * g.kdiag; const char* cB = (const char*)g.Bt + (size_t)cur.pn * tstepB + (size_t)cur.pm * g.kdiag;
    S.a_ready(cur);
    PG8_STAGE(PG8_SB(0, 0), cB, voffB); PG8_STAGE(PG8_SA(0, 0), cA, voffA); PG8_STAGE(PG8_SB(0, 1), cB + hstepB, voffB); PG8_STAGE(PG8_SA(0, 1), cA + hstepA, voffA);
    if (wr == 1) PG8_BAR;
    PG8_WAIT_V(4); PG8_BAR;
    PG8_STAGE(PG8_SB(1, 0), cB + kstep, voffB); PG8_STAGE(PG8_SA(1, 0), cA + kstep, voffA); PG8_STAGE(PG8_SB(1, 1), cB + hstepB + kstep, voffB);
    PG8_WAIT_V(6); PG8_BAR;
    for (;;) {
        const bool has_next = S.next(ui + 1, nxt);
        const char* nA = has_next ? (const char*)g.A + (size_t)nxt.pm * tstepA + (size_t)nxt.pm * g.kdiag : cA; const char* nB = has_next ? (const char*)g.Bt + (size_t)nxt.pn * tstepB + (size_t)nxt.pm * g.kdiag : cB;
        for (int t = 0; t < nt; t += 2) {
            const bool last = (t == nt - 2);
            const char* a1 = cA + (size_t)(t + 1) * kstep;
            const char* a2 = last ? nA : cA + (size_t)(t + 2) * kstep; const char* b2 = last ? nB : cB + (size_t)(t + 2) * kstep;
            const char* a3 = a2 + kstep; const char* b3 = b2 + kstep;
            if (last && has_next) S.a_ready(nxt);
            if constexpr (Epi::MIDK > 0) { if (t == Epi::MIDK) {
                if constexpr (F8) asm volatile("s_nop 15\n\ts_nop 7" ::: "memory");
                int fr_ = fr, fq_ = fq; asm volatile("" : "+v"(fr_), "+v"(fq_));
                E.mid(acc, cur, wr, wc, fr_, fq_);
                asm volatile("s_waitcnt vmcnt(0)\n\ts_nop 7" ::: "memory"); } }
            PG8_LDB(B0, 0, 0); PG8_SCHED; PG8_LDA(At, 0, 0); PG8_STAGE(PG8_SA(1, 1), a1 + hstepA, voffA);
            PG8_WAIT_L(8); PG8_BAR; PG8_WAIT_L(0); PG8_MMA(0, 0, At, B0); PG8_BAR; PG8_SCHED;
            PG8_LDB(B1, 0, 1); PG8_STAGE(PG8_SB(0, 0), b2, voffB);
            PG8_BAR; PG8_WAIT_L(0); PG8_MMA(0, 1, At, B1); PG8_BAR;
            PG8_LDA(At, 0, 1); PG8_STAGE(PG8_SA(0, 0), a2, voffA);
            PG8_BAR; PG8_WAIT_L(0); PG8_MMA(1, 0, At, B0); PG8_BAR; PG8_SCHED;
            PG8_STAGE(PG8_SB(0, 1), b2 + hstepB, voffB);
            PG8_WAIT_V(6); PG8_BAR; PG8_MMA(1, 1, At, B1); PG8_BAR;
            PG8_LDB(B0, 1, 0); PG8_SCHED; PG8_LDA(At, 1, 0); PG8_STAGE(PG8_SA(0, 1), a2 + hstepA, voffA);
            PG8_WAIT_L(8); PG8_BAR; PG8_WAIT_L(0); PG8_MMA(0, 0, At, B0); PG8_BAR; PG8_SCHED;
            PG8_LDB(B1, 1, 1); PG8_STAGE(PG8_SB(1, 0), b3, voffB);
            PG8_BAR; PG8_WAIT_L(0); PG8_MMA(0, 1, At, B1); PG8_BAR;
            PG8_LDA(At, 1, 1); PG8_STAGE(PG8_SA(1, 0), a3, voffA);
            PG8_BAR; PG8_WAIT_L(0); PG8_MMA(1, 0, At, B0); PG8_BAR; PG8_SCHED;
            PG8_STAGE(PG8_SB(1, 1), b3 + hstepB, voffB);
            PG8_WAIT_V(6); PG8_BAR; PG8_MMA(1, 1, At, B1); PG8_BAR;
        }
        if constexpr (F8) asm volatile("s_nop 15\n\ts_nop 7" ::: "memory");
        if constexpr (!Epi::AFTER_DRAIN) { int fr_ = fr, fq_ = fq; asm volatile("" : "+v"(fr_), "+v"(fq_));
            E(acc, cur, wr, wc, fr_, fq_); S.done(cur); }
        if (!has_next) break;
#pragma unroll
        for (int a = 0; a < 2; ++a)
#pragma unroll
            for (int b = 0; b < 2; ++b)
#pragma unroll
                for (int m = 0; m < 4; ++m)
#pragma unroll
                    for (int n = 0; n < 2; ++n) acc[a][b][m][n] = (f32x4){0.f, 0.f, 0.f, 0.f};
        cur = nxt; cA = nA; cB = nB; ++ui;
    }
    PG8_WAIT_V(0);
    if (wr == 0) PG8_BAR;
    PG8_BAR;
    if constexpr (Epi::AFTER_DRAIN) { E.fused(acc, cur, wr, wc, fr, fq, lds, wid, lane); S.done(cur); }
#undef PG8_SA
#undef PG8_SB
#undef PG8_STAGE
#undef PG8_LDF
#undef PG8_LDA
#undef PG8_LDB
#undef PG8_MMA
#undef PG8_WAIT_V
#undef PG8_WAIT_L
#undef PG8_BAR
#undef PG8_SCHED
}
}

typedef unsigned short bf16_t;
typedef short bf16x8 __attribute__((ext_vector_type(8)));
typedef short s16x4 __attribute__((ext_vector_type(4)));
typedef float f32x2 __attribute__((ext_vector_type(2)));
typedef float f32x4 __attribute__((ext_vector_type(4)));
typedef float f32x16 __attribute__((ext_vector_type(16)));
typedef unsigned u32x2 __attribute__((ext_vector_type(2)));
typedef unsigned u32x4 __attribute__((ext_vector_type(4)));
typedef __bf16 bf16v2 __attribute__((ext_vector_type(2)));

constexpr int NB = 4, SEQ = 4096, NT = NB * SEQ, DM = 2048;
constexpr int NPROJ = 7936;
constexpr int NCMP = 255;
constexpr float QSCALE = 0.125f * 1.4426950408889634f;
constexpr float LOG2E = 1.4426950408889634f;
constexpr float NEGBIG = -1e30f;
constexpr float OATT_SCALE = 64.f, Y2_SCALE = 16.f, MIX_SCALE = 64.f; constexpr int UA_LD = 2048;

constexpr size_t WS_BAR   = 0;
constexpr size_t WS_MOD   = 65536;
constexpr size_t WS_CB    = WS_MOD + 196608;
constexpr size_t WS_A16   = WS_CB + 2048;
constexpr size_t WS_W     = 327680;
constexpr size_t WS_WIN   = WS_W;
constexpr size_t WS_WGLU  = WS_WIN + (size_t)NPROJ * 2048 * 2;
constexpr size_t WS_WUA   = WS_WGLU + 2097152;
constexpr size_t WS_WUS   = WS_WUA + 4194304;
constexpr size_t WS_WOUT  = WS_WUS + 4194304;
constexpr size_t WS_WQ    = WS_WOUT + 8388608;
constexpr size_t WS_KBD   = WS_WQ + 8388608;
constexpr size_t WS_WSC   = WS_KBD + 8388608;
constexpr size_t WS_WC1   = WS_WSC + 8388608;
constexpr size_t WS_S5B1  = WS_WC1 + 2097152;
constexpr size_t WS_S5B2  = WS_S5B1 + 8388608;
constexpr size_t WS_HID   = WS_S5B2 + 12582912;
constexpr size_t WS_CKV   = WS_HID + 4194304;
constexpr size_t WS_GATE  = WS_CKV + 1048576;
constexpr size_t WS_SELM  = WS_GATE + 3145728;
constexpr size_t WS_RA    = WS_SELM + 524288;
constexpr size_t WS_RB    = WS_RA + 67108864;
constexpr size_t WS_RC    = WS_RB + 134217728;
constexpr size_t WS_RD    = WS_RC + 134217728;
constexpr size_t WS_END   = WS_RD + 134217728;
constexpr size_t WS_H = WS_RA, WS_HSC = WS_RD + 104857600  , WS_OC = WS_RA, WS_OW = WS_RA + 33554432, WS_MIX = WS_RA, WS_H2 = WS_RA;
constexpr size_t WS_MG = WS_RB, WS_SC = WS_RB;
constexpr size_t WS_Q = WS_RC, WS_KV = WS_RC + 33554432, WS_A2 = WS_KV + 6 * 8388608, WS_X1 = WS_RC, WS_H2I8 = WS_RC + 67108864  ;
constexpr size_t WS_XL = WS_RD, WS_YACT = WS_RD + 33554432, WS_OATT = WS_RD + 67108864  , WS_Y2 = WS_OATT + 1024, WS_TMP = WS_RD, WS_YA8 = WS_RD + 109051904  , WS_WC2 = WS_RD + 125829120  , WS_PU = WS_RD, WS_PV = WS_RD + 33554432, WS_PSU = WS_RD + 67108864, WS_PSV = WS_RD + 67108864 + 65536, WS_EX = WS_RD + 68157440, WS_GT = WS_EX + 8388608, WS_SS = WS_GT + 8388608, WS_SU = WS_SS + 1048576  , WS_W8 = WS_SU + 1048576  , WS_WT = WS_SU + 4194304  , WS_PA = WS_RB;

constexpr int LDS_BYTES = 147456;
constexpr int LDS_MISC = 131072;

struct Params {
    const float* x; const float* c; const float* ada_w; const float* ada_b; const float* norm_mix_g; const float* norm_ffn_g; const float* w_in;
    const float* cmp_pos; const float* cmp_w1; const float* cmp_b1; const float* cmp_w2; const float* cmp_b2; const float* rel_bias;
    const float* s5_lam_re; const float* s5_lam_im; const float* s5_log_step; const float* s5_b_re; const float* s5_b_im; const float* s5_c_re; const float* s5_c_im; const float* s5_d;
    const float* glu_w; const float* glu_b; const float* w_up_attn; const float* w_up_ssm; const float* w_out; const float* peer_w_q; const float* peer_sub_keys;
    const float* peer_u; const float* peer_v; const float* final_g;
    float* out; unsigned char* ws; int ph_lo, ph_hi;
};

#define DI __device__ __forceinline__
DI unsigned pk_bf16(float lo, float hi) { bf16v2 v; v[0] = (__bf16)lo; v[1] = (__bf16)hi; return __builtin_bit_cast(unsigned, v); }
DI bf16_t f2bf(float x) { return (bf16_t)(pk_bf16(x, 0.f) & 0xffffu); }
DI float bf_lo(unsigned u) { return __uint_as_float(u << 16); }
DI float bf_hi(unsigned u) { return __uint_as_float(u & 0xffff0000u); }
DI float bf2f(bf16_t b) { return __uint_as_float(((unsigned)b) << 16); }
DI bf16v2 bf16pair(unsigned w) { return __builtin_bit_cast(bf16v2, w); }
DI float dot2_bf16(unsigned w, unsigned x, float acc) { return __builtin_amdgcn_fdot2_f32_bf16(__builtin_bit_cast(bf16v2, w), __builtin_bit_cast(bf16v2, x), acc, false); }
DI float sigm(float x) { return __builtin_amdgcn_rcpf(1.f + __builtin_amdgcn_exp2f(-1.4426950408889634f * x)); }
DI float gelu_tanh(float x) { const float u = 1.5957691216f * (x + 0.044715f * x * x * x); return x * __builtin_amdgcn_rcpf(1.f + __builtin_amdgcn_exp2f(-1.4426950408889634f * u)); }
DI float xor32_add(float x) { const auto r = __builtin_amdgcn_permlane32_swap(__float_as_uint(x), __float_as_uint(x), false, false); return __uint_as_float(r[0]) + __uint_as_float(r[1]); }
DI float xor16_add(float x) { const auto r = __builtin_amdgcn_permlane16_swap(__float_as_uint(x), __float_as_uint(x), false, false); return __uint_as_float(r[0]) + __uint_as_float(r[1]); }
DI float xor32_max(float x) { const auto r = __builtin_amdgcn_permlane32_swap(__float_as_uint(x), __float_as_uint(x), false, false); return fmaxf(__uint_as_float(r[0]), __uint_as_float(r[1])); }
DI float row16_sum(float v) {
    asm volatile("s_nop 1\n\tv_add_f32_dpp %0, %0, %0 quad_perm:[1,0,3,2] row_mask:0xf bank_mask:0xf\n\ts_nop 1\n\tv_add_f32_dpp %0, %0, %0 quad_perm:[2,3,0,1] row_mask:0xf bank_mask:0xf\n\t"
                 "s_nop 1\n\tv_add_f32_dpp %0, %0, %0 row_half_mirror row_mask:0xf bank_mask:0xf\n\ts_nop 1\n\tv_add_f32_dpp %0, %0, %0 row_mirror row_mask:0xf bank_mask:0xf\n\ts_nop 1" : "+v"(v));
    return v; }
DI float wave_sum(float v) { return xor32_add(xor16_add(row16_sum(v))); }
DI float reduce8_row16(const float (&v)[8], int li) {
    const bool b3 = (li & 8) != 0, b2 = (li & 4) != 0, b1 = (li & 2) != 0; float t[4], u[2], w, z;
#pragma unroll
    for (int k = 0; k < 4; ++k) { const float keep = b3 ? v[4 + k] : v[k], send = b3 ? v[k] : v[4 + k];
        asm volatile("s_nop 1\n\tv_add_f32_dpp %0, %1, %2 row_mirror row_mask:0xf bank_mask:0xf" : "=v"(t[k]) : "v"(send), "v"(keep)); }
#pragma unroll
    for (int k = 0; k < 2; ++k) { const float keep = b2 ? t[2 + k] : t[k], send = b2 ? t[k] : t[2 + k];
        asm volatile("s_nop 1\n\tv_add_f32_dpp %0, %1, %2 row_half_mirror row_mask:0xf bank_mask:0xf" : "=v"(u[k]) : "v"(send), "v"(keep)); }
    { const float keep = b1 ? u[1] : u[0], send = b1 ? u[0] : u[1];
      asm volatile("s_nop 1\n\tv_add_f32_dpp %0, %1, %2 quad_perm:[3,2,1,0] row_mask:0xf bank_mask:0xf" : "=v"(w) : "v"(send), "v"(keep)); }
    asm volatile("s_nop 1\n\tv_add_f32_dpp %0, %1, %1 quad_perm:[1,0,3,2] row_mask:0xf bank_mask:0xf" : "=v"(z) : "v"(w));
    return z; }
DI unsigned row16_max_u32(unsigned v) {
    asm volatile("s_nop 1\n\tv_max_u32_dpp %0, %0, %0 quad_perm:[1,0,3,2] row_mask:0xf bank_mask:0xf\n\ts_nop 1\n\tv_max_u32_dpp %0, %0, %0 quad_perm:[2,3,0,1] row_mask:0xf bank_mask:0xf\n\t"
                 "s_nop 1\n\tv_max_u32_dpp %0, %0, %0 row_half_mirror row_mask:0xf bank_mask:0xf\n\ts_nop 1\n\tv_max_u32_dpp %0, %0, %0 row_mirror row_mask:0xf bank_mask:0xf\n\ts_nop 1" : "+v"(v));
    return v; }
DI unsigned wave_max_u32(unsigned v) {
    v = row16_max_u32(v);
    { const auto r = __builtin_amdgcn_permlane16_swap(v, v, false, false); v = max(r[0], r[1]); }
    { const auto r = __builtin_amdgcn_permlane32_swap(v, v, false, false); v = max(r[0], r[1]); }
    return (unsigned)__builtin_amdgcn_readfirstlane((int)v); }
DI unsigned mono_u32(float x) { const unsigned b = __float_as_uint(x); return b ^ (((int)b >> 31) | 0x80000000u); }
DI void store8_bf16(bf16_t* p, f32x4 a, f32x4 b) { u32x4 w; w[0] = pk_bf16(a[0], a[1]); w[1] = pk_bf16(a[2], a[3]); w[2] = pk_bf16(b[0], b[1]); w[3] = pk_bf16(b[2], b[3]); *(u32x4*)p = w; }
DI float clamp448(float x) { return __builtin_amdgcn_fmed3f(x, -448.f, 448.f); }
DI void store8_fp8(unsigned char* p, f32x4 a, f32x4 b, float sc) {
    int p0 = __builtin_amdgcn_cvt_pk_fp8_f32(clamp448(a[0] * sc), clamp448(a[1] * sc), 0, false); p0 = __builtin_amdgcn_cvt_pk_fp8_f32(clamp448(a[2] * sc), clamp448(a[3] * sc), p0, true);
    int p1 = __builtin_amdgcn_cvt_pk_fp8_f32(clamp448(b[0] * sc), clamp448(b[1] * sc), 0, false); p1 = __builtin_amdgcn_cvt_pk_fp8_f32(clamp448(b[2] * sc), clamp448(b[3] * sc), p1, true);
    u32x2 w; w[0] = (unsigned)p0; w[1] = (unsigned)p1; *(u32x2*)p = w; }
DI void load8_bf16(const bf16_t* p, f32x4& a, f32x4& b) { const u32x4 w = *(const u32x4*)p; a = (f32x4){bf_lo(w[0]), bf_hi(w[0]), bf_lo(w[1]), bf_hi(w[1])}; b = (f32x4){bf_lo(w[2]), bf_hi(w[2]), bf_lo(w[3]), bf_hi(w[3])}; }

#define EPI_ROWS(ai, m) for (int ai = 0; ai < 2; ++ai) for (int m = 0; m < 4; ++m)
struct EpiProj {
    static constexpr bool PERM = true, AFTER_DRAIN = false; static constexpr int MIDK = 0;
    unsigned char* ws; const float* hsc;
    DI void operator()(const f32x4 (&acc)[2][2][4][2], const pg8::Unit& u, int wr, int wc, int fr, int fq) const {
        const int pn = u.pn;
#pragma unroll
        for (int ai = 0; ai < 2; ++ai)
#pragma unroll
            for (int m = 0; m < 4; ++m) {
                const int row = u.pm * 256 + ai * 128 + wr * 64 + m * 16 + fr;
                const int b = row >> 12, t = row & 4095; const float rsc = hsc[row] * (1.f / 2048.f);
#pragma unroll
                for (int bj = 0; bj < 2; ++bj) {
                    const int c8 = bj * 128 + wc * 32 + fq * 8;
                    f32x4 v0 = acc[ai][bj][m][0] * rsc, v1 = acc[ai][bj][m][1] * rsc;
                    if (pn < 4) {
                        store8_bf16((bf16_t*)(ws + WS_Q) + (size_t)row * 1024 + pn * 256 + c8, v0 * QSCALE, v1 * QSCALE);
                    } else if (pn < 10) {
                        const int k = c8 >> 6, dd = c8 & 63;
                        store8_bf16((bf16_t*)(ws + WS_KV) + (size_t)(pn - 4) * 4194304 + ((size_t)((b * 4 + k) * 4096 + t)) * 64 + dd, v0, v1);
                    } else if (pn < 14) {
                        const int cu = (pn - 10) * 256 + c8, g = cu >> 4, h0 = cu & 15;
                        store8_bf16((bf16_t*)(ws + WS_A2) + ((size_t)(g * 1024 + b * 256 + (t >> 4))) * 384 + (t & 15) * 16 + h0, v0, v1);
                    } else if (pn < 30) {
                        unsigned w0 = 0u, w1 = 0u;
#pragma unroll
                        for (int e = 0; e < 4; ++e) { w0 = __builtin_amdgcn_cvt_pk_u8_f32(__builtin_rintf(sigm(v0[e]) * 255.f), e, w0); w1 = __builtin_amdgcn_cvt_pk_u8_f32(__builtin_rintf(sigm(v1[e]) * 255.f), e, w1); }
                        u32x2 w; w[0] = w0; w[1] = w1; *(u32x2*)(ws + WS_MG + (size_t)row * 4096 + (pn - 14) * 256 + c8) = w;
                    } else {
                        if (c8 < 48) { float* gp = (float*)(ws + WS_GATE) + (size_t)row * 48 + c8; f32x4 s0, s1;
#pragma unroll
                            for (int e = 0; e < 4; ++e) { s0[e] = sigm(v0[e]); s1[e] = sigm(v1[e]); }
                            *(f32x4*)gp = s0; *(f32x4*)(gp + 4) = s1; }
                    }
                }
            }
    }
};
struct EpiBf16Plain {
    static constexpr bool PERM = true, AFTER_DRAIN = false; static constexpr int MIDK = 0;
    bf16_t* O; int ldc;
    DI void operator()(const f32x4 (&acc)[2][2][4][2], const pg8::Unit& u, int wr, int wc, int fr, int fq) const {
#pragma unroll
        for (int ai = 0; ai < 2; ++ai)
#pragma unroll
            for (int m = 0; m < 4; ++m) { const int row = u.pm * 256 + ai * 128 + wr * 64 + m * 16 + fr;
#pragma unroll
                for (int bj = 0; bj < 2; ++bj) { const int col = u.pn * 256 + bj * 128 + wc * 32 + fq * 8; store8_bf16(O + (size_t)row * ldc + col, acc[ai][bj][m][0], acc[ai][bj][m][1]); } }
    }
};
struct EpiCmp1 {
    static constexpr bool PERM = true, AFTER_DRAIN = false; static constexpr int MIDK = 0;
    bf16_t* O; const float* bias;
    DI void operator()(const f32x4 (&acc)[2][2][4][2], const pg8::Unit& u, int wr, int wc, int fr, int fq) const {
        const float* bi = bias + (u.pm >> 4) * 256;
#pragma unroll
        for (int ai = 0; ai < 2; ++ai)
#pragma unroll
            for (int m = 0; m < 4; ++m) { const int row = u.pm * 256 + ai * 128 + wr * 64 + m * 16 + fr;
#pragma unroll
                for (int bj = 0; bj < 2; ++bj) { const int col = bj * 128 + wc * 32 + fq * 8; f32x4 v0 = acc[ai][bj][m][0] + *(const f32x4*)(bi + col), v1 = acc[ai][bj][m][1] + *(const f32x4*)(bi + col + 4);
#pragma unroll
                    for (int e = 0; e < 4; ++e) { v0[e] = gelu_tanh(v0[e]); v1[e] = gelu_tanh(v1[e]); }
                    store8_bf16(O + (size_t)row * 256 + col, v0, v1); } }
    }
};
struct EpiCmp2 {
    static constexpr bool PERM = true, AFTER_DRAIN = false; static constexpr int MIDK = 0;
    bf16_t* O; const float* b2;
    DI void operator()(const f32x4 (&acc)[2][2][4][2], const pg8::Unit& u, int wr, int wc, int fr, int fq) const {
        if (wc >= 2) return;
        const int col = wc * 32 + fq * 8; const float* bi = b2 + (u.pm >> 4) * 64 + col; const f32x4 c0 = *(const f32x4*)bi, c1 = *(const f32x4*)(bi + 4);
#pragma unroll
        for (int ai = 0; ai < 2; ++ai)
#pragma unroll
            for (int m = 0; m < 4; ++m) { const int row = u.pm * 256 + ai * 128 + wr * 64 + m * 16 + fr; const bool live = (row & 255) < NCMP;
                const f32x4 z = {0.f, 0.f, 0.f, 0.f};
                store8_bf16(O + (size_t)row * 64 + col, live ? acc[ai][0][m][0] + c0 : z, live ? acc[ai][0][m][1] + c1 : z); }
    }
};
struct EpiS5G1 {
    static constexpr bool PERM = false, AFTER_DRAIN = false; static constexpr int MIDK = 0;
    float* X;
    DI void operator()(const f32x4 (&acc)[2][2][4][2], const pg8::Unit& u, int wr, int wc, int fr, int fq) const {
#pragma unroll
        for (int ai = 0; ai < 2; ++ai)
#pragma unroll
            for (int m = 0; m < 4; ++m) { const int row = u.pm * 256 + ai * 128 + wr * 64 + m * 16 + fr;
#pragma unroll
                for (int n = 0; n < 2; ++n) { const int col = wc * 32 + n * 16 + fq * 4; *(f32x4*)(X + (size_t)row * 128 + col) = acc[ai][0][m][n]; } }
    }
};
struct EpiS5G2 {
    static constexpr bool PERM = true, AFTER_DRAIN = false; static constexpr int MIDK = 0;
    bf16_t* Y; unsigned char* Y8;
    DI void operator()(const f32x4 (&acc)[2][2][4][2], const pg8::Unit& u, int wr, int wc, int fr, int fq) const {
        const int g = u.pm >> 2;
#pragma unroll
        for (int ai = 0; ai < 2; ++ai)
#pragma unroll
            for (int m = 0; m < 4; ++m) { const int rg = (u.pm & 3) * 256 + ai * 128 + wr * 64 + m * 16 + fr;
                const int b = rg >> 8, ch = rg & 255;
#pragma unroll
                for (int bj = 0; bj < 2; ++bj) { const int c8 = bj * 128 + wc * 32 + fq * 8, tau = c8 >> 4, h0 = c8 & 15; f32x4 v0 = acc[ai][bj][m][0], v1 = acc[ai][bj][m][1];
#pragma unroll
                    for (int e = 0; e < 4; ++e) { v0[e] = gelu_tanh(v0[e]); v1[e] = gelu_tanh(v1[e]); }
                    store8_bf16(Y + ((size_t)(b * 4096 + ch * 16 + tau)) * 1024 + g * 16 + h0, v0, v1); store8_fp8(Y8 + ((size_t)(b * 4096 + ch * 16 + tau)) * 1024 + g * 16 + h0, v0, v1, Y2_SCALE); } }
    }
};
struct EpiGlu {
    static constexpr bool PERM = true, AFTER_DRAIN = false; static constexpr int MIDK = 0;
    const bf16_t* Y; bf16_t* O; const float* bias;
    DI void operator()(const f32x4 (&acc)[2][2][4][2], const pg8::Unit& u, int wr, int wc, int fr, int fq) const {
#pragma unroll
        for (int bj = 0; bj < 2; ++bj) { const int col = u.pn * 256 + bj * 128 + wc * 32 + fq * 8; const f32x4 b0 = *(const f32x4*)(bias + col), b1 = *(const f32x4*)(bias + col + 4);
            u32x4 yv[8];
#pragma unroll
            for (int q = 0; q < 8; ++q) { const int row = u.pm * 256 + (q >> 2) * 128 + wr * 64 + (q & 3) * 16 + fr; yv[q] = *(const u32x4*)(Y + (size_t)row * 1024 + col); }
#pragma unroll
            for (int q = 0; q < 8; ++q) { const int ai = q >> 2, m = q & 3, row = u.pm * 256 + ai * 128 + wr * 64 + m * 16 + fr;
                const f32x4 y0 = (f32x4){bf_lo(yv[q][0]), bf_hi(yv[q][0]), bf_lo(yv[q][1]), bf_hi(yv[q][1])}, y1 = (f32x4){bf_lo(yv[q][2]), bf_hi(yv[q][2]), bf_lo(yv[q][3]), bf_hi(yv[q][3])};
                f32x4 v0 = acc[ai][bj][m][0] * (1.f / (Y2_SCALE * 1024.f)) + b0, v1 = acc[ai][bj][m][1] * (1.f / (Y2_SCALE * 1024.f)) + b1;
#pragma unroll
                for (int e = 0; e < 4; ++e) { v0[e] = y0[e] * sigm(v0[e]); v1[e] = y1[e] * sigm(v1[e]); }
                store8_fp8((unsigned char*)O + (size_t)row * UA_LD + col, v0, v1, Y2_SCALE); } }
    }
};
DI f32x4 u8x4_f32(unsigned w) { return (f32x4){(float)(w & 0xFFu), (float)((w >> 8) & 0xFFu), (float)((w >> 16) & 0xFFu), (float)(w >> 24)}; }
struct EpiUpF {
    static constexpr bool PERM = true, AFTER_DRAIN = false; static constexpr int MIDK = 8;
    const unsigned char* MG; unsigned char* O;
    DI void mid(f32x4 (&acc)[2][2][4][2], const pg8::Unit& u, int wr, int wc, int fr, int fq) const {
#pragma unroll
        for (int bj = 0; bj < 2; ++bj) { const int col = u.pn * 256 + bj * 128 + wc * 32 + fq * 8;
            u32x2 ga[8], gb[8];
#pragma unroll
            for (int q = 0; q < 8; ++q) { const int row = u.pm * 256 + (q >> 2) * 128 + wr * 64 + (q & 3) * 16 + fr; ga[q] = *(const u32x2*)(MG + (size_t)row * 4096 + col); gb[q] = *(const u32x2*)(MG + (size_t)row * 4096 + 2048 + col); }
#pragma unroll
            for (int q = 0; q < 8; ++q) { const int ai = q >> 2, m = q & 3;
#pragma unroll
                for (int h = 0; h < 2; ++h) { const f32x4 a = u8x4_f32(ga[q][h]), b = u8x4_f32(gb[q][h]); f32x4 r;
#pragma unroll
                    for (int e = 0; e < 4; ++e) r[e] = a[e] * __builtin_amdgcn_rcpf(fmaxf(b[e], 1e-30f));
                    acc[ai][bj][m][h] = acc[ai][bj][m][h] * (r * (Y2_SCALE / OATT_SCALE)); } } }
    }
    DI void operator()(const f32x4 (&acc)[2][2][4][2], const pg8::Unit& u, int wr, int wc, int fr, int fq) const {
#pragma unroll
        for (int bj = 0; bj < 2; ++bj) { const int col = u.pn * 256 + bj * 128 + wc * 32 + fq * 8;
            u32x2 gv[8];
#pragma unroll
            for (int q = 0; q < 8; ++q) { const int row = u.pm * 256 + (q >> 2) * 128 + wr * 64 + (q & 3) * 16 + fr; gv[q] = *(const u32x2*)(MG + (size_t)row * 4096 + 2048 + col); }
#pragma unroll
            for (int q = 0; q < 8; ++q) { const int ai = q >> 2, m = q & 3, row = u.pm * 256 + ai * 128 + wr * 64 + m * 16 + fr;
                f32x4 g0 = u8x4_f32(gv[q][0]), g1 = u8x4_f32(gv[q][1]);
#pragma unroll
                for (int e = 0; e < 4; ++e) { g0[e] = fmaxf(g0[e], 1e-30f); g1[e] = fmaxf(g1[e], 1e-30f); }
                const f32x4 v0 = acc[ai][bj][m][0] * (g0 * (1.f / (255.f * Y2_SCALE * 1024.f))), v1 = acc[ai][bj][m][1] * (g1 * (1.f / (255.f * Y2_SCALE * 1024.f)));
                store8_fp8(O + (size_t)row * 2048 + col, v0, v1, MIX_SCALE); } }
    }
};
struct EpiOut {
    static constexpr bool PERM = true, AFTER_DRAIN = false; static constexpr int MIDK = 0;
    const float* X; const float* mod; bf16_t* O;
    DI void operator()(const f32x4 (&acc)[2][2][4][2], const pg8::Unit& u, int wr, int wc, int fr, int fq) const {
        const float* g1 = mod + ((u.pm * 256) >> 12) * 12288 + 4096;
#pragma unroll
        for (int bj = 0; bj < 2; ++bj) { const int col = u.pn * 256 + bj * 128 + wc * 32 + fq * 8;
            const f32x4 g0 = *(const f32x4*)(g1 + col) * (1.f / (MIX_SCALE * 2048.f)), g4 = *(const f32x4*)(g1 + col + 4) * (1.f / (MIX_SCALE * 2048.f));
#pragma unroll
            for (int ai = 0; ai < 2; ++ai) { f32x4 xv[4][2];
#pragma unroll
                for (int m = 0; m < 4; ++m) { const int row = u.pm * 256 + ai * 128 + wr * 64 + m * 16 + fr; xv[m][0] = *(const f32x4*)(X + (size_t)row * 2048 + col); xv[m][1] = *(const f32x4*)(X + (size_t)row * 2048 + col + 4); }
#pragma unroll
                for (int m = 0; m < 4; ++m) { const int row = u.pm * 256 + ai * 128 + wr * 64 + m * 16 + fr;
                    const f32x4 a = xv[m][0] + g0 * acc[ai][bj][m][0], b = xv[m][1] + g4 * acc[ai][bj][m][1];
                    u32x4 w; w[0] = pk_bf16(a[0], a[1]); w[1] = pk_bf16(a[2], a[3]); w[2] = pk_bf16(b[0], b[1]); w[3] = pk_bf16(b[2], b[3]);
                    *(u32x4*)(O + (size_t)row * 2048 + col) = w; } } }
    }
};
struct EpiF32Plain {
    static constexpr bool PERM = true, AFTER_DRAIN = false; static constexpr int MIDK = 0;
    float* C; int ldc;
    DI void operator()(const f32x4 (&acc)[2][2][4][2], const pg8::Unit& u, int wr, int wc, int fr, int fq) const {
#pragma unroll
        for (int ai = 0; ai < 2; ++ai)
#pragma unroll
            for (int m = 0; m < 4; ++m) { const int row = u.pm * 256 + ai * 128 + wr * 64 + m * 16 + fr;
#pragma unroll
                for (int bj = 0; bj < 2; ++bj) { const int col = u.pn * 256 + bj * 128 + wc * 32 + fq * 8; *(f32x4*)(C + (size_t)row * ldc + col) = acc[ai][bj][m][0]; *(f32x4*)(C + (size_t)row * ldc + col + 4) = acc[ai][bj][m][1]; } }
    }
};
DI unsigned pk_f16(float lo, float hi) { typedef _Float16 f16v2 __attribute__((ext_vector_type(2))); f16v2 v; v[0] = (_Float16)lo; v[1] = (_Float16)hi; return __builtin_bit_cast(unsigned, v); }
struct EpiF16Plain {
    static constexpr bool PERM = true, AFTER_DRAIN = false; static constexpr int MIDK = 0;
    unsigned short* C; int ldc;
    DI void operator()(const f32x4 (&acc)[2][2][4][2], const pg8::Unit& u, int wr, int wc, int fr, int fq) const {
#pragma unroll
        for (int ai = 0; ai < 2; ++ai)
#pragma unroll
            for (int m = 0; m < 4; ++m) { const int row = u.pm * 256 + ai * 128 + wr * 64 + m * 16 + fr;
#pragma unroll
                for (int bj = 0; bj < 2; ++bj) { const int col = u.pn * 256 + bj * 128 + wc * 32 + fq * 8; const f32x4 a = acc[ai][bj][m][0], b = acc[ai][bj][m][1];
                    u32x4 w; w[0] = pk_f16(a[0], a[1]); w[1] = pk_f16(a[2], a[3]); w[2] = pk_f16(b[0], b[1]); w[3] = pk_f16(b[2], b[3]);
                    *(u32x4*)(C + (size_t)row * ldc + col) = w; } }
    }
};
struct GroupOrder {
    int n, G, c, div;
    DI bool next(int i, pg8::Unit& u) const { const int L = i * G + c; if (L >= n) return false; u.pm = L; u.pn = L / div; return true; }
    DI void a_ready(const pg8::Unit&) const {}
    DI void done(const pg8::Unit&) const {}
};

template <int MODE> DI int src_col(int n) {
    if (MODE == 0) return n;
    if (MODE == 2) return n < 64 ? n : -1;
    if (n < 2560) return n; if (n < 7680) return n + 48; if (n < 7728) return n - 7680 + 2560; return -1; }
template <int MODE, bool F8OUT = false> DI void tconv_tiles(const float* __restrict__ src, int ld, int K, int Nd, bf16_t* __restrict__ dst, LAS float* tile, int& off, int bx, int G, float f8scale = 1.f, int ldd = 0) {
    const int tid = threadIdx.x, ntk = K >> 6, ntot = ntk * (Nd >> 8), LD = ldd ? ldd : K;
    const int first = (bx + G - (off % G)) % G; off += ntot;
    const int j = tid & 63, i0 = tid >> 6; float w[4][8];
#define TCONV_LOAD(it_) do { const int n0_ = ((it_) / ntk) << 8, k0_ = ((it_) % ntk) << 6; _Pragma("unroll") for (int c = 0; c < 4; ++c) { const int sc = src_col<MODE>(n0_ + 64 * c + j); \
        _Pragma("unroll") for (int rr = 0; rr < 8; ++rr) w[c][rr] = sc >= 0 ? src[(size_t)(k0_ + i0 + 8 * rr) * ld + sc] : 0.f; } } while (0)
    if (first < ntot) TCONV_LOAD(first);
    for (int it = first; it < ntot; it += G) {
        const int n0 = (it / ntk) << 8, k0 = (it % ntk) << 6;
        __syncthreads();
#pragma unroll
        for (int c = 0; c < 4; ++c)
#pragma unroll
            for (int rr = 0; rr < 8; ++rr) tile[c * 4160 + (i0 + 8 * rr) * 65 + j] = w[c][rr];
        if (it + G < ntot) TCONV_LOAD(it + G);
        __syncthreads();
#pragma unroll
        for (int c = 0; c < 4; ++c) { const int jj = tid >> 3, ii0 = (tid & 7) * 8; float v[8];
#pragma unroll
          for (int e = 0; e < 8; ++e) v[e] = tile[c * 4160 + (ii0 + e) * 65 + jj];
          if constexpr (F8OUT) { int p0 = __builtin_amdgcn_cvt_pk_fp8_f32(clamp448(v[0] * f8scale), clamp448(v[1] * f8scale), 0, false); p0 = __builtin_amdgcn_cvt_pk_fp8_f32(clamp448(v[2] * f8scale), clamp448(v[3] * f8scale), p0, true);
              int p1 = __builtin_amdgcn_cvt_pk_fp8_f32(clamp448(v[4] * f8scale), clamp448(v[5] * f8scale), 0, false); p1 = __builtin_amdgcn_cvt_pk_fp8_f32(clamp448(v[6] * f8scale), clamp448(v[7] * f8scale), p1, true);
              u32x2 wv; wv[0] = (unsigned)p0; wv[1] = (unsigned)p1; *(u32x2*)((unsigned char*)dst + (size_t)(n0 + 64 * c + jj) * LD + k0 + ii0) = wv; }
          else { u32x4 wv; wv[0] = pk_bf16(v[0], v[1]); wv[1] = pk_bf16(v[2], v[3]); wv[2] = pk_bf16(v[4], v[5]); wv[3] = pk_bf16(v[6], v[7]);
              *(u32x4*)(dst + (size_t)(n0 + 64 * c + jj) * LD + k0 + ii0) = wv; } }
    }
#undef TCONV_LOAD
}
DI void conv_bf16_flat(const float* __restrict__ src, bf16_t* __restrict__ dst, size_t n8  , size_t first, size_t stride) {
    for (size_t i = first; i < n8; i += stride) { const f32x4 a = *(const f32x4*)(src + i * 8), b = *(const f32x4*)(src + i * 8 + 4); store8_bf16(dst + i * 8, a, b); }
}

DI void conv_rows_fp8(const float* __restrict__ src, unsigned char* __restrict__ dst, float* __restrict__ inv_scale, int nrows) {
    const int lane = threadIdx.x & 63, wave = __builtin_amdgcn_readfirstlane(threadIdx.x >> 6);
    for (int row = blockIdx.x * 8 + wave; row < nrows; row += gridDim.x * 8) {
        const float* sr = src + (size_t)row * 2048; f32x4 v[8]; float am = 0.f;
#pragma unroll
        for (int k = 0; k < 8; ++k) { v[k] = *(const f32x4*)(sr + k * 256 + lane * 4); am = fmaxf(am, fmaxf(fmaxf(fabsf(v[k][0]), fabsf(v[k][1])), fmaxf(fabsf(v[k][2]), fabsf(v[k][3])))); }
#pragma unroll
        for (int o = 32; o >= 1; o >>= 1) am = fmaxf(am, __shfl_xor(am, o));
        const float sc = am > 0.f ? 448.f / am : 1.f;
#pragma unroll
        for (int k = 0; k < 8; ++k) { int p = __builtin_amdgcn_cvt_pk_fp8_f32(v[k][0] * sc, v[k][1] * sc, 0, false); p = __builtin_amdgcn_cvt_pk_fp8_f32(v[k][2] * sc, v[k][3] * sc, p, true);
            *(unsigned*)(dst + (size_t)k * 4194304 + (size_t)row * 256 + lane * 4) = (unsigned)p; }
        if (lane == 0) inv_scale[row] = am > 0.f ? am / 448.f : 1.f;
    }
}

DI void p0_prologue(const Params& P, LAS unsigned char* lds) {
    unsigned char* ws = P.ws; const int tid = threadIdx.x, G = gridDim.x, bx = blockIdx.x;
    LAS float* fl = (LAS float*)lds;
    {
        LAS float* sc = fl;
        LAS float* red = fl + 8192;
        for (int i = tid; i < 8192; i += 512) { const float v = P.c[i]; sc[i] = v / (1.f + __expf(-v)); }
        __syncthreads();
        for (int it = bx; it < 192 + 8; it += G) {
            const bool is_cb = it >= 192;
            const int col = tid & 63, kg = tid >> 6;
            float a0 = 0.f, a1 = 0.f, a2 = 0.f, a3 = 0.f;
            if (!is_cb) {
                const float* wp = P.ada_w + (size_t)(kg * 256) * 12288 + it * 64 + col;
                for (int j0 = 0; j0 < 256; j0 += 32) { float w[32];
#pragma unroll
                    for (int j = 0; j < 32; ++j) w[j] = wp[(size_t)(j0 + j) * 12288];
#pragma unroll
                    for (int j = 0; j < 32; ++j) { const int jj = kg * 256 + j0 + j; a0 += sc[jj] * w[j]; a1 += sc[2048 + jj] * w[j]; a2 += sc[4096 + jj] * w[j]; a3 += sc[6144 + jj] * w[j]; } }
            } else {
                const int i = (it - 192) >> 2, c0 = ((it - 192) & 3) * 64;
                const float* wp = P.cmp_w1 + (size_t)i * 2048 * 256 + (size_t)(kg * 256) * 256 + c0 + col; const float* pp = P.cmp_pos + i * 2048 + kg * 256;
                for (int j0 = 0; j0 < 256; j0 += 32) { float w[32];
#pragma unroll
                    for (int j = 0; j < 32; ++j) w[j] = wp[(size_t)(j0 + j) * 256];
#pragma unroll
                    for (int j = 0; j < 32; ++j) a0 += pp[j0 + j] * w[j]; }
            }
            red[(kg * 4 + 0) * 64 + col] = a0; red[(kg * 4 + 1) * 64 + col] = a1; red[(kg * 4 + 2) * 64 + col] = a2; red[(kg * 4 + 3) * 64 + col] = a3;
            __syncthreads();
            if (tid < 256) { const int b = tid >> 6, cc = tid & 63; float s = 0.f;
#pragma unroll
                for (int q = 0; q < 8; ++q) s += red[(q * 4 + b) * 64 + cc];
                if (!is_cb) ((float*)(ws + WS_MOD))[b * 12288 + it * 64 + cc] = s + P.ada_b[it * 64 + cc];
                else if (b == 0) { const int i = (it - 192) >> 2, c0 = ((it - 192) & 3) * 64; ((float*)(ws + WS_CB))[i * 256 + c0 + cc] = s + P.cmp_b1[i * 256 + c0 + cc]; } }
            __syncthreads();
        }
    }
    for (int g4 = bx; g4 < 256; g4 += G) {
        const int g = g4 >> 2, part = g4 & 3;
        LAS double* pw = (LAS double*)lds;
        LAS double* ff = pw + 17 * 64 * 2;
        LAS double* bb = ff + 128;
        LAS float* cc = (LAS float*)(bb + 2048);
        LAS float* kern = cc + 2048;
        __syncthreads();
        const double step = exp((double)P.s5_log_step[g]);
        if (tid < 64) { const int p = tid; const double lr = P.s5_lam_re[g * 64 + p], li = P.s5_lam_im[g * 64 + p];
            const double mag = exp(lr * step), ang = li * step; const double br = mag * cos(ang), bi = mag * sin(ang);
            double cr = 1.0, ci = 0.0;
            for (int dl = 0; dl < 17; ++dl) { pw[(dl * 64 + p) * 2] = cr; pw[(dl * 64 + p) * 2 + 1] = ci;
                if (dl == 1) { const double nr = cr - 1.0, den = lr * lr + li * li; ff[p * 2] = (nr * lr + ci * li) / den; ff[p * 2 + 1] = (ci * lr - nr * li) / den; }
                if (dl == 16 && part == 0) { float* a16 = (float*)(ws + WS_A16) + (g * 64 + p) * 2; a16[0] = (float)cr; a16[1] = (float)ci; }
                const double nr2 = cr * br - ci * bi, ni2 = cr * bi + ci * br; cr = nr2; ci = ni2; } }
        for (int i = tid; i < 1024; i += 512) { const int h = i >> 6, p = i & 63; cc[i * 2] = P.s5_c_re[(g * 16 + h) * 64 + p]; cc[i * 2 + 1] = P.s5_c_im[(g * 16 + h) * 64 + p]; }
        __syncthreads();
        for (int i = tid; i < 1024; i += 512) { const int p = i >> 4; const double br = P.s5_b_re[g * 1024 + i], bi = P.s5_b_im[g * 1024 + i], fr = ff[p * 2], fi = ff[p * 2 + 1];
            bb[i * 2] = fr * br - fi * bi; bb[i * 2 + 1] = fr * bi + fi * br; }
        __syncthreads();
        if (tid < 256) {
            const int dl = tid >> 4, h = 4 * part + ((tid >> 2) & 3), h20 = 4 * (tid & 3); double s0 = 0.0, s1 = 0.0, s2 = 0.0, s3 = 0.0;
            for (int p = 0; p < 64; ++p) { const double cr = cc[(h * 64 + p) * 2], ci = cc[(h * 64 + p) * 2 + 1], ar = pw[(dl * 64 + p) * 2], ai = pw[(dl * 64 + p) * 2 + 1];
                const double zr = cr * ar - ci * ai, zi = cr * ai + ci * ar; const LAS double* bp = bb + (p * 16 + h20) * 2;
                s0 += zr * bp[0] - zi * bp[1]; s1 += zr * bp[2] - zi * bp[3]; s2 += zr * bp[4] - zi * bp[5]; s3 += zr * bp[6] - zi * bp[7]; }
            LAS float* ko = kern + (dl * 16 + h) * 16 + h20; ko[0] = (float)s0; ko[1] = (float)s1; ko[2] = (float)s2; ko[3] = (float)s3; }
        __syncthreads();
        bf16_t* B2 = (bf16_t*)(ws + WS_S5B2) + (size_t)g * 256 * 384;
        for (int i = tid; i < 64 * 384 / 2; i += 512) {
            const int rr = i / 192, c0 = (i % 192) * 2, tau = rr >> 2, h = 4 * part + (rr & 3), row = tau * 16 + h; float v[2];
#pragma unroll
            for (int e = 0; e < 2; ++e) { const int col = c0 + e; float x;
                if (col < 256) { const int s = col >> 4, h2 = col & 15; x = (s <= tau) ? kern[((tau - s) * 16 + h) * 16 + h2] : 0.f; if (s == tau && h2 == h) x += P.s5_d[g * 16 + h]; }
                else { const int p = (col - 256) & 63; const double cr = cc[(h * 64 + p) * 2], ci = cc[(h * 64 + p) * 2 + 1], ar = pw[((tau + 1) * 64 + p) * 2], ai = pw[((tau + 1) * 64 + p) * 2 + 1];
                    x = (col < 320) ? (float)(cr * ar - ci * ai) : (float)(-(cr * ai + ci * ar)); }
                v[e] = x; }
            *(unsigned*)(B2 + (size_t)row * 384 + c0) = pk_bf16(v[0], v[1]); }
        bf16_t* B1 = (bf16_t*)(ws + WS_S5B1) + (size_t)g * 256 * 256;
        for (int i = tid; i < 64 * 256 / 2; i += 512) {
            const int n = 64 * part + (i >> 7), c0 = (i & 127) * 2; float v[2];
#pragma unroll
            for (int e = 0; e < 2; ++e) { const int col = c0 + e, s = col >> 4, h = col & 15; float x = 0.f;
                if (n < 128) { const int p = n & 63; const double ar = pw[((15 - s) * 64 + p) * 2], ai = pw[((15 - s) * 64 + p) * 2 + 1], br = bb[(p * 16 + h) * 2], bi = bb[(p * 16 + h) * 2 + 1];
                    x = (n < 64) ? (float)(ar * br - ai * bi) : (float)(ar * bi + ai * br); }
                v[e] = x; }
            *(unsigned*)(B1 + (size_t)n * 256 + c0) = pk_bf16(v[0], v[1]); }
    }
    __syncthreads();
    LAS float* tile = fl;
    int toff = 0;
    tconv_tiles<1, true>(P.w_in, 7728, 2048, NPROJ, (bf16_t*)(ws + WS_WIN), tile, toff, bx, G, 2048.f);
    tconv_tiles<0, true>(P.glu_w, 1024, 1024, 1024, (bf16_t*)(ws + WS_WGLU), tile, toff, bx, G, 1024.f);
    tconv_tiles<0, true>(P.w_up_attn, 2048, 1024, 2048, (bf16_t*)(ws + WS_WUA), tile, toff, bx, G, 1024.f, 2048);
    tconv_tiles<0, true>(P.w_up_ssm, 2048, 1024, 2048, (bf16_t*)(ws + WS_WUA + 1024), tile, toff, bx, G, 1024.f, 2048);
    tconv_tiles<0, true>(P.w_out, 2048, 2048, 2048, (bf16_t*)(ws + WS_WOUT), tile, toff, bx, G, 2048.f);
    tconv_tiles<0>(P.cmp_w1, 256, 2048, 256, (bf16_t*)(ws + WS_WC1), tile, toff, bx, G);
    tconv_tiles<0>(P.cmp_w1 + 2048 * 256, 256, 2048, 256, (bf16_t*)(ws + WS_WC1) + 256 * 2048, tile, toff, bx, G);
    tconv_tiles<2>(P.cmp_w2, 64, 256, 256, (bf16_t*)(ws + WS_WC2), tile, toff, bx, G);
    tconv_tiles<2>(P.cmp_w2 + 256 * 64, 64, 256, 256, (bf16_t*)(ws + WS_WC2) + 256 * 256, tile, toff, bx, G);
    __syncthreads();
    const size_t gt = (size_t)bx * 512 + tid, gs = (size_t)G * 512;
    conv_bf16_flat(P.peer_w_q, (bf16_t*)(ws + WS_WQ), (size_t)2048 * 2048 / 8, gt, gs);
    { bf16_t* kb = (bf16_t*)(ws + WS_KBD);
      for (size_t i = gt; i < (size_t)2048 * 2048 / 8; i += gs) { const int row = (int)(i >> 8), k0 = (int)(i & 255) * 8, hc = row >> 7, n = row & 127;
          if ((k0 >> 7) == hc) { const float* s = P.peer_sub_keys + ((size_t)(hc * 128 + n)) * 128 + (k0 & 127); store8_bf16(kb + i * 8, *(const f32x4*)s, *(const f32x4*)(s + 4)); }
          else *(u32x4*)(kb + i * 8) = (u32x4){0u, 0u, 0u, 0u}; } }
}

DI void phase_norm(const bf16_t* __restrict__ X, const float* __restrict__ gain, const float* __restrict__ mod, int sh_off, int sc_off, bf16_t* __restrict__ H, unsigned char* __restrict__ H8, float* __restrict__ HS) {
    const int lane = threadIdx.x & 63, wave = __builtin_amdgcn_readfirstlane(threadIdx.x >> 6);
    int curb = -1; f32x4 Gv[8], Sv[8];
    const int rstep = gridDim.x * 8;
    for (int row0 = blockIdx.x * 8 + wave; row0 < NT; row0 += 2 * rstep) {
        const bool two = row0 + rstep < NT; const int row1 = two ? row0 + rstep : row0;
        u32x2 xa[8], xb[8];
#pragma unroll
        for (int k = 0; k < 8; ++k) { xa[k] = *(const u32x2*)(X + (size_t)row0 * 2048 + k * 256 + lane * 4); xb[k] = *(const u32x2*)(X + (size_t)row1 * 2048 + k * 256 + lane * 4); }
#pragma unroll
        for (int rr = 0; rr < 2; ++rr) { if (rr == 1 && !two) break;
            const int row = rr ? row1 : row0; const int bb = row >> 12;
            if (bb != curb) { curb = bb; const float* mb = mod + bb * 12288;
#pragma unroll
                for (int k = 0; k < 8; ++k) { const int d = k * 256 + lane * 4; const f32x4 g = *(const f32x4*)(gain + d), sc = *(const f32x4*)(mb + sc_off + d); Sv[k] = *(const f32x4*)(mb + sh_off + d);
#pragma unroll
                    for (int e = 0; e < 4; ++e) Gv[k][e] = g[e] * (1.f + sc[e]); } }
            f32x4 v[8]; float ss = 0.f;
#pragma unroll
            for (int k = 0; k < 8; ++k) { const u32x2 xw = rr ? xb[k] : xa[k]; v[k][0] = bf_lo(xw[0]); v[k][1] = bf_hi(xw[0]); v[k][2] = bf_lo(xw[1]); v[k][3] = bf_hi(xw[1]);
                ss += v[k][0] * v[k][0] + v[k][1] * v[k][1] + v[k][2] * v[k][2] + v[k][3] * v[k][3]; }
            ss = wave_sum(ss); const float rs = rsqrtf(ss * (1.f / 2048.f) + 1e-6f);
            float am = 0.f;
#pragma unroll
            for (int k = 0; k < 8; ++k) { const int d = k * 256 + lane * 4;
#pragma unroll
                for (int e = 0; e < 4; ++e) { v[k][e] = (v[k][e] * rs) * Gv[k][e] + Sv[k][e]; am = fmaxf(am, fabsf(v[k][e])); }
                u32x2 w; w[0] = pk_bf16(v[k][0], v[k][1]); w[1] = pk_bf16(v[k][2], v[k][3]); *(u32x2*)(H + (size_t)row * 2048 + d) = w; }
            am = __uint_as_float(wave_max_u32(__float_as_uint(am)));
            const float q = am > 0.f ? 127.f / am : 1.f;
#pragma unroll
            for (int k = 0; k < 8; ++k) { unsigned pk = 0u;
#pragma unroll
                for (int e = 0; e < 4; ++e) pk = __builtin_amdgcn_cvt_pk_u8_f32(__builtin_rintf(v[k][e] * q) + 128.f, e, pk);
                *(unsigned*)(H8 + (size_t)row * 2048 + k * 256 + lane * 4) = pk ^ 0x80808080u; }
            if (lane < 8) HS[(size_t)row * 8 + lane] = am > 0.f ? am * (1.f / 127.f) : 1.f; }
    }
}

DI void phase_norm_f8(const float* __restrict__ X, const float* __restrict__ gain, const float* __restrict__ mod, int sh_off, int sc_off, unsigned char* __restrict__ H8, float* __restrict__ hsc) {
    const int lane = threadIdx.x & 63, wave = __builtin_amdgcn_readfirstlane(threadIdx.x >> 6);
    for (int row = blockIdx.x * 8 + wave; row < NT; row += gridDim.x * 8) {
        const float* xr = X + (size_t)row * 2048; f32x4 v[8]; float ss = 0.f;
#pragma unroll
        for (int k = 0; k < 8; ++k) { v[k] = *(const f32x4*)(xr + k * 256 + lane * 4); ss += v[k][0] * v[k][0] + v[k][1] * v[k][1] + v[k][2] * v[k][2] + v[k][3] * v[k][3]; }
        ss = wave_sum(ss); const float rs = rsqrtf(ss * (1.f / 2048.f) + 1e-6f);
        const float* mb = mod + (row >> 12) * 12288; float am = 0.f;
#pragma unroll
        for (int k = 0; k < 8; ++k) { const int d = k * 256 + lane * 4; const f32x4 g = *(const f32x4*)(gain + d), sc = *(const f32x4*)(mb + sc_off + d), sh = *(const f32x4*)(mb + sh_off + d);
#pragma unroll
            for (int e = 0; e < 4; ++e) { v[k][e] = v[k][e] * rs * g[e] * (1.f + sc[e]) + sh[e]; am = fmaxf(am, fabsf(v[k][e])); } }
#pragma unroll
        for (int o = 32; o >= 1; o >>= 1) am = fmaxf(am, __shfl_xor(am, o));
        const float q = am > 0.f ? 448.f / am : 1.f;
#pragma unroll
        for (int k = 0; k < 8; ++k) { int p = __builtin_amdgcn_cvt_pk_fp8_f32(v[k][0] * q, v[k][1] * q, 0, false); p = __builtin_amdgcn_cvt_pk_fp8_f32(v[k][2] * q, v[k][3] * q, p, true);
            *(unsigned*)(H8 + (size_t)row * 2048 + k * 256 + lane * 4) = (unsigned)p; }
        if (lane == 0) hsc[row] = am > 0.f ? am * (1.f / 448.f) : 1.f;
    }
}

DI void phase_cmp2(const Params& P) {
    unsigned char* ws = P.ws; const bf16_t* hid = (const bf16_t*)(ws + WS_HID); bf16_t* ckv = (bf16_t*)(ws + WS_CKV);
    for (int o = blockIdx.x * 512 + threadIdx.x; o < 2 * 16 * 256 * 64; o += gridDim.x * 512) {
        const int dd = o & 63, row = o >> 6, i = row >> 12, n = row & 255;
        float s = 0.f;
        if (n < NCMP) { const bf16_t* hr = hid + (size_t)row * 256; const float* w2 = P.cmp_w2 + i * 256 * 64 + dd; s = P.cmp_b2[i * 64 + dd];
#pragma unroll 4
            for (int j = 0; j < 256; j += 8) { const u32x4 hv = *(const u32x4*)(hr + j);
#pragma unroll
                for (int e = 0; e < 4; ++e) { s += bf_lo(hv[e]) * w2[(j + 2 * e) * 64]; s += bf_hi(hv[e]) * w2[(j + 2 * e + 1) * 64]; } } }
        ckv[o] = f2bf(s);
    }
}
DI void phase_scan(const Params& P, LAS unsigned char* lds) {
    unsigned char* ws = P.ws; const int lane = threadIdx.x & 63, wave = __builtin_amdgcn_readfirstlane(threadIdx.x >> 6);
    LAS float* ex = (LAS float*)lds;
    for (int bg = blockIdx.x; bg < 256; bg += gridDim.x) {
        const int b = bg >> 6, g = bg & 63, p = lane, c0 = wave * 32;
        const float ar = ((const float*)(ws + WS_A16))[(g * 64 + p) * 2], ai = ((const float*)(ws + WS_A16))[(g * 64 + p) * 2 + 1];
        const float* xl = (const float*)(ws + WS_XL) + (size_t)(g * 1024 + b * 256 + c0) * 128; bf16_t* a2 = (bf16_t*)(ws + WS_A2) + (size_t)(g * 1024 + b * 256 + c0) * 384 + 256;
        float lr[32], li[32];
#pragma unroll
        for (int e = 0; e < 32; ++e) { lr[e] = xl[(size_t)e * 128 + p]; li[e] = xl[(size_t)e * 128 + 64 + p]; }
        float er = 0.f, ei = 0.f;
#pragma unroll
        for (int e = 0; e < 32; ++e) { const float nr = ar * er - ai * ei + lr[e], ni = ar * ei + ai * er + li[e]; er = nr; ei = ni; }
        float qr = ar, qi = ai;
#pragma unroll
        for (int s = 0; s < 5; ++s) { const float nr = qr * qr - qi * qi, ni = 2.f * qr * qi; qr = nr; qi = ni; }
        __syncthreads();
        ex[(wave * 64 + lane) * 2] = er; ex[(wave * 64 + lane) * 2 + 1] = ei;
        __syncthreads();
        float xr = 0.f, xi = 0.f;
        for (int w = 0; w < wave; ++w) { const float sr = ex[(w * 64 + lane) * 2], si = ex[(w * 64 + lane) * 2 + 1]; const float nr = qr * xr - qi * xi + sr, ni = qr * xi + qi * xr + si; xr = nr; xi = ni; }
#pragma unroll
        for (int e = 0; e < 32; ++e) { a2[(size_t)e * 384 + p] = f2bf(xr); a2[(size_t)e * 384 + 64 + p] = f2bf(xi);
            const float nr = ar * xr - ai * xi + lr[e], ni = ar * xi + ai * xr + li[e]; xr = nr; xi = ni; }
    }
}

constexpr int AT_K = 0, AT_V = 18432, AT_TB = 34816, AT_IMP = 43008, AT_END = 112640;
#define MFMA32(a, b, c) __builtin_amdgcn_mfma_f32_32x32x16_bf16((a), (b), (c), 0, 0, 0)

DI void attn_setup_tables(const Params& P, LAS unsigned char* lds) {
    LAS float* tb = (LAS float*)(lds + AT_TB);
    __syncthreads();
    for (int i = threadIdx.x; i < 16 * 128; i += 512) { const int hd = i >> 7, dist = i & 127; int bk = dist;
        if (dist >= 16) { const float lr = __logf((float)dist * (1.f / 16.f)) / 2.0794415417f; bk = min(16 + (int)(lr * 16.f), 31); }
        tb[i] = P.rel_bias[bk * 16 + hd] * LOG2E; }
    __syncthreads();
}

#define ATTN_BODY \
             \
            bf16x8 vfr[2][2][2]; \
            f32x16 sacc[2]; \
_Pragma("unroll") \
            for (int kb = 0; kb < 2; ++kb) { \
_Pragma("unroll") \
                for (int i = 0; i < 16; ++i) sacc[kb][i] = 0.f; \
_Pragma("unroll") \
                for (int s = 0; s < 4; ++s) { const bf16x8 kf = *(const LAS bf16x8*)(Kl + krd + kb * 32 * 144 + s * 32); sacc[kb] = MFMA32(kf, qf[s], sacc[kb]); } } \
            if (pass == 0 && MODE != 0) {                                             \
_Pragma("unroll") \
                for (int kb = 0; kb < 2; ++kb) \
_Pragma("unroll") \
                    for (int s2 = 0; s2 < 2; ++s2) \
_Pragma("unroll") \
                        for (int db = 0; db < 2; ++db) { const unsigned a0 = (unsigned)(32 * kb + 16 * s2) * 128u + vrow * 128u + vcol[db]; \
                            const s16x4 lo = __builtin_amdgcn_ds_read_tr16_b64_v4i16((LAS s16x4*)(Vl + a0)), hi = __builtin_amdgcn_ds_read_tr16_b64_v4i16((LAS s16x4*)(Vl + a0 + 8 * 128)); \
                            vfr[kb][s2][db] = __builtin_shufflevector(lo, hi, 0, 1, 2, 3, 4, 5, 6, 7); } \
            } \
             \
            const bool near = (MODE == 0) ? (1024 * j + 1152 > qb * 64) : ((qb - j <= 2) || (MODE == 2 && j == qb - 8));        \
            const bool lsel = (MODE != 1) || (((j < 32 ? (mlo >> j) : (mhi >> (j - 32))) & 1u) != 0u); \
            if (near) { \
                const int dq = (MODE == 0) ? (tq - 31 - 1024 * j) : (tq - 64 * j); \
_Pragma("unroll") \
                for (int kb = 0; kb < 2; ++kb) \
_Pragma("unroll") \
                    for (int i = 0; i < 16; ++i) { const int kl = 32 * kb + (i & 3) + 8 * (i >> 2) + 4 * h; const int dist = dq - ((MODE == 0) ? 16 * kl : kl); \
                        bool ok = (dist >= 0) && lsel; if (MODE == 2) ok = ok && (dist < 512); \
                        sacc[kb][i] = (sacc[kb][i] + tb[min(max(dist, 0), 127)]) + (ok ? 0.f : NEGBIG); if (i == 15) __builtin_amdgcn_sched_barrier(0); }      \
            } else { \
                const float cb = lsel ? farb : NEGBIG;                   \
_Pragma("unroll") \
                for (int kb = 0; kb < 2; ++kb) \
_Pragma("unroll") \
                    for (int i = 0; i < 16; ++i) sacc[kb][i] += cb; \
            } \
            bf16x8 pf[2][2]; \
            if (pass == 0) { \
                 \
                float mx = fmaxf(fmaxf(sacc[0][0], sacc[0][1]), sacc[1][0]); \
_Pragma("unroll") \
                for (int kb = 0; kb < 2; ++kb) \
_Pragma("unroll") \
                    for (int i = 0; i < 16; i += 2) mx = fmaxf(fmaxf(mx, sacc[kb][i]), sacc[kb][i + 1]); \
                mx = xor32_max(mx); \
                const float m_new = fmaxf(m_run, mx); \
                if (__any(m_new > m_run)) { const float alpha = __builtin_amdgcn_exp2f(m_run - m_new); l_run *= alpha; \
_Pragma("unroll") \
                    for (int i = 0; i < 16; ++i) { oacc[0][i] *= alpha; oacc[1][i] *= alpha; } } \
                m_run = m_new; \
                f32x2 ls2 = {0.f, 0.f}; const f32x2 mn2 = {m_new, m_new}; \
_Pragma("unroll") \
                for (int kb = 0; kb < 2; ++kb) \
_Pragma("unroll") \
                    for (int i = 0; i < 16; i += 2) { f32x2 d2 = (f32x2){sacc[kb][i], sacc[kb][i + 1]} - mn2; d2.x = __builtin_amdgcn_exp2f(d2.x); d2.y = __builtin_amdgcn_exp2f(d2.y); sacc[kb][i] = d2.x; sacc[kb][i + 1] = d2.y; ls2 += d2; } \
                l_run += ls2.x + ls2.y; \
            } else { \
_Pragma("unroll") \
                for (int kb = 0; kb < 2; ++kb) \
_Pragma("unroll") \
                    for (int i = 0; i < 16; ++i) sacc[kb][i] = __builtin_amdgcn_exp2f(sacc[kb][i] - m_fin) * inv_fin; \
            } \
_Pragma("unroll") \
            for (int kb = 0; kb < 2; ++kb) \
_Pragma("unroll") \
                for (int s2 = 0; s2 < 2; ++s2) { u32x4 w; \
_Pragma("unroll") \
                    for (int e = 0; e < 4; ++e) w[e] = pk_bf16(sacc[kb][8 * s2 + 2 * e], sacc[kb][8 * s2 + 2 * e + 1]); \
                    pf[kb][s2] = __builtin_bit_cast(bf16x8, w); } \
            if (pass == 0) { \
                 \
_Pragma("unroll") \
                for (int kb = 0; kb < 2; ++kb) \
_Pragma("unroll") \
                    for (int s2 = 0; s2 < 2; ++s2) \
_Pragma("unroll") \
                        for (int db = 0; db < 2; ++db) { \
                            if (MODE != 0) oacc[db] = MFMA32(vfr[kb][s2][db], pf[kb][s2], oacc[db]); \
                            else { const unsigned a0 = (unsigned)(32 * kb + 16 * s2) * 128u + vrow * 128u + vcol[db]; \
                                const s16x4 lo = __builtin_amdgcn_ds_read_tr16_b64_v4i16((LAS s16x4*)(Vl + a0)), hi = __builtin_amdgcn_ds_read_tr16_b64_v4i16((LAS s16x4*)(Vl + a0 + 8 * 128)); \
                                oacc[db] = MFMA32(__builtin_shufflevector(lo, hi, 0, 1, 2, 3, 4, 5, 6, 7), pf[kb][s2], oacc[db]); } } \
            } else { \
                 \
                bf16x8 mfrag[2][2]; \
_Pragma("unroll") \
                for (int kb = 0; kb < 2; ++kb) \
_Pragma("unroll") \
                    for (int s2 = 0; s2 < 2; ++s2) \
_Pragma("unroll") \
                        for (int jj = 0; jj < 8; ++jj) { const int key = 32 * kb + 16 * s2 + 8 * (jj >> 2) + 4 * h + (jj & 3); \
                            mfrag[kb][s2][jj] = (key == 4 * r - 1 || key == 4 * r + 3) ? (short)0x3F00 : ((key >= 4 * r && key <= 4 * r + 2) ? (short)0x3F80 : (short)0); } \
                f32x16 ia; \
_Pragma("unroll") \
                for (int i = 0; i < 16; ++i) ia[i] = 0.f; \
_Pragma("unroll") \
                for (int kb = 0; kb < 2; ++kb) \
_Pragma("unroll") \
                    for (int s2 = 0; s2 < 2; ++s2) ia = MFMA32(mfrag[kb][s2], pf[kb][s2], ia); \
                LAS float* ip = (LAS float*)(lds + AT_IMP) + (g * 64 + tq_loc) * 68 + 16 * j; \
_Pragma("unroll") \
                for (int i = 0; i < 9; ++i) { const int jp = (i & 3) + 8 * (i >> 2) + 4 * h; if (jp <= 16) ip[jp] += ia[i]; } \
            } \


template <int MODE> DI void attn_unit(const Params& P, LAS unsigned char* lds, int b, int k, int qb) {
    unsigned char* ws = P.ws;
    const int tid = threadIdx.x, lane = tid & 63, wave = __builtin_amdgcn_readfirstlane(tid >> 6);
    const int g = wave >> 1, th = wave & 1, r = lane & 31, h = lane >> 5;
    const int tq_loc = th * 32 + r, tq = qb * 64 + tq_loc, hd = k * 4 + g, bk = b * 4 + k;
    const LAS float* tb = (const LAS float*)(lds + AT_TB) + hd * 128;
    const float farb = tb[127];
    bf16x8 qf[4];
    { const bf16_t* qg = (const bf16_t*)(ws + WS_Q) + ((size_t)(b * 4096 + tq)) * 1024 + hd * 64 + 8 * h;
#pragma unroll
      for (int s = 0; s < 4; ++s) qf[s] = *(const bf16x8*)(qg + 16 * s); }
    const bf16_t *Kg, *Vg;
    if (MODE == 0) { Kg = (const bf16_t*)(ws + WS_CKV) + (size_t)bk * 256 * 64; Vg = Kg + 16 * 256 * 64; }
    else { Kg = (const bf16_t*)(ws + WS_KV) + (size_t)(MODE == 1 ? 2 : 4) * 4194304 + (size_t)bk * 4096 * 64; Vg = Kg + 4194304; }
    unsigned long long tiles; unsigned mlo = 0u, mhi = 0u;
    if (MODE == 0) { const int kmax = min(3, (4 * qb + 2) >> 6); tiles = (2ull << kmax) - 1ull; }
    else if (MODE == 2) { const int lo = max(0, qb - 8); tiles = ((2ull << qb) - 1ull) & ~((1ull << lo) - 1ull); }
    else { const unsigned* sm = (const unsigned*)(ws + WS_SELM) + ((size_t)(bk * 4096 + qb * 64)) * 2;
        mlo = sm[tq_loc * 2]; mhi = sm[tq_loc * 2 + 1];
        unsigned ulo = sm[lane * 2], uhi = sm[lane * 2 + 1];
#pragma unroll
        for (int o = 32; o >= 1; o >>= 1) { ulo |= __shfl_xor(ulo, o); uhi |= __shfl_xor(uhi, o); }
        tiles = (((unsigned long long)(unsigned)__builtin_amdgcn_readfirstlane(uhi) << 32) | (unsigned)__builtin_amdgcn_readfirstlane(ulo)) & ((2ull << qb) - 1ull); }
    const int ntile = __popcll(tiles);
    const int skey = tid >> 3, sch = tid & 7;
    const unsigned kst = (unsigned)(skey * 144 + sch * 16), vst = (unsigned)(skey * 128 + ((sch ^ (((skey >> 1) & 1) << 2)) * 16));
    const int q4 = (lane & 15) >> 2, pp = lane & 3, blk = (lane >> 4) & 1;
    const unsigned vrow = (unsigned)(4 * h + q4);
    unsigned vcol[2];
#pragma unroll
    for (int db = 0; db < 2; ++db) { const int ch = 4 * db + 2 * blk + (pp >> 1); vcol[db] = (unsigned)(((ch ^ (((q4 >> 1) & 1) << 2)) * 16) + (pp & 1) * 8); }
    const unsigned krd = (unsigned)(r * 144 + 16 * h);

    f32x16 oacc[2]; float m_run = NEGBIG, l_run = 0.f;
#pragma unroll
    for (int i = 0; i < 16; ++i) { oacc[0][i] = 0.f; oacc[1][i] = 0.f; }
    float m_fin = 0.f, inv_fin = 0.f;

#define ATTN_STEP(KR, VR, JV, PAR) { const int j = JV; \
            LAS unsigned char* Kl = lds + AT_K + (PAR) * 9216; LAS unsigned char* Vl = lds + AT_V + (PAR) * 8192; \
            *(LAS u32x4*)(Kl + kst) = KR; *(LAS u32x4*)(Vl + vst) = VR; \
            __syncthreads(); \
            { const int j2 = rem ? __ffsll((long long)rem) - 1 : JV; rem &= rem - 1ull; JV = j2; \
              KR = *(const u32x4*)(Kg + (size_t)(j2 * 64 + skey) * 64 + sch * 8); VR = *(const u32x4*)(Vg + (size_t)(j2 * 64 + skey) * 64 + sch * 8); } \
            ATTN_BODY }
#define ATTN_PASS(PASSC) { constexpr int pass = (PASSC); \
        if (MODE == 0 && pass == 1) {                                    \
            LAS float* imp = (LAS float*)(lds + AT_IMP); \
            for (int i = tid; i < 4 * 64 * 68; i += 512) imp[i] = 0.f; \
        } \
        __syncthreads();                                                 \
         \
        unsigned long long rem = tiles; int jA = __ffsll((long long)rem) - 1; rem &= rem - 1ull; int jB = rem ? __ffsll((long long)rem) - 1 : jA; rem &= rem - 1ull; \
        u32x4 kregA = *(const u32x4*)(Kg + (size_t)(jA * 64 + skey) * 64 + sch * 8), vregA = *(const u32x4*)(Vg + (size_t)(jA * 64 + skey) * 64 + sch * 8); \
        u32x4 kregB = *(const u32x4*)(Kg + (size_t)(jB * 64 + skey) * 64 + sch * 8), vregB = *(const u32x4*)(Vg + (size_t)(jB * 64 + skey) * 64 + sch * 8); \
        if constexpr (true) { rem = tiles & (tiles - 1ull);           \
            for (int it = 0; it < ntile; ++it) ATTN_STEP(kregA, vregA, jA, (it & 1)) \
        } else { \
            for (int it = 0; it < ntile; it += 2) { \
                ATTN_STEP(kregA, vregA, jA, 0) \
                if (it + 1 < ntile) ATTN_STEP(kregB, vregB, jB, 1) \
            } \
        } \
        if (pass == 0) { \
            const float lt = xor32_add(l_run); const bool live = m_run > -1e29f; const float inv = live ? 1.f / lt : 0.f; \
            m_fin = live ? m_run : 0.f; inv_fin = inv; \
             \
            int tqo = tq; asm volatile("" : "+v"(tqo)); \
            bf16_t* og = (bf16_t*)(ws + (MODE == 0 ? WS_OC : (MODE == 2 ? WS_OW : WS_OATT))) + ((size_t)(b * 4096 + tqo)) * 1024 + hd * 64; \
            float g0 = 0.f, g1 = 1.f, g2 = 0.f; const bf16_t *oc = nullptr, *ow = nullptr; \
            if (MODE == 1) { const float* gp = (const float*)(ws + WS_GATE) + (size_t)(b * 4096 + tqo) * 48 + hd * 3; g0 = gp[0]; g1 = gp[1]; g2 = gp[2]; \
                oc = (const bf16_t*)(ws + WS_OC) + ((size_t)(b * 4096 + tqo)) * 1024 + hd * 64; ow = (const bf16_t*)(ws + WS_OW) + ((size_t)(b * 4096 + tqo)) * 1024 + hd * 64; } \
_Pragma("unroll") \
            for (int db = 0; db < 2; ++db) \
_Pragma("unroll") \
                for (int a = 0; a < 4; ++a) { const int d0 = 32 * db + 8 * a + 4 * h; float v[4]; \
_Pragma("unroll") \
                    for (int e = 0; e < 4; ++e) v[e] = oacc[db][4 * a + e] * inv; \
                    if (MODE == 1) { const u32x2 c2 = *(const u32x2*)(oc + d0), w2 = *(const u32x2*)(ow + d0); \
                        v[0] = g1 * v[0] + g0 * bf_lo(c2[0]) + g2 * bf_lo(w2[0]); v[1] = g1 * v[1] + g0 * bf_hi(c2[0]) + g2 * bf_hi(w2[0]); \
                        v[2] = g1 * v[2] + g0 * bf_lo(c2[1]) + g2 * bf_lo(w2[1]); v[3] = g1 * v[3] + g0 * bf_hi(c2[1]) + g2 * bf_hi(w2[1]); } \
                    if (MODE == 1) { int p8 = __builtin_amdgcn_cvt_pk_fp8_f32(clamp448(v[0] * OATT_SCALE), clamp448(v[1] * OATT_SCALE), 0, false); p8 = __builtin_amdgcn_cvt_pk_fp8_f32(clamp448(v[2] * OATT_SCALE), clamp448(v[3] * OATT_SCALE), p8, true); \
                        *(int*)((unsigned char*)(ws + WS_OATT) + ((size_t)(b * 4096 + tqo)) * UA_LD + hd * 64 + d0) = p8; } \
                    else { u32x2 w; w[0] = pk_bf16(v[0], v[1]); w[1] = pk_bf16(v[2], v[3]); *(u32x2*)(og + d0) = w; } } \
        } \
     }
    ATTN_PASS(0)
    if constexpr (MODE == 0) ATTN_PASS(1)
#undef ATTN_PASS
#undef ATTN_STEP
    if (MODE == 0) {
        __syncthreads();
        const LAS float* imp = (const LAS float*)(lds + AT_IMP); unsigned* sm = (unsigned*)(ws + WS_SELM) + ((size_t)(bk * 4096 + qb * 64)) * 2;
        const int cur = qb;
        for (int tk = 0; tk < 8; ++tk) { const int tok = wave * 8 + tk, jb = lane;
            const float v = imp[(0 * 64 + tok) * 68 + jb] + imp[(1 * 64 + tok) * 68 + jb] + imp[(2 * 64 + tok) * 68 + jb] + imp[(3 * 64 + tok) * 68 + jb];
            const bool valid = jb <= cur, forced = valid && (jb == 0 || jb == cur || jb == cur - 1);
            bool sel = forced;
            if (cur <= 15) sel = valid;
            else { unsigned key = (valid && !forced) ? ((__float_as_uint(fmaxf(v, 0.f)) & ~63u) | (unsigned)(63 - jb)) : 0u;
                for (int rd = 0; rd < 13; ++rd) { const unsigned w = wave_max_u32(key); const int win = 63 - (int)(w & 63u); if (jb == win && w != 0u) { sel = true; key = 0u; } } }
            const unsigned long long bal = __ballot(sel);
            if (lane == 0) { sm[tok * 2] = (unsigned)bal; sm[tok * 2 + 1] = (unsigned)(bal >> 32); } }
    }
}

constexpr float AT_THR = 6.f;
#define AP_QK(S, Kl_, C_) { const f32x16 z16_ = {0.f, 0.f, 0.f, 0.f, 0.f, 0.f, 0.f, 0.f, 0.f, 0.f, 0.f, 0.f, 0.f, 0.f, 0.f, 0.f}; _Pragma("unroll") for (int kb = 0; kb < 2; ++kb) { S[kb] = MFMA32(kones, C_, z16_);        \
        _Pragma("unroll") for (int s = 0; s < 4; ++s) { const bf16x8 kf = *(const LAS bf16x8*)((Kl_) + krd + kb * 32 * 144 + s * 32); S[kb] = MFMA32(kf, qf[s], S[kb]); } } }
#define AP_CSEL(C_, jt) bf16x8 C_; { const int j_ = (jt); const bool lsel_ = (MODE != 1) || (((j_ < 32 ? (mlo >> j_) : (mhi >> (j_ - 32))) & 1u) != 0u); const bool near_ = (qb - j_ <= 2) || (MODE == 2 && j_ == qb - 8); \
        const float cs_ = (lsel_ || near_) ? cref : NEGBIG; u32x4 cw_ = {0u, 0u, 0u, 0u}; cw_[0] = (h == 0) ? (__float_as_uint(cs_) >> 16) : 0u; C_ = __builtin_bit_cast(bf16x8, cw_); }
#define AP_NEAR(S, jt) { const int j_ = (jt); const bool near_ = (qb - j_ <= 2) || (MODE == 2 && j_ == qb - 8); \
        if (near_) { const bool lsel_ = (MODE != 1) || (((j_ < 32 ? (mlo >> j_) : (mhi >> (j_ - 32))) & 1u) != 0u); const int dq = tq - 64 * j_; \
            _Pragma("unroll") for (int kb = 0; kb < 2; ++kb) _Pragma("unroll") for (int i = 0; i < 16; ++i) { const int kl = 32 * kb + (i & 3) + 8 * (i >> 2) + 4 * h; const int dist = dq - kl; \
                bool ok = (dist >= 0) && lsel_; if (MODE == 2) ok = ok && (dist < 512); \
                S[kb][i] = (S[kb][i] + (tb[min(max(dist, 0), 127)] - farb)) + (ok ? 0.f : NEGBIG); } } }
#define AP_STEP(SC, SN, PAR, HASNEXT) { \
        LAS unsigned char* Kn = lds + AT_K + ((PAR) ^ 1) * 9216; LAS unsigned char* Vc = lds + AT_V + (PAR) * 8192; \
        *(LAS u32x4*)(Kn + kst) = kreg; *(LAS u32x4*)(Vc + vst) = vreg; \
        __syncthreads(); \
        { vreg = *(const u32x4*)(Vg + (size_t)(jn * 64 + skey) * 64 + sch * 8); kreg = *(const u32x4*)(Kg + (size_t)(jnn * 64 + skey) * 64 + sch * 8); } \
        const bool hn_ = (HASNEXT); \
        float mx = fmaxf(fmaxf(SC[0][0], SC[0][1]), SC[1][0]); \
        _Pragma("unroll") for (int kb = 0; kb < 2; ++kb) _Pragma("unroll") for (int i = 0; i < 16; i += 2) mx = fmaxf(fmaxf(mx, SC[kb][i]), SC[kb][i + 1]); \
        mx = xor32_max(mx); \
        if (__any(mx > AT_THR || (mx < -24.f && mx > -1e29f))) {         \
            const float dw = (mx > -1e29f) ? mx : 0.f, cnew = __uint_as_float(pk_bf16(cref - dw, 0.f) << 16), dl = cref - cnew, alpha = __builtin_amdgcn_exp2f(-dl); cref = cnew; m_run += dl; l_run *= alpha;        \
            _Pragma("unroll") for (int i = 0; i < 16; ++i) { oacc[0][i] *= alpha; oacc[1][i] *= alpha; SC[0][i] -= dl; SC[1][i] -= dl; } } \
        AP_CSEL(cn_, jn) \
        AP_QK(SN, Kn, cn_)        \
        float ls0 = 0.f, ls1 = 0.f; \
        _Pragma("unroll") for (int kb = 0; kb < 2; ++kb) _Pragma("unroll") for (int i = 0; i < 16; i += 2) { const float p0 = __builtin_amdgcn_exp2f(SC[kb][i]), p1 = __builtin_amdgcn_exp2f(SC[kb][i + 1]); SC[kb][i] = p0; SC[kb][i + 1] = p1; ls0 += p0; ls1 += p1; } \
        l_run += ls0 + ls1; \
        _Pragma("unroll") for (int kb = 0; kb < 2; ++kb) _Pragma("unroll") for (int s2 = 0; s2 < 2; ++s2) { u32x4 w; \
            _Pragma("unroll") for (int e = 0; e < 4; ++e) w[e] = pk_bf16(SC[kb][8 * s2 + 2 * e], SC[kb][8 * s2 + 2 * e + 1]); \
            const bf16x8 pf = __builtin_bit_cast(bf16x8, w); \
            _Pragma("unroll") for (int db = 0; db < 2; ++db) { const unsigned a0 = (unsigned)(32 * kb + 16 * s2) * 128u + vrow * 128u + vcol[db]; \
                const s16x4 lo = __builtin_amdgcn_ds_read_tr16_b64_v4i16((LAS s16x4*)(Vc + a0)), hi = __builtin_amdgcn_ds_read_tr16_b64_v4i16((LAS s16x4*)(Vc + a0 + 8 * 128)); \
                oacc[db] = MFMA32(__builtin_shufflevector(lo, hi, 0, 1, 2, 3, 4, 5, 6, 7), pf, oacc[db]); } } \
        if (hn_) AP_NEAR(SN, jn) \
        jn = jnn; jnn = rem ? __ffsll((long long)rem) - 1 : jnn; rem &= rem - 1ull; }

template <int MODE> DI void attn_unit_pipe(const Params& P, LAS unsigned char* lds, int b, int k, int qb) {
    unsigned char* ws = P.ws;
    const int tid = threadIdx.x, lane = tid & 63, wave = __builtin_amdgcn_readfirstlane(tid >> 6);
    const int g = wave >> 1, th = wave & 1, r = lane & 31, h = lane >> 5;
    const int tq_loc = th * 32 + r, tq = qb * 64 + tq_loc, hd = k * 4 + g, bk = b * 4 + k;
    const LAS float* tb = (const LAS float*)(lds + AT_TB) + hd * 128;
    const float farb = tb[127];
    bf16x8 qf[4];
    { const bf16_t* qg = (const bf16_t*)(ws + WS_Q) + ((size_t)(b * 4096 + tq)) * 1024 + hd * 64 + 8 * h;
#pragma unroll
      for (int s = 0; s < 4; ++s) qf[s] = *(const bf16x8*)(qg + 16 * s); }
    const bf16_t* Kg = (const bf16_t*)(ws + WS_KV) + (size_t)(MODE == 1 ? 2 : 4) * 4194304 + (size_t)bk * 4096 * 64; const bf16_t* Vg = Kg + 4194304;
    unsigned long long tiles; unsigned mlo = 0u, mhi = 0u;
    if (MODE == 2) { const int lo = max(0, qb - 8); tiles = ((2ull << qb) - 1ull) & ~((1ull << lo) - 1ull); }
    else { const unsigned* sm = (const unsigned*)(ws + WS_SELM) + ((size_t)(bk * 4096 + qb * 64)) * 2;
        mlo = sm[tq_loc * 2]; mhi = sm[tq_loc * 2 + 1];
        unsigned ulo = sm[lane * 2], uhi = sm[lane * 2 + 1];
#pragma unroll
        for (int o = 32; o >= 1; o >>= 1) { ulo |= __shfl_xor(ulo, o); uhi |= __shfl_xor(uhi, o); }
        tiles = (((unsigned long long)(unsigned)__builtin_amdgcn_readfirstlane(uhi) << 32) | (unsigned)__builtin_amdgcn_readfirstlane(ulo)) & ((2ull << qb) - 1ull); }
    const int ntile = __popcll(tiles);
    const int skey = tid >> 3, sch = tid & 7;
    const unsigned kst = (unsigned)(skey * 144 + sch * 16), vst = (unsigned)(skey * 128 + ((sch ^ (((skey >> 1) & 1) << 2)) * 16));
    const int q4 = (lane & 15) >> 2, pp = lane & 3, blk = (lane >> 4) & 1;
    const unsigned vrow = (unsigned)(4 * h + q4);
    unsigned vcol[2];
#pragma unroll
    for (int db = 0; db < 2; ++db) { const int ch = 4 * db + 2 * blk + (pp >> 1); vcol[db] = (unsigned)(((ch ^ (((q4 >> 1) & 1) << 2)) * 16) + (pp & 1) * 8); }
    const unsigned krd = (unsigned)(r * 144 + 16 * h);
    f32x16 oacc[2], sA[2], sB[2]; float m_run = 0.f, l_run = 0.f;
    float cref = __uint_as_float(pk_bf16(farb, 0.f) << 16);
    bf16x8 kones; { u32x4 kw_ = {0u, 0u, 0u, 0u}; kw_[0] = (h == 0) ? 0x3F80u : 0u; kones = __builtin_bit_cast(bf16x8, kw_); }
#pragma unroll
    for (int i = 0; i < 16; ++i) { oacc[0][i] = 0.f; oacc[1][i] = 0.f; }
    unsigned long long rem = tiles; const int jc = __ffsll((long long)rem) - 1; rem &= rem - 1ull;
    int jn = rem ? __ffsll((long long)rem) - 1 : jc; rem &= rem - 1ull; int jnn = rem ? __ffsll((long long)rem) - 1 : jn; rem &= rem - 1ull;
    u32x4 kreg = *(const u32x4*)(Kg + (size_t)(jc * 64 + skey) * 64 + sch * 8), vreg = *(const u32x4*)(Vg + (size_t)(jc * 64 + skey) * 64 + sch * 8);
    __syncthreads();
    *(LAS u32x4*)(lds + AT_K + kst) = kreg;
    kreg = *(const u32x4*)(Kg + (size_t)(jn * 64 + skey) * 64 + sch * 8);
    __syncthreads();
    { AP_CSEL(c0_, jc) AP_QK(sA, lds + AT_K, c0_) AP_NEAR(sA, jc) }
    for (int it = 0; it < ntile; it += 2) {
        AP_STEP(sA, sB, 0, it + 1 < ntile)
        if (it + 1 < ntile) AP_STEP(sB, sA, 1, it + 2 < ntile)
    }
    const float lt = xor32_add(l_run); const float inv = lt > 0.f ? 1.f / lt : 0.f;
    int tqo = tq; asm volatile("" : "+v"(tqo));
    float g0 = 0.f, g1 = 1.f, g2 = 0.f; const bf16_t *oc = nullptr, *ow = nullptr;
    if (MODE == 1) { const float* gp = (const float*)(ws + WS_GATE) + (size_t)(b * 4096 + tqo) * 48 + hd * 3; g0 = gp[0]; g1 = gp[1]; g2 = gp[2];
        oc = (const bf16_t*)(ws + WS_OC) + ((size_t)(b * 4096 + tqo)) * 1024 + hd * 64; ow = (const bf16_t*)(ws + WS_OW) + ((size_t)(b * 4096 + tqo)) * 1024 + hd * 64; }
#pragma unroll
    for (int db = 0; db < 2; ++db)
#pragma unroll
        for (int a = 0; a < 4; ++a) { const int d0 = 32 * db + 8 * a + 4 * h; float v[4];
#pragma unroll
            for (int e = 0; e < 4; ++e) v[e] = oacc[db][4 * a + e] * inv;
            if (MODE == 1) { const u32x2 c2 = *(const u32x2*)(oc + d0), w2 = *(const u32x2*)(ow + d0);
                v[0] = g1 * v[0] + g0 * bf_lo(c2[0]) + g2 * bf_lo(w2[0]); v[1] = g1 * v[1] + g0 * bf_hi(c2[0]) + g2 * bf_hi(w2[0]);
                v[2] = g1 * v[2] + g0 * bf_lo(c2[1]) + g2 * bf_lo(w2[1]); v[3] = g1 * v[3] + g0 * bf_hi(c2[1]) + g2 * bf_hi(w2[1]);
                int p8 = __builtin_amdgcn_cvt_pk_fp8_f32(clamp448(v[0] * OATT_SCALE), clamp448(v[1] * OATT_SCALE), 0, false); p8 = __builtin_amdgcn_cvt_pk_fp8_f32(clamp448(v[2] * OATT_SCALE), clamp448(v[3] * OATT_SCALE), p8, true);
                *(int*)((unsigned char*)(ws + WS_OATT) + ((size_t)(b * 4096 + tqo)) * UA_LD + hd * 64 + d0) = p8; }
            else { u32x2 w; w[0] = pk_bf16(v[0], v[1]); w[1] = pk_bf16(v[2], v[3]); *(u32x2*)((bf16_t*)(ws + WS_OW) + ((size_t)(b * 4096 + tqo)) * 1024 + hd * 64 + d0) = w; } }
}
#undef AP_STEP
#undef AP_NEAR
#undef AP_CSEL
#undef AP_QK

DI void phase_attn_win_early(const Params& P, LAS unsigned char* lds) {
    if (gridDim.x != 256) return;
    const int bx = blockIdx.x; if (bx >= 128 && bx < 160) return;
    attn_setup_tables(P, lds);
    const int nb = bx < 128 ? bx : bx - 32;
    for (int u = nb; u < 672; u += 224) { const int qb = u >> 4, bk = u & 15; attn_unit_pipe<2>(P, lds, bk >> 2, bk & 3, qb); }
}
DI void phase_attn_win_p4(const Params& P, LAS unsigned char* lds) {
    if (gridDim.x != 256 || blockIdx.x >= 96) return;
    __syncthreads();
    attn_setup_tables(P, lds);
    const int u = 672 + blockIdx.x, qb = u >> 4, bk = u & 15; attn_unit_pipe<2>(P, lds, bk >> 2, bk & 3, qb);
}
DI void phase_attn_cmp_win(const Params& P, LAS unsigned char* lds) {
    attn_setup_tables(P, lds);
    for (int u = blockIdx.x; u < 1024; u += gridDim.x) { const int qb = 63 - (u >> 4), bk = u & 15; attn_unit<0>(P, lds, bk >> 2, bk & 3, qb); }
    for (int u = (gridDim.x == 256 ? 768 : 0) + blockIdx.x; u < 1024; u += gridDim.x) { const int qb = u >> 4, bk = u & 15; attn_unit_pipe<2>(P, lds, bk >> 2, bk & 3, qb); }
}
DI void phase_attn_sel(const Params& P, LAS unsigned char* lds) {
    attn_setup_tables(P, lds);
    for (int pr = blockIdx.x; pr < 512; pr += gridDim.x) { const int bk = pr >> 5, qp = pr & 31;
        attn_unit_pipe<1>(P, lds, bk >> 2, bk & 3, 63 - qp); attn_unit_pipe<1>(P, lds, bk >> 2, bk & 3, qp); }
}

DI unsigned row_max_u32(unsigned v) {
    asm volatile("s_nop 1\n\tv_max_u32_dpp %0, %0, %0 quad_perm:[1,0,3,2] row_mask:0xf bank_mask:0xf\n\ts_nop 1\n\tv_max_u32_dpp %0, %0, %0 quad_perm:[2,3,0,1] row_mask:0xf bank_mask:0xf\n\t"
                 "s_nop 1\n\tv_max_u32_dpp %0, %0, %0 row_half_mirror row_mask:0xf bank_mask:0xf\n\ts_nop 1\n\tv_max_u32_dpp %0, %0, %0 row_mirror row_mask:0xf bank_mask:0xf\n\ts_nop 1" : "+v"(v));
    return v; }
DI float row_max_f32(float v) {
    asm volatile("s_nop 1\n\tv_max_f32_dpp %0, %0, %0 quad_perm:[1,0,3,2] row_mask:0xf bank_mask:0xf\n\ts_nop 1\n\tv_max_f32_dpp %0, %0, %0 quad_perm:[2,3,0,1] row_mask:0xf bank_mask:0xf\n\t"
                 "s_nop 1\n\tv_max_f32_dpp %0, %0, %0 row_half_mirror row_mask:0xf bank_mask:0xf\n\ts_nop 1\n\tv_max_f32_dpp %0, %0, %0 row_mirror row_mask:0xf bank_mask:0xf\n\ts_nop 1" : "+v"(v));
    return v; }
DI float row_sum_f32(float v) {
    asm volatile("s_nop 1\n\tv_add_f32_dpp %0, %0, %0 quad_perm:[1,0,3,2] row_mask:0xf bank_mask:0xf\n\ts_nop 1\n\tv_add_f32_dpp %0, %0, %0 quad_perm:[2,3,0,1] row_mask:0xf bank_mask:0xf\n\t"
                 "s_nop 1\n\tv_add_f32_dpp %0, %0, %0 row_half_mirror row_mask:0xf bank_mask:0xf\n\ts_nop 1\n\tv_add_f32_dpp %0, %0, %0 row_mirror row_mask:0xf bank_mask:0xf\n\ts_nop 1" : "+v"(v));
    return v; }
DI float demono_f32(unsigned u) { return __uint_as_float((u & 0x80000000u) ? (u ^ 0x80000000u) : ~u); }

#define PK_CE(x, y) do { const unsigned hi_ = max(x, y), lo_ = min(x, y); x = hi_; y = lo_; } while (0)
DI void peer_stage1(const u32x4& sh, int li, LAS float* vsr, LAS int* nsr) {
    unsigned s[8];
#pragma unroll
    for (int e = 0; e < 8; ++e) { const unsigned hb = (e & 1) ? (sh[e >> 1] & 0xFFFF0000u) : (sh[e >> 1] << 16);
        s[e] = ((hb ^ (((int)hb >> 31) | 0x80000000u)) & 0xFFFF0000u) | (unsigned)(127 - (8 * li + e)); }
    PK_CE(s[0], s[1]); PK_CE(s[2], s[3]); PK_CE(s[4], s[5]); PK_CE(s[6], s[7]); PK_CE(s[0], s[2]); PK_CE(s[1], s[3]); PK_CE(s[4], s[6]); PK_CE(s[5], s[7]); PK_CE(s[1], s[2]); PK_CE(s[5], s[6]);
    PK_CE(s[0], s[4]); PK_CE(s[1], s[5]); PK_CE(s[2], s[6]); PK_CE(s[3], s[7]); PK_CE(s[2], s[4]); PK_CE(s[3], s[5]); PK_CE(s[1], s[2]); PK_CE(s[3], s[4]); PK_CE(s[5], s[6]);
    unsigned win = 0u;
    for (int rd = 0; rd < 16; ++rd) {
        const unsigned m = row_max_u32(s[0]); const bool w = s[0] == m;
#pragma unroll
        for (int i = 0; i < 7; ++i) s[i] = w ? s[i + 1] : s[i];
        s[7] = w ? 0u : s[7];
        if (li == rd) win = m; }
    { const unsigned u = win & 0xFFFF0000u, hb = (u & 0x80000000u) ? (u ^ 0x80000000u) : (~u & 0xFFFF0000u);
      vsr[li] = (float)__builtin_bit_cast(_Float16, (unsigned short)(hb >> 16)); nsr[li] = 127 - (int)(win & 127u); }
}
DI void conv_row_store(const Params& P, int crow, int lane, const f32x4 (&v)[8]) {
    unsigned char* ws = P.ws; float am = 0.f;
#pragma unroll
    for (int k8 = 0; k8 < 8; ++k8) am = fmaxf(am, fmaxf(fmaxf(fabsf(v[k8][0]), fabsf(v[k8][1])), fmaxf(fabsf(v[k8][2]), fabsf(v[k8][3]))));
    am = __uint_as_float(wave_max_u32(__float_as_uint(am)));
    unsigned char* dst = ws + WS_PU + (size_t)(crow >> 14) * 33554432 + (size_t)(crow & 16383) * 256 + lane * 4;
    const float sc = am > 0.f ? 127.f / am : 1.f;
#pragma unroll
    for (int k8 = 0; k8 < 8; ++k8) { unsigned pk = 0u;
#pragma unroll
        for (int e = 0; e < 4; ++e) pk = __builtin_amdgcn_cvt_pk_u8_f32(__builtin_rintf(v[k8][e] * sc) + 128.f, e, pk);
        *(unsigned*)(dst + (size_t)k8 * 4194304) = pk ^ 0x80808080u; }
    if (lane == 0) ((float*)(ws + WS_PSU))[crow] = am > 0.f ? am / 127.f : 1.f;
}
DI void phase_peer(const Params& P, LAS unsigned char* lds) {
    unsigned char* ws = P.ws; const int lane = threadIdx.x & 63, wave = __builtin_amdgcn_readfirstlane(threadIdx.x >> 6), rw = lane >> 4, li = lane & 15;
    const unsigned short* SC = (const unsigned short*)(ws + WS_SC);
    LAS unsigned char* ptab = lds + 8192;
    LAS float* vs = (LAS float*)(lds + wave * 1024); LAS int* ns = (LAS int*)(lds + wave * 1024 + 512);
    __syncthreads();
    if (threadIdx.x == 0) { int q = 0; for (int a = 0; a < 16; ++a) for (int b = 0; b < 16 / (a + 1); ++b) ptab[q++] = (unsigned char)(a * 16 + b); for (; q < 64; ++q) ptab[q] = 0; }
    __syncthreads();
    int abq[4];
#pragma unroll
    for (int j = 0; j < 4; ++j) abq[j] = ptab[li + 16 * j];
    const int w0 = blockIdx.x * 8 + wave, wstep = gridDim.x * 8;
    const int nit = ((NT - w0 + wstep - 1) / wstep) * 2;
    int crow = w0;
    const unsigned short* sp0 = SC + (size_t)w0 * 2048 + rw * 128 + li * 8;
    u32x4 sa = *(const u32x4*)sp0, sc_ = *(const u32x4*)(sp0 + 512);
    for (int it = 0; it < nit; ++it) {
        const int t = w0 + (it >> 1) * wstep, bp = it & 1;
        const int itn = it + 1 < nit ? it + 1 : it; const unsigned short* spn = SC + (size_t)(w0 + (itn >> 1) * wstep) * 2048 + ((itn & 1) * 8 + rw) * 128 + li * 8;
        const u32x4 na = *(const u32x4*)spn, nc = *(const u32x4*)(spn + 512);
        asm volatile("" : "+v"(sa), "+v"(sc_));
        const bool cv = crow < 32768;
        f32x4 v[8];
        if (cv) { const float* sr = (crow < 16384 ? P.peer_u : P.peer_v) + (size_t)(crow & 16383) * 2048 + lane * 4;
#pragma unroll
            for (int k = 0; k < 8; ++k) v[k] = *(const f32x4*)(sr + k * 256); }
        peer_stage1(sa, li, vs + rw * 16, ns + rw * 16);
        peer_stage1(sc_, li, vs + 64 + rw * 16, ns + 64 + rw * 16);
        const LAS float* v1 = vs + rw * 32; const LAS float* v2 = v1 + 16;
        unsigned k[4];
#pragma unroll
        for (int j = 0; j < 4; ++j) { const int q = li + 16 * j; const float c = v1[abq[j] >> 4] + v2[abq[j] & 15]; k[j] = (q < 50) ? ((mono_u32(c) & ~63u) | (unsigned)(63 - q)) : 0u; }
        PK_CE(k[0], k[1]); PK_CE(k[2], k[3]); PK_CE(k[0], k[2]); PK_CE(k[1], k[3]); PK_CE(k[1], k[2]);
        unsigned w2 = 0u;
        for (int rd = 0; rd < 16; ++rd) {
            const unsigned m = row_max_u32(k[0]); const bool w = k[0] == m;
            k[0] = w ? k[1] : k[0]; k[1] = w ? k[2] : k[1]; k[2] = w ? k[3] : k[2]; k[3] = w ? 0u : k[3];
            if (li == rd) w2 = m; }
        {
            const int ab = ptab[63 - (int)(w2 & 63u)], a = ab >> 4, b = ab & 15;
            const float tsv = v1[a] + v2[b]; const int ee = ns[rw * 32 + a] * 128 + ns[rw * 32 + 16 + b];
            const float mx = row_max_f32(tsv), ex = __expf(tsv - mx), sm = row16_sum(ex);
            const int slot = (4 * bp + rw) * 16 + li;
            ((int*)(ws + WS_EX))[(size_t)t * 128 + slot] = ee; ((float*)(ws + WS_GT))[(size_t)t * 128 + slot] = ex / sm; }
        if (cv) { conv_row_store(P, crow, lane, v); crow += wstep; }
        sa = na; sc_ = nc;
    }
    for (; crow < 32768; crow += wstep) { const float* sr = (crow < 16384 ? P.peer_u : P.peer_v) + (size_t)(crow & 16383) * 2048 + lane * 4; f32x4 v[8];
#pragma unroll
        for (int k8 = 0; k8 < 8; ++k8) v[k8] = *(const f32x4*)(sr + k8 * 256);
        conv_row_store(P, crow, lane, v); }
}
#undef PK_CE

DI void peer_slice_map(const Params& P, LAS unsigned char* lds, int& vx, int& rank, int& nrank) {
    volatile LAS unsigned* misc = (volatile LAS unsigned*)(lds + LDS_MISC);
    const unsigned* bar = (const unsigned*)(P.ws + WS_BAR);
    const int xcc = (int)misc[4], rk = (int)misc[5];
    bool ok = true; int mine = 0;
#pragma unroll
    for (int j = 0; j < 16; ++j) { const unsigned c = __hip_atomic_load(bar + XB_XCNT(j), __ATOMIC_RELAXED, __HIP_MEMORY_SCOPE_AGENT); if (j < 8 ? c == 0u : c != 0u) ok = false; if (j == xcc) mine = (int)c; }
    if (ok && (P.ph_hi - P.ph_lo > 1)) { vx = xcc; rank = rk; nrank = mine; }
    else { vx = blockIdx.x & 7; rank = blockIdx.x >> 3; nrank = (gridDim.x + 7 - vx) >> 3; }
}
DI void phase_peer_a(const Params& P, LAS unsigned char* lds) {
    unsigned char* ws = P.ws; const int lane = threadIdx.x & 63, wave = __builtin_amdgcn_readfirstlane(threadIdx.x >> 6); int vx, rank, nrank; peer_slice_map(P, lds, vx, rank, nrank);
    const int gq = lane >> 4, li = lane & 15;
    LAS int* el = (LAS int*)(lds + wave * 1024);
    const unsigned char* PU = ws + WS_PU + (size_t)vx * 4194304; const unsigned li16 = (unsigned)li * 16u; const unsigned char* H8 = ws + WS_H2I8 + vx * 256 + li * 16;
    const float* HS = (const float*)(ws + WS_SU);
    float* PA = (float*)(ws + WS_PA) + (size_t)vx * NT * 128;
    int e0 = 0, e1 = 0; u32x4 hn = {0u, 0u, 0u, 0u}; float hsn = 0.f;
    { const int t0 = rank * 8 + wave; if (t0 < NT) { const int* exg = (const int*)(ws + WS_EX) + (size_t)t0 * 128; e0 = exg[lane]; e1 = exg[64 + lane]; hn = *(const u32x4*)(H8 + (size_t)t0 * 2048); hsn = HS[(size_t)t0 * 8 + vx]; } }
    for (int t = rank * 8 + wave; t < NT; t += nrank * 8) {
        el[lane] = e0; el[64 + lane] = e1;
        const u32x4 hq = hn; const float hs = hsn;
        { const int tn = t + nrank * 8 < NT ? t + nrank * 8 : t; const int* exg = (const int*)(ws + WS_EX) + (size_t)tn * 128; e0 = exg[lane]; e1 = exg[64 + lane]; hn = *(const u32x4*)(H8 + (size_t)tn * 2048); hsn = HS[(size_t)tn * 8 + vx]; }
#pragma unroll
        for (int jb = 0; jb < 32; jb += 8) {
            u32x4 rw[8];
#pragma unroll
            for (int i = 0; i < 8; ++i) { const unsigned ex = (unsigned)el[4 * (jb + i) + gq]; rw[i] = *(const u32x4*)(PU + (ex * 256u + li16)); }
            float pr[8];
#pragma unroll
            for (int i = 0; i < 8; ++i) { int a = 0;
#pragma unroll
                for (int q = 0; q < 4; ++q) a = __builtin_amdgcn_sdot4((int)rw[i][q], (int)hq[q], a, false);
                pr[i] = (float)a; }
            const float tot = reduce8_row16(pr, li);
            if (!(li & 1)) PA[(size_t)t * 128 + gq * 32 + jb + (li >> 1)] = tot * hs;
        }
    }
}
DI float xor16_max(float x) { const auto r = __builtin_amdgcn_permlane16_swap(__float_as_uint(x), __float_as_uint(x), false, false); return fmaxf(__uint_as_float(r[0]), __uint_as_float(r[1])); }
DI void phase_peer_w(const Params& P) {
    unsigned char* ws = P.ws; const float* PA = (const float*)(ws + WS_PA); const float* GT = (const float*)(ws + WS_GT); const int* EX = (const int*)(ws + WS_EX); const float* PS = (const float*)(ws + WS_PSU);
    const int lane = threadIdx.x & 63, wave = __builtin_amdgcn_readfirstlane(threadIdx.x >> 6), d = lane & 31, gq = d >> 3;
    for (int t2 = (blockIdx.x * 8 + wave) * 2; t2 < NT; t2 += gridDim.x * 16) { const int t = t2 + (lane >> 5);
        float w[4], m = 0.f;
        f32x4 a4 = {0.f, 0.f, 0.f, 0.f};
#pragma unroll
        for (int x = 0; x < 8; ++x) a4 += *(const f32x4*)(PA + (size_t)x * NT * 128 + (size_t)t * 128 + gq * 32 + 4 * (d & 7));
#pragma unroll
        for (int k = 0; k < 4; ++k) { const size_t i = (size_t)t * 128 + 16 * (d & 7) + 4 * k + gq;
            const int ee = EX[i];
            w[k] = GT[i] * PS[16384 + ee] * gelu_tanh(a4[k] * PS[ee]); m = fmaxf(m, fabsf(w[k])); }
        m = xor16_max(row_max_f32(m));
        const float qs = m > 0.f ? 127.f / m : 0.f; unsigned pk = 0u;
#pragma unroll
        for (int k = 0; k < 4; ++k) pk = __builtin_amdgcn_cvt_pk_u8_f32(__builtin_rintf(w[k] * qs) + 128.f, k, pk);
        ((unsigned*)(ws + WS_W8))[(size_t)t * 32 + d] = pk ^ 0x80808080u;
        if (d == 0) ((float*)(ws + WS_WT))[t] = m * (1.f / 127.f);
    }
    for (size_t i = (size_t)blockIdx.x * 512 + threadIdx.x; i < (size_t)NT * 8; i += (size_t)gridDim.x * 512) ((unsigned*)(ws + WS_SS))[i] = 0xFFFFFFFFu;
}
DI void peer_b_finish(unsigned* SSN, float* out, int tp, const f32x4& yp, unsigned sv, const f32x4& fg, int d, int lane) {
    while (__builtin_amdgcn_ballot_w64(sv == 0xFFFFFFFFu) != 0ull) { __builtin_amdgcn_s_sleep(1); sv = lane < 8 ? xb_ld(SSN + (size_t)tp * 8 + lane) : 0u; }
    const float tot = __builtin_amdgcn_readfirstlane(row16_sum(__uint_as_float(sv)));
    const float rs = rsqrtf(tot * (1.f / 2048.f) + 1e-6f);
    f32x4 o;
#pragma unroll
    for (int e = 0; e < 4; ++e) o[e] = yp[e] * rs * fg[e];
    *(f32x4*)(out + (size_t)tp * 2048 + d) = o;
}
DI void phase_peer_b(const Params& P, LAS unsigned char* lds) {
    unsigned char* ws = P.ws; const int lane = threadIdx.x & 63, wave = __builtin_amdgcn_readfirstlane(threadIdx.x >> 6); int vx, rank, nrank; peer_slice_map(P, lds, vx, rank, nrank);
    const int gq = lane >> 4, li = lane & 15;
    LAS int* el = (LAS int*)(lds + wave * 1024);
    const unsigned char* PV = ws + WS_PV + (size_t)vx * 4194304; const unsigned li16 = (unsigned)li * 16u;
    const bf16_t* X1 = (const bf16_t*)(ws + WS_X1); const float* mod = (const float*)(ws + WS_MOD);
    const unsigned char* W8 = ws + WS_W8 + gq * 32; const float* WT = (const float*)(ws + WS_WT);
    unsigned* SSN = (unsigned*)(ws + WS_SS);
    const int cq = ((gq & 1) << 1) | (gq >> 1); const int d = vx * 256 + li * 16 + 4 * cq;
    const f32x4 fg = *(const f32x4*)(P.final_g + d);
    f32x4 yA = {0.f, 0.f, 0.f, 0.f}, yB = {0.f, 0.f, 0.f, 0.f}; int tA = -1, tB = -1;
    int e0 = 0, e1 = 0; u32x2 wn[4]; float wtn = 0.f;
#pragma unroll
    for (int j = 0; j < 4; ++j) wn[j] = (u32x2){0u, 0u};
    { const int t0 = rank * 8 + wave; if (t0 < NT) { const int* exg = (const int*)(ws + WS_EX) + (size_t)t0 * 128; e0 = exg[lane]; e1 = exg[64 + lane];
#pragma unroll
        for (int j = 0; j < 4; ++j) wn[j] = *(const u32x2*)(W8 + (size_t)t0 * 128 + 8 * j);
        wtn = WT[t0]; } }
    for (int t = rank * 8 + wave; t < NT; t += nrank * 8) {
        el[lane] = e0; el[64 + lane] = e1;
        u32x2 wq[4];
#pragma unroll
        for (int j = 0; j < 4; ++j) wq[j] = wn[j];
        const float wt = wtn;
        { const int tn = t + nrank * 8 < NT ? t + nrank * 8 : t; const int* exg = (const int*)(ws + WS_EX) + (size_t)tn * 128; e0 = exg[lane]; e1 = exg[64 + lane];
#pragma unroll
          for (int j = 0; j < 4; ++j) wn[j] = *(const u32x2*)(W8 + (size_t)tn * 128 + 8 * j);
          wtn = WT[tn]; }
        const u32x2 xw = *(const u32x2*)(X1 + (size_t)t * 2048 + d); const f32x4 ga = *(const f32x4*)(mod + (t >> 12) * 12288 + 10240 + d);
        int acc[16]; unsigned sv = 0u;
        if (tA >= 0 && lane < 8) sv = xb_ld(SSN + (size_t)tA * 8 + lane);
#pragma unroll
        for (int i = 0; i < 16; ++i) acc[i] = 0;
#pragma unroll
        for (int jb = 0; jb < 32; jb += 8) {
            u32x4 rw[8];
#pragma unroll
            for (int i = 0; i < 8; ++i) { const unsigned ex = (unsigned)el[4 * (jb + i) + gq]; rw[i] = *(const u32x4*)(PV + (ex * 256u + li16)); }
#pragma unroll
            for (int h = 0; h < 2; ++h) { const int w4 = (int)wq[jb >> 3][h];
#pragma unroll
                for (int q = 0; q < 4; ++q) { const unsigned e0 = rw[4 * h][q], e1 = rw[4 * h + 1][q], e2 = rw[4 * h + 2][q], e3 = rw[4 * h + 3][q];
                    const unsigned t0 = __builtin_amdgcn_perm(e1, e0, 0x05010400u), t1 = __builtin_amdgcn_perm(e1, e0, 0x07030602u), t2 = __builtin_amdgcn_perm(e3, e2, 0x05010400u), t3 = __builtin_amdgcn_perm(e3, e2, 0x07030602u);
                    acc[4 * q + 0] = __builtin_amdgcn_sdot4((int)__builtin_amdgcn_perm(t2, t0, 0x05040100u), w4, acc[4 * q + 0], false);
                    acc[4 * q + 1] = __builtin_amdgcn_sdot4((int)__builtin_amdgcn_perm(t2, t0, 0x07060302u), w4, acc[4 * q + 1], false);
                    acc[4 * q + 2] = __builtin_amdgcn_sdot4((int)__builtin_amdgcn_perm(t3, t1, 0x05040100u), w4, acc[4 * q + 2], false);
                    acc[4 * q + 3] = __builtin_amdgcn_sdot4((int)__builtin_amdgcn_perm(t3, t1, 0x07060302u), w4, acc[4 * q + 3], false); } }
        }
        unsigned w8[8]; float o4[4];
#pragma unroll
        for (int k = 0; k < 8; ++k) { const auto r = __builtin_amdgcn_permlane16_swap((unsigned)acc[k], (unsigned)acc[8 + k], false, false); w8[k] = r[0] + r[1]; }
#pragma unroll
        for (int k = 0; k < 4; ++k) { const auto r = __builtin_amdgcn_permlane32_swap(w8[k], w8[4 + k], false, false); o4[k] = (float)(int)(r[0] + r[1]) * wt; }
        const f32x4 xa = {bf_lo(xw[0]), bf_hi(xw[0]), bf_lo(xw[1]), bf_hi(xw[1])};
        f32x4 y; float ss = 0.f;
#pragma unroll
        for (int e = 0; e < 4; ++e) { y[e] = xa[e] + ga[e] * o4[e]; ss += y[e] * y[e]; }
        ss = wave_sum(ss); if (lane == 0) { unsigned sb_ = __float_as_uint(ss); sb_ = sb_ == 0xFFFFFFFFu ? 0x7FC00000u : sb_;
            __hip_atomic_store(SSN + (size_t)t * 8 + vx, sb_, __ATOMIC_RELAXED, __HIP_MEMORY_SCOPE_AGENT); }
        if (tA >= 0) peer_b_finish(SSN, P.out, tA, yA, sv, fg, d, lane);
        tA = tB; yA = yB; tB = t; yB = y;
    }
    if (tA >= 0) peer_b_finish(SSN, P.out, tA, yA, 0xFFFFFFFFu, fg, d, lane);
    if (tB >= 0) peer_b_finish(SSN, P.out, tB, yB, 0xFFFFFFFFu, fg, d, lane);
}


constexpr int N_PHASES = 15;
template <int K> DI void run_phase(const Params& P, LAS unsigned char* lds) {
    unsigned char* ws = P.ws; const int G = gridDim.x, bx = blockIdx.x, tid = threadIdx.x; (void)G; (void)bx; (void)tid;
    if constexpr (K == 0) { p0_prologue(P, lds); }
    if constexpr (K == 1) { phase_norm_f8(P.x, P.norm_mix_g, (const float*)(ws + WS_MOD), 0, 2048, ws + WS_H, (float*)(ws + WS_HSC)); }
    if constexpr (K == 2) {
        { pg8::Gemm g{(const bf16_t*)(ws + WS_H), (const bf16_t*)(ws + WS_WIN), 2048, 2048, 2048}; pg8::StaticOrder S; S.init(NT, NPROJ, G, bx); EpiProj E{ws, (const float*)(ws + WS_HSC)};
          pg8::gemm_phase<EpiProj, pg8::StaticOrder, true>(lds, g, S, E); }
        { pg8::Gemm g{(const bf16_t*)(ws + WS_KBD), (const bf16_t*)(ws + WS_WQ), 2048, 2048, 256, 512}; pg8::StaticOrder S; S.init(2048, 2048, G, (bx + 64) % G); EpiBf16Plain E{(bf16_t*)(ws + WS_WSC), 2048};
          pg8::gemm_phase<EpiBf16Plain, pg8::StaticOrder>(lds, g, S, E); }
    }
    if constexpr (K == 3) {
        { pg8::Gemm g{(const bf16_t*)(ws + WS_A2), (const bf16_t*)(ws + WS_S5B1), 384, 256, 256}; GroupOrder S{256, G, bx, 4}; EpiS5G1 E{(float*)(ws + WS_XL)};
          pg8::gemm_phase<EpiS5G1, GroupOrder>(lds, g, S, E); }
        { pg8::Gemm g{(const bf16_t*)(ws + WS_KV), (const bf16_t*)(ws + WS_WC1), 1024, 2048, 2048}; GroupOrder S{32, G, (bx + 128) % G, 16}; EpiCmp1 E{(bf16_t*)(ws + WS_HID), (const float*)(ws + WS_CB)};
          pg8::gemm_phase<EpiCmp1, GroupOrder>(lds, g, S, E); }
        phase_attn_win_early(P, lds);
    }
    if constexpr (K == 4) {
        phase_scan(P, lds);
        __syncthreads();
        { pg8::Gemm g{(const bf16_t*)(ws + WS_HID), (const bf16_t*)(ws + WS_WC2), 256, 256, 256}; GroupOrder S{32, G, (bx + 128) % G, 16}; EpiCmp2 E{(bf16_t*)(ws + WS_CKV), P.cmp_b2};
          pg8::gemm_phase<EpiCmp2, GroupOrder>(lds, g, S, E); }
        phase_attn_win_p4(P, lds);
    }
    if constexpr (K == 5) {
        { pg8::Gemm g{(const bf16_t*)(ws + WS_A2), (const bf16_t*)(ws + WS_S5B2), 384, 384, 384}; GroupOrder S{256, G, bx, 4}; EpiS5G2 E{(bf16_t*)(ws + WS_YACT), ws + WS_YA8};
          pg8::gemm_phase<EpiS5G2, GroupOrder>(lds, g, S, E); }
        phase_attn_cmp_win(P, lds);
    }
    if constexpr (K == 6) {
        { pg8::Gemm g{(const bf16_t*)(ws + WS_YA8), (const bf16_t*)(ws + WS_WGLU), 1024, 1024, 1024}; pg8::StaticOrder S; S.init(NT, 1024, G, bx); EpiGlu E{(const bf16_t*)(ws + WS_YACT), (bf16_t*)(ws + WS_Y2), P.glu_b};
          pg8::gemm_phase<EpiGlu, pg8::StaticOrder, true>(lds, g, S, E); }
        phase_attn_sel(P, lds);
    }
    if constexpr (K == 7) {
        pg8::Gemm g{(const bf16_t*)(ws + WS_OATT), (const bf16_t*)(ws + WS_WUA), 2048, 2048, 2048}; pg8::StaticOrder S; S.init(NT, 2048, G, bx); EpiUpF E{ws + WS_MG, ws + WS_MIX};
        pg8::gemm_phase<EpiUpF, pg8::StaticOrder, true>(lds, g, S, E);
    }
    if constexpr (K == 8) {
        pg8::Gemm g{(const bf16_t*)(ws + WS_MIX), (const bf16_t*)(ws + WS_WOUT), 2048, 2048, 2048}; pg8::StaticOrder S; S.init(NT, 2048, G, bx); EpiOut E{P.x, (const float*)(ws + WS_MOD), (bf16_t*)(ws + WS_X1)};
        pg8::gemm_phase<EpiOut, pg8::StaticOrder, true>(lds, g, S, E);
    }
    if constexpr (K == 9) {
        phase_norm((const bf16_t*)(ws + WS_X1), P.norm_ffn_g, (const float*)(ws + WS_MOD), 6144, 8192, (bf16_t*)(ws + WS_H2), ws + WS_H2I8, (float*)(ws + WS_SU));
    }
    if constexpr (K == 10) {
        pg8::Gemm g{(const bf16_t*)(ws + WS_H2), (const bf16_t*)(ws + WS_WSC), 2048, 2048, 2048}; pg8::StaticOrder S; S.init(NT, 2048, G, bx); EpiF16Plain E{(unsigned short*)(ws + WS_SC), 2048};
        pg8::gemm_phase<EpiF16Plain, pg8::StaticOrder>(lds, g, S, E);
    }
    if constexpr (K == 11) { phase_peer(P, lds); }
    if constexpr (K == 12) { phase_peer_a(P, lds); }
    if constexpr (K == 13) { phase_peer_w(P); }
    if constexpr (K == 14) { phase_peer_b(P, lds); }
}

__global__ void __launch_bounds__(512, 2) mk_fwd(Params P) {
    extern __shared__ __attribute__((aligned(16))) unsigned char lds_raw[];
    LAS unsigned char* lds = (LAS unsigned char*)lds_raw;
    unsigned char* ws = P.ws;
    const int G = gridDim.x, bx = blockIdx.x, tid = threadIdx.x;
    volatile LAS unsigned* misc = (volatile LAS unsigned*)(lds + LDS_MISC);
    if (tid < 8) misc[tid] = 0u;
    __syncthreads();
    const int lo = P.ph_lo, hi = P.ph_hi;
    XcdBarrier bar; bar.bar = (unsigned*)(ws + WS_BAR); bar.x = 0; bar.st = misc;
    if (hi - lo > 1) bar = xcd_barrier_post((unsigned*)(ws + WS_BAR), misc);
    if (tid == 0) { const unsigned xcc = xb_xcc_id(); misc[4] = xcc; misc[5] = (hi - lo > 1) ? xb_add((unsigned*)(ws + WS_BAR) + 8192 + 64 * (xcc & 15u), 1u) : 0u; }
    __syncthreads();
#define IN(k) (lo <= (k) && (k) < hi)
#define SEAM(k) do { if (IN(k) && IN((k) + 1)) xcd_barrier(bar); } while (0)

    if (IN(0)) run_phase<0>(P, lds);
    SEAM(0);
    if (IN(1)) run_phase<1>(P, lds);
    SEAM(1);
    if (IN(2)) run_phase<2>(P, lds);
    SEAM(2);
    if (IN(3)) run_phase<3>(P, lds);
    SEAM(3);
    if (IN(4)) run_phase<4>(P, lds);
    SEAM(4);
    if (IN(5)) run_phase<5>(P, lds);
    SEAM(5);
    if (IN(6)) run_phase<6>(P, lds);
    SEAM(6);
    if (IN(7)) run_phase<7>(P, lds);
    SEAM(7);
    if (IN(8)) run_phase<8>(P, lds);
    SEAM(8);
    if (IN(9)) run_phase<9>(P, lds);
    SEAM(9);
    if (IN(10)) run_phase<10>(P, lds);
    SEAM(10);
    if (IN(11)) run_phase<11>(P, lds);
    SEAM(11);
    if (IN(12)) run_phase<12>(P, lds);
    SEAM(12);
    if (IN(13)) run_phase<13>(P, lds);
    SEAM(13);
    if (IN(14)) run_phase<14>(P, lds);
#undef IN
#undef SEAM
}

extern "C" void kernel_launch(void* const* d_in, const int* in_sizes, int n_in, void* d_out, int out_size, void* d_ws, size_t ws_size, hipStream_t stream) {
    static int grid = 0;
    if (grid == 0) {
        if (n_in != 31 || ws_size < WS_END) { fprintf(stderr, "kernel_launch: expected 31 inputs and >= %zu bytes of workspace (got %d, %zu)\n", (size_t)WS_END, n_in, ws_size); grid = -1; return; }
        int dev = 0, cus = 0, per_cu = 0;
        if (hipGetDevice(&dev) != hipSuccess || hipDeviceGetAttribute(&cus, hipDeviceAttributeMultiprocessorCount, dev) != hipSuccess) { grid = -1; return; }
        if (hipFuncSetAttribute((const void*)mk_fwd, hipFuncAttributeMaxDynamicSharedMemorySize, LDS_BYTES) != hipSuccess) { fprintf(stderr, "kernel_launch: hipFuncSetAttribute failed\n"); grid = -1; return; }
        if (hipOccupancyMaxActiveBlocksPerMultiprocessor(&per_cu, (const void*)mk_fwd, 512, LDS_BYTES) != hipSuccess || per_cu < 1) { fprintf(stderr, "kernel_launch: occupancy query reports %d blocks per CU\n", per_cu); (void)hipGetLastError(); grid = -1; return; }
        grid = cus;
    }
    if (grid < 0) return;
    (void)hipMemsetAsync((char*)d_ws + WS_BAR, 0, 65536, stream);
    Params p{};
    const float** f = (const float**)&p;
    for (int i = 0; i < 31; ++i) f[i] = (const float*)d_in[i];
    p.out = (float*)d_out; p.ws = (unsigned char*)d_ws;
#if MK_PER_PHASE
    for (int ph = 0; ph < N_PHASES; ++ph) { p.ph_lo = ph; p.ph_hi = ph + 1; hipLaunchKernelGGL(mk_fwd, dim3(grid), dim3(512), LDS_BYTES, stream, p); }
#else
    p.ph_lo = 0; p.ph_hi = N_PHASES; hipLaunchKernelGGL(mk_fwd, dim3(grid), dim3(512), LDS_BYTES, stream, p);
#endif
}
```
